# Optimizing an MI355X kernel written in HIP

```python
import jax, jax.numpy as jnp
from jax import lax
import numpy as np

D_MODEL = 1024
BATCH = 8
SEQ = 2048
DEPTH = 2

D_MIX = D_MODEL
POOL_WINDOWS = (2, 4, 8, 16)
POOL_GROUPS = len(POOL_WINDOWS)
POOL_WIDTH = D_MIX // 4
POOL_CH = POOL_WIDTH // POOL_GROUPS
SG_HEADS = 4
SG_WIDTH = D_MIX // 4
SG_DIM = SG_WIDTH // SG_HEADS
SG_CHUNK = 128
MLA_HEADS = 8
MLA_WIDTH = D_MIX - POOL_WIDTH - SG_WIDTH
V_DIM = MLA_WIDTH // MLA_HEADS
QK_NOPE = 64
QK_ROPE = 32
Q_LORA = D_MODEL // 4
KV_LORA = D_MODEL // 8
ROPE_THETA = 10000.0
Q_BLOCK = 128
ATTN_SCALE = (QK_NOPE + QK_ROPE) ** -0.5
IN_SPLITS = (POOL_WIDTH,
             POOL_WIDTH + SG_WIDTH,
             POOL_WIDTH + 2 * SG_WIDTH,
             POOL_WIDTH + 2 * SG_WIDTH + Q_LORA,
             POOL_WIDTH + 2 * SG_WIDTH + Q_LORA + KV_LORA)
N_IN = POOL_WIDTH + 2 * SG_WIDTH + Q_LORA + KV_LORA + QK_ROPE
N_EXPERTS = 64
TOP_K = 8
N_EXPERT_GROUPS = 8
TOPK_GROUPS = 4
EXPERT_FF = D_MODEL // 4
SHARED_FF = EXPERT_FF
ROUTED_SCALE = 2.5
EXPERT_BLOCK = 128
EPS = 1e-6
MAX_POS_OFFSET = 1024

kernel_name = 'hymba_pool_sgu_mla_moe_adaln'


def _rms_norm(x, gain=None):
    xf = x.astype(jnp.float32)
    y = xf * lax.rsqrt(jnp.mean(xf * xf, axis=-1, keepdims=True) + EPS)
    if gain is not None:
        y = y * gain.astype(jnp.float32)
    return y.astype(x.dtype)


def _ada_norm(x, shift, scale):
    return _rms_norm(x) * (1 + scale) + shift


def _pool_mixer(a, w_pool, pool_scale):
    b, s, _ = a.shape
    af = a.astype(jnp.float32)
    csum = jnp.cumsum(af, axis=1)
    t = jnp.arange(1, s + 1, dtype=jnp.float32)[:, None]
    means = []
    for g, w in enumerate(POOL_WINDOWS):
        cg = csum[..., g * POOL_CH:(g + 1) * POOL_CH]
        lag = jnp.pad(cg, ((0, 0), (w, 0), (0, 0)))[:, :s]
        means.append((cg - lag) / jnp.minimum(t, float(w)))
    d = (jnp.stack(means, axis=2) - af.reshape(b, s, POOL_GROUPS, POOL_CH)).astype(a.dtype)
    y = jnp.einsum('bsgc,gcd->bsgd', d, w_pool).reshape(b, s, POOL_WIDTH)
    return y * pool_scale


def _spatial_gating(u, v, w_spatial, b_spatial):
    b, s, _ = u.shape
    u = jax.nn.gelu(u)
    vf = jax.nn.gelu(v).astype(jnp.float32)
    mu = jnp.mean(vf, axis=-1, keepdims=True)
    var = jnp.mean(jnp.square(vf - mu), axis=-1, keepdims=True)
    vn = ((vf - mu) * lax.rsqrt(var + EPS)).astype(v.dtype)
    vn = vn.reshape(b, s // SG_CHUNK, SG_CHUNK, SG_HEADS, SG_DIM)
    causal = jnp.tril(jnp.ones((SG_CHUNK, SG_CHUNK), w_spatial.dtype))
    mixed = jnp.einsum('htk,bnkhd->bnthd', w_spatial * causal, vn) + b_spatial.T[:, :, None]
    return u * mixed.reshape(b, s, SG_WIDTH)


def _rope(x, cos, sin):
    half = x.shape[-1] // 2
    xf = x.astype(jnp.float32)
    x1, x2 = xf[..., :half], xf[..., half:]
    return jnp.concatenate([x1 * cos - x2 * sin, x2 * cos + x1 * sin], axis=-1).astype(x.dtype)


def _latent_attention(cq, ckv, k_pe, positions, g_q, w_uq, g_kv, w_ukv):
    b, s, _ = cq.shape
    q = (_rms_norm(cq, g_q) @ w_uq).reshape(b, s, MLA_HEADS, QK_NOPE + QK_ROPE)
    kv = (_rms_norm(ckv, g_kv) @ w_ukv).reshape(b, s, MLA_HEADS, QK_NOPE + V_DIM)
    q_nope, q_pe = q[..., :QK_NOPE], q[..., QK_NOPE:]
    k_nope, v = kv[..., :QK_NOPE], kv[..., QK_NOPE:]
    inv_freq = ROPE_THETA ** (-jnp.arange(0, QK_ROPE, 2, dtype=jnp.float32) / QK_ROPE)
    ang = positions.astype(jnp.float32)[..., None] * inv_freq
    cos, sin = jnp.cos(ang), jnp.sin(ang)
    q_pe = _rope(q_pe, cos[:, :, None], sin[:, :, None])
    k_pe = _rope(k_pe, cos, sin)
    outs = []
    for i in range(s // Q_BLOCK):
        q0, k_end = i * Q_BLOCK, (i + 1) * Q_BLOCK
        scores = (jnp.einsum('bqhd,bkhd->bhqk', q_nope[:, q0:k_end], k_nope[:, :k_end])
                  + jnp.einsum('bqhr,bkr->bhqk', q_pe[:, q0:k_end], k_pe[:, :k_end])
                  ).astype(jnp.float32) * ATTN_SCALE
        causal = jnp.arange(k_end)[None, :] <= (q0 + jnp.arange(Q_BLOCK))[:, None]
        probs = jax.nn.softmax(jnp.where(causal, scores, -jnp.inf), axis=-1).astype(v.dtype)
        outs.append(jnp.einsum('bhqk,bkhd->bqhd', probs, v[:, :k_end]))
    return jnp.concatenate(outs, axis=1).reshape(b, s, MLA_WIDTH)


def _token_mixer(h, positions, w_in, w_pool, pool_scale, w_spatial, b_spatial,
                 g_q, w_uq, g_kv, w_ukv, w_out):
    a, u, v, cq, ckv, k_pe = jnp.split(h @ w_in, IN_SPLITS, axis=-1)
    y = jnp.concatenate([
        _pool_mixer(a, w_pool, pool_scale),
        _spatial_gating(u, v, w_spatial, b_spatial),
        _latent_attention(cq, ckv, k_pe, positions, g_q, w_uq, g_kv, w_ukv),
    ], axis=-1)
    return y @ w_out


def _swiglu(x, w_gate, w_up, w_down):
    return (jax.nn.silu(x @ w_gate) * (x @ w_up)) @ w_down


def _route(xf, w_router, router_bias):
    t = xf.shape[0]
    per_group = N_EXPERTS // N_EXPERT_GROUPS
    scores = jax.nn.sigmoid((xf @ w_router).astype(jnp.float32))
    sel = scores + router_bias.astype(jnp.float32)
    group_score = lax.top_k(sel.reshape(t, N_EXPERT_GROUPS, per_group), 2)[0].sum(-1)
    top_groups = lax.top_k(group_score, TOPK_GROUPS)[1]
    group_mask = jax.nn.one_hot(top_groups, N_EXPERT_GROUPS).sum(1) > 0
    sel = jnp.where(jnp.repeat(group_mask, per_group, axis=1), sel, -jnp.inf)
    top_idx = lax.top_k(sel, TOP_K)[1]
    top_w = jnp.take_along_axis(scores, top_idx, axis=-1)
    top_w = top_w / jnp.sum(top_w, axis=-1, keepdims=True) * ROUTED_SCALE
    return top_idx, top_w


def _routed_experts(xf, top_idx, top_w, w_gate, w_up, w_down):
    t, d = xf.shape
    n_assign = t * TOP_K
    flat_e = top_idx.reshape(-1)
    order = jnp.argsort(flat_e)
    e_sorted = flat_e[order]
    tok_sorted = (order // TOP_K).astype(jnp.int32)
    w_sorted = top_w.reshape(-1)[order].astype(xf.dtype)
    counts = jnp.bincount(flat_e, length=N_EXPERTS)
    padded = (counts + EXPERT_BLOCK - 1) // EXPERT_BLOCK * EXPERT_BLOCK
    pad_end = jnp.cumsum(padded)
    pad_start = pad_end - padded
    start = jnp.cumsum(counts) - counts
    dest = pad_start[e_sorted] + jnp.arange(n_assign) - start[e_sorted]
    n_blocks = -(-(n_assign + N_EXPERTS * (EXPERT_BLOCK - 1)) // EXPERT_BLOCK)
    n_rows = n_blocks * EXPERT_BLOCK
    row_tok = jnp.full((n_rows,), t, jnp.int32).at[dest].set(tok_sorted)
    row_w = jnp.zeros((n_rows,), xf.dtype).at[dest].set(w_sorted)
    block_e = jnp.minimum(
        jnp.searchsorted(pad_end, jnp.arange(n_blocks) * EXPERT_BLOCK, side='right'),
        N_EXPERTS - 1)
    x_rows = jnp.concatenate([xf, jnp.zeros((1, d), xf.dtype)], axis=0)[row_tok]
    x_rows = x_rows.reshape(n_blocks, EXPERT_BLOCK, d)

    def expert_block(args):
        xb, e = args
        return _swiglu(xb, w_gate[e], w_up[e], w_down[e])

    y_rows = lax.map(expert_block, (x_rows, block_e)).reshape(n_rows, d)
    return jax.ops.segment_sum(y_rows * row_w[:, None], row_tok, num_segments=t + 1)[:t]


def _moe(h, w_router, router_bias, w_gate, w_up, w_down, ws_gate, ws_up, ws_down):
    b, s, d = h.shape
    xf = h.reshape(b * s, d)
    top_idx, top_w = _route(xf, w_router, router_bias)
    y = _routed_experts(xf, top_idx, top_w, w_gate, w_up, w_down) + _swiglu(xf, ws_gate, ws_up, ws_down)
    return y.reshape(b, s, d)


def setup_inputs(seed: int = 0) -> dict:
    key = jax.random.key(seed)
    ks = jax.random.split(key, 26)
    L = DEPTH
    f32 = jnp.float32

    def nrm(k, shape, fan_in, mult=1.0):
        return jax.random.normal(k, shape, f32) * (mult * fan_in ** -0.5)

    def gain(k, shape):
        return 1.0 + 0.02 * jax.random.normal(k, shape, f32)

    offsets = jax.random.randint(ks[2], (BATCH, 1), 0, MAX_POS_OFFSET, dtype=jnp.int32)
    positions = offsets + jnp.arange(SEQ, dtype=jnp.int32)[None, :]
    return {
        'x': jax.random.normal(ks[0], (BATCH, SEQ, D_MODEL), f32),
        'c': jax.random.normal(ks[1], (BATCH, D_MODEL), f32),
        'positions': positions,
        'w_ada': nrm(ks[3], (L, D_MODEL, 6 * D_MODEL), D_MODEL, 0.5),
        'b_ada': 0.02 * jax.random.normal(ks[4], (L, 6 * D_MODEL), f32),
        'w_in': nrm(ks[5], (L, D_MODEL, N_IN), D_MODEL),
        'w_pool': nrm(ks[6], (L, POOL_GROUPS, POOL_CH, POOL_CH), POOL_CH),
        'pool_scale': gain(ks[7], (L, POOL_WIDTH)),
        'w_spatial': nrm(ks[8], (L, SG_HEADS, SG_CHUNK, SG_CHUNK), SG_CHUNK),
        'b_spatial': gain(ks[9], (L, SG_HEADS, SG_CHUNK)),
        'g_q': gain(ks[10], (L, Q_LORA)),
        'w_uq': nrm(ks[11], (L, Q_LORA, MLA_HEADS * (QK_NOPE + QK_ROPE)), Q_LORA),
        'g_kv': gain(ks[12], (L, KV_LORA)),
        'w_ukv': nrm(ks[13], (L, KV_LORA, MLA_HEADS * (QK_NOPE + V_DIM)), KV_LORA),
        'w_out': nrm(ks[14], (L, D_MIX, D_MODEL), D_MIX),
        'w_router': nrm(ks[15], (L, D_MODEL, N_EXPERTS), D_MODEL),
        'router_bias': 0.01 * jax.random.normal(ks[16], (L, N_EXPERTS), f32),
        'w_gate': nrm(ks[17], (L, N_EXPERTS, D_MODEL, EXPERT_FF), D_MODEL),
        'w_up': nrm(ks[18], (L, N_EXPERTS, D_MODEL, EXPERT_FF), D_MODEL),
        'w_down': nrm(ks[19], (L, N_EXPERTS, EXPERT_FF, D_MODEL), EXPERT_FF),
        'ws_gate': nrm(ks[20], (L, D_MODEL, SHARED_FF), D_MODEL),
        'ws_up': nrm(ks[21], (L, D_MODEL, SHARED_FF), D_MODEL),
        'ws_down': nrm(ks[22], (L, SHARED_FF, D_MODEL), SHARED_FF),
        'final_gain': gain(ks[23], (D_MODEL,)),
    }


def reference(x, c, positions, w_ada, b_ada, w_in, w_pool, pool_scale, w_spatial, b_spatial,
              g_q, w_uq, g_kv, w_ukv, w_out, w_router, router_bias, w_gate, w_up, w_down,
              ws_gate, ws_up, ws_down, final_gain):
    cond = jax.nn.silu(c)
    for l in range(DEPTH):
        mod = (cond @ w_ada[l] + b_ada[l])[:, None, :]
        shift1, scale1, gate1, shift2, scale2, gate2 = jnp.split(mod, 6, axis=-1)
        h = _ada_norm(x, shift1, scale1)
        x = x + gate1 * _token_mixer(h, positions, w_in[l], w_pool[l], pool_scale[l],
                                     w_spatial[l], b_spatial[l], g_q[l], w_uq[l],
                                     g_kv[l], w_ukv[l], w_out[l])
        h = _ada_norm(x, shift2, scale2)
        x = x + gate2 * _moe(h, w_router[l], router_bias[l], w_gate[l], w_up[l], w_down[l],
                             ws_gate[l], ws_up[l], ws_down[l])
    return _rms_norm(x, final_gain)
```

```cpp
#include <hip/hip_runtime.h>
#include <stdint.h>
#include <cstdio>

#define DI __device__ __forceinline__
#define LAS __attribute__((address_space(3)))

typedef unsigned short bf16_t;
typedef short bf16x8 __attribute__((ext_vector_type(8)));
typedef short s16x4 __attribute__((ext_vector_type(4)));
typedef float f32x4 __attribute__((ext_vector_type(4)));
typedef float f32x2 __attribute__((ext_vector_type(2)));
typedef unsigned u32x4 __attribute__((ext_vector_type(4)));
typedef unsigned u32x2 __attribute__((ext_vector_type(2)));
typedef __bf16 bf16x2_t __attribute__((ext_vector_type(2)));

constexpr int T_ = 16384, D_ = 1024, S_ = 2048, NIN = 1184;
constexpr int NTHREADS = 256;
constexpr int SMEM_MAIN = 65536, SMEM_EXTRA = 2048;
constexpr float EPS = 1e-6f;
constexpr int CSTRIDE = 64;
constexpr int LISTCAP = 16384;
constexpr int CONV_ITEMS = 592 + 96 + 64 + 512 + 384 + 24576;

struct P {
  const float *x, *c; const int* pos;
  const float *w_ada, *b_ada, *w_in, *w_pool, *pool_scale, *w_spatial, *b_spatial, *g_q, *w_uq, *g_kv, *w_ukv, *w_out,
      *w_router, *router_bias, *w_gate, *w_up, *w_down, *ws_gate, *ws_up, *ws_down, *final_gain;
  float* out;
  unsigned* bar; int* cnt; float* mod; float* ropec; float* ropes;
  bf16_t *win_t, *wuq_t, *wukv_t, *wout_t, *wsg_t, *wsd_t, *wgu_t, *wd_t;
  bf16_t *h, *proj, *Q, *Kb, *V, *Y, *yrows, *ysh, *act;
  int* list; float* topw;
};

DI unsigned pack2(float lo, float hi) { f32x2 f = {lo, hi}; bf16x2_t b = __builtin_convertvector(f, bf16x2_t); return __builtin_bit_cast(unsigned, b); }
DI float bf2f(unsigned short b) { return __uint_as_float(((unsigned)b) << 16); }
DI float bflo(unsigned u) { return __uint_as_float(u << 16); }
DI float bfhi(unsigned u) { return __uint_as_float(u & 0xffff0000u); }
DI int otid() { int t = threadIdx.x; asm volatile("" : "+v"(t)); return t; }
DI float wsum(float v) { for (int o = 32; o; o >>= 1) v += __shfl_xor(v, o); return v; }
DI float silu_f(float x) { return x / (1.f + __expf(-x)); }
DI float gelu_tanh(float x) { float z = 0.7978845608028654f * (x + 0.044715f * x * x * x); float e = __expf(2.f * z); float t = 1.f - 2.f / (1.f + e); return 0.5f * x * (1.f + t); }

#define XB_TMO      128
#define XB_XCNT(j)  (256  + 64 * (j))
#define XB_XSUB(j)  (1280 + 64 * (j))
#define XB_XGEN(j)  (2304 + 64 * (j))
#define XB_TOP      3328
#define XB_TOPGEN   3392
#define XCD_BAR_WORDS 3456
#define XB_SPIN_CAP (1u << 20)
DI unsigned xb_ld(unsigned* p) { return __hip_atomic_load(p, __ATOMIC_RELAXED, __HIP_MEMORY_SCOPE_AGENT); }
DI unsigned xb_add(unsigned* p, unsigned v) { return __hip_atomic_fetch_add(p, v, __ATOMIC_RELAXED, __HIP_MEMORY_SCOPE_AGENT); }
DI unsigned xb_xcc_id() { return (unsigned)__builtin_amdgcn_s_getreg((3 << 11) | 20) & 0xFu; }
#define XB_SPIN(cond, bar) do { unsigned _sp = 0; while (cond) { __builtin_amdgcn_s_sleep(1); \
    if ((++_sp & 255u) == 0u) { if (xb_ld(&(bar)[XB_TMO])) break; if (_sp > XB_SPIN_CAP) { atomicAdd(&(bar)[XB_TMO], 1u); break; } } } } while (0)
struct XcdBarrier { unsigned* bar; unsigned x; volatile LAS unsigned* st; };
DI XcdBarrier xcd_barrier_post(unsigned* bar, volatile LAS unsigned* st) {
  XcdBarrier b; b.bar = bar; b.x = xb_xcc_id(); b.st = st;
  if (threadIdx.x == 0) (void)xb_add(&bar[XB_XCNT(b.x)], 1u);
  return b;
}
DI void xcd_barrier_complete(unsigned* bar, unsigned x, unsigned& nloc, unsigned& nx) {
  const unsigned G = gridDim.x * gridDim.y * gridDim.z;
  unsigned sum, cnt, mine, sp = 0u;
  for (;;) {
    sum = 0u; cnt = 0u; mine = 0u;
#pragma unroll
    for (unsigned j = 0; j < 16; ++j) { const unsigned c = xb_ld(&bar[XB_XCNT(j)]); sum += c; cnt += (c > 0u) ? 1u : 0u; mine = (j == x) ? c : mine; }
    if (sum == G) break;
    __builtin_amdgcn_s_sleep(1);
    if ((++sp & 255u) == 0u) { if (xb_ld(&bar[XB_TMO])) break; if (sp > XB_SPIN_CAP) { atomicAdd(&bar[XB_TMO], 1u); break; } }
  }
  nloc = mine > 0u ? mine : 1u; nx = cnt > 0u ? cnt : 1u;
}
DI void xcd_barrier(const XcdBarrier& b) {
  asm volatile("s_waitcnt vmcnt(0)" ::: "memory");
  __syncthreads();
  if (threadIdx.x == 0) {
    unsigned* bar = b.bar;
    __builtin_amdgcn_s_waitcnt(0);
    unsigned nloc = b.st[0], nx = b.st[1];
    if (nloc == 0u) { xcd_barrier_complete(bar, b.x, nloc, nx); b.st[0] = nloc; b.st[1] = nx; }
    const unsigned old = xb_add(&bar[XB_XSUB(b.x)], 1u);
    const unsigned gen = old / nloc;
    if (old + 1u == (gen + 1u) * nloc) {
      __builtin_amdgcn_fence(__ATOMIC_RELEASE, "agent");
      asm volatile("s_waitcnt vmcnt(0)" ::: "memory");
      const unsigned og = xb_add(&bar[XB_TOP], 1u);
      const unsigned tg = og / nx;
      if (og + 1u == (tg + 1u) * nx) xb_add(&bar[XB_TOPGEN], 1u);
      else XB_SPIN(xb_ld(&bar[XB_TOPGEN]) == tg, bar);
      __builtin_amdgcn_fence(__ATOMIC_ACQUIRE, "agent");
      xb_add(&bar[XB_XGEN(b.x)], 1u);
      asm volatile("s_waitcnt vmcnt(0)" ::: "memory");
    } else {
      XB_SPIN(xb_ld(&bar[XB_XGEN(b.x)]) == gen, bar);
      __builtin_amdgcn_fence(__ATOMIC_ACQUIRE, "agent");
      asm volatile("s_waitcnt vmcnt(0)" ::: "memory");
    }
  }
  __syncthreads();
}

template <class Epi>
DI void gemm128(unsigned char* smem, const bf16_t* (&ap)[4], const bf16_t* (&bp)[4], int nk, Epi&& epi) {
  const int tid = otid(), lane = tid & 63, w = tid >> 6;
  const int wm = w >> 1, wn = w & 1;
  const int r_s = tid >> 3, c_s = tid & 7;
  const int st_off = r_s * 128 + ((c_s ^ (r_s & 7)) << 4);
  const int fr = lane & 15, fq = lane >> 4;
  const int sw0 = ((0 + fq) ^ (fr & 7)) << 4, sw1 = ((4 + fq) ^ (fr & 7)) << 4;
  const int arow_off = (wm * 64 + fr) * 128, brow_off = 32768 + (wn * 64 + fr) * 128;
  u32x4 ra[4], rb[4];
  f32x4 acc[4][4];
#pragma unroll
  for (int i = 0; i < 4; ++i)
#pragma unroll
    for (int j = 0; j < 4; ++j) acc[i][j] = (f32x4){0.f, 0.f, 0.f, 0.f};
#pragma unroll
  for (int j = 0; j < 4; ++j) { ra[j] = *(const u32x4*)(ap[j]); rb[j] = *(const u32x4*)(bp[j]); }
#pragma unroll
  for (int j = 0; j < 4; ++j) { *(u32x4*)(smem + st_off + j * 4096) = ra[j]; *(u32x4*)(smem + 32768 + st_off + j * 4096) = rb[j]; }
  __syncthreads();
  for (int kt = 0; kt < nk; ++kt) {
    const int cur = (kt & 1) * 16384;
    const bool more = (kt + 1 < nk);
    if (more) {
#pragma unroll
      for (int j = 0; j < 4; ++j) { ra[j] = *(const u32x4*)(ap[j] + (kt + 1) * 64); rb[j] = *(const u32x4*)(bp[j] + (kt + 1) * 64); }
    }
#pragma unroll
    for (int ks = 0; ks < 2; ++ks) {
      const int sw = ks ? sw1 : sw0;
      bf16x8 af[4], bfr[4];
#pragma unroll
      for (int i = 0; i < 4; ++i) af[i] = *(const bf16x8*)(smem + cur + arow_off + i * 2048 + sw);
#pragma unroll
      for (int j = 0; j < 4; ++j) bfr[j] = *(const bf16x8*)(smem + cur + brow_off + j * 2048 + sw);
#pragma unroll
      for (int i = 0; i < 4; ++i)
#pragma unroll
        for (int j = 0; j < 4; ++j) acc[i][j] = __builtin_amdgcn_mfma_f32_16x16x32_bf16(bfr[j], af[i], acc[i][j], 0, 0, 0);
    }
    if (more) {
      const int nxt = 16384 - cur;
#pragma unroll
      for (int j = 0; j < 4; ++j) { *(u32x4*)(smem + nxt + st_off + j * 4096) = ra[j]; *(u32x4*)(smem + 32768 + nxt + st_off + j * 4096) = rb[j]; }
    }
    __syncthreads();
  }
  epi(acc, wm, wn, fr, fq);
}

DI void item_mod(const P& p, unsigned char* smem, int item) {
  const int l = item / 96, cb = item % 96;
  const int tid = otid(), w = tid >> 6, lane = tid & 63;
  float* sc = (float*)smem;
  float* red = (float*)(smem + 32768);
  __syncthreads();
  for (int i = tid; i < 8192; i += NTHREADS) sc[i] = silu_f(p.c[i]);
  __syncthreads();
  const int col = cb * 64 + lane;
  const float* W = p.w_ada + (size_t)l * 1024 * 6144 + col;
  float acc[8];
#pragma unroll
  for (int b = 0; b < 8; ++b) acc[b] = 0.f;
  for (int k = w * 256; k < w * 256 + 256; ++k) {
    const float wv = W[(size_t)k * 6144];
#pragma unroll
    for (int b = 0; b < 8; ++b) acc[b] += sc[b * 1024 + k] * wv;
  }
#pragma unroll
  for (int b = 0; b < 8; ++b) red[(w * 8 + b) * 64 + lane] = acc[b];
  __syncthreads();
  for (int o = tid; o < 512; o += NTHREADS) {
    const int b = o >> 6, cc = o & 63;
    const float v = red[(0 * 8 + b) * 64 + cc] + red[(1 * 8 + b) * 64 + cc] + red[(2 * 8 + b) * 64 + cc] + red[(3 * 8 + b) * 64 + cc];
    p.mod[((size_t)l * 8 + b) * 6144 + cb * 64 + cc] = v + p.b_ada[(size_t)l * 6144 + cb * 64 + cc];
  }
}

DI void conv_tile(unsigned char* smem, const float* src, int ldsrc, int k0, int n0, bf16_t* dst, int lddst, int mode, const float* kscale) {
  float* t = (float*)smem;
  const int tid = otid();
  __syncthreads();
  {
    const int kk = tid >> 3, nq = tid & 7;
#pragma unroll
    for (int hh = 0; hh < 2; ++hh) {
      const int k = kk + 32 * hh;
      const float4 v = *(const float4*)(src + (size_t)(k0 + k) * ldsrc + n0 + nq * 4);
      const float s = kscale ? kscale[k0 + k] : 1.f;
      t[k * 33 + nq * 4 + 0] = v.x * s; t[k * 33 + nq * 4 + 1] = v.y * s; t[k * 33 + nq * 4 + 2] = v.z * s; t[k * 33 + nq * 4 + 3] = v.w * s;
    }
  }
  __syncthreads();
  {
    const int n = tid >> 3, kc = tid & 7;
    u32x4 wv;
    wv.x = pack2(t[(kc * 8 + 0) * 33 + n], t[(kc * 8 + 1) * 33 + n]);
    wv.y = pack2(t[(kc * 8 + 2) * 33 + n], t[(kc * 8 + 3) * 33 + n]);
    wv.z = pack2(t[(kc * 8 + 4) * 33 + n], t[(kc * 8 + 5) * 33 + n]);
    wv.w = pack2(t[(kc * 8 + 6) * 33 + n], t[(kc * 8 + 7) * 33 + n]);
    const int nn = n0 + n;
    const int orow = (mode == 0) ? nn : (32 * (nn >> 4) + (nn & 15) + (mode == 2 ? 16 : 0));
    *(u32x4*)(dst + (size_t)orow * lddst + k0 + kc * 8) = wv;
  }
}

DI void item_conv(const P& p, unsigned char* smem, int l, int idx) {
  if (idx < 592) { conv_tile(smem, p.w_in + (size_t)l * 1024 * NIN, NIN, (idx / 37) * 64, (idx % 37) * 32, p.win_t, 1024, 0, nullptr); return; }
  idx -= 592;
  if (idx < 96) { conv_tile(smem, p.w_uq + (size_t)l * 256 * 768, 768, (idx / 24) * 64, (idx % 24) * 32, p.wuq_t, 256, 0, p.g_q + l * 256); return; }
  idx -= 96;
  if (idx < 64) { conv_tile(smem, p.w_ukv + (size_t)l * 128 * 1024, 1024, (idx / 32) * 64, (idx % 32) * 32, p.wukv_t, 128, 0, p.g_kv + l * 128); return; }
  idx -= 64;
  if (idx < 512) { conv_tile(smem, p.w_out + (size_t)l * 1024 * 1024, 1024, (idx / 32) * 64, (idx % 32) * 32, p.wout_t, 1024, 0, nullptr); return; }
  idx -= 512;
  if (idx < 128) { conv_tile(smem, p.ws_gate + (size_t)l * 1024 * 256, 256, (idx / 8) * 64, (idx % 8) * 32, p.wsg_t, 1024, 1, nullptr); return; }
  idx -= 128;
  if (idx < 128) { conv_tile(smem, p.ws_up + (size_t)l * 1024 * 256, 256, (idx / 8) * 64, (idx % 8) * 32, p.wsg_t, 1024, 2, nullptr); return; }
  idx -= 128;
  if (idx < 128) { conv_tile(smem, p.ws_down + (size_t)l * 256 * 1024, 1024, (idx / 32) * 64, (idx % 32) * 32, p.wsd_t, 256, 0, nullptr); return; }
  idx -= 128;
  const int e = idx / 384, r = idx % 384;
  if (r < 128) conv_tile(smem, p.w_gate + ((size_t)l * 64 + e) * 1024 * 256, 256, (r / 8) * 64, (r % 8) * 32, p.wgu_t + (size_t)e * 512 * 1024, 1024, 1, nullptr);
  else if (r < 256) conv_tile(smem, p.w_up + ((size_t)l * 64 + e) * 1024 * 256, 256, ((r - 128) / 8) * 64, ((r - 128) % 8) * 32, p.wgu_t + (size_t)e * 512 * 1024, 1024, 2, nullptr);
  else conv_tile(smem, p.w_down + ((size_t)l * 64 + e) * 256 * 1024, 1024, ((r - 256) / 32) * 64, ((r - 256) % 32) * 32, p.wd_t + (size_t)e * 1024 * 256, 256, 0, nullptr);
}

DI void item_rope(const P& p, int item) {
  const int i = item * NTHREADS + otid();
  const int t = i >> 4, f = i & 15;
  const float inv = exp2f(-(float)(2 * f) * (13.287712379549449f / 32.f));
  const float ang = (float)p.pos[t] * inv;
  const double rev = (double)ang * 0.15915494309189535;
  const float fr = (float)(rev - floor(rev));
  p.ropec[i] = __builtin_amdgcn_cosf(fr);
  p.ropes[i] = __builtin_amdgcn_sinf(fr);
}

DI void item_norm0(const P& p, int item) {
  const int tid = otid(), w = tid >> 6, lane = tid & 63;
  const int t = item * 4 + w, b = t >> 11;
  const float* xr = p.x + (size_t)t * 1024;
  const float* md = p.mod + (size_t)b * 6144;
  float4 v[4]; float ss = 0.f;
#pragma unroll
  for (int j = 0; j < 4; ++j) { v[j] = *(const float4*)(xr + j * 256 + lane * 4); ss += v[j].x * v[j].x + v[j].y * v[j].y + v[j].z * v[j].z + v[j].w * v[j].w; }
  ss = wsum(ss);
  const float rstd = rsqrtf(ss * (1.f / 1024.f) + EPS);
#pragma unroll
  for (int j = 0; j < 4; ++j) {
    const int idx = j * 256 + lane * 4;
    const float4 sh = *(const float4*)(md + idx), sc = *(const float4*)(md + 1024 + idx);
    u32x2 o;
    o.x = pack2(v[j].x * rstd * (1.f + sc.x) + sh.x, v[j].y * rstd * (1.f + sc.y) + sh.y);
    o.y = pack2(v[j].z * rstd * (1.f + sc.z) + sh.z, v[j].w * rstd * (1.f + sc.w) + sh.w);
    *(u32x2*)(p.h + (size_t)t * 1024 + idx) = o;
  }
}

DI void item_p1(const P& p, unsigned char* smem, int item) {
  const int m = item / 10, nt = item % 10;
  const int tid = otid(), r_s = tid >> 3, c_s = tid & 7;
  const bf16_t* ap[4]; const bf16_t* bp[4];
#pragma unroll
  for (int j = 0; j < 4; ++j) {
    const int row = r_s + 32 * j;
    ap[j] = p.h + (size_t)(m * 128 + row) * 1024 + c_s * 8;
    int n = nt * 128 + row; n = n < NIN ? n : NIN - 1;
    bp[j] = p.win_t + (size_t)n * 1024 + c_s * 8;
  }
  bf16_t* proj = p.proj;
  gemm128(smem, ap, bp, 16, [=](f32x4 (&acc)[4][4], int wm, int wn, int fr, int fq) {
#pragma unroll
    for (int i = 0; i < 4; ++i) {
      const int t = m * 128 + wm * 64 + i * 16 + fr;
#pragma unroll
      for (int j = 0; j < 4; ++j) {
        const int n = nt * 128 + wn * 64 + j * 16 + fq * 4;
        if (n < NIN) { u32x2 o; o.x = pack2(acc[i][j][0], acc[i][j][1]); o.y = pack2(acc[i][j][2], acc[i][j][3]); *(u32x2*)(proj + (size_t)t * NIN + n) = o; }
      }
    }
  });
}

DI void item_qproj(const P& p, unsigned char* smem, int item) {
  const int m = item / 6, nt = item % 6;
  const int tid = otid(), r_s = tid >> 3, c_s = tid & 7;
  float* rowf = (float*)(smem + SMEM_MAIN + 1024);
  __syncthreads();
  {
    const int row = tid >> 1, half = tid & 1;
    const bf16_t* src = p.proj + (size_t)(m * 128 + row) * NIN + 768 + half * 128;
    float ss = 0.f;
#pragma unroll
    for (int q = 0; q < 16; ++q) {
      const u32x4 v = *(const u32x4*)(src + q * 8);
      ss += bflo(v.x) * bflo(v.x) + bfhi(v.x) * bfhi(v.x) + bflo(v.y) * bflo(v.y) + bfhi(v.y) * bfhi(v.y) + bflo(v.z) * bflo(v.z) + bfhi(v.z) * bfhi(v.z) + bflo(v.w) * bflo(v.w) + bfhi(v.w) * bfhi(v.w);
    }
    ss += __shfl_xor(ss, 1);
    if (half == 0) rowf[row] = rsqrtf(ss * (1.f / 256.f) + EPS);
  }
  const bf16_t* ap[4]; const bf16_t* bp[4];
#pragma unroll
  for (int j = 0; j < 4; ++j) {
    const int row = r_s + 32 * j;
    ap[j] = p.proj + (size_t)(m * 128 + row) * NIN + 768 + c_s * 8;
    bp[j] = p.wuq_t + (size_t)(nt * 128 + row) * 256 + c_s * 8;
  }
  bf16_t* Q = p.Q; const float* ropec = p.ropec; const float* ropes = p.ropes;
  const float QS = 0.10206207261596577f * 1.4426950408889634f;
  gemm128(smem, ap, bp, 4, [=](f32x4 (&acc)[4][4], int wm, int wn, int fr, int fq) {
#pragma unroll
    for (int i = 0; i < 4; ++i) {
      const int tl = wm * 64 + i * 16 + fr, t = m * 128 + tl;
      const int b = t >> 11, s = t & 2047;
      const float rs = rowf[tl] * QS;
#pragma unroll
      for (int j = 0; j < 4; ++j) {
        const int c0 = nt * 128 + wn * 64 + j * 16;
        const int head = c0 / 96, d0 = c0 % 96;
        bf16_t* dst = Q + ((size_t)((b * 8 + head) * 2048 + s)) * 96 + d0 + fq * 4;
        if (d0 == 64) {
          if (j < 3) {
            const float4 cs = *(const float4*)(ropec + (size_t)t * 16 + fq * 4), sn = *(const float4*)(ropes + (size_t)t * 16 + fq * 4);
            const f32x4 x1 = acc[i][j] * rs, x2 = acc[i][j + 1 < 4 ? j + 1 : 3] * rs;
            u32x2 o1, o2;
            o1.x = pack2(x1[0] * cs.x - x2[0] * sn.x, x1[1] * cs.y - x2[1] * sn.y);
            o1.y = pack2(x1[2] * cs.z - x2[2] * sn.z, x1[3] * cs.w - x2[3] * sn.w);
            o2.x = pack2(x2[0] * cs.x + x1[0] * sn.x, x2[1] * cs.y + x1[1] * sn.y);
            o2.y = pack2(x2[2] * cs.z + x1[2] * sn.z, x2[3] * cs.w + x1[3] * sn.w);
            *(u32x2*)dst = o1; *(u32x2*)(dst + 16) = o2;
          }
        } else if (d0 != 80) {
          const f32x4 x = acc[i][j] * rs;
          u32x2 o; o.x = pack2(x[0], x[1]); o.y = pack2(x[2], x[3]);
          *(u32x2*)dst = o;
        }
      }
    }
  });
}

DI void item_kvproj(const P& p, unsigned char* smem, int item) {
  const int m = item >> 3, head = item & 7;
  const int tid = otid(), r_s = tid >> 3, c_s = tid & 7;
  float* rowf = (float*)(smem + SMEM_MAIN + 1024);
  __syncthreads();
  {
    const int row = tid >> 1, half = tid & 1;
    const int t = m * 128 + row, b = t >> 11, s = t & 2047;
    const bf16_t* src = p.proj + (size_t)t * NIN + 1024 + half * 64;
    float ss = 0.f;
#pragma unroll
    for (int q = 0; q < 8; ++q) {
      const u32x4 v = *(const u32x4*)(src + q * 8);
      ss += bflo(v.x) * bflo(v.x) + bfhi(v.x) * bfhi(v.x) + bflo(v.y) * bflo(v.y) + bfhi(v.y) * bfhi(v.y) + bflo(v.z) * bflo(v.z) + bfhi(v.z) * bfhi(v.z) + bflo(v.w) * bflo(v.w) + bfhi(v.w) * bfhi(v.w);
    }
    ss += __shfl_xor(ss, 1);
    if (half == 0) rowf[row] = rsqrtf(ss * (1.f / 128.f) + EPS);
    const bf16_t* kp = p.proj + (size_t)t * NIN + 1152 + half * 8;
    const u32x4 a1 = *(const u32x4*)kp, a2 = *(const u32x4*)(kp + 16);
    const float* cp = p.ropec + (size_t)t * 16 + half * 8; const float* sp = p.ropes + (size_t)t * 16 + half * 8;
    const float4 c0 = *(const float4*)cp, c1 = *(const float4*)(cp + 4), s0 = *(const float4*)sp, s1 = *(const float4*)(sp + 4);
    const float x1[8] = {bflo(a1.x), bfhi(a1.x), bflo(a1.y), bfhi(a1.y), bflo(a1.z), bfhi(a1.z), bflo(a1.w), bfhi(a1.w)};
    const float x2[8] = {bflo(a2.x), bfhi(a2.x), bflo(a2.y), bfhi(a2.y), bflo(a2.z), bfhi(a2.z), bflo(a2.w), bfhi(a2.w)};
    const float cc[8] = {c0.x, c0.y, c0.z, c0.w, c1.x, c1.y, c1.z, c1.w};
    const float sn[8] = {s0.x, s0.y, s0.z, s0.w, s1.x, s1.y, s1.z, s1.w};
    u32x4 o1, o2;
    o1.x = pack2(x1[0] * cc[0] - x2[0] * sn[0], x1[1] * cc[1] - x2[1] * sn[1]);
    o1.y = pack2(x1[2] * cc[2] - x2[2] * sn[2], x1[3] * cc[3] - x2[3] * sn[3]);
    o1.z = pack2(x1[4] * cc[4] - x2[4] * sn[4], x1[5] * cc[5] - x2[5] * sn[5]);
    o1.w = pack2(x1[6] * cc[6] - x2[6] * sn[6], x1[7] * cc[7] - x2[7] * sn[7]);
    o2.x = pack2(x2[0] * cc[0] + x1[0] * sn[0], x2[1] * cc[1] + x1[1] * sn[1]);
    o2.y = pack2(x2[2] * cc[2] + x1[2] * sn[2], x2[3] * cc[3] + x1[3] * sn[3]);
    o2.z = pack2(x2[4] * cc[4] + x1[4] * sn[4], x2[5] * cc[5] + x1[5] * sn[5]);
    o2.w = pack2(x2[6] * cc[6] + x1[6] * sn[6], x2[7] * cc[7] + x1[7] * sn[7]);
    bf16_t* kd = p.Kb + ((size_t)((b * 8 + head) * 2048 + s)) * 96 + 64 + half * 8;
    *(u32x4*)kd = o1; *(u32x4*)(kd + 16) = o2;
  }
  const bf16_t* ap[4]; const bf16_t* bp[4];
#pragma unroll
  for (int j = 0; j < 4; ++j) {
    const int row = r_s + 32 * j;
    ap[j] = p.proj + (size_t)(m * 128 + row) * NIN + 1024 + c_s * 8;
    bp[j] = p.wukv_t + (size_t)(head * 128 + row) * 128 + c_s * 8;
  }
  bf16_t* Kb = p.Kb; bf16_t* V = p.V;
  gemm128(smem, ap, bp, 2, [=](f32x4 (&acc)[4][4], int wm, int wn, int fr, int fq) {
#pragma unroll
    for (int i = 0; i < 4; ++i) {
      const int tl = wm * 64 + i * 16 + fr, t = m * 128 + tl;
      const int b = t >> 11, s = t & 2047;
      const float rs = rowf[tl];
      const size_t rowi = (size_t)((b * 8 + head) * 2048 + s);
#pragma unroll
      for (int j = 0; j < 4; ++j) {
        const int d = j * 16 + fq * 4;
        const f32x4 x = acc[i][j] * rs;
        u32x2 o; o.x = pack2(x[0], x[1]); o.y = pack2(x[2], x[3]);
        if (wn == 0) *(u32x2*)(Kb + rowi * 96 + d) = o; else *(u32x2*)(V + rowi * 64 + d) = o;
      }
    }
  });
}

DI void item_pool(const P& p, unsigned char* smem, int l, int item) {
  const int tid = otid();
  const int t0 = item * 64, s0 = t0 & 2047;
  float* dl = (float*)smem;
  __syncthreads();
  {
    const int c = tid, g = c >> 6, wdw = 2 << g;
    const bf16_t* a = p.proj + c;
    float sacc = 0.f;
    for (int j = 1; j < wdw; ++j) { if (s0 - j >= 0) sacc += bf2f(a[(size_t)(t0 - j) * NIN]); }
    for (int tl = 0; tl < 64; ++tl) {
      const int sp = s0 + tl;
      const float av = bf2f(a[(size_t)(t0 + tl) * NIN]);
      sacc += av;
      const int cw = (sp + 1 < wdw) ? sp + 1 : wdw;
      dl[tl * 256 + c] = sacc / (float)cw - av;
      if (sp - wdw + 1 >= 0) sacc -= bf2f(a[(size_t)(t0 + tl - wdw + 1) * NIN]);
    }
  }
  __syncthreads();
  {
    const int g = tid >> 6, dd = tid & 63;
    const float* wp = p.w_pool + ((size_t)(l * 4 + g) * 64) * 64 + dd;
    float wreg[64];
#pragma unroll
    for (int c = 0; c < 64; ++c) wreg[c] = wp[c * 64];
    const float psc = p.pool_scale[l * 256 + tid];
    for (int tl = 0; tl < 64; ++tl) {
      float acc = 0.f;
      const float4* dr = (const float4*)(dl + tl * 256 + g * 64);
#pragma unroll
      for (int c4 = 0; c4 < 16; ++c4) { const float4 d = dr[c4]; acc += d.x * wreg[c4 * 4] + d.y * wreg[c4 * 4 + 1] + d.z * wreg[c4 * 4 + 2] + d.w * wreg[c4 * 4 + 3]; }
      const f32x2 f = {acc * psc, 0.f}; const bf16x2_t bb = __builtin_convertvector(f, bf16x2_t);
      p.Y[(size_t)(t0 + tl) * 1024 + tid] = (bf16_t)(__builtin_bit_cast(unsigned, bb) & 0xffffu);
    }
  }
}

DI void item_sgu(const P& p, unsigned char* smem, int l, int item) {
  const int tid = otid(), w = tid >> 6, lane = tid & 63;
  const int chunk = item >> 2, hh = item & 3;
  const int t0 = chunk * 128;
  float* vn = (float*)smem;
  __syncthreads();
  for (int q = 0; q < 32; ++q) {
    const int tl = w * 32 + q;
    const u32x2 raw = *(const u32x2*)(p.proj + (size_t)(t0 + tl) * NIN + 512 + lane * 4);
    float x0 = gelu_tanh(bflo(raw.x)), x1 = gelu_tanh(bfhi(raw.x)), x2 = gelu_tanh(bflo(raw.y)), x3 = gelu_tanh(bfhi(raw.y));
    const float mu = wsum(x0 + x1 + x2 + x3) * (1.f / 256.f);
    x0 -= mu; x1 -= mu; x2 -= mu; x3 -= mu;
    const float var = wsum(x0 * x0 + x1 * x1 + x2 * x2 + x3 * x3) * (1.f / 256.f);
    const float rstd = rsqrtf(var + EPS);
    if ((lane >> 4) == hh) { float4 o = {x0 * rstd, x1 * rstd, x2 * rstd, x3 * rstd}; *(float4*)(vn + tl * 64 + (lane & 15) * 4) = o; }
  }
  __syncthreads();
  {
    const int d = lane;
    const int tq = __builtin_amdgcn_readfirstlane(w);
    for (int i = 0; i < 32; ++i) {
      const int t = i * 4 + tq;
      const float* wrow = p.w_spatial + ((size_t)((l * 4 + hh) * 128 + t)) * 128;
      float acc = 0.f;
      for (int k = 0; k <= t; ++k) acc += wrow[k] * vn[k * 64 + d];
      const float bias = p.b_spatial[(l * 4 + hh) * 128 + t];
      const float u = gelu_tanh(bf2f(p.proj[(size_t)(t0 + t) * NIN + 256 + hh * 64 + d]));
      const f32x2 f = {u * (acc + bias), 0.f}; const bf16x2_t bb = __builtin_convertvector(f, bf16x2_t);
      p.Y[(size_t)(t0 + t) * 1024 + 256 + hh * 64 + d] = (bf16_t)(__builtin_bit_cast(unsigned, bb) & 0xffffu);
    }
  }
}

DI void item_attn(const P& p, unsigned char* smem, int item) {
  const int tid = otid(), w = tid >> 6, lane = tid & 63;
  const int fr = lane & 15, fq = lane >> 4;
  const int rnd = item >> 9, blk = item & 511;
  const int qb = rnd == 0 ? 15 - (blk >> 6) : (blk >> 6);
  const int bh = blk & 63, b = bh >> 3, h = bh & 7;
  const int q0 = qb * 128;
  const int nkt = 2 * qb + 2;
  const bf16_t* Qg = p.Q + (size_t)bh * 2048 * 96;
  const bf16_t* Kg = p.Kb + (size_t)bh * 2048 * 96;
  const bf16_t* Vg = p.V + (size_t)bh * 2048 * 64;
  int kkey[3], kdst[3], kc[3];
#pragma unroll
  for (int j = 0; j < 3; ++j) { const int id = tid + 256 * j; kkey[j] = id / 12; kc[j] = id % 12; kdst[j] = kkey[j] * 256 + ((kc[j] ^ (kkey[j] & 15)) << 4); }
  int vkey[2], vdst[2], vc[2];
#pragma unroll
  for (int j = 0; j < 2; ++j) { const int id = tid + 256 * j; vkey[j] = id >> 3; vc[j] = id & 7; vdst[j] = vkey[j] * 128 + (((vc[j] >> 1) ^ ((vkey[j] >> 1) & 3)) << 5) + ((vc[j] & 1) << 4); }
  bf16x8 qf[3][2];
#pragma unroll
  for (int ks = 0; ks < 3; ++ks)
#pragma unroll
    for (int f = 0; f < 2; ++f) qf[ks][f] = *(const bf16x8*)(Qg + (size_t)(q0 + 32 * w + 16 * f + fr) * 96 + ks * 32 + fq * 8);
  f32x4 o[4][2];
#pragma unroll
  for (int f = 0; f < 4; ++f) { o[f][0] = (f32x4){0.f, 0.f, 0.f, 0.f}; o[f][1] = (f32x4){0.f, 0.f, 0.f, 0.f}; }
  float mrun[2] = {-INFINITY, -INFINITY}, lrun[2] = {0.f, 0.f};
  u32x4 rk[3], rv[2];
  __syncthreads();
#pragma unroll
  for (int j = 0; j < 3; ++j) rk[j] = *(const u32x4*)(Kg + (size_t)kkey[j] * 96 + kc[j] * 8);
#pragma unroll
  for (int j = 0; j < 2; ++j) rv[j] = *(const u32x4*)(Vg + (size_t)vkey[j] * 64 + vc[j] * 8);
#pragma unroll
  for (int j = 0; j < 3; ++j) *(u32x4*)(smem + kdst[j]) = rk[j];
#pragma unroll
  for (int j = 0; j < 2; ++j) *(u32x4*)(smem + 32768 + vdst[j]) = rv[j];
  __syncthreads();
  const int rowmin = q0 + 32 * w;
  for (int kt = 0; kt < nkt; ++kt) {
    const int cur = kt & 1;
    const bool more = kt + 1 < nkt;
    if (more) {
      const int key0n = (kt + 1) * 64;
#pragma unroll
      for (int j = 0; j < 3; ++j) rk[j] = *(const u32x4*)(Kg + (size_t)(key0n + kkey[j]) * 96 + kc[j] * 8);
#pragma unroll
      for (int j = 0; j < 2; ++j) rv[j] = *(const u32x4*)(Vg + (size_t)(key0n + vkey[j]) * 64 + vc[j] * 8);
    }
    const int key0 = kt * 64;
    if (key0 <= rowmin + 31) {
      const unsigned char* Kl = smem + cur * 16384;
      const unsigned char* Vl = smem + 32768 + cur * 8192;
      f32x4 st[4][2];
#pragma unroll
      for (int kf = 0; kf < 4; ++kf) { st[kf][0] = (f32x4){0.f, 0.f, 0.f, 0.f}; st[kf][1] = (f32x4){0.f, 0.f, 0.f, 0.f}; }
#pragma unroll
      for (int ks = 0; ks < 3; ++ks)
#pragma unroll
        for (int kf = 0; kf < 4; ++kf) {
          const int key = kf * 16 + fr;
          const bf16x8 a = *(const bf16x8*)(Kl + key * 256 + (((ks * 4 + fq) ^ (key & 15)) << 4));
          st[kf][0] = __builtin_amdgcn_mfma_f32_16x16x32_bf16(a, qf[ks][0], st[kf][0], 0, 0, 0);
          st[kf][1] = __builtin_amdgcn_mfma_f32_16x16x32_bf16(a, qf[ks][1], st[kf][1], 0, 0, 0);
        }
      const bool needmask = (key0 + 63 > rowmin);
#pragma unroll
      for (int f = 0; f < 2; ++f) {
        const int qabs = rowmin + 16 * f + fr;
        if (needmask) {
#pragma unroll
          for (int kf = 0; kf < 4; ++kf)
#pragma unroll
            for (int r = 0; r < 4; ++r) { const int kabs = key0 + kf * 16 + fq * 4 + r; if (kabs > qabs) st[kf][f][r] = -INFINITY; }
        }
        float mx = st[0][f][0];
#pragma unroll
        for (int kf = 0; kf < 4; ++kf)
#pragma unroll
          for (int r = 0; r < 4; ++r) mx = fmaxf(mx, st[kf][f][r]);
        mx = fmaxf(mx, __shfl_xor(mx, 16)); mx = fmaxf(mx, __shfl_xor(mx, 32));
        const float mnew = fmaxf(mrun[f], mx);
        const float alpha = __builtin_amdgcn_exp2f(mrun[f] - mnew);
        mrun[f] = mnew;
        float ls = 0.f;
#pragma unroll
        for (int kf = 0; kf < 4; ++kf)
#pragma unroll
          for (int r = 0; r < 4; ++r) { const float pv = __builtin_amdgcn_exp2f(st[kf][f][r] - mnew); st[kf][f][r] = pv; ls += pv; }
        lrun[f] = lrun[f] * alpha + ls;
#pragma unroll
        for (int df = 0; df < 4; ++df) o[df][f] = o[df][f] * alpha;
      }
      bf16x8 pf[2][2];
#pragma unroll
      for (int kb = 0; kb < 2; ++kb)
#pragma unroll
        for (int f = 0; f < 2; ++f) {
          u32x4 u;
          u.x = pack2(st[2 * kb][f][0], st[2 * kb][f][1]); u.y = pack2(st[2 * kb][f][2], st[2 * kb][f][3]);
          u.z = pack2(st[2 * kb + 1][f][0], st[2 * kb + 1][f][1]); u.w = pack2(st[2 * kb + 1][f][2], st[2 * kb + 1][f][3]);
          pf[kb][f] = __builtin_bit_cast(bf16x8, u);
        }
      const int qq = fr >> 2, pp = fr & 3;
#pragma unroll
      for (int kb = 0; kb < 2; ++kb)
#pragma unroll
        for (int df = 0; df < 4; ++df) {
          const int keyA = kb * 32 + fq * 4 + qq, keyB = keyA + 16;
          const int offA = keyA * 128 + ((df ^ ((keyA >> 1) & 3)) << 5) + pp * 8;
          const int offB = keyB * 128 + ((df ^ ((keyB >> 1) & 3)) << 5) + pp * 8;
          const s16x4 lo = __builtin_amdgcn_ds_read_tr16_b64_v4i16((LAS s16x4*)(Vl + offA));
          const s16x4 hi = __builtin_amdgcn_ds_read_tr16_b64_v4i16((LAS s16x4*)(Vl + offB));
          bf16x8 vf; vf[0] = lo[0]; vf[1] = lo[1]; vf[2] = lo[2]; vf[3] = lo[3]; vf[4] = hi[0]; vf[5] = hi[1]; vf[6] = hi[2]; vf[7] = hi[3];
          o[df][0] = __builtin_amdgcn_mfma_f32_16x16x32_bf16(vf, pf[kb][0], o[df][0], 0, 0, 0);
          o[df][1] = __builtin_amdgcn_mfma_f32_16x16x32_bf16(vf, pf[kb][1], o[df][1], 0, 0, 0);
        }
    }
    if (more) {
      const int nx = cur ^ 1;
#pragma unroll
      for (int j = 0; j < 3; ++j) *(u32x4*)(smem + nx * 16384 + kdst[j]) = rk[j];
#pragma unroll
      for (int j = 0; j < 2; ++j) *(u32x4*)(smem + 32768 + nx * 8192 + vdst[j]) = rv[j];
    }
    __syncthreads();
  }
#pragma unroll
  for (int f = 0; f < 2; ++f) {
    float lt = lrun[f]; lt += __shfl_xor(lt, 16); lt += __shfl_xor(lt, 32);
    const float inv = 1.f / lt;
    const int t = b * 2048 + rowmin + 16 * f + fr;
#pragma unroll
    for (int df = 0; df < 4; ++df) {
      const f32x4 x = o[df][f] * inv;
      u32x2 ov; ov.x = pack2(x[0], x[1]); ov.y = pack2(x[2], x[3]);
      *(u32x2*)(p.Y + (size_t)t * 1024 + 512 + h * 64 + df * 16 + fq * 4) = ov;
    }
  }
}

DI void item_p4(const P& p, unsigned char* smem, int l, int item) {
  const int m = item >> 3, nt = item & 7;
  const int tid = otid(), r_s = tid >> 3, c_s = tid & 7;
  const bf16_t* ap[4]; const bf16_t* bp[4];
#pragma unroll
  for (int j = 0; j < 4; ++j) {
    const int row = r_s + 32 * j;
    ap[j] = p.Y + (size_t)(m * 128 + row) * 1024 + c_s * 8;
    bp[j] = p.wout_t + (size_t)(nt * 128 + row) * 1024 + c_s * 8;
  }
  const float* xin = (l == 0) ? p.x : p.out;
  float* xout = p.out;
  const float* mod = p.mod + (size_t)l * 8 * 6144 + 2048;
  gemm128(smem, ap, bp, 16, [=](f32x4 (&acc)[4][4], int wm, int wn, int fr, int fq) {
#pragma unroll
    for (int i = 0; i < 4; ++i) {
      const int t = m * 128 + wm * 64 + i * 16 + fr, b = t >> 11;
#pragma unroll
      for (int j = 0; j < 4; ++j) {
        const int n = nt * 128 + wn * 64 + j * 16 + fq * 4;
        const float4 xv = *(const float4*)(xin + (size_t)t * 1024 + n);
        const float4 g = *(const float4*)(mod + (size_t)b * 6144 + n);
        float4 ov = {xv.x + g.x * acc[i][j][0], xv.y + g.y * acc[i][j][1], xv.z + g.z * acc[i][j][2], xv.w + g.w * acc[i][j][3]};
        *(float4*)(xout + (size_t)t * 1024 + n) = ov;
      }
    }
  });
}

DI void item_p5(const P& p, unsigned char* smem, int l, int item) {
  const int tid = otid(), w = tid >> 6, lane = tid & 63;
  float* hl = (float*)smem + w * 4096;
  const int tb = item * 16 + w * 4;
  __syncthreads();
#pragma unroll
  for (int q = 0; q < 4; ++q) {
    const int t = tb + q, b = t >> 11;
    const float* xr = p.out + (size_t)t * 1024;
    const float* md = p.mod + ((size_t)l * 8 + b) * 6144;
    float4 v[4]; float ss = 0.f;
#pragma unroll
    for (int j = 0; j < 4; ++j) { v[j] = *(const float4*)(xr + j * 256 + lane * 4); ss += v[j].x * v[j].x + v[j].y * v[j].y + v[j].z * v[j].z + v[j].w * v[j].w; }
    ss = wsum(ss);
    const float rstd = rsqrtf(ss * (1.f / 1024.f) + EPS);
#pragma unroll
    for (int j = 0; j < 4; ++j) {
      const int idx = j * 256 + lane * 4;
      const float4 sh = *(const float4*)(md + 3072 + idx), sc = *(const float4*)(md + 4096 + idx);
      float4 hv = {v[j].x * rstd * (1.f + sc.x) + sh.x, v[j].y * rstd * (1.f + sc.y) + sh.y, v[j].z * rstd * (1.f + sc.z) + sh.z, v[j].w * rstd * (1.f + sc.w) + sh.w};
      *(float4*)(hl + q * 1024 + idx) = hv;
      u32x2 o; o.x = pack2(hv.x, hv.y); o.y = pack2(hv.z, hv.w);
      *(u32x2*)(p.h + (size_t)t * 1024 + idx) = o;
    }
  }
  __syncthreads();
  float acc[4] = {0.f, 0.f, 0.f, 0.f};
  const float* wr = p.w_router + (size_t)l * 1024 * 64 + lane;
  for (int k = 0; k < 1024; k += 4) {
    const float w0 = wr[(k + 0) * 64], w1 = wr[(k + 1) * 64], w2 = wr[(k + 2) * 64], w3 = wr[(k + 3) * 64];
#pragma unroll
    for (int q = 0; q < 4; ++q) { const float4 hv = *(const float4*)(hl + q * 1024 + k); acc[q] += hv.x * w0 + hv.y * w1 + hv.z * w2 + hv.w * w3; }
  }
  const float bias = p.router_bias[l * 64 + lane];
  bool chosen[4]; float wgt[4]; int kidx[4]; int cnt_local = 0;
#pragma unroll
  for (int q = 0; q < 4; ++q) {
    const float s = 1.f / (1.f + __expf(-acc[q]));
    const float sel = s + bias;
    float m1 = sel; m1 = fmaxf(m1, __shfl_xor(m1, 1)); m1 = fmaxf(m1, __shfl_xor(m1, 2)); m1 = fmaxf(m1, __shfl_xor(m1, 4));
    const unsigned long long eq = __ballot(sel == m1);
    const int gbase = lane & ~7;
    const unsigned gm = (unsigned)((eq >> gbase) & 0xffull);
    const int first = gbase + __ffs(gm) - 1;
    float m2 = (lane == first) ? -INFINITY : sel;
    m2 = fmaxf(m2, __shfl_xor(m2, 1)); m2 = fmaxf(m2, __shfl_xor(m2, 2)); m2 = fmaxf(m2, __shfl_xor(m2, 4));
    const float gs = m1 + m2;
    const int myg = lane >> 3; int rank = 0;
#pragma unroll
    for (int j = 0; j < 8; ++j) { const float gj = __shfl(gs, j * 8); rank += ((gj > gs) || (gj == gs && j < myg)) ? 1 : 0; }
    const bool gsel = rank < 4;
    const float sm = gsel ? sel : -INFINITY;
    int r = 0;
    for (int j = 0; j < 64; ++j) { const float sj = __shfl(sm, j); r += ((sj > sm) || (sj == sm && j < lane)) ? 1 : 0; }
    const bool ch = gsel && (r < 8);
    const float tot = wsum(ch ? s : 0.f);
    const unsigned long long cm = __ballot(ch);
    chosen[q] = ch; wgt[q] = s / tot * 2.5f; kidx[q] = __popcll(cm & ((1ull << lane) - 1ull));
    cnt_local += ch ? 1 : 0;
  }
  int base = 0;
  if (cnt_local > 0) base = atomicAdd(p.cnt + (l * 64 + lane) * CSTRIDE, cnt_local);
#pragma unroll
  for (int q = 0; q < 4; ++q) {
    if (chosen[q]) {
      const int slot = (tb + q) * 8 + kidx[q];
      p.list[(size_t)lane * LISTCAP + base] = slot; ++base;
      p.topw[slot] = wgt[q];
    }
  }
}

DI void moe_table(const P& p, unsigned char* smem, int l) {
  int* start = (int*)(smem + SMEM_MAIN);
  __syncthreads();
  if (threadIdx.x == 0) {
    int s = 0;
    for (int e = 0; e < 64; ++e) { start[e] = s; s += (p.cnt[(l * 64 + e) * CSTRIDE] + 127) >> 7; }
    start[64] = s;
  }
  __syncthreads();
}
DI void moe_rows(const P& p, unsigned char* smem, int l, int mt, int& e_out) {
  const int* start = (const int*)(smem + SMEM_MAIN);
  int* rowinfo = (int*)(smem + SMEM_MAIN + 512);
  const int tid = otid();
  int e;
  if (mt >= start[64]) { e = 64; if (tid < 128) rowinfo[tid] = T_ * 8 + (mt - start[64]) * 128 + tid; }
  else {
    e = 0;
    for (int q = 1; q < 64; ++q) e = (start[q] <= mt) ? q : e;
    const int tl = mt - start[e];
    const int cnt = p.cnt[(l * 64 + e) * CSTRIDE];
    if (tid < 128) { const int idx = tl * 128 + tid; rowinfo[tid] = idx < cnt ? p.list[(size_t)e * LISTCAP + idx] : -1; }
  }
  e_out = e;
}

DI void item_p7(const P& p, unsigned char* smem, int l, int item) {
  const int mt = item >> 2, nt = item & 3;
  const int tid = otid(), r_s = tid >> 3, c_s = tid & 7;
  int* rowinfo = (int*)(smem + SMEM_MAIN + 512);
  __syncthreads();
  int e; moe_rows(p, smem, l, mt, e);
  __syncthreads();
  const bf16_t* wbase = (e == 64) ? p.wsg_t : p.wgu_t + (size_t)e * 512 * 1024;
  const bf16_t* ap[4]; const bf16_t* bp[4];
#pragma unroll
  for (int j = 0; j < 4; ++j) {
    const int row = r_s + 32 * j;
    const int slot = rowinfo[row];
    const int tok = slot < 0 ? 0 : (slot >= T_ * 8 ? slot - T_ * 8 : slot >> 3);
    ap[j] = p.h + (size_t)tok * 1024 + c_s * 8;
    bp[j] = wbase + (size_t)(nt * 128 + row) * 1024 + c_s * 8;
  }
  bf16_t* act = p.act;
  gemm128(smem, ap, bp, 16, [=](f32x4 (&acc)[4][4], int wm, int wn, int fr, int fq) {
#pragma unroll
    for (int i = 0; i < 4; ++i) {
      const int slot = rowinfo[wm * 64 + i * 16 + fr];
      if (slot >= 0) {
#pragma unroll
        for (int jj = 0; jj < 2; ++jj) {
          const f32x4 g = acc[i][2 * jj], u = acc[i][2 * jj + 1];
          u32x2 o; o.x = pack2(silu_f(g[0]) * u[0], silu_f(g[1]) * u[1]); o.y = pack2(silu_f(g[2]) * u[2], silu_f(g[3]) * u[3]);
          *(u32x2*)(act + (size_t)slot * 256 + nt * 64 + wn * 32 + jj * 16 + fq * 4) = o;
        }
      }
    }
  });
}

DI void item_p8(const P& p, unsigned char* smem, int l, int item) {
  const int mt = item >> 3, nt = item & 7;
  const int tid = otid(), r_s = tid >> 3, c_s = tid & 7;
  int* rowinfo = (int*)(smem + SMEM_MAIN + 512);
  __syncthreads();
  int e; moe_rows(p, smem, l, mt, e);
  __syncthreads();
  const bf16_t* wbase = (e == 64) ? p.wsd_t : p.wd_t + (size_t)e * 1024 * 256;
  const bf16_t* ap[4]; const bf16_t* bp[4];
#pragma unroll
  for (int j = 0; j < 4; ++j) {
    const int row = r_s + 32 * j;
    const int slot = rowinfo[row];
    ap[j] = p.act + (size_t)(slot < 0 ? 0 : slot) * 256 + c_s * 8;
    bp[j] = wbase + (size_t)(nt * 128 + row) * 256 + c_s * 8;
  }
  bf16_t* yrows = p.yrows; bf16_t* ysh = p.ysh; const float* topw = p.topw;
  gemm128(smem, ap, bp, 4, [=](f32x4 (&acc)[4][4], int wm, int wn, int fr, int fq) {
#pragma unroll
    for (int i = 0; i < 4; ++i) {
      const int slot = rowinfo[wm * 64 + i * 16 + fr];
      if (slot >= 0) {
        const bool shared = slot >= T_ * 8;
        const float wv = shared ? 1.f : topw[slot];
        bf16_t* dst = shared ? ysh + (size_t)(slot - T_ * 8) * 1024 : yrows + (size_t)slot * 1024;
#pragma unroll
        for (int j = 0; j < 4; ++j) {
          const f32x4 x = acc[i][j] * wv;
          u32x2 o; o.x = pack2(x[0], x[1]); o.y = pack2(x[2], x[3]);
          *(u32x2*)(dst + nt * 128 + wn * 64 + j * 16 + fq * 4) = o;
        }
      }
    }
  });
}

DI void item_p9(const P& p, int l, int item) {
  const int tid = otid(), w = tid >> 6, lane = tid & 63;
  const int t = item * 4 + w, b = t >> 11;
  const float* md = p.mod + ((size_t)l * 8 + b) * 6144;
  float4 v[4]; float ss = 0.f;
#pragma unroll
  for (int j = 0; j < 4; ++j) {
    const int idx = j * 256 + lane * 4;
    u32x2 y = *(const u32x2*)(p.ysh + (size_t)t * 1024 + idx);
    float a0 = bflo(y.x), a1 = bfhi(y.x), a2 = bflo(y.y), a3 = bfhi(y.y);
#pragma unroll
    for (int k = 0; k < 8; ++k) {
      y = *(const u32x2*)(p.yrows + ((size_t)t * 8 + k) * 1024 + idx);
      a0 += bflo(y.x); a1 += bfhi(y.x); a2 += bflo(y.y); a3 += bfhi(y.y);
    }
    const float4 xv = *(const float4*)(p.out + (size_t)t * 1024 + idx);
    const float4 g = *(const float4*)(md + 5120 + idx);
    v[j] = (float4){xv.x + g.x * a0, xv.y + g.y * a1, xv.z + g.z * a2, xv.w + g.w * a3};
    ss += v[j].x * v[j].x + v[j].y * v[j].y + v[j].z * v[j].z + v[j].w * v[j].w;
  }
  ss = wsum(ss);
  const float rstd = rsqrtf(ss * (1.f / 1024.f) + EPS);
  if (l == 0) {
    const float* md1 = p.mod + ((size_t)8 + b) * 6144;
#pragma unroll
    for (int j = 0; j < 4; ++j) {
      const int idx = j * 256 + lane * 4;
      *(float4*)(p.out + (size_t)t * 1024 + idx) = v[j];
      const float4 sh = *(const float4*)(md1 + idx), sc = *(const float4*)(md1 + 1024 + idx);
      u32x2 o;
      o.x = pack2(v[j].x * rstd * (1.f + sc.x) + sh.x, v[j].y * rstd * (1.f + sc.y) + sh.y);
      o.y = pack2(v[j].z * rstd * (1.f + sc.z) + sh.z, v[j].w * rstd * (1.f + sc.w) + sh.w);
      *(u32x2*)(p.h + (size_t)t * 1024 + idx) = o;
    }
  } else {
#pragma unroll
    for (int j = 0; j < 4; ++j) {
      const int idx = j * 256 + lane * 4;
      const float4 fg = *(const float4*)(p.final_gain + idx);
      *(float4*)(p.out + (size_t)t * 1024 + idx) = (float4){v[j].x * rstd * fg.x, v[j].y * rstd * fg.y, v[j].z * rstd * fg.z, v[j].w * rstd * fg.w};
    }
  }
}

__global__ void __launch_bounds__(NTHREADS, 2) fwd_megakernel(P p) {
  __shared__ __attribute__((aligned(16))) unsigned char smem[SMEM_MAIN + SMEM_EXTRA];
  const int G = gridDim.x, bid = blockIdx.x;
  volatile LAS unsigned* stw = (volatile LAS unsigned*)(smem + SMEM_MAIN + 2032);
  if (threadIdx.x == 0) { stw[0] = 0u; stw[1] = 0u; }
  __syncthreads();
  XcdBarrier bar = xcd_barrier_post(p.bar, stw);

  for (int it = bid; it < 192 + 1024 + CONV_ITEMS; it += G) {
    if (it < 192) item_mod(p, smem, it);
    else if (it < 192 + 1024) item_rope(p, it - 192);
    else item_conv(p, smem, 0, it - 192 - 1024);
  }
  xcd_barrier(bar);
  for (int it = bid; it < T_ / 4; it += G) item_norm0(p, it);
  xcd_barrier(bar);

  for (int l = 0; l < 2; ++l) {
    for (int it = bid; it < 1280; it += G) item_p1(p, smem, it);
    xcd_barrier(bar);
    for (int it = bid; it < 768 + 1024 + 256 + 512; it += G) {
      if (it < 768) item_qproj(p, smem, it);
      else if (it < 1792) item_kvproj(p, smem, it - 768);
      else if (it < 2048) item_pool(p, smem, l, it - 1792);
      else item_sgu(p, smem, l, it - 2048);
    }
    xcd_barrier(bar);
    for (int it = bid; it < 1024; it += G) item_attn(p, smem, it);
    xcd_barrier(bar);
    for (int it = bid; it < 1024; it += G) item_p4(p, smem, l, it);
    xcd_barrier(bar);
    for (int it = bid; it < 1024; it += G) item_p5(p, smem, l, it);
    xcd_barrier(bar);
    moe_table(p, smem, l);
    const int nmt = ((const int*)(smem + SMEM_MAIN))[64] + 128;
    for (int it = bid; it < nmt * 4; it += G) item_p7(p, smem, l, it);
    xcd_barrier(bar);
    for (int it = bid; it < nmt * 8; it += G) item_p8(p, smem, l, it);
    xcd_barrier(bar);
    const int n9 = T_ / 4 + (l == 0 ? CONV_ITEMS : 0);
    for (int it = bid; it < n9; it += G) {
      if (it < T_ / 4) item_p9(p, l, it);
      else item_conv(p, smem, 1, it - T_ / 4);
    }
    if (l == 0) xcd_barrier(bar);
  }
}

extern "C" void kernel_launch(void* const* d_in, const int* in_sizes, int n_in, void* d_out, int out_size, void* d_ws, size_t ws_size,
                              hipStream_t stream) {
  P p{};
  p.x = (const float*)d_in[0]; p.c = (const float*)d_in[1]; p.pos = (const int*)d_in[2];
  p.w_ada = (const float*)d_in[3]; p.b_ada = (const float*)d_in[4]; p.w_in = (const float*)d_in[5]; p.w_pool = (const float*)d_in[6];
  p.pool_scale = (const float*)d_in[7]; p.w_spatial = (const float*)d_in[8]; p.b_spatial = (const float*)d_in[9]; p.g_q = (const float*)d_in[10];
  p.w_uq = (const float*)d_in[11]; p.g_kv = (const float*)d_in[12]; p.w_ukv = (const float*)d_in[13]; p.w_out = (const float*)d_in[14];
  p.w_router = (const float*)d_in[15]; p.router_bias = (const float*)d_in[16]; p.w_gate = (const float*)d_in[17]; p.w_up = (const float*)d_in[18];
  p.w_down = (const float*)d_in[19]; p.ws_gate = (const float*)d_in[20]; p.ws_up = (const float*)d_in[21]; p.ws_down = (const float*)d_in[22];
  p.final_gain = (const float*)d_in[23];
  p.out = (float*)d_out;
  unsigned char* ws = (unsigned char*)d_ws;
  size_t off = 0;
  auto take = [&](size_t bytes) { unsigned char* r = ws + off; off += (bytes + 255) & ~(size_t)255; return r; };
  const size_t ctrl_bytes = (size_t)XCD_BAR_WORDS * 4 + (size_t)2 * 64 * CSTRIDE * 4;
  p.bar = (unsigned*)take(ctrl_bytes);
  p.cnt = (int*)(p.bar + XCD_BAR_WORDS);
  p.mod = (float*)take((size_t)2 * 8 * 6144 * 4);
  p.ropec = (float*)take((size_t)T_ * 16 * 4);
  p.ropes = (float*)take((size_t)T_ * 16 * 4);
  p.win_t = (bf16_t*)take((size_t)NIN * 1024 * 2);
  p.wuq_t = (bf16_t*)take((size_t)768 * 256 * 2);
  p.wukv_t = (bf16_t*)take((size_t)1024 * 128 * 2);
  p.wout_t = (bf16_t*)take((size_t)1024 * 1024 * 2);
  p.wsg_t = (bf16_t*)take((size_t)512 * 1024 * 2);
  p.wsd_t = (bf16_t*)take((size_t)1024 * 256 * 2);
  p.wgu_t = (bf16_t*)take((size_t)64 * 512 * 1024 * 2);
  p.wd_t = (bf16_t*)take((size_t)64 * 1024 * 256 * 2);
  p.h = (bf16_t*)take((size_t)T_ * 1024 * 2);
  p.act = (bf16_t*)take((size_t)(T_ * 8 + T_) * 256 * 2);
  p.ysh = (bf16_t*)take((size_t)T_ * 1024 * 2);
  p.list = (int*)take((size_t)64 * LISTCAP * 4);
  p.topw = (float*)take((size_t)T_ * 8 * 4);
  const size_t big0 = off;
  p.yrows = (bf16_t*)take((size_t)T_ * 8 * 1024 * 2);
  off = big0;
  p.proj = (bf16_t*)take((size_t)T_ * NIN * 2);
  p.Q = (bf16_t*)take((size_t)T_ * 8 * 96 * 2);
  p.Kb = (bf16_t*)take((size_t)T_ * 8 * 96 * 2);
  p.V = (bf16_t*)take((size_t)T_ * 8 * 64 * 2);
  p.Y = (bf16_t*)take((size_t)T_ * 1024 * 2);
  const size_t need = big0 + (size_t)T_ * 8 * 1024 * 2 + 256;
  if (need > ws_size) { fprintf(stderr, "workspace too small: need %zu have %zu\n", need, ws_size); return; }

  hipMemsetAsync(p.bar, 0, ctrl_bytes, stream);
  static int grid_blocks = 0;
  if (!grid_blocks) {
    int dev = 0, cus = 0, per_cu = 0;
    hipGetDevice(&dev);
    hipDeviceGetAttribute(&cus, hipDeviceAttributeMultiprocessorCount, dev);
    hipOccupancyMaxActiveBlocksPerMultiprocessor(&per_cu, fwd_megakernel, NTHREADS, 0);
    if (per_cu > 2) per_cu = 2;
    if (per_cu < 1) per_cu = 1;
    grid_blocks = cus * per_cu;
  }
  void* args[] = {&p};
  hipError_t e = hipLaunchCooperativeKernel((void*)fwd_megakernel, dim3(grid_blocks), dim3(NTHREADS), args, 0, stream);
  if (e != hipSuccess) fprintf(stderr, "cooperative launch failed: %s (grid %d)\n", hipGetErrorString(e), grid_blocks);
}
```

```cpp
#include <hip/hip_runtime.h>
#include <stdint.h>
#include <cstdio>

#define DI __device__ __forceinline__
#define LAS __attribute__((address_space(3)))

typedef unsigned short bf16_t;
typedef short bf16x8 __attribute__((ext_vector_type(8)));
typedef short s16x4 __attribute__((ext_vector_type(4)));
typedef float f32x4 __attribute__((ext_vector_type(4)));
typedef float f32x2 __attribute__((ext_vector_type(2)));
typedef unsigned u32x4 __attribute__((ext_vector_type(4)));
typedef unsigned u32x2 __attribute__((ext_vector_type(2)));
typedef __bf16 bf16x2_t __attribute__((ext_vector_type(2)));

constexpr int T_ = 16384, D_ = 1024, S_ = 2048, NIN = 1184;
constexpr int NTHREADS = 256;
constexpr int SMEM_MAIN = 65536, SMEM_EXTRA = 2048;
constexpr float EPS = 1e-6f;
constexpr int CSTRIDE = 64;
constexpr int LISTCAP = 16384;
constexpr int CONV_ITEMS = 592 + 96 + 64 + 512 + 384 + 24576;

struct P {
  const float *x, *c; const int* pos;
  const float *w_ada, *b_ada, *w_in, *w_pool, *pool_scale, *w_spatial, *b_spatial, *g_q, *w_uq, *g_kv, *w_ukv, *w_out,
      *w_router, *router_bias, *w_gate, *w_up, *w_down, *ws_gate, *ws_up, *ws_down, *final_gain;
  float* out;
  unsigned* bar; int* cnt; float* mod; float* ropec; float* ropes;
  bf16_t *win_t, *wuq_t, *wukv_t, *wout_t, *wsg_t, *wsd_t, *wgu_t, *wd_t;
  bf16_t *wsp_b, *wpool_t, *wr_hi, *wr_lo;
  bf16_t *h, *proj, *Q, *Kb, *V, *Y, *yrows, *ysh, *act;
  int* list; float* topw;
};

DI unsigned pack2(float lo, float hi) { f32x2 f = {lo, hi}; bf16x2_t b = __builtin_convertvector(f, bf16x2_t); return __builtin_bit_cast(unsigned, b); }
DI float bf2f(unsigned short b) { return __uint_as_float(((unsigned)b) << 16); }
DI float bflo(unsigned u) { return __uint_as_float(u << 16); }
DI float bfhi(unsigned u) { return __uint_as_float(u & 0xffff0000u); }
DI int otid() { int t = threadIdx.x; asm volatile("" : "+v"(t)); return t; }
DI float wsum(float v) { for (int o = 32; o; o >>= 1) v += __shfl_xor(v, o); return v; }
DI float silu_f(float x) { return x / (1.f + __expf(-x)); }
DI float gelu_tanh(float x) { float z = 0.7978845608028654f * (x + 0.044715f * x * x * x); float e = __expf(2.f * z); float t = 1.f - 2.f / (1.f + e); return 0.5f * x * (1.f + t); }

#define XB_TMO      128
#define XB_XCNT(j)  (256  + 64 * (j))
#define XB_XSUB(j)  (1280 + 64 * (j))
#define XB_XGEN(j)  (2304 + 64 * (j))
#define XB_TOP      3328
#define XB_TOPGEN   3392
#define XCD_BAR_WORDS 3456
#define XB_SPIN_CAP (1u << 20)
DI unsigned xb_ld(unsigned* p) { return __hip_atomic_load(p, __ATOMIC_RELAXED, __HIP_MEMORY_SCOPE_AGENT); }
DI unsigned xb_add(unsigned* p, unsigned v) { return __hip_atomic_fetch_add(p, v, __ATOMIC_RELAXED, __HIP_MEMORY_SCOPE_AGENT); }
DI unsigned xb_xcc_id() { return (unsigned)__builtin_amdgcn_s_getreg((3 << 11) | 20) & 0xFu; }
#define XB_SPIN(cond, bar) do { unsigned _sp = 0; while (cond) { __builtin_amdgcn_s_sleep(1); \
    if ((++_sp & 255u) == 0u) { if (xb_ld(&(bar)[XB_TMO])) break; if (_sp > XB_SPIN_CAP) { atomicAdd(&(bar)[XB_TMO], 1u); break; } } } } while (0)
struct XcdBarrier { unsigned* bar; unsigned x; volatile LAS unsigned* st; };
DI XcdBarrier xcd_barrier_post(unsigned* bar, volatile LAS unsigned* st) {
  XcdBarrier b; b.bar = bar; b.x = xb_xcc_id(); b.st = st;
  if (threadIdx.x == 0) (void)xb_add(&bar[XB_XCNT(b.x)], 1u);
  return b;
}
DI void xcd_barrier_complete(unsigned* bar, unsigned x, unsigned& nloc, unsigned& nx) {
  const unsigned G = gridDim.x * gridDim.y * gridDim.z;
  unsigned sum, cnt, mine, sp = 0u;
  for (;;) {
    sum = 0u; cnt = 0u; mine = 0u;
#pragma unroll
    for (unsigned j = 0; j < 16; ++j) { const unsigned c = xb_ld(&bar[XB_XCNT(j)]); sum += c; cnt += (c > 0u) ? 1u : 0u; mine = (j == x) ? c : mine; }
    if (sum == G) break;
    __builtin_amdgcn_s_sleep(1);
    if ((++sp & 255u) == 0u) { if (xb_ld(&bar[XB_TMO])) break; if (sp > XB_SPIN_CAP) { atomicAdd(&bar[XB_TMO], 1u); break; } }
  }
  nloc = mine > 0u ? mine : 1u; nx = cnt > 0u ? cnt : 1u;
}
DI void xcd_barrier(const XcdBarrier& b) {
  asm volatile("s_waitcnt vmcnt(0)" ::: "memory");
  __syncthreads();
  if (threadIdx.x == 0) {
    unsigned* bar = b.bar;
    __builtin_amdgcn_s_waitcnt(0);
    unsigned nloc = b.st[0], nx = b.st[1];
    if (nloc == 0u) { xcd_barrier_complete(bar, b.x, nloc, nx); b.st[0] = nloc; b.st[1] = nx; }
    const unsigned old = xb_add(&bar[XB_XSUB(b.x)], 1u);
    const unsigned gen = old / nloc;
    if (old + 1u == (gen + 1u) * nloc) {
      __builtin_amdgcn_fence(__ATOMIC_RELEASE, "agent");
      asm volatile("s_waitcnt vmcnt(0)" ::: "memory");
      const unsigned og = xb_add(&bar[XB_TOP], 1u);
      const unsigned tg = og / nx;
      if (og + 1u == (tg + 1u) * nx) xb_add(&bar[XB_TOPGEN], 1u);
      else XB_SPIN(xb_ld(&bar[XB_TOPGEN]) == tg, bar);
      __builtin_amdgcn_fence(__ATOMIC_ACQUIRE, "agent");
      xb_add(&bar[XB_XGEN(b.x)], 1u);
      asm volatile("s_waitcnt vmcnt(0)" ::: "memory");
    } else {
      XB_SPIN(xb_ld(&bar[XB_XGEN(b.x)]) == gen, bar);
      __builtin_amdgcn_fence(__ATOMIC_ACQUIRE, "agent");
      asm volatile("s_waitcnt vmcnt(0)" ::: "memory");
    }
  }
  __syncthreads();
}

template <class Epi>
DI void gemm128(unsigned char* smem, const bf16_t* (&ap)[4], const bf16_t* (&bp)[4], int nk, Epi&& epi) {
  const int tid = otid(), lane = tid & 63, w = tid >> 6;
  const int wm = w >> 1, wn = w & 1;
  const int r_s = tid >> 3, c_s = tid & 7;
  const int st_off = r_s * 128 + ((c_s ^ (r_s & 7)) << 4);
  const int fr = lane & 15, fq = lane >> 4;
  const int sw0 = ((0 + fq) ^ (fr & 7)) << 4, sw1 = ((4 + fq) ^ (fr & 7)) << 4;
  const int arow_off = (wm * 64 + fr) * 128, brow_off = 32768 + (wn * 64 + fr) * 128;
  u32x4 ra[4], rb[4];
  f32x4 acc[4][4];
#pragma unroll
  for (int i = 0; i < 4; ++i)
#pragma unroll
    for (int j = 0; j < 4; ++j) acc[i][j] = (f32x4){0.f, 0.f, 0.f, 0.f};
#pragma unroll
  for (int j = 0; j < 4; ++j) { ra[j] = *(const u32x4*)(ap[j]); rb[j] = *(const u32x4*)(bp[j]); }
#pragma unroll
  for (int j = 0; j < 4; ++j) { *(u32x4*)(smem + st_off + j * 4096) = ra[j]; *(u32x4*)(smem + 32768 + st_off + j * 4096) = rb[j]; }
  __syncthreads();
  for (int kt = 0; kt < nk; ++kt) {
    const int cur = (kt & 1) * 16384;
    const bool more = (kt + 1 < nk);
    if (more) {
#pragma unroll
      for (int j = 0; j < 4; ++j) { ra[j] = *(const u32x4*)(ap[j] + (kt + 1) * 64); rb[j] = *(const u32x4*)(bp[j] + (kt + 1) * 64); }
    }
#pragma unroll
    for (int ks = 0; ks < 2; ++ks) {
      const int sw = ks ? sw1 : sw0;
      bf16x8 af[4], bfr[4];
#pragma unroll
      for (int i = 0; i < 4; ++i) af[i] = *(const bf16x8*)(smem + cur + arow_off + i * 2048 + sw);
#pragma unroll
      for (int j = 0; j < 4; ++j) bfr[j] = *(const bf16x8*)(smem + cur + brow_off + j * 2048 + sw);
#pragma unroll
      for (int i = 0; i < 4; ++i)
#pragma unroll
        for (int j = 0; j < 4; ++j) acc[i][j] = __builtin_amdgcn_mfma_f32_16x16x32_bf16(bfr[j], af[i], acc[i][j], 0, 0, 0);
    }
    if (more) {
      const int nxt = 16384 - cur;
#pragma unroll
      for (int j = 0; j < 4; ++j) { *(u32x4*)(smem + nxt + st_off + j * 4096) = ra[j]; *(u32x4*)(smem + 32768 + nxt + st_off + j * 4096) = rb[j]; }
    }
    __syncthreads();
  }
  epi(acc, wm, wn, fr, fq);
}

DI void item_mod(const P& p, unsigned char* smem, int item) {
  const int l = item / 96, cb = item % 96;
  const int tid = otid(), w = tid >> 6, lane = tid & 63;
  float* sc = (float*)smem;
  float* red = (float*)(smem + 32768);
  __syncthreads();
  for (int i = tid; i < 8192; i += NTHREADS) sc[i] = silu_f(p.c[i]);
  __syncthreads();
  const int col = cb * 64 + lane;
  const float* W = p.w_ada + (size_t)l * 1024 * 6144 + col;
  float acc[8];
#pragma unroll
  for (int b = 0; b < 8; ++b) acc[b] = 0.f;
  for (int k = w * 256; k < w * 256 + 256; ++k) {
    const float wv = W[(size_t)k * 6144];
#pragma unroll
    for (int b = 0; b < 8; ++b) acc[b] += sc[b * 1024 + k] * wv;
  }
#pragma unroll
  for (int b = 0; b < 8; ++b) red[(w * 8 + b) * 64 + lane] = acc[b];
  __syncthreads();
  for (int o = tid; o < 512; o += NTHREADS) {
    const int b = o >> 6, cc = o & 63;
    const float v = red[(0 * 8 + b) * 64 + cc] + red[(1 * 8 + b) * 64 + cc] + red[(2 * 8 + b) * 64 + cc] + red[(3 * 8 + b) * 64 + cc];
    p.mod[((size_t)l * 8 + b) * 6144 + cb * 64 + cc] = v + p.b_ada[(size_t)l * 6144 + cb * 64 + cc];
  }
}

DI void conv_tile(unsigned char* smem, const float* src, int ldsrc, int k0, int n0, bf16_t* dst, int lddst, int mode, const float* kscale) {
  float* t = (float*)smem;
  const int tid = otid();
  __syncthreads();
  {
    const int kk = tid >> 3, nq = tid & 7;
#pragma unroll
    for (int hh = 0; hh < 2; ++hh) {
      const int k = kk + 32 * hh;
      const float4 v = *(const float4*)(src + (size_t)(k0 + k) * ldsrc + n0 + nq * 4);
      const float s = kscale ? kscale[k0 + k] : 1.f;
      t[k * 33 + nq * 4 + 0] = v.x * s; t[k * 33 + nq * 4 + 1] = v.y * s; t[k * 33 + nq * 4 + 2] = v.z * s; t[k * 33 + nq * 4 + 3] = v.w * s;
    }
  }
  __syncthreads();
  {
    const int n = tid >> 3, kc = tid & 7;
    u32x4 wv;
    wv.x = pack2(t[(kc * 8 + 0) * 33 + n], t[(kc * 8 + 1) * 33 + n]);
    wv.y = pack2(t[(kc * 8 + 2) * 33 + n], t[(kc * 8 + 3) * 33 + n]);
    wv.z = pack2(t[(kc * 8 + 4) * 33 + n], t[(kc * 8 + 5) * 33 + n]);
    wv.w = pack2(t[(kc * 8 + 6) * 33 + n], t[(kc * 8 + 7) * 33 + n]);
    const int nn = n0 + n;
    const int orow = (mode == 0) ? nn : (32 * (nn >> 4) + (nn & 15) + (mode == 2 ? 16 : 0));
    *(u32x4*)(dst + (size_t)orow * lddst + k0 + kc * 8) = wv;
  }
}

DI void item_conv(const P& p, unsigned char* smem, int l, int idx) {
  if (idx < 592) { conv_tile(smem, p.w_in + (size_t)l * 1024 * NIN, NIN, (idx / 37) * 64, (idx % 37) * 32, p.win_t, 1024, 0, nullptr); return; }
  idx -= 592;
  if (idx < 96) { conv_tile(smem, p.w_uq + (size_t)l * 256 * 768, 768, (idx / 24) * 64, (idx % 24) * 32, p.wuq_t, 256, 0, p.g_q + l * 256); return; }
  idx -= 96;
  if (idx < 64) { conv_tile(smem, p.w_ukv + (size_t)l * 128 * 1024, 1024, (idx / 32) * 64, (idx % 32) * 32, p.wukv_t, 128, 0, p.g_kv + l * 128); return; }
  idx -= 64;
  if (idx < 512) { conv_tile(smem, p.w_out + (size_t)l * 1024 * 1024, 1024, (idx / 32) * 64, (idx % 32) * 32, p.wout_t, 1024, 0, nullptr); return; }
  idx -= 512;
  if (idx < 128) { conv_tile(smem, p.ws_gate + (size_t)l * 1024 * 256, 256, (idx / 8) * 64, (idx % 8) * 32, p.wsg_t, 1024, 1, nullptr); return; }
  idx -= 128;
  if (idx < 128) { conv_tile(smem, p.ws_up + (size_t)l * 1024 * 256, 256, (idx / 8) * 64, (idx % 8) * 32, p.wsg_t, 1024, 2, nullptr); return; }
  idx -= 128;
  if (idx < 128) { conv_tile(smem, p.ws_down + (size_t)l * 256 * 1024, 1024, (idx / 32) * 64, (idx % 32) * 32, p.wsd_t, 256, 0, nullptr); return; }
  idx -= 128;
  const int e = idx / 384, r = idx % 384;
  if (r < 128) conv_tile(smem, p.w_gate + ((size_t)l * 64 + e) * 1024 * 256, 256, (r / 8) * 64, (r % 8) * 32, p.wgu_t + (size_t)e * 512 * 1024, 1024, 1, nullptr);
  else if (r < 256) conv_tile(smem, p.w_up + ((size_t)l * 64 + e) * 1024 * 256, 256, ((r - 128) / 8) * 64, ((r - 128) % 8) * 32, p.wgu_t + (size_t)e * 512 * 1024, 1024, 2, nullptr);
  else conv_tile(smem, p.w_down + ((size_t)l * 64 + e) * 256 * 1024, 1024, ((r - 256) / 32) * 64, ((r - 256) % 32) * 32, p.wd_t + (size_t)e * 1024 * 256, 256, 0, nullptr);
}

constexpr int MISC_ITEMS = 64 + 128 + 512;
DI void item_misc(const P& p, int item) {
  const int tid = otid();
  if (item < 64) {
    const int i = (item * NTHREADS + tid) * 8;
    const int k0 = i & 127, t = (i >> 7) & 127;
    const float4 a = *(const float4*)(p.w_spatial + i), c = *(const float4*)(p.w_spatial + i + 4);
    u32x4 o;
    o.x = pack2(k0 + 0 <= t ? a.x : 0.f, k0 + 1 <= t ? a.y : 0.f); o.y = pack2(k0 + 2 <= t ? a.z : 0.f, k0 + 3 <= t ? a.w : 0.f);
    o.z = pack2(k0 + 4 <= t ? c.x : 0.f, k0 + 5 <= t ? c.y : 0.f); o.w = pack2(k0 + 6 <= t ? c.z : 0.f, k0 + 7 <= t ? c.w : 0.f);
    *(u32x4*)(p.wsp_b + i) = o;
  } else if (item < 64 + 128) {
    const int i = (item - 64) * NTHREADS + tid;
    const int c = i & 63, dd = (i >> 6) & 63, lg = i >> 12;
    const f32x2 f = {p.w_pool[((size_t)lg * 64 + c) * 64 + dd], 0.f}; const bf16x2_t bb = __builtin_convertvector(f, bf16x2_t);
    p.wpool_t[i] = (bf16_t)(__builtin_bit_cast(unsigned, bb) & 0xffffu);
  } else {
    const int i = (item - 192) * NTHREADS + tid;
    const int e = i & 63, k = (i >> 6) & 1023, l = i >> 16;
    const float v = p.w_router[i];
    const unsigned hi = pack2(v, 0.f) & 0xffffu;
    const unsigned lo = pack2(v - bflo(hi), 0.f) & 0xffffu;
    p.wr_hi[(size_t)l * 65536 + e * 1024 + k] = (bf16_t)hi;
    p.wr_lo[(size_t)l * 65536 + e * 1024 + k] = (bf16_t)lo;
  }
}

DI void item_rope(const P& p, int item) {
  const int i = item * NTHREADS + otid();
  const int t = i >> 4, f = i & 15;
  const float inv = exp2f(-(float)(2 * f) * (13.287712379549449f / 32.f));
  const float ang = (float)p.pos[t] * inv;
  const double rev = (double)ang * 0.15915494309189535;
  const float fr = (float)(rev - floor(rev));
  p.ropec[i] = __builtin_amdgcn_cosf(fr);
  p.ropes[i] = __builtin_amdgcn_sinf(fr);
}

DI void item_norm0(const P& p, int item) {
  const int tid = otid(), w = tid >> 6, lane = tid & 63;
  const int t = item * 4 + w, b = t >> 11;
  const float* xr = p.x + (size_t)t * 1024;
  const float* md = p.mod + (size_t)b * 6144;
  float4 v[4]; float ss = 0.f;
#pragma unroll
  for (int j = 0; j < 4; ++j) { v[j] = *(const float4*)(xr + j * 256 + lane * 4); ss += v[j].x * v[j].x + v[j].y * v[j].y + v[j].z * v[j].z + v[j].w * v[j].w; }
  ss = wsum(ss);
  const float rstd = rsqrtf(ss * (1.f / 1024.f) + EPS);
#pragma unroll
  for (int j = 0; j < 4; ++j) {
    const int idx = j * 256 + lane * 4;
    const float4 sh = *(const float4*)(md + idx), sc = *(const float4*)(md + 1024 + idx);
    u32x2 o;
    o.x = pack2(v[j].x * rstd * (1.f + sc.x) + sh.x, v[j].y * rstd * (1.f + sc.y) + sh.y);
    o.y = pack2(v[j].z * rstd * (1.f + sc.z) + sh.z, v[j].w * rstd * (1.f + sc.w) + sh.w);
    *(u32x2*)(p.h + (size_t)t * 1024 + idx) = o;
  }
}

DI void item_p1(const P& p, unsigned char* smem, int item) {
  const int m = item / 10, nt = item % 10;
  const int tid = otid(), r_s = tid >> 3, c_s = tid & 7;
  const bf16_t* ap[4]; const bf16_t* bp[4];
#pragma unroll
  for (int j = 0; j < 4; ++j) {
    const int row = r_s + 32 * j;
    ap[j] = p.h + (size_t)(m * 128 + row) * 1024 + c_s * 8;
    int n = nt * 128 + row; n = n < NIN ? n : NIN - 1;
    bp[j] = p.win_t + (size_t)n * 1024 + c_s * 8;
  }
  bf16_t* proj = p.proj;
  gemm128(smem, ap, bp, 16, [=](f32x4 (&acc)[4][4], int wm, int wn, int fr, int fq) {
#pragma unroll
    for (int i = 0; i < 4; ++i) {
      const int t = m * 128 + wm * 64 + i * 16 + fr;
#pragma unroll
      for (int j = 0; j < 4; ++j) {
        const int n = nt * 128 + wn * 64 + j * 16 + fq * 4;
        if (n < NIN) { u32x2 o; o.x = pack2(acc[i][j][0], acc[i][j][1]); o.y = pack2(acc[i][j][2], acc[i][j][3]); *(u32x2*)(proj + (size_t)t * NIN + n) = o; }
      }
    }
  });
}

DI void item_qproj(const P& p, unsigned char* smem, int item) {
  const int m = item / 6, nt = item % 6;
  const int tid = otid(), r_s = tid >> 3, c_s = tid & 7;
  float* rowf = (float*)(smem + SMEM_MAIN + 1024);
  __syncthreads();
  {
    const int row = tid >> 1, half = tid & 1;
    const bf16_t* src = p.proj + (size_t)(m * 128 + row) * NIN + 768 + half * 128;
    float ss = 0.f;
#pragma unroll
    for (int q = 0; q < 16; ++q) {
      const u32x4 v = *(const u32x4*)(src + q * 8);
      ss += bflo(v.x) * bflo(v.x) + bfhi(v.x) * bfhi(v.x) + bflo(v.y) * bflo(v.y) + bfhi(v.y) * bfhi(v.y) + bflo(v.z) * bflo(v.z) + bfhi(v.z) * bfhi(v.z) + bflo(v.w) * bflo(v.w) + bfhi(v.w) * bfhi(v.w);
    }
    ss += __shfl_xor(ss, 1);
    if (half == 0) rowf[row] = rsqrtf(ss * (1.f / 256.f) + EPS);
  }
  const bf16_t* ap[4]; const bf16_t* bp[4];
#pragma unroll
  for (int j = 0; j < 4; ++j) {
    const int row = r_s + 32 * j;
    ap[j] = p.proj + (size_t)(m * 128 + row) * NIN + 768 + c_s * 8;
    bp[j] = p.wuq_t + (size_t)(nt * 128 + row) * 256 + c_s * 8;
  }
  bf16_t* Q = p.Q; const float* ropec = p.ropec; const float* ropes = p.ropes;
  const float QS = 0.10206207261596577f * 1.4426950408889634f;
  gemm128(smem, ap, bp, 4, [=](f32x4 (&acc)[4][4], int wm, int wn, int fr, int fq) {
#pragma unroll
    for (int i = 0; i < 4; ++i) {
      const int tl = wm * 64 + i * 16 + fr, t = m * 128 + tl;
      const int b = t >> 11, s = t & 2047;
      const float rs = rowf[tl] * QS;
#pragma unroll
      for (int j = 0; j < 4; ++j) {
        const int c0 = nt * 128 + wn * 64 + j * 16;
        const int head = c0 / 96, d0 = c0 % 96;
        bf16_t* dst = Q + ((size_t)((b * 8 + head) * 2048 + s)) * 96 + d0 + fq * 4;
        if (d0 == 64) {
          if (j < 3) {
            const float4 cs = *(const float4*)(ropec + (size_t)t * 16 + fq * 4), sn = *(const float4*)(ropes + (size_t)t * 16 + fq * 4);
            const f32x4 x1 = acc[i][j] * rs, x2 = acc[i][j + 1 < 4 ? j + 1 : 3] * rs;
            u32x2 o1, o2;
            o1.x = pack2(x1[0] * cs.x - x2[0] * sn.x, x1[1] * cs.y - x2[1] * sn.y);
            o1.y = pack2(x1[2] * cs.z - x2[2] * sn.z, x1[3] * cs.w - x2[3] * sn.w);
            o2.x = pack2(x2[0] * cs.x + x1[0] * sn.x, x2[1] * cs.y + x1[1] * sn.y);
            o2.y = pack2(x2[2] * cs.z + x1[2] * sn.z, x2[3] * cs.w + x1[3] * sn.w);
            *(u32x2*)dst = o1; *(u32x2*)(dst + 16) = o2;
          }
        } else if (d0 != 80) {
          const f32x4 x = acc[i][j] * rs;
          u32x2 o; o.x = pack2(x[0], x[1]); o.y = pack2(x[2], x[3]);
          *(u32x2*)dst = o;
        }
      }
    }
  });
}

DI void item_kvproj(const P& p, unsigned char* smem, int item) {
  const int m = item >> 3, head = item & 7;
  const int tid = otid(), r_s = tid >> 3, c_s = tid & 7;
  float* rowf = (float*)(smem + SMEM_MAIN + 1024);
  __syncthreads();
  {
    const int row = tid >> 1, half = tid & 1;
    const int t = m * 128 + row, b = t >> 11, s = t & 2047;
    const bf16_t* src = p.proj + (size_t)t * NIN + 1024 + half * 64;
    float ss = 0.f;
#pragma unroll
    for (int q = 0; q < 8; ++q) {
      const u32x4 v = *(const u32x4*)(src + q * 8);
      ss += bflo(v.x) * bflo(v.x) + bfhi(v.x) * bfhi(v.x) + bflo(v.y) * bflo(v.y) + bfhi(v.y) * bfhi(v.y) + bflo(v.z) * bflo(v.z) + bfhi(v.z) * bfhi(v.z) + bflo(v.w) * bflo(v.w) + bfhi(v.w) * bfhi(v.w);
    }
    ss += __shfl_xor(ss, 1);
    if (half == 0) rowf[row] = rsqrtf(ss * (1.f / 128.f) + EPS);
    const bf16_t* kp = p.proj + (size_t)t * NIN + 1152 + half * 8;
    const u32x4 a1 = *(const u32x4*)kp, a2 = *(const u32x4*)(kp + 16);
    const float* cp = p.ropec + (size_t)t * 16 + half * 8; const float* sp = p.ropes + (size_t)t * 16 + half * 8;
    const float4 c0 = *(const float4*)cp, c1 = *(const float4*)(cp + 4), s0 = *(const float4*)sp, s1 = *(const float4*)(sp + 4);
    const float x1[8] = {bflo(a1.x), bfhi(a1.x), bflo(a1.y), bfhi(a1.y), bflo(a1.z), bfhi(a1.z), bflo(a1.w), bfhi(a1.w)};
    const float x2[8] = {bflo(a2.x), bfhi(a2.x), bflo(a2.y), bfhi(a2.y), bflo(a2.z), bfhi(a2.z), bflo(a2.w), bfhi(a2.w)};
    const float cc[8] = {c0.x, c0.y, c0.z, c0.w, c1.x, c1.y, c1.z, c1.w};
    const float sn[8] = {s0.x, s0.y, s0.z, s0.w, s1.x, s1.y, s1.z, s1.w};
    u32x4 o1, o2;
    o1.x = pack2(x1[0] * cc[0] - x2[0] * sn[0], x1[1] * cc[1] - x2[1] * sn[1]);
    o1.y = pack2(x1[2] * cc[2] - x2[2] * sn[2], x1[3] * cc[3] - x2[3] * sn[3]);
    o1.z = pack2(x1[4] * cc[4] - x2[4] * sn[4], x1[5] * cc[5] - x2[5] * sn[5]);
    o1.w = pack2(x1[6] * cc[6] - x2[6] * sn[6], x1[7] * cc[7] - x2[7] * sn[7]);
    o2.x = pack2(x2[0] * cc[0] + x1[0] * sn[0], x2[1] * cc[1] + x1[1] * sn[1]);
    o2.y = pack2(x2[2] * cc[2] + x1[2] * sn[2], x2[3] * cc[3] + x1[3] * sn[3]);
    o2.z = pack2(x2[4] * cc[4] + x1[4] * sn[4], x2[5] * cc[5] + x1[5] * sn[5]);
    o2.w = pack2(x2[6] * cc[6] + x1[6] * sn[6], x2[7] * cc[7] + x1[7] * sn[7]);
    bf16_t* kd = p.Kb + ((size_t)((b * 8 + head) * 2048 + s)) * 96 + 64 + half * 8;
    *(u32x4*)kd = o1; *(u32x4*)(kd + 16) = o2;
  }
  const bf16_t* ap[4]; const bf16_t* bp[4];
#pragma unroll
  for (int j = 0; j < 4; ++j) {
    const int row = r_s + 32 * j;
    ap[j] = p.proj + (size_t)(m * 128 + row) * NIN + 1024 + c_s * 8;
    bp[j] = p.wukv_t + (size_t)(head * 128 + row) * 128 + c_s * 8;
  }
  bf16_t* Kb = p.Kb; bf16_t* V = p.V;
  gemm128(smem, ap, bp, 2, [=](f32x4 (&acc)[4][4], int wm, int wn, int fr, int fq) {
#pragma unroll
    for (int i = 0; i < 4; ++i) {
      const int tl = wm * 64 + i * 16 + fr, t = m * 128 + tl;
      const int b = t >> 11, s = t & 2047;
      const float rs = rowf[tl];
      const size_t rowi = (size_t)((b * 8 + head) * 2048 + s);
#pragma unroll
      for (int j = 0; j < 4; ++j) {
        const int d = j * 16 + fq * 4;
        const f32x4 x = acc[i][j] * rs;
        u32x2 o; o.x = pack2(x[0], x[1]); o.y = pack2(x[2], x[3]);
        if (wn == 0) *(u32x2*)(Kb + rowi * 96 + d) = o; else *(u32x2*)(V + rowi * 64 + d) = o;
      }
    }
  });
}

DI void item_pool(const P& p, unsigned char* smem, int l, int item) {
  const int tid = otid(), w = tid >> 6, lane = tid & 63, fr = lane & 15, fq = lane >> 4;
  const int tile = item >> 2, g = item & 3;
  const int t0 = tile * 128, s0 = t0 & 2047;
  const int wdw = 2 << g;
  unsigned char* al = smem;
  unsigned char* dl = smem + 20480;
  __syncthreads();
  for (int id = tid; id < 143 * 8; id += NTHREADS) {
    const int row = id >> 3, c = id & 7;
    const int srel = s0 - 15 + row;
    u32x4 v = (u32x4){0u, 0u, 0u, 0u};
    if (srel >= 0) v = *(const u32x4*)(p.proj + (size_t)(t0 - 15 + row) * NIN + g * 64 + c * 8);
    *(u32x4*)(al + row * 128 + c * 16) = v;
  }
  __syncthreads();
  {
    const int tl = tid >> 1, cb = (tid & 1) * 4;
    const int pos = s0 + tl;
    const int nw = (pos + 1 < wdw) ? pos + 1 : wdw;
    const float inv = 1.f / (float)nw;
#pragma unroll
    for (int q = 0; q < 4; ++q) {
      const int c = cb + q;
      float sm[8];
#pragma unroll
      for (int e = 0; e < 8; ++e) sm[e] = 0.f;
      for (int j = 0; j < nw; ++j) {
        const u32x4 v = *(const u32x4*)(al + (tl + 15 - j) * 128 + c * 16);
        sm[0] += bflo(v.x); sm[1] += bfhi(v.x); sm[2] += bflo(v.y); sm[3] += bfhi(v.y); sm[4] += bflo(v.z); sm[5] += bfhi(v.z); sm[6] += bflo(v.w); sm[7] += bfhi(v.w);
      }
      const u32x4 a = *(const u32x4*)(al + (tl + 15) * 128 + c * 16);
      u32x4 o;
      o.x = pack2(sm[0] * inv - bflo(a.x), sm[1] * inv - bfhi(a.x)); o.y = pack2(sm[2] * inv - bflo(a.y), sm[3] * inv - bfhi(a.y));
      o.z = pack2(sm[4] * inv - bflo(a.z), sm[5] * inv - bfhi(a.z)); o.w = pack2(sm[6] * inv - bflo(a.w), sm[7] * inv - bfhi(a.w));
      *(u32x4*)(dl + tl * 128 + ((c ^ (tl & 7)) << 4)) = o;
    }
  }
  __syncthreads();
  {
    const bf16_t* wp = p.wpool_t + ((size_t)(l * 4 + g) * 64) * 64;
    f32x4 acc[2][4];
#pragma unroll
    for (int i = 0; i < 2; ++i)
#pragma unroll
      for (int j = 0; j < 4; ++j) acc[i][j] = (f32x4){0.f, 0.f, 0.f, 0.f};
#pragma unroll
    for (int ks = 0; ks < 2; ++ks) {
      bf16x8 df[2], wf[4];
#pragma unroll
      for (int i = 0; i < 2; ++i) { const int row = w * 32 + i * 16 + fr; df[i] = *(const bf16x8*)(dl + row * 128 + (((ks * 4 + fq) ^ (row & 7)) << 4)); }
#pragma unroll
      for (int j = 0; j < 4; ++j) wf[j] = *(const bf16x8*)(wp + (size_t)(j * 16 + fr) * 64 + ks * 32 + fq * 8);
#pragma unroll
      for (int i = 0; i < 2; ++i)
#pragma unroll
        for (int j = 0; j < 4; ++j) acc[i][j] = __builtin_amdgcn_mfma_f32_16x16x32_bf16(wf[j], df[i], acc[i][j], 0, 0, 0);
    }
#pragma unroll
    for (int i = 0; i < 2; ++i) {
      const int t = t0 + w * 32 + i * 16 + fr;
#pragma unroll
      for (int j = 0; j < 4; ++j) {
        const int cc = g * 64 + j * 16 + fq * 4;
        const float4 ps = *(const float4*)(p.pool_scale + l * 256 + cc);
        u32x2 o; o.x = pack2(acc[i][j][0] * ps.x, acc[i][j][1] * ps.y); o.y = pack2(acc[i][j][2] * ps.z, acc[i][j][3] * ps.w);
        *(u32x2*)(p.Y + (size_t)t * 1024 + cc) = o;
      }
    }
  }
}

DI void item_sgu(const P& p, unsigned char* smem, int l, int chunk) {
  const int tid = otid(), w = tid >> 6, lane = tid & 63, fr = lane & 15, fq = lane >> 4;
  const int t0 = chunk * 128;
  unsigned char* vn = smem;
  __syncthreads();
#pragma unroll 1
  for (int ps = 0; ps < 4; ++ps) {
    const int tl = ps * 32 + (tid >> 3), part = tid & 7;
    const bf16_t* src = p.proj + (size_t)(t0 + tl) * NIN + 512 + part * 32;
    float x[32];
#pragma unroll
    for (int q = 0; q < 4; ++q) {
      const u32x4 v = *(const u32x4*)(src + q * 8);
      x[q * 8 + 0] = gelu_tanh(bflo(v.x)); x[q * 8 + 1] = gelu_tanh(bfhi(v.x)); x[q * 8 + 2] = gelu_tanh(bflo(v.y)); x[q * 8 + 3] = gelu_tanh(bfhi(v.y));
      x[q * 8 + 4] = gelu_tanh(bflo(v.z)); x[q * 8 + 5] = gelu_tanh(bfhi(v.z)); x[q * 8 + 6] = gelu_tanh(bflo(v.w)); x[q * 8 + 7] = gelu_tanh(bfhi(v.w));
    }
    float sm = 0.f;
#pragma unroll
    for (int e = 0; e < 32; ++e) sm += x[e];
    sm += __shfl_xor(sm, 1); sm += __shfl_xor(sm, 2); sm += __shfl_xor(sm, 4);
    const float mu = sm * (1.f / 256.f);
    float vs = 0.f;
#pragma unroll
    for (int e = 0; e < 32; ++e) { x[e] -= mu; vs += x[e] * x[e]; }
    vs += __shfl_xor(vs, 1); vs += __shfl_xor(vs, 2); vs += __shfl_xor(vs, 4);
    const float rstd = rsqrtf(vs * (1.f / 256.f) + EPS);
#pragma unroll
    for (int q = 0; q < 4; ++q) {
      const int c = part * 4 + q;
      u32x4 o;
      o.x = pack2(x[q * 8 + 0] * rstd, x[q * 8 + 1] * rstd); o.y = pack2(x[q * 8 + 2] * rstd, x[q * 8 + 3] * rstd);
      o.z = pack2(x[q * 8 + 4] * rstd, x[q * 8 + 5] * rstd); o.w = pack2(x[q * 8 + 6] * rstd, x[q * 8 + 7] * rstd);
      *(u32x4*)(vn + tl * 512 + (((c >> 1) ^ (tl & 7)) << 5) + ((c & 1) << 4)) = o;
    }
  }
  __syncthreads();
  const int qq = fr >> 2, pp = fr & 3;
#pragma unroll 1
  for (int hh = 0; hh < 4; ++hh) {
    f32x4 acc[4][2];
#pragma unroll
    for (int df = 0; df < 4; ++df) { acc[df][0] = (f32x4){0.f, 0.f, 0.f, 0.f}; acc[df][1] = (f32x4){0.f, 0.f, 0.f, 0.f}; }
    const bf16_t* wb = p.wsp_b + ((size_t)(l * 4 + hh) * 128) * 128;
    for (int kb = 0; kb <= w; ++kb) {
      bf16x8 wf[2];
#pragma unroll
      for (int f = 0; f < 2; ++f) {
        const bf16_t* wr = wb + (size_t)((2 * w + f) * 16 + fr) * 128 + kb * 32 + fq * 4;
        const u32x2 lo = *(const u32x2*)wr, hi = *(const u32x2*)(wr + 16);
        u32x4 u; u.x = lo.x; u.y = lo.y; u.z = hi.x; u.w = hi.y;
        wf[f] = __builtin_bit_cast(bf16x8, u);
      }
#pragma unroll
      for (int df = 0; df < 4; ++df) {
        const int keyA = kb * 32 + fq * 4 + qq, keyB = keyA + 16;
        const int slot = hh * 4 + df;
        const s16x4 lo = __builtin_amdgcn_ds_read_tr16_b64_v4i16((LAS s16x4*)(vn + keyA * 512 + ((slot ^ (keyA & 7)) << 5) + pp * 8));
        const s16x4 hi = __builtin_amdgcn_ds_read_tr16_b64_v4i16((LAS s16x4*)(vn + keyB * 512 + ((slot ^ (keyB & 7)) << 5) + pp * 8));
        bf16x8 vf; vf[0] = lo[0]; vf[1] = lo[1]; vf[2] = lo[2]; vf[3] = lo[3]; vf[4] = hi[0]; vf[5] = hi[1]; vf[6] = hi[2]; vf[7] = hi[3];
        acc[df][0] = __builtin_amdgcn_mfma_f32_16x16x32_bf16(vf, wf[0], acc[df][0], 0, 0, 0);
        acc[df][1] = __builtin_amdgcn_mfma_f32_16x16x32_bf16(vf, wf[1], acc[df][1], 0, 0, 0);
      }
    }
#pragma unroll
    for (int f = 0; f < 2; ++f) {
      const int tl = (2 * w + f) * 16 + fr, t = t0 + tl;
      const float bias = p.b_spatial[(l * 4 + hh) * 128 + tl];
#pragma unroll
      for (int df = 0; df < 4; ++df) {
        const int d = hh * 64 + df * 16 + fq * 4;
        const u32x2 uu = *(const u32x2*)(p.proj + (size_t)t * NIN + 256 + d);
        u32x2 o;
        o.x = pack2(gelu_tanh(bflo(uu.x)) * (acc[df][f][0] + bias), gelu_tanh(bfhi(uu.x)) * (acc[df][f][1] + bias));
        o.y = pack2(gelu_tanh(bflo(uu.y)) * (acc[df][f][2] + bias), gelu_tanh(bfhi(uu.y)) * (acc[df][f][3] + bias));
        *(u32x2*)(p.Y + (size_t)t * 1024 + 256 + d) = o;
      }
    }
  }
}

DI void item_attn(const P& p, unsigned char* smem, int item) {
  const int tid = otid(), w = tid >> 6, lane = tid & 63;
  const int fr = lane & 15, fq = lane >> 4;
  const int rnd = item >> 9, blk = item & 511;
  const int qb = rnd == 0 ? 15 - (blk >> 6) : (blk >> 6);
  const int bh = blk & 63, b = bh >> 3, h = bh & 7;
  const int q0 = qb * 128;
  const int nkt = 2 * qb + 2;
  const bf16_t* Qg = p.Q + (size_t)bh * 2048 * 96;
  const bf16_t* Kg = p.Kb + (size_t)bh * 2048 * 96;
  const bf16_t* Vg = p.V + (size_t)bh * 2048 * 64;
  int kkey[3], kdst[3], kc[3];
#pragma unroll
  for (int j = 0; j < 3; ++j) { const int id = tid + 256 * j; kkey[j] = id / 12; kc[j] = id % 12; kdst[j] = kkey[j] * 256 + ((kc[j] ^ (kkey[j] & 15)) << 4); }
  int vkey[2], vdst[2], vc[2];
#pragma unroll
  for (int j = 0; j < 2; ++j) { const int id = tid + 256 * j; vkey[j] = id >> 3; vc[j] = id & 7; vdst[j] = vkey[j] * 128 + (((vc[j] >> 1) ^ ((vkey[j] >> 1) & 3)) << 5) + ((vc[j] & 1) << 4); }
  bf16x8 qf[3][2];
#pragma unroll
  for (int ks = 0; ks < 3; ++ks)
#pragma unroll
    for (int f = 0; f < 2; ++f) qf[ks][f] = *(const bf16x8*)(Qg + (size_t)(q0 + 32 * w + 16 * f + fr) * 96 + ks * 32 + fq * 8);
  f32x4 o[4][2];
#pragma unroll
  for (int f = 0; f < 4; ++f) { o[f][0] = (f32x4){0.f, 0.f, 0.f, 0.f}; o[f][1] = (f32x4){0.f, 0.f, 0.f, 0.f}; }
  float mrun[2] = {-INFINITY, -INFINITY}, lrun[2] = {0.f, 0.f};
  u32x4 rk[3], rv[2];
  __syncthreads();
#pragma unroll
  for (int j = 0; j < 3; ++j) rk[j] = *(const u32x4*)(Kg + (size_t)kkey[j] * 96 + kc[j] * 8);
#pragma unroll
  for (int j = 0; j < 2; ++j) rv[j] = *(const u32x4*)(Vg + (size_t)vkey[j] * 64 + vc[j] * 8);
#pragma unroll
  for (int j = 0; j < 3; ++j) *(u32x4*)(smem + kdst[j]) = rk[j];
#pragma unroll
  for (int j = 0; j < 2; ++j) *(u32x4*)(smem + 32768 + vdst[j]) = rv[j];
  __syncthreads();
  const int rowmin = q0 + 32 * w;
  for (int kt = 0; kt < nkt; ++kt) {
    const int cur = kt & 1;
    const bool more = kt + 1 < nkt;
    if (more) {
      const int key0n = (kt + 1) * 64;
#pragma unroll
      for (int j = 0; j < 3; ++j) rk[j] = *(const u32x4*)(Kg + (size_t)(key0n + kkey[j]) * 96 + kc[j] * 8);
#pragma unroll
      for (int j = 0; j < 2; ++j) rv[j] = *(const u32x4*)(Vg + (size_t)(key0n + vkey[j]) * 64 + vc[j] * 8);
    }
    const int key0 = kt * 64;
    if (key0 <= rowmin + 31) {
      const unsigned char* Kl = smem + cur * 16384;
      const unsigned char* Vl = smem + 32768 + cur * 8192;
      f32x4 st[4][2];
#pragma unroll
      for (int kf = 0; kf < 4; ++kf) { st[kf][0] = (f32x4){0.f, 0.f, 0.f, 0.f}; st[kf][1] = (f32x4){0.f, 0.f, 0.f, 0.f}; }
#pragma unroll
      for (int ks = 0; ks < 3; ++ks)
#pragma unroll
        for (int kf = 0; kf < 4; ++kf) {
          const int key = kf * 16 + fr;
          const bf16x8 a = *(const bf16x8*)(Kl + key * 256 + (((ks * 4 + fq) ^ (key & 15)) << 4));
          st[kf][0] = __builtin_amdgcn_mfma_f32_16x16x32_bf16(a, qf[ks][0], st[kf][0], 0, 0, 0);
          st[kf][1] = __builtin_amdgcn_mfma_f32_16x16x32_bf16(a, qf[ks][1], st[kf][1], 0, 0, 0);
        }
      const bool needmask = (key0 + 63 > rowmin);
#pragma unroll
      for (int f = 0; f < 2; ++f) {
        const int qabs = rowmin + 16 * f + fr;
        if (needmask) {
#pragma unroll
          for (int kf = 0; kf < 4; ++kf)
#pragma unroll
            for (int r = 0; r < 4; ++r) { const int kabs = key0 + kf * 16 + fq * 4 + r; if (kabs > qabs) st[kf][f][r] = -INFINITY; }
        }
        float mx = st[0][f][0];
#pragma unroll
        for (int kf = 0; kf < 4; ++kf)
#pragma unroll
          for (int r = 0; r < 4; ++r) mx = fmaxf(mx, st[kf][f][r]);
        mx = fmaxf(mx, __shfl_xor(mx, 16)); mx = fmaxf(mx, __shfl_xor(mx, 32));
        const float mnew = fmaxf(mrun[f], mx);
        const float alpha = __builtin_amdgcn_exp2f(mrun[f] - mnew);
        mrun[f] = mnew;
        float ls = 0.f;
#pragma unroll
        for (int kf = 0; kf < 4; ++kf)
#pragma unroll
          for (int r = 0; r < 4; ++r) { const float pv = __builtin_amdgcn_exp2f(st[kf][f][r] - mnew); st[kf][f][r] = pv; ls += pv; }
        lrun[f] = lrun[f] * alpha + ls;
#pragma unroll
        for (int df = 0; df < 4; ++df) o[df][f] = o[df][f] * alpha;
      }
      bf16x8 pf[2][2];
#pragma unroll
      for (int kb = 0; kb < 2; ++kb)
#pragma unroll
        for (int f = 0; f < 2; ++f) {
          u32x4 u;
          u.x = pack2(st[2 * kb][f][0], st[2 * kb][f][1]); u.y = pack2(st[2 * kb][f][2], st[2 * kb][f][3]);
          u.z = pack2(st[2 * kb + 1][f][0], st[2 * kb + 1][f][1]); u.w = pack2(st[2 * kb + 1][f][2], st[2 * kb + 1][f][3]);
          pf[kb][f] = __builtin_bit_cast(bf16x8, u);
        }
      const int qq = fr >> 2, pp = fr & 3;
#pragma unroll
      for (int kb = 0; kb < 2; ++kb)
#pragma unroll
        for (int df = 0; df < 4; ++df) {
          const int keyA = kb * 32 + fq * 4 + qq, keyB = keyA + 16;
          const int offA = keyA * 128 + ((df ^ ((keyA >> 1) & 3)) << 5) + pp * 8;
          const int offB = keyB * 128 + ((df ^ ((keyB >> 1) & 3)) << 5) + pp * 8;
          const s16x4 lo = __builtin_amdgcn_ds_read_tr16_b64_v4i16((LAS s16x4*)(Vl + offA));
          const s16x4 hi = __builtin_amdgcn_ds_read_tr16_b64_v4i16((LAS s16x4*)(Vl + offB));
          bf16x8 vf; vf[0] = lo[0]; vf[1] = lo[1]; vf[2] = lo[2]; vf[3] = lo[3]; vf[4] = hi[0]; vf[5] = hi[1]; vf[6] = hi[2]; vf[7] = hi[3];
          o[df][0] = __builtin_amdgcn_mfma_f32_16x16x32_bf16(vf, pf[kb][0], o[df][0], 0, 0, 0);
          o[df][1] = __builtin_amdgcn_mfma_f32_16x16x32_bf16(vf, pf[kb][1], o[df][1], 0, 0, 0);
        }
    }
    if (more) {
      const int nx = cur ^ 1;
#pragma unroll
      for (int j = 0; j < 3; ++j) *(u32x4*)(smem + nx * 16384 + kdst[j]) = rk[j];
#pragma unroll
      for (int j = 0; j < 2; ++j) *(u32x4*)(smem + 32768 + nx * 8192 + vdst[j]) = rv[j];
    }
    __syncthreads();
  }
#pragma unroll
  for (int f = 0; f < 2; ++f) {
    float lt = lrun[f]; lt += __shfl_xor(lt, 16); lt += __shfl_xor(lt, 32);
    const float inv = 1.f / lt;
    const int t = b * 2048 + rowmin + 16 * f + fr;
#pragma unroll
    for (int df = 0; df < 4; ++df) {
      const f32x4 x = o[df][f] * inv;
      u32x2 ov; ov.x = pack2(x[0], x[1]); ov.y = pack2(x[2], x[3]);
      *(u32x2*)(p.Y + (size_t)t * 1024 + 512 + h * 64 + df * 16 + fq * 4) = ov;
    }
  }
}

DI void item_p4(const P& p, unsigned char* smem, int l, int item) {
  const int m = item >> 3, nt = item & 7;
  const int tid = otid(), r_s = tid >> 3, c_s = tid & 7;
  const bf16_t* ap[4]; const bf16_t* bp[4];
#pragma unroll
  for (int j = 0; j < 4; ++j) {
    const int row = r_s + 32 * j;
    ap[j] = p.Y + (size_t)(m * 128 + row) * 1024 + c_s * 8;
    bp[j] = p.wout_t + (size_t)(nt * 128 + row) * 1024 + c_s * 8;
  }
  const float* xin = (l == 0) ? p.x : p.out;
  float* xout = p.out;
  const float* mod = p.mod + (size_t)l * 8 * 6144 + 2048;
  gemm128(smem, ap, bp, 16, [=](f32x4 (&acc)[4][4], int wm, int wn, int fr, int fq) {
#pragma unroll
    for (int i = 0; i < 4; ++i) {
      const int t = m * 128 + wm * 64 + i * 16 + fr, b = t >> 11;
#pragma unroll
      for (int j = 0; j < 4; ++j) {
        const int n = nt * 128 + wn * 64 + j * 16 + fq * 4;
        const float4 xv = *(const float4*)(xin + (size_t)t * 1024 + n);
        const float4 g = *(const float4*)(mod + (size_t)b * 6144 + n);
        float4 ov = {xv.x + g.x * acc[i][j][0], xv.y + g.y * acc[i][j][1], xv.z + g.z * acc[i][j][2], xv.w + g.w * acc[i][j][3]};
        *(float4*)(xout + (size_t)t * 1024 + n) = ov;
      }
    }
  });
}

DI void item_p5(const P& p, unsigned char* smem, int l, int item) {
  const int tid = otid(), w = tid >> 6, lane = tid & 63, fr = lane & 15, fq = lane >> 4;
  const int tb = item * 64 + w * 16;
  const int t = tb + fr, b = t >> 11;
  const float* xr = p.out + (size_t)t * 1024 + fq * 8;
  const float* md = p.mod + ((size_t)l * 8 + b) * 6144 + fq * 8;
  float ss = 0.f;
#pragma unroll 8
  for (int ks = 0; ks < 32; ++ks) {
    const float4 a = *(const float4*)(xr + ks * 32), c = *(const float4*)(xr + ks * 32 + 4);
    ss += a.x * a.x + a.y * a.y + a.z * a.z + a.w * a.w + c.x * c.x + c.y * c.y + c.z * c.z + c.w * c.w;
  }
  ss += __shfl_xor(ss, 16); ss += __shfl_xor(ss, 32);
  const float rstd = rsqrtf(ss * (1.f / 1024.f) + EPS);
  f32x4 acc[4];
#pragma unroll
  for (int nf = 0; nf < 4; ++nf) acc[nf] = (f32x4){0.f, 0.f, 0.f, 0.f};
  const bf16_t* whi = p.wr_hi + (size_t)l * 65536 + (size_t)fr * 1024 + fq * 8;
  const bf16_t* wlo = p.wr_lo + (size_t)l * 65536 + (size_t)fr * 1024 + fq * 8;
  bf16_t* hdst = p.h + (size_t)t * 1024 + fq * 8;
#pragma unroll 2
  for (int ks = 0; ks < 32; ++ks) {
    const float4 xa = *(const float4*)(xr + ks * 32), xb = *(const float4*)(xr + ks * 32 + 4);
    const float4 sa = *(const float4*)(md + 4096 + ks * 32), sb = *(const float4*)(md + 4096 + ks * 32 + 4);
    const float4 ha = *(const float4*)(md + 3072 + ks * 32), hb = *(const float4*)(md + 3072 + ks * 32 + 4);
    float hv[8];
    hv[0] = xa.x * rstd * (1.f + sa.x) + ha.x; hv[1] = xa.y * rstd * (1.f + sa.y) + ha.y; hv[2] = xa.z * rstd * (1.f + sa.z) + ha.z; hv[3] = xa.w * rstd * (1.f + sa.w) + ha.w;
    hv[4] = xb.x * rstd * (1.f + sb.x) + hb.x; hv[5] = xb.y * rstd * (1.f + sb.y) + hb.y; hv[6] = xb.z * rstd * (1.f + sb.z) + hb.z; hv[7] = xb.w * rstd * (1.f + sb.w) + hb.w;
    u32x4 uh, ul;
    uh.x = pack2(hv[0], hv[1]); uh.y = pack2(hv[2], hv[3]); uh.z = pack2(hv[4], hv[5]); uh.w = pack2(hv[6], hv[7]);
    ul.x = pack2(hv[0] - bflo(uh.x), hv[1] - bfhi(uh.x)); ul.y = pack2(hv[2] - bflo(uh.y), hv[3] - bfhi(uh.y));
    ul.z = pack2(hv[4] - bflo(uh.z), hv[5] - bfhi(uh.z)); ul.w = pack2(hv[6] - bflo(uh.w), hv[7] - bfhi(uh.w));
    *(u32x4*)(hdst + ks * 32) = uh;
    const bf16x8 bh = __builtin_bit_cast(bf16x8, uh), bl = __builtin_bit_cast(bf16x8, ul);
#pragma unroll
    for (int nf = 0; nf < 4; ++nf) {
      const bf16x8 ah = *(const bf16x8*)(whi + (size_t)nf * 16 * 1024 + ks * 32), al = *(const bf16x8*)(wlo + (size_t)nf * 16 * 1024 + ks * 32);
      acc[nf] = __builtin_amdgcn_mfma_f32_16x16x32_bf16(ah, bh, acc[nf], 0, 0, 0);
      acc[nf] = __builtin_amdgcn_mfma_f32_16x16x32_bf16(ah, bl, acc[nf], 0, 0, 0);
      acc[nf] = __builtin_amdgcn_mfma_f32_16x16x32_bf16(al, bh, acc[nf], 0, 0, 0);
    }
  }
  float* lg = (float*)smem + w * 1024;
  int* info = (int*)(smem + 16384) + w * 1024;
  __syncthreads();
#pragma unroll
  for (int nf = 0; nf < 4; ++nf) *(f32x4*)(lg + fr * 64 + nf * 16 + fq * 4) = acc[nf];
  __syncthreads();
  const float bias = p.router_bias[l * 64 + lane];
  int cnt_local = 0;
#pragma unroll 1
  for (int q = 0; q < 16; ++q) {
    const float s = 1.f / (1.f + __expf(-lg[q * 64 + lane]));
    const float sel = s + bias;
    float m1 = sel; m1 = fmaxf(m1, __shfl_xor(m1, 1)); m1 = fmaxf(m1, __shfl_xor(m1, 2)); m1 = fmaxf(m1, __shfl_xor(m1, 4));
    const unsigned long long eq = __ballot(sel == m1);
    const int gbase = lane & ~7;
    const unsigned gm = (unsigned)((eq >> gbase) & 0xffull);
    const int first = gbase + __ffs(gm) - 1;
    float m2 = (lane == first) ? -INFINITY : sel;
    m2 = fmaxf(m2, __shfl_xor(m2, 1)); m2 = fmaxf(m2, __shfl_xor(m2, 2)); m2 = fmaxf(m2, __shfl_xor(m2, 4));
    const float gs = m1 + m2;
    const int myg = lane >> 3; int rank = 0;
#pragma unroll
    for (int j = 0; j < 8; ++j) { const float gj = __shfl(gs, j * 8); rank += ((gj > gs) || (gj == gs && j < myg)) ? 1 : 0; }
    const bool gsel = rank < 4;
    const float sm = gsel ? sel : -INFINITY;
    int r = 0;
#pragma unroll 8
    for (int j = 0; j < 64; ++j) { const float sj = __shfl(sm, j); r += ((sj > sm) || (sj == sm && j < lane)) ? 1 : 0; }
    const bool ch = gsel && (r < 8);
    const float tot = wsum(ch ? s : 0.f);
    const unsigned long long cm = __ballot(ch);
    const int kidx = __popcll(cm & ((1ull << lane) - 1ull));
    info[q * 64 + lane] = ch ? kidx : -1;
    if (ch) p.topw[(size_t)(tb + q) * 8 + kidx] = s / tot * 2.5f;
    cnt_local += ch ? 1 : 0;
  }
  int base = 0;
  if (cnt_local > 0) base = atomicAdd(p.cnt + (l * 64 + lane) * CSTRIDE, cnt_local);
#pragma unroll 1
  for (int q = 0; q < 16; ++q) {
    const int k = info[q * 64 + lane];
    if (k >= 0) { p.list[(size_t)lane * LISTCAP + base] = (tb + q) * 8 + k; ++base; }
  }
}

DI void moe_table(const P& p, unsigned char* smem, int l) {
  int* start = (int*)(smem + SMEM_MAIN);
  __syncthreads();
  if (threadIdx.x == 0) {
    int s = 0;
    for (int e = 0; e < 64; ++e) { start[e] = s; s += (p.cnt[(l * 64 + e) * CSTRIDE] + 127) >> 7; }
    start[64] = s;
  }
  __syncthreads();
}
DI void moe_rows(const P& p, unsigned char* smem, int l, int mt, int& e_out) {
  const int* start = (const int*)(smem + SMEM_MAIN);
  int* rowinfo = (int*)(smem + SMEM_MAIN + 512);
  const int tid = otid();
  int e;
  if (mt >= start[64]) { e = 64; if (tid < 128) rowinfo[tid] = T_ * 8 + (mt - start[64]) * 128 + tid; }
  else {
    e = 0;
    for (int q = 1; q < 64; ++q) e = (start[q] <= mt) ? q : e;
    const int tl = mt - start[e];
    const int cnt = p.cnt[(l * 64 + e) * CSTRIDE];
    if (tid < 128) { const int idx = tl * 128 + tid; rowinfo[tid] = idx < cnt ? p.list[(size_t)e * LISTCAP + idx] : -1; }
  }
  e_out = e;
}

DI void item_p7(const P& p, unsigned char* smem, int l, int item) {
  const int mt = item >> 2, nt = item & 3;
  const int tid = otid(), r_s = tid >> 3, c_s = tid & 7;
  int* rowinfo = (int*)(smem + SMEM_MAIN + 512);
  __syncthreads();
  int e; moe_rows(p, smem, l, mt, e);
  __syncthreads();
  const bf16_t* wbase = (e == 64) ? p.wsg_t : p.wgu_t + (size_t)e * 512 * 1024;
  const bf16_t* ap[4]; const bf16_t* bp[4];
#pragma unroll
  for (int j = 0; j < 4; ++j) {
    const int row = r_s + 32 * j;
    const int slot = rowinfo[row];
    const int tok = slot < 0 ? 0 : (slot >= T_ * 8 ? slot - T_ * 8 : slot >> 3);
    ap[j] = p.h + (size_t)tok * 1024 + c_s * 8;
    bp[j] = wbase + (size_t)(nt * 128 + row) * 1024 + c_s * 8;
  }
  bf16_t* act = p.act;
  gemm128(smem, ap, bp, 16, [=](f32x4 (&acc)[4][4], int wm, int wn, int fr, int fq) {
#pragma unroll
    for (int i = 0; i < 4; ++i) {
      const int slot = rowinfo[wm * 64 + i * 16 + fr];
      if (slot >= 0) {
#pragma unroll
        for (int jj = 0; jj < 2; ++jj) {
          const f32x4 g = acc[i][2 * jj], u = acc[i][2 * jj + 1];
          u32x2 o; o.x = pack2(silu_f(g[0]) * u[0], silu_f(g[1]) * u[1]); o.y = pack2(silu_f(g[2]) * u[2], silu_f(g[3]) * u[3]);
          *(u32x2*)(act + (size_t)slot * 256 + nt * 64 + wn * 32 + jj * 16 + fq * 4) = o;
        }
      }
    }
  });
}

DI void item_p8(const P& p, unsigned char* smem, int l, int item) {
  const int mt = item >> 3, nt = item & 7;
  const int tid = otid(), r_s = tid >> 3, c_s = tid & 7;
  int* rowinfo = (int*)(smem + SMEM_MAIN + 512);
  __syncthreads();
  int e; moe_rows(p, smem, l, mt, e);
  __syncthreads();
  const bf16_t* wbase = (e == 64) ? p.wsd_t : p.wd_t + (size_t)e * 1024 * 256;
  const bf16_t* ap[4]; const bf16_t* bp[4];
#pragma unroll
  for (int j = 0; j < 4; ++j) {
    const int row = r_s + 32 * j;
    const int slot = rowinfo[row];
    ap[j] = p.act + (size_t)(slot < 0 ? 0 : slot) * 256 + c_s * 8;
    bp[j] = wbase + (size_t)(nt * 128 + row) * 256 + c_s * 8;
  }
  bf16_t* yrows = p.yrows; bf16_t* ysh = p.ysh; const float* topw = p.topw;
  gemm128(smem, ap, bp, 4, [=](f32x4 (&acc)[4][4], int wm, int wn, int fr, int fq) {
#pragma unroll
    for (int i = 0; i < 4; ++i) {
      const int slot = rowinfo[wm * 64 + i * 16 + fr];
      if (slot >= 0) {
        const bool shared = slot >= T_ * 8;
        const float wv = shared ? 1.f : topw[slot];
        bf16_t* dst = shared ? ysh + (size_t)(slot - T_ * 8) * 1024 : yrows + (size_t)slot * 1024;
#pragma unroll
        for (int j = 0; j < 4; ++j) {
          const f32x4 x = acc[i][j] * wv;
          u32x2 o; o.x = pack2(x[0], x[1]); o.y = pack2(x[2], x[3]);
          *(u32x2*)(dst + nt * 128 + wn * 64 + j * 16 + fq * 4) = o;
        }
      }
    }
  });
}

DI void item_p9(const P& p, int l, int item) {
  const int tid = otid(), w = tid >> 6, lane = tid & 63;
  const int t = item * 4 + w, b = t >> 11;
  const float* md = p.mod + ((size_t)l * 8 + b) * 6144;
  float4 v[4]; float ss = 0.f;
#pragma unroll
  for (int j = 0; j < 4; ++j) {
    const int idx = j * 256 + lane * 4;
    u32x2 y = *(const u32x2*)(p.ysh + (size_t)t * 1024 + idx);
    float a0 = bflo(y.x), a1 = bfhi(y.x), a2 = bflo(y.y), a3 = bfhi(y.y);
#pragma unroll
    for (int k = 0; k < 8; ++k) {
      y = *(const u32x2*)(p.yrows + ((size_t)t * 8 + k) * 1024 + idx);
      a0 += bflo(y.x); a1 += bfhi(y.x); a2 += bflo(y.y); a3 += bfhi(y.y);
    }
    const float4 xv = *(const float4*)(p.out + (size_t)t * 1024 + idx);
    const float4 g = *(const float4*)(md + 5120 + idx);
    v[j] = (float4){xv.x + g.x * a0, xv.y + g.y * a1, xv.z + g.z * a2, xv.w + g.w * a3};
    ss += v[j].x * v[j].x + v[j].y * v[j].y + v[j].z * v[j].z + v[j].w * v[j].w;
  }
  ss = wsum(ss);
  const float rstd = rsqrtf(ss * (1.f / 1024.f) + EPS);
  if (l == 0) {
    const float* md1 = p.mod + ((size_t)8 + b) * 6144;
#pragma unroll
    for (int j = 0; j < 4; ++j) {
      const int idx = j * 256 + lane * 4;
      *(float4*)(p.out + (size_t)t * 1024 + idx) = v[j];
      const float4 sh = *(const float4*)(md1 + idx), sc = *(const float4*)(md1 + 1024 + idx);
      u32x2 o;
      o.x = pack2(v[j].x * rstd * (1.f + sc.x) + sh.x, v[j].y * rstd * (1.f + sc.y) + sh.y);
      o.y = pack2(v[j].z * rstd * (1.f + sc.z) + sh.z, v[j].w * rstd * (1.f + sc.w) + sh.w);
      *(u32x2*)(p.h + (size_t)t * 1024 + idx) = o;
    }
  } else {
#pragma unroll
    for (int j = 0; j < 4; ++j) {
      const int idx = j * 256 + lane * 4;
      const float4 fg = *(const float4*)(p.final_gain + idx);
      *(float4*)(p.out + (size_t)t * 1024 + idx) = (float4){v[j].x * rstd * fg.x, v[j].y * rstd * fg.y, v[j].z * rstd * fg.z, v[j].w * rstd * fg.w};
    }
  }
}

__global__ void __launch_bounds__(NTHREADS, 2) fwd_megakernel(P p) {
  __shared__ __attribute__((aligned(16))) unsigned char smem[SMEM_MAIN + SMEM_EXTRA];
  const int G = gridDim.x, bid = blockIdx.x;
  volatile LAS unsigned* stw = (volatile LAS unsigned*)(smem + SMEM_MAIN + 2032);
  if (threadIdx.x == 0) { stw[0] = 0u; stw[1] = 0u; }
  __syncthreads();
  XcdBarrier bar = xcd_barrier_post(p.bar, stw);

  for (int it = bid; it < 192 + 1024 + MISC_ITEMS + CONV_ITEMS; it += G) {
    if (it < 192) item_mod(p, smem, it);
    else if (it < 192 + 1024) item_rope(p, it - 192);
    else if (it < 192 + 1024 + MISC_ITEMS) item_misc(p, it - 192 - 1024);
    else item_conv(p, smem, 0, it - 192 - 1024 - MISC_ITEMS);
  }
  xcd_barrier(bar);
  for (int it = bid; it < T_ / 4; it += G) item_norm0(p, it);
  xcd_barrier(bar);

  for (int l = 0; l < 2; ++l) {
    for (int it = bid; it < 1280; it += G) item_p1(p, smem, it);
    xcd_barrier(bar);
    for (int it = bid; it < 128 + 512 + 768 + 1024; it += G) {
      if (it < 128) item_sgu(p, smem, l, it);
      else if (it < 640) item_pool(p, smem, l, it - 128);
      else if (it < 1408) item_qproj(p, smem, it - 640);
      else item_kvproj(p, smem, it - 1408);
    }
    xcd_barrier(bar);
    for (int it = bid; it < 1024; it += G) item_attn(p, smem, it);
    xcd_barrier(bar);
    for (int it = bid; it < 1024; it += G) item_p4(p, smem, l, it);
    xcd_barrier(bar);
    for (int it = bid; it < 256; it += G) item_p5(p, smem, l, it);
    xcd_barrier(bar);
    moe_table(p, smem, l);
    const int nmt = ((const int*)(smem + SMEM_MAIN))[64] + 128;
    for (int it = bid; it < nmt * 4; it += G) item_p7(p, smem, l, it);
    xcd_barrier(bar);
    for (int it = bid; it < nmt * 8; it += G) item_p8(p, smem, l, it);
    xcd_barrier(bar);
    const int n9 = T_ / 4 + (l == 0 ? CONV_ITEMS : 0);
    for (int it = bid; it < n9; it += G) {
      if (it < T_ / 4) item_p9(p, l, it);
      else item_conv(p, smem, 1, it - T_ / 4);
    }
    if (l == 0) xcd_barrier(bar);
  }
}

extern "C" void kernel_launch(void* const* d_in, const int* in_sizes, int n_in, void* d_out, int out_size, void* d_ws, size_t ws_size,
                              hipStream_t stream) {
  P p{};
  p.x = (const float*)d_in[0]; p.c = (const float*)d_in[1]; p.pos = (const int*)d_in[2];
  p.w_ada = (const float*)d_in[3]; p.b_ada = (const float*)d_in[4]; p.w_in = (const float*)d_in[5]; p.w_pool = (const float*)d_in[6];
  p.pool_scale = (const float*)d_in[7]; p.w_spatial = (const float*)d_in[8]; p.b_spatial = (const float*)d_in[9]; p.g_q = (const float*)d_in[10];
  p.w_uq = (const float*)d_in[11]; p.g_kv = (const float*)d_in[12]; p.w_ukv = (const float*)d_in[13]; p.w_out = (const float*)d_in[14];
  p.w_router = (const float*)d_in[15]; p.router_bias = (const float*)d_in[16]; p.w_gate = (const float*)d_in[17]; p.w_up = (const float*)d_in[18];
  p.w_down = (const float*)d_in[19]; p.ws_gate = (const float*)d_in[20]; p.ws_up = (const float*)d_in[21]; p.ws_down = (const float*)d_in[22];
  p.final_gain = (const float*)d_in[23];
  p.out = (float*)d_out;
  unsigned char* ws = (unsigned char*)d_ws;
  size_t off = 0;
  auto take = [&](size_t bytes) { unsigned char* r = ws + off; off += (bytes + 255) & ~(size_t)255; return r; };
  const size_t ctrl_bytes = (size_t)XCD_BAR_WORDS * 4 + (size_t)2 * 64 * CSTRIDE * 4;
  p.bar = (unsigned*)take(ctrl_bytes);
  p.cnt = (int*)(p.bar + XCD_BAR_WORDS);
  p.mod = (float*)take((size_t)2 * 8 * 6144 * 4);
  p.ropec = (float*)take((size_t)T_ * 16 * 4);
  p.ropes = (float*)take((size_t)T_ * 16 * 4);
  p.win_t = (bf16_t*)take((size_t)NIN * 1024 * 2);
  p.wuq_t = (bf16_t*)take((size_t)768 * 256 * 2);
  p.wukv_t = (bf16_t*)take((size_t)1024 * 128 * 2);
  p.wout_t = (bf16_t*)take((size_t)1024 * 1024 * 2);
  p.wsg_t = (bf16_t*)take((size_t)512 * 1024 * 2);
  p.wsd_t = (bf16_t*)take((size_t)1024 * 256 * 2);
  p.wsp_b = (bf16_t*)take((size_t)2 * 4 * 128 * 128 * 2);
  p.wpool_t = (bf16_t*)take((size_t)2 * 4 * 64 * 64 * 2);
  p.wr_hi = (bf16_t*)take((size_t)2 * 64 * 1024 * 2);
  p.wr_lo = (bf16_t*)take((size_t)2 * 64 * 1024 * 2);
  p.wgu_t = (bf16_t*)take((size_t)64 * 512 * 1024 * 2);
  p.wd_t = (bf16_t*)take((size_t)64 * 1024 * 256 * 2);
  p.h = (bf16_t*)take((size_t)T_ * 1024 * 2);
  p.act = (bf16_t*)take((size_t)(T_ * 8 + T_) * 256 * 2);
  p.ysh = (bf16_t*)take((size_t)T_ * 1024 * 2);
  p.list = (int*)take((size_t)64 * LISTCAP * 4);
  p.topw = (float*)take((size_t)T_ * 8 * 4);
  const size_t big0 = off;
  p.yrows = (bf16_t*)take((size_t)T_ * 8 * 1024 * 2);
  off = big0;
  p.proj = (bf16_t*)take((size_t)T_ * NIN * 2);
  p.Q = (bf16_t*)take((size_t)T_ * 8 * 96 * 2);
  p.Kb = (bf16_t*)take((size_t)T_ * 8 * 96 * 2);
  p.V = (bf16_t*)take((size_t)T_ * 8 * 64 * 2);
  p.Y = (bf16_t*)take((size_t)T_ * 1024 * 2);
  const size_t need = big0 + (size_t)T_ * 8 * 1024 * 2 + 256;
  if (need > ws_size) { fprintf(stderr, "workspace too small: need %zu have %zu\n", need, ws_size); return; }

  hipMemsetAsync(p.bar, 0, ctrl_bytes, stream);
  static int grid_blocks = 0;
  if (!grid_blocks) {
    int dev = 0, cus = 0, per_cu = 0;
    hipGetDevice(&dev);
    hipDeviceGetAttribute(&cus, hipDeviceAttributeMultiprocessorCount, dev);
    hipOccupancyMaxActiveBlocksPerMultiprocessor(&per_cu, fwd_megakernel, NTHREADS, 0);
    if (per_cu > 2) per_cu = 2;
    if (per_cu < 1) per_cu = 1;
    grid_blocks = cus * per_cu;
  }
  void* args[] = {&p};
  hipError_t e = hipLaunchCooperativeKernel((void*)fwd_megakernel, dim3(grid_blocks), dim3(NTHREADS), args, 0, stream);
  if (e != hipSuccess) fprintf(stderr, "cooperative launch failed: %s (grid %d)\n", hipGetErrorString(e), grid_blocks);
}
```

```cpp
#include <hip/hip_runtime.h>
#include <stdint.h>
#include <cstdio>

#define DI __device__ __forceinline__
#define LAS __attribute__((address_space(3)))

typedef unsigned short bf16_t;
typedef short bf16x8 __attribute__((ext_vector_type(8)));
typedef short s16x4 __attribute__((ext_vector_type(4)));
typedef float f32x4 __attribute__((ext_vector_type(4)));
typedef float f32x2 __attribute__((ext_vector_type(2)));
typedef unsigned u32x4 __attribute__((ext_vector_type(4)));
typedef unsigned u32x2 __attribute__((ext_vector_type(2)));
typedef __bf16 bf16x2_t __attribute__((ext_vector_type(2)));

constexpr int T_ = 16384, D_ = 1024, S_ = 2048, NIN = 1184;
constexpr int NTHREADS = 256;
constexpr int SMEM_MAIN = 65536, SMEM_EXTRA = 2048;
constexpr float EPS = 1e-6f;
constexpr int CSTRIDE = 64;
constexpr int LISTCAP = 16384;
constexpr int CONV_ITEMS = 592 + 24 + 16 + 128 + 96 + 6144;

struct P {
  const float *x, *c; const int* pos;
  const float *w_ada, *b_ada, *w_in, *w_pool, *pool_scale, *w_spatial, *b_spatial, *g_q, *w_uq, *g_kv, *w_ukv, *w_out,
      *w_router, *router_bias, *w_gate, *w_up, *w_down, *ws_gate, *ws_up, *ws_down, *final_gain;
  float* out;
  unsigned* bar; int* cnt; float* mod; float* ropec; float* ropes;
  bf16_t *win_t, *wuq_t, *wukv_t, *wout_t, *wsg_t, *wsd_t, *wgu_t, *wd_t;
  bf16_t *wsp_b, *wpool_t, *wr_hi, *wr_lo;
  bf16_t *h, *proj, *Q, *Kb, *V, *Y, *yrows, *ysh, *act;
  float* rowss;
  int* list; float* topw;
};

DI unsigned pack2(float lo, float hi) { f32x2 f = {lo, hi}; bf16x2_t b = __builtin_convertvector(f, bf16x2_t); return __builtin_bit_cast(unsigned, b); }
DI float bf2f(unsigned short b) { return __uint_as_float(((unsigned)b) << 16); }
DI float bflo(unsigned u) { return __uint_as_float(u << 16); }
DI float bfhi(unsigned u) { return __uint_as_float(u & 0xffff0000u); }
DI int otid() { int t = threadIdx.x; asm volatile("" : "+v"(t)); return t; }
DI float wsum(float v) { for (int o = 32; o; o >>= 1) v += __shfl_xor(v, o); return v; }
DI float silu_f(float x) { return x / (1.f + __expf(-x)); }
DI float gelu_tanh(float x) { float z = 0.7978845608028654f * (x + 0.044715f * x * x * x); float e = __expf(2.f * z); float t = 1.f - 2.f / (1.f + e); return 0.5f * x * (1.f + t); }

#define XB_TMO      128
#define XB_XCNT(j)  (256  + 64 * (j))
#define XB_XSUB(j)  (1280 + 64 * (j))
#define XB_XGEN(j)  (2304 + 64 * (j))
#define XB_TOP      3328
#define XB_TOPGEN   3392
#define XCD_BAR_WORDS 3456
#define XB_SPIN_CAP (1u << 20)
DI unsigned xb_ld(unsigned* p) { return __hip_atomic_load(p, __ATOMIC_RELAXED, __HIP_MEMORY_SCOPE_AGENT); }
DI unsigned xb_add(unsigned* p, unsigned v) { return __hip_atomic_fetch_add(p, v, __ATOMIC_RELAXED, __HIP_MEMORY_SCOPE_AGENT); }
DI unsigned xb_xcc_id() { return (unsigned)__builtin_amdgcn_s_getreg((3 << 11) | 20) & 0xFu; }
#define XB_SPIN(cond, bar) do { unsigned _sp = 0; while (cond) { __builtin_amdgcn_s_sleep(1); \
    if ((++_sp & 255u) == 0u) { if (xb_ld(&(bar)[XB_TMO])) break; if (_sp > XB_SPIN_CAP) { atomicAdd(&(bar)[XB_TMO], 1u); break; } } } } while (0)
struct XcdBarrier { unsigned* bar; unsigned x; volatile LAS unsigned* st; };
DI XcdBarrier xcd_barrier_post(unsigned* bar, volatile LAS unsigned* st) {
  XcdBarrier b; b.bar = bar; b.x = xb_xcc_id(); b.st = st;
  if (threadIdx.x == 0) (void)xb_add(&bar[XB_XCNT(b.x)], 1u);
  return b;
}
DI void xcd_barrier_complete(unsigned* bar, unsigned x, unsigned& nloc, unsigned& nx) {
  const unsigned G = gridDim.x * gridDim.y * gridDim.z;
  unsigned sum, cnt, mine, sp = 0u;
  for (;;) {
    sum = 0u; cnt = 0u; mine = 0u;
#pragma unroll
    for (unsigned j = 0; j < 16; ++j) { const unsigned c = xb_ld(&bar[XB_XCNT(j)]); sum += c; cnt += (c > 0u) ? 1u : 0u; mine = (j == x) ? c : mine; }
    if (sum == G) break;
    __builtin_amdgcn_s_sleep(1);
    if ((++sp & 255u) == 0u) { if (xb_ld(&bar[XB_TMO])) break; if (sp > XB_SPIN_CAP) { atomicAdd(&bar[XB_TMO], 1u); break; } }
  }
  nloc = mine > 0u ? mine : 1u; nx = cnt > 0u ? cnt : 1u;
}
DI void xcd_barrier(const XcdBarrier& b) {
  asm volatile("s_waitcnt vmcnt(0)" ::: "memory");
  __syncthreads();
  if (threadIdx.x == 0) {
    unsigned* bar = b.bar;
    __builtin_amdgcn_s_waitcnt(0);
    unsigned nloc = b.st[0], nx = b.st[1];
    if (nloc == 0u) { xcd_barrier_complete(bar, b.x, nloc, nx); b.st[0] = nloc; b.st[1] = nx; }
    const unsigned old = xb_add(&bar[XB_XSUB(b.x)], 1u);
    const unsigned gen = old / nloc;
    if (old + 1u == (gen + 1u) * nloc) {
      __builtin_amdgcn_fence(__ATOMIC_RELEASE, "agent");
      asm volatile("s_waitcnt vmcnt(0)" ::: "memory");
      const unsigned og = xb_add(&bar[XB_TOP], 1u);
      const unsigned tg = og / nx;
      if (og + 1u == (tg + 1u) * nx) xb_add(&bar[XB_TOPGEN], 1u);
      else XB_SPIN(xb_ld(&bar[XB_TOPGEN]) == tg, bar);
      __builtin_amdgcn_fence(__ATOMIC_ACQUIRE, "agent");
      xb_add(&bar[XB_XGEN(b.x)], 1u);
      asm volatile("s_waitcnt vmcnt(0)" ::: "memory");
    } else {
      XB_SPIN(xb_ld(&bar[XB_XGEN(b.x)]) == gen, bar);
      __builtin_amdgcn_fence(__ATOMIC_ACQUIRE, "agent");
      asm volatile("s_waitcnt vmcnt(0)" ::: "memory");
    }
  }
  __syncthreads();
}


template <int RB> DI void ot_put(unsigned char* base, int row, int unit, u32x2 v) { *(u32x2*)(base + row * RB + ((unit ^ (row & 15)) << 3)) = v; }
template <int RB> DI u32x4 ot_get(const unsigned char* base, int row, int chunk) {
  const u32x4 v = *(const u32x4*)(base + row * RB + ((chunk ^ ((row & 15) >> 1)) << 4));
  return (row & 1) ? (u32x4){v.z, v.w, v.x, v.y} : v;
}

template <class Epi>
DI void gemm128(unsigned char* smem, const bf16_t* (&ap)[4], const bf16_t* (&bp)[4], int nk, Epi&& epi) {
  const int tid = otid(), lane = tid & 63, w = tid >> 6;
  const int wm = w >> 1, wn = w & 1;
  const int r_s = tid >> 3, c_s = tid & 7;
  const int st_off = r_s * 128 + ((c_s ^ (r_s & 7)) << 4);
  const int fr = lane & 15, fq = lane >> 4;
  const int sw0 = ((0 + fq) ^ (fr & 7)) << 4, sw1 = ((4 + fq) ^ (fr & 7)) << 4;
  const int arow_off = (wm * 64 + fr) * 128, brow_off = 32768 + (wn * 64 + fr) * 128;
  u32x4 ra[4], rb[4];
  f32x4 acc[4][4];
#pragma unroll
  for (int i = 0; i < 4; ++i)
#pragma unroll
    for (int j = 0; j < 4; ++j) acc[i][j] = (f32x4){0.f, 0.f, 0.f, 0.f};
#pragma unroll
  for (int j = 0; j < 4; ++j) { ra[j] = *(const u32x4*)(ap[j]); rb[j] = *(const u32x4*)(bp[j]); }
#pragma unroll
  for (int j = 0; j < 4; ++j) { *(u32x4*)(smem + st_off + j * 4096) = ra[j]; *(u32x4*)(smem + 32768 + st_off + j * 4096) = rb[j]; }
  __syncthreads();
  for (int kt = 0; kt < nk; ++kt) {
    const int cur = (kt & 1) * 16384;
    const bool more = (kt + 1 < nk);
    if (more) {
#pragma unroll
      for (int j = 0; j < 4; ++j) { ra[j] = *(const u32x4*)(ap[j] + (kt + 1) * 64); rb[j] = *(const u32x4*)(bp[j] + (kt + 1) * 64); }
    }
#pragma unroll
    for (int ks = 0; ks < 2; ++ks) {
      const int sw = ks ? sw1 : sw0;
      bf16x8 af[4], bfr[4];
#pragma unroll
      for (int i = 0; i < 4; ++i) af[i] = *(const bf16x8*)(smem + cur + arow_off + i * 2048 + sw);
#pragma unroll
      for (int j = 0; j < 4; ++j) bfr[j] = *(const bf16x8*)(smem + cur + brow_off + j * 2048 + sw);
#pragma unroll
      for (int i = 0; i < 4; ++i)
#pragma unroll
        for (int j = 0; j < 4; ++j) acc[i][j] = __builtin_amdgcn_mfma_f32_16x16x32_bf16(bfr[j], af[i], acc[i][j], 0, 0, 0);
    }
    if (more) {
      const int nxt = 16384 - cur;
#pragma unroll
      for (int j = 0; j < 4; ++j) { *(u32x4*)(smem + nxt + st_off + j * 4096) = ra[j]; *(u32x4*)(smem + 32768 + nxt + st_off + j * 4096) = rb[j]; }
    }
    __syncthreads();
  }
  epi(acc, wm, wn, fr, fq);
}


template <class Epi>
DI void gemm128_stream(unsigned char* smem, const bf16_t* (&ap)[4], const bf16_t* (&bp)[4], int nk, int ntile, size_t btile_stride, Epi&& epi) {
  const int tid = otid(), lane = tid & 63, w = tid >> 6;
  const int wm = w >> 1, wn = w & 1;
  const int r_s = tid >> 3, c_s = tid & 7;
  const int st_off = r_s * 128 + ((c_s ^ (r_s & 7)) << 4);
  const int fr = lane & 15, fq = lane >> 4;
  const int sw0 = ((0 + fq) ^ (fr & 7)) << 4, sw1 = ((4 + fq) ^ (fr & 7)) << 4;
  const int arow_off = (wm * 64 + fr) * 128, brow_off = 32768 + (wn * 64 + fr) * 128;
  u32x4 ra[4], rb[4];
  f32x4 acc[4][4];
#pragma unroll
  for (int i = 0; i < 4; ++i)
#pragma unroll
    for (int j = 0; j < 4; ++j) acc[i][j] = (f32x4){0.f, 0.f, 0.f, 0.f};
#pragma unroll
  for (int j = 0; j < 4; ++j) { ra[j] = *(const u32x4*)(ap[j]); rb[j] = *(const u32x4*)(bp[j]); }
#pragma unroll
  for (int j = 0; j < 4; ++j) { *(u32x4*)(smem + st_off + j * 4096) = ra[j]; *(u32x4*)(smem + 32768 + st_off + j * 4096) = rb[j]; }
  __syncthreads();
  const int total = nk * ntile;
  int kt = 0, tile = 0;
  for (int s = 0; s < total; ++s) {
    const int cur = (s & 1) * 16384;
    const bool more = (s + 1 < total);
    int nkt = kt + 1, ntl = tile;
    if (nkt == nk) { nkt = 0; ++ntl; }
    if (more) {
      const size_t bo = (size_t)ntl * btile_stride + nkt * 64;
#pragma unroll
      for (int j = 0; j < 4; ++j) { ra[j] = *(const u32x4*)(ap[j] + nkt * 64); rb[j] = *(const u32x4*)(bp[j] + bo); }
    }
#pragma unroll
    for (int ks = 0; ks < 2; ++ks) {
      const int sw = ks ? sw1 : sw0;
      bf16x8 af[4], bfr[4];
#pragma unroll
      for (int i = 0; i < 4; ++i) af[i] = *(const bf16x8*)(smem + cur + arow_off + i * 2048 + sw);
#pragma unroll
      for (int j = 0; j < 4; ++j) bfr[j] = *(const bf16x8*)(smem + cur + brow_off + j * 2048 + sw);
#pragma unroll
      for (int i = 0; i < 4; ++i)
#pragma unroll
        for (int j = 0; j < 4; ++j) acc[i][j] = __builtin_amdgcn_mfma_f32_16x16x32_bf16(bfr[j], af[i], acc[i][j], 0, 0, 0);
    }
    if (more) {
      const int nxt = 16384 - cur;
#pragma unroll
      for (int j = 0; j < 4; ++j) { *(u32x4*)(smem + nxt + st_off + j * 4096) = ra[j]; *(u32x4*)(smem + 32768 + nxt + st_off + j * 4096) = rb[j]; }
    }
    if (kt == nk - 1) {
      epi(acc, tile, cur, wm, wn, fr, fq);
#pragma unroll
      for (int i = 0; i < 4; ++i)
#pragma unroll
        for (int j = 0; j < 4; ++j) acc[i][j] = (f32x4){0.f, 0.f, 0.f, 0.f};
    }
    __syncthreads();
    kt = nkt; tile = ntl;
  }
}

DI void item_mod(const P& p, unsigned char* smem, int item) {
  const int l = item / 96, cb = item % 96;
  const int tid = otid(), w = tid >> 6, lane = tid & 63;
  float* sc = (float*)smem;
  float* red = (float*)(smem + 32768);
  __syncthreads();
  for (int i = tid; i < 8192; i += NTHREADS) sc[i] = silu_f(p.c[i]);
  __syncthreads();
  const int col = cb * 64 + lane;
  const float* W = p.w_ada + (size_t)l * 1024 * 6144 + col;
  float acc[8];
#pragma unroll
  for (int b = 0; b < 8; ++b) acc[b] = 0.f;
  for (int k0 = w * 256; k0 < w * 256 + 256; k0 += 16) {
    float wv[16];
#pragma unroll
    for (int u = 0; u < 16; ++u) wv[u] = W[(size_t)(k0 + u) * 6144];
#pragma unroll
    for (int u = 0; u < 16; ++u)
#pragma unroll
      for (int b = 0; b < 8; ++b) acc[b] += sc[b * 1024 + k0 + u] * wv[u];
  }
#pragma unroll
  for (int b = 0; b < 8; ++b) red[(w * 8 + b) * 64 + lane] = acc[b];
  __syncthreads();
  for (int o = tid; o < 512; o += NTHREADS) {
    const int b = o >> 6, cc = o & 63;
    const float v = red[(0 * 8 + b) * 64 + cc] + red[(1 * 8 + b) * 64 + cc] + red[(2 * 8 + b) * 64 + cc] + red[(3 * 8 + b) * 64 + cc];
    p.mod[((size_t)l * 8 + b) * 6144 + cb * 64 + cc] = v + p.b_ada[(size_t)l * 6144 + cb * 64 + cc];
  }
}

DI void conv_tile(unsigned char* smem, const float* src, int ldsrc, int k0, int n0, bf16_t* dst, int lddst, int mode, const float* kscale) {
  float* t = (float*)smem;
  const int tid = otid();
  __syncthreads();
  {
    const int kk = tid >> 3, nq = tid & 7;
#pragma unroll
    for (int hh = 0; hh < 2; ++hh) {
      const int k = kk + 32 * hh;
      const float4 v = *(const float4*)(src + (size_t)(k0 + k) * ldsrc + n0 + nq * 4);
      const float s = kscale ? kscale[k0 + k] : 1.f;
      t[k * 33 + nq * 4 + 0] = v.x * s; t[k * 33 + nq * 4 + 1] = v.y * s; t[k * 33 + nq * 4 + 2] = v.z * s; t[k * 33 + nq * 4 + 3] = v.w * s;
    }
  }
  __syncthreads();
  {
    const int n = tid >> 3, kc = tid & 7;
    u32x4 wv;
    wv.x = pack2(t[(kc * 8 + 0) * 33 + n], t[(kc * 8 + 1) * 33 + n]);
    wv.y = pack2(t[(kc * 8 + 2) * 33 + n], t[(kc * 8 + 3) * 33 + n]);
    wv.z = pack2(t[(kc * 8 + 4) * 33 + n], t[(kc * 8 + 5) * 33 + n]);
    wv.w = pack2(t[(kc * 8 + 6) * 33 + n], t[(kc * 8 + 7) * 33 + n]);
    const int nn = n0 + n;
    const int orow = (mode == 0) ? nn : (32 * (nn >> 4) + (nn & 15) + (mode == 2 ? 16 : 0));
    *(u32x4*)(dst + (size_t)orow * lddst + k0 + kc * 8) = wv;
  }
}

DI void conv_big(unsigned char* smem, const float* src, int ldsrc, int k0, int n0, bf16_t* dst, int lddst, int mode, const float* kscale) {
  float* t = (float*)smem;
  const int tid = otid();
  __syncthreads();
  {
    const int c4 = tid & 31, r0 = tid >> 5;
    float4 v[8];
#pragma unroll
    for (int hh = 0; hh < 8; ++hh) v[hh] = *(const float4*)(src + (size_t)(k0 + r0 + 8 * hh) * ldsrc + n0 + c4 * 4);
#pragma unroll
    for (int hh = 0; hh < 8; ++hh) {
      const int k = r0 + 8 * hh;
      const float sc = kscale ? kscale[k0 + k] : 1.f;
      *(float4*)(t + k * 132 + c4 * 4) = (float4){v[hh].x * sc, v[hh].y * sc, v[hh].z * sc, v[hh].w * sc};
    }
  }
  __syncthreads();
  {
    const int n = tid >> 1, kh = tid & 1;
    const int nn = n0 + n;
    const int orow = (mode == 0) ? nn : (32 * (nn >> 4) + (nn & 15) + (mode == 2 ? 16 : 0));
    bf16_t* d = dst + (size_t)orow * lddst + k0 + kh * 32;
#pragma unroll
    for (int c = 0; c < 4; ++c) {
      const float* tp = t + (kh * 32 + c * 8) * 132 + n;
      u32x4 wv;
      wv.x = pack2(tp[0 * 132], tp[1 * 132]); wv.y = pack2(tp[2 * 132], tp[3 * 132]); wv.z = pack2(tp[4 * 132], tp[5 * 132]); wv.w = pack2(tp[6 * 132], tp[7 * 132]);
      *(u32x4*)(d + c * 8) = wv;
    }
  }
}

DI void item_conv(const P& p, unsigned char* smem, int l, int idx) {
  if (idx < 592) { conv_tile(smem, p.w_in + (size_t)l * 1024 * NIN, NIN, (idx / 37) * 64, (idx % 37) * 32, p.win_t, 1024, 0, nullptr); return; }
  idx -= 592;
  if (idx < 24) { conv_big(smem, p.w_uq + (size_t)l * 256 * 768, 768, (idx / 6) * 64, (idx % 6) * 128, p.wuq_t, 256, 0, p.g_q + l * 256); return; }
  idx -= 24;
  if (idx < 16) { conv_big(smem, p.w_ukv + (size_t)l * 128 * 1024, 1024, (idx / 8) * 64, (idx % 8) * 128, p.wukv_t, 128, 0, p.g_kv + l * 128); return; }
  idx -= 16;
  if (idx < 128) { conv_big(smem, p.w_out + (size_t)l * 1024 * 1024, 1024, (idx / 8) * 64, (idx % 8) * 128, p.wout_t, 1024, 0, nullptr); return; }
  idx -= 128;
  if (idx < 32) { conv_big(smem, p.ws_gate + (size_t)l * 1024 * 256, 256, (idx / 2) * 64, (idx % 2) * 128, p.wsg_t, 1024, 1, nullptr); return; }
  idx -= 32;
  if (idx < 32) { conv_big(smem, p.ws_up + (size_t)l * 1024 * 256, 256, (idx / 2) * 64, (idx % 2) * 128, p.wsg_t, 1024, 2, nullptr); return; }
  idx -= 32;
  if (idx < 32) { conv_big(smem, p.ws_down + (size_t)l * 256 * 1024, 1024, (idx / 8) * 64, (idx % 8) * 128, p.wsd_t, 256, 0, nullptr); return; }
  idx -= 32;
  const int e = idx / 96, r = idx % 96;
  if (r < 32) conv_big(smem, p.w_gate + ((size_t)l * 64 + e) * 1024 * 256, 256, (r / 2) * 64, (r % 2) * 128, p.wgu_t + (size_t)e * 512 * 1024, 1024, 1, nullptr);
  else if (r < 64) conv_big(smem, p.w_up + ((size_t)l * 64 + e) * 1024 * 256, 256, ((r - 32) / 2) * 64, ((r - 32) % 2) * 128, p.wgu_t + (size_t)e * 512 * 1024, 1024, 2, nullptr);
  else conv_big(smem, p.w_down + ((size_t)l * 64 + e) * 256 * 1024, 1024, ((r - 64) / 8) * 64, ((r - 64) % 8) * 128, p.wd_t + (size_t)e * 1024 * 256, 256, 0, nullptr);
}

constexpr int MISC_ITEMS = 64 + 128 + 512;
DI void item_misc(const P& p, int item) {
  const int tid = otid();
  if (item < 64) {
    const int i = (item * NTHREADS + tid) * 8;
    const int k0 = i & 127, t = (i >> 7) & 127;
    const float4 a = *(const float4*)(p.w_spatial + i), c = *(const float4*)(p.w_spatial + i + 4);
    u32x4 o;
    o.x = pack2(k0 + 0 <= t ? a.x : 0.f, k0 + 1 <= t ? a.y : 0.f); o.y = pack2(k0 + 2 <= t ? a.z : 0.f, k0 + 3 <= t ? a.w : 0.f);
    o.z = pack2(k0 + 4 <= t ? c.x : 0.f, k0 + 5 <= t ? c.y : 0.f); o.w = pack2(k0 + 6 <= t ? c.z : 0.f, k0 + 7 <= t ? c.w : 0.f);
    *(u32x4*)(p.wsp_b + i) = o;
  } else if (item < 64 + 128) {
    const int i = (item - 64) * NTHREADS + tid;
    const int c = i & 63, dd = (i >> 6) & 63, lg = i >> 12;
    const f32x2 f = {p.w_pool[((size_t)lg * 64 + c) * 64 + dd], 0.f}; const bf16x2_t bb = __builtin_convertvector(f, bf16x2_t);
    p.wpool_t[i] = (bf16_t)(__builtin_bit_cast(unsigned, bb) & 0xffffu);
  } else {
    const int i = (item - 192) * NTHREADS + tid;
    const int e = i & 63, k = (i >> 6) & 1023, l = i >> 16;
    const float v = p.w_router[i];
    const unsigned hi = pack2(v, 0.f) & 0xffffu;
    const unsigned lo = pack2(v - bflo(hi), 0.f) & 0xffffu;
    p.wr_hi[(size_t)l * 65536 + e * 1024 + k] = (bf16_t)hi;
    p.wr_lo[(size_t)l * 65536 + e * 1024 + k] = (bf16_t)lo;
  }
}

DI void item_rope(const P& p, int item) {
  const int i = item * NTHREADS + otid();
  const int t = i >> 4, f = i & 15;
  const float inv = exp2f(-(float)(2 * f) * (13.287712379549449f / 32.f));
  const float ang = (float)p.pos[t] * inv;
  const double rev = (double)ang * 0.15915494309189535;
  const float fr = (float)(rev - floor(rev));
  p.ropec[i] = __builtin_amdgcn_cosf(fr);
  p.ropes[i] = __builtin_amdgcn_sinf(fr);
}

DI void item_norm0(const P& p, int item) {
  const int tid = otid(), w = tid >> 6, lane = tid & 63;
  const int t = item * 4 + w, b = t >> 11;
  const float* xr = p.x + (size_t)t * 1024;
  const float* md = p.mod + (size_t)b * 6144;
  float4 v[4]; float ss = 0.f;
#pragma unroll
  for (int j = 0; j < 4; ++j) { v[j] = *(const float4*)(xr + j * 256 + lane * 4); ss += v[j].x * v[j].x + v[j].y * v[j].y + v[j].z * v[j].z + v[j].w * v[j].w; }
  ss = wsum(ss);
  const float rstd = rsqrtf(ss * (1.f / 1024.f) + EPS);
#pragma unroll
  for (int j = 0; j < 4; ++j) {
    const int idx = j * 256 + lane * 4;
    const float4 sh = *(const float4*)(md + idx), sc = *(const float4*)(md + 1024 + idx);
    u32x2 o;
    o.x = pack2(v[j].x * rstd * (1.f + sc.x) + sh.x, v[j].y * rstd * (1.f + sc.y) + sh.y);
    o.y = pack2(v[j].z * rstd * (1.f + sc.z) + sh.z, v[j].w * rstd * (1.f + sc.w) + sh.w);
    *(u32x2*)(p.h + (size_t)t * 1024 + idx) = o;
  }
}

DI void item_p1(const P& p, unsigned char* smem, int item) {
  const int m = item / 10, nt = item % 10;
  const int tid = otid(), r_s = tid >> 3, c_s = tid & 7;
  __syncthreads();
  const bf16_t* ap[4]; const bf16_t* bp[4];
#pragma unroll
  for (int j = 0; j < 4; ++j) {
    const int row = r_s + 32 * j;
    ap[j] = p.h + (size_t)(m * 128 + row) * 1024 + c_s * 8;
    int n = nt * 128 + row; n = n < NIN ? n : NIN - 1;
    bp[j] = p.win_t + (size_t)n * 1024 + c_s * 8;
  }
  bf16_t* proj = p.proj;
  gemm128(smem, ap, bp, 16, [=](f32x4 (&acc)[4][4], int wm, int wn, int fr, int fq) {
    unsigned char* ob = smem + wm * 16384;
#pragma unroll
    for (int i = 0; i < 4; ++i)
#pragma unroll
      for (int j = 0; j < 4; ++j) {
        u32x2 o; o.x = pack2(acc[i][j][0], acc[i][j][1]); o.y = pack2(acc[i][j][2], acc[i][j][3]);
        ot_put<256>(ob, i * 16 + fr, wn * 16 + j * 4 + fq, o);
      }
    __syncthreads();
    {
      const int tid2 = fq * 16 + fr + 64 * (wm * 2 + wn);
      const int chunk = tid2 & 15;
      if (nt * 128 + chunk * 8 < NIN) {
#pragma unroll
        for (int i = 0; i < 8; ++i) {
          const int row = (tid2 >> 4) + 16 * i;
          const u32x4 v = ot_get<256>(smem + (row >> 6) * 16384, row & 63, chunk);
          *(u32x4*)(proj + (size_t)(m * 128 + row) * NIN + nt * 128 + chunk * 8) = v;
        }
      }
    }
  });
}

DI void item_qproj(const P& p, unsigned char* smem, int item) {
  const int m = item / 6, nt = item % 6;
  const int tid = otid(), r_s = tid >> 3, c_s = tid & 7;
  float* rowf = (float*)(smem + SMEM_MAIN + 1024);
  __syncthreads();
  {
    const int row = tid >> 1, half = tid & 1;
    const bf16_t* src = p.proj + (size_t)(m * 128 + row) * NIN + 768 + half * 128;
    float ss = 0.f;
#pragma unroll
    for (int q = 0; q < 16; ++q) {
      const u32x4 v = *(const u32x4*)(src + q * 8);
      ss += bflo(v.x) * bflo(v.x) + bfhi(v.x) * bfhi(v.x) + bflo(v.y) * bflo(v.y) + bfhi(v.y) * bfhi(v.y) + bflo(v.z) * bflo(v.z) + bfhi(v.z) * bfhi(v.z) + bflo(v.w) * bflo(v.w) + bfhi(v.w) * bfhi(v.w);
    }
    ss += __shfl_xor(ss, 1);
    if (half == 0) rowf[row] = rsqrtf(ss * (1.f / 256.f) + EPS);
  }
  const bf16_t* ap[4]; const bf16_t* bp[4];
#pragma unroll
  for (int j = 0; j < 4; ++j) {
    const int row = r_s + 32 * j;
    ap[j] = p.proj + (size_t)(m * 128 + row) * NIN + 768 + c_s * 8;
    bp[j] = p.wuq_t + (size_t)(nt * 128 + row) * 256 + c_s * 8;
  }
  bf16_t* Q = p.Q; const float* ropec = p.ropec; const float* ropes = p.ropes;
  const float QS = 0.10206207261596577f * 1.4426950408889634f;
  gemm128(smem, ap, bp, 4, [=](f32x4 (&acc)[4][4], int wm, int wn, int fr, int fq) {
#pragma unroll
    for (int i = 0; i < 4; ++i) {
      const int tl = wm * 64 + i * 16 + fr, t = m * 128 + tl;
      const int b = t >> 11, s = t & 2047;
      const float rs = rowf[tl] * QS;
#pragma unroll
      for (int j = 0; j < 4; ++j) {
        const int c0 = nt * 128 + wn * 64 + j * 16;
        const int head = c0 / 96, d0 = c0 % 96;
        bf16_t* dst = Q + ((size_t)((b * 8 + head) * 2048 + s)) * 96 + d0 + fq * 4;
        if (d0 == 64) {
          if (j < 3) {
            const float4 cs = *(const float4*)(ropec + (size_t)t * 16 + fq * 4), sn = *(const float4*)(ropes + (size_t)t * 16 + fq * 4);
            const f32x4 x1 = acc[i][j] * rs, x2 = acc[i][j + 1 < 4 ? j + 1 : 3] * rs;
            u32x2 o1, o2;
            o1.x = pack2(x1[0] * cs.x - x2[0] * sn.x, x1[1] * cs.y - x2[1] * sn.y);
            o1.y = pack2(x1[2] * cs.z - x2[2] * sn.z, x1[3] * cs.w - x2[3] * sn.w);
            o2.x = pack2(x2[0] * cs.x + x1[0] * sn.x, x2[1] * cs.y + x1[1] * sn.y);
            o2.y = pack2(x2[2] * cs.z + x1[2] * sn.z, x2[3] * cs.w + x1[3] * sn.w);
            *(u32x2*)dst = o1; *(u32x2*)(dst + 16) = o2;
          }
        } else if (d0 != 80) {
          const f32x4 x = acc[i][j] * rs;
          u32x2 o; o.x = pack2(x[0], x[1]); o.y = pack2(x[2], x[3]);
          *(u32x2*)dst = o;
        }
      }
    }
  });
}

DI void item_kvproj(const P& p, unsigned char* smem, int item) {
  const int m = item >> 3, head = item & 7;
  const int tid = otid(), r_s = tid >> 3, c_s = tid & 7;
  float* rowf = (float*)(smem + SMEM_MAIN + 1024);
  __syncthreads();
  {
    const int row = tid >> 1, half = tid & 1;
    const int t = m * 128 + row, b = t >> 11, s = t & 2047;
    const bf16_t* src = p.proj + (size_t)t * NIN + 1024 + half * 64;
    float ss = 0.f;
#pragma unroll
    for (int q = 0; q < 8; ++q) {
      const u32x4 v = *(const u32x4*)(src + q * 8);
      ss += bflo(v.x) * bflo(v.x) + bfhi(v.x) * bfhi(v.x) + bflo(v.y) * bflo(v.y) + bfhi(v.y) * bfhi(v.y) + bflo(v.z) * bflo(v.z) + bfhi(v.z) * bfhi(v.z) + bflo(v.w) * bflo(v.w) + bfhi(v.w) * bfhi(v.w);
    }
    ss += __shfl_xor(ss, 1);
    if (half == 0) rowf[row] = rsqrtf(ss * (1.f / 128.f) + EPS);
    const bf16_t* kp = p.proj + (size_t)t * NIN + 1152 + half * 8;
    const u32x4 a1 = *(const u32x4*)kp, a2 = *(const u32x4*)(kp + 16);
    const float* cp = p.ropec + (size_t)t * 16 + half * 8; const float* sp = p.ropes + (size_t)t * 16 + half * 8;
    const float4 c0 = *(const float4*)cp, c1 = *(const float4*)(cp + 4), s0 = *(const float4*)sp, s1 = *(const float4*)(sp + 4);
    const float x1[8] = {bflo(a1.x), bfhi(a1.x), bflo(a1.y), bfhi(a1.y), bflo(a1.z), bfhi(a1.z), bflo(a1.w), bfhi(a1.w)};
    const float x2[8] = {bflo(a2.x), bfhi(a2.x), bflo(a2.y), bfhi(a2.y), bflo(a2.z), bfhi(a2.z), bflo(a2.w), bfhi(a2.w)};
    const float cc[8] = {c0.x, c0.y, c0.z, c0.w, c1.x, c1.y, c1.z, c1.w};
    const float sn[8] = {s0.x, s0.y, s0.z, s0.w, s1.x, s1.y, s1.z, s1.w};
    u32x4 o1, o2;
    o1.x = pack2(x1[0] * cc[0] - x2[0] * sn[0], x1[1] * cc[1] - x2[1] * sn[1]);
    o1.y = pack2(x1[2] * cc[2] - x2[2] * sn[2], x1[3] * cc[3] - x2[3] * sn[3]);
    o1.z = pack2(x1[4] * cc[4] - x2[4] * sn[4], x1[5] * cc[5] - x2[5] * sn[5]);
    o1.w = pack2(x1[6] * cc[6] - x2[6] * sn[6], x1[7] * cc[7] - x2[7] * sn[7]);
    o2.x = pack2(x2[0] * cc[0] + x1[0] * sn[0], x2[1] * cc[1] + x1[1] * sn[1]);
    o2.y = pack2(x2[2] * cc[2] + x1[2] * sn[2], x2[3] * cc[3] + x1[3] * sn[3]);
    o2.z = pack2(x2[4] * cc[4] + x1[4] * sn[4], x2[5] * cc[5] + x1[5] * sn[5]);
    o2.w = pack2(x2[6] * cc[6] + x1[6] * sn[6], x2[7] * cc[7] + x1[7] * sn[7]);
    bf16_t* kd = p.Kb + ((size_t)((b * 8 + head) * 2048 + s)) * 96 + 64 + half * 8;
    *(u32x4*)kd = o1; *(u32x4*)(kd + 16) = o2;
  }
  const bf16_t* ap[4]; const bf16_t* bp[4];
#pragma unroll
  for (int j = 0; j < 4; ++j) {
    const int row = r_s + 32 * j;
    ap[j] = p.proj + (size_t)(m * 128 + row) * NIN + 1024 + c_s * 8;
    bp[j] = p.wukv_t + (size_t)(head * 128 + row) * 128 + c_s * 8;
  }
  bf16_t* Kb = p.Kb; bf16_t* V = p.V;
  gemm128(smem, ap, bp, 2, [=](f32x4 (&acc)[4][4], int wm, int wn, int fr, int fq) {
#pragma unroll
    for (int i = 0; i < 4; ++i) {
      const int tl = wm * 64 + i * 16 + fr, t = m * 128 + tl;
      const int b = t >> 11, s = t & 2047;
      const float rs = rowf[tl];
      const size_t rowi = (size_t)((b * 8 + head) * 2048 + s);
#pragma unroll
      for (int j = 0; j < 4; ++j) {
        const int d = j * 16 + fq * 4;
        const f32x4 x = acc[i][j] * rs;
        u32x2 o; o.x = pack2(x[0], x[1]); o.y = pack2(x[2], x[3]);
        if (wn == 0) *(u32x2*)(Kb + rowi * 96 + d) = o; else *(u32x2*)(V + rowi * 64 + d) = o;
      }
    }
  });
}

DI void item_pool(const P& p, unsigned char* smem, int l, int item) {
  const int tid = otid(), w = tid >> 6, lane = tid & 63, fr = lane & 15, fq = lane >> 4;
  const int tile = item >> 2, g = item & 3;
  const int t0 = tile * 128, s0 = t0 & 2047;
  const int wdw = 2 << g;
  unsigned char* al = smem;
  unsigned char* dl = smem + 20480;
  __syncthreads();
  for (int id = tid; id < 143 * 8; id += NTHREADS) {
    const int row = id >> 3, c = id & 7;
    const int srel = s0 - 15 + row;
    u32x4 v = (u32x4){0u, 0u, 0u, 0u};
    if (srel >= 0) v = *(const u32x4*)(p.proj + (size_t)(t0 - 15 + row) * NIN + g * 64 + c * 8);
    *(u32x4*)(al + row * 128 + c * 16) = v;
  }
  __syncthreads();
  {
    const int tl = tid >> 1, cb = (tid & 1) * 4;
    const int pos = s0 + tl;
    const int nw = (pos + 1 < wdw) ? pos + 1 : wdw;
    const float inv = 1.f / (float)nw;
#pragma unroll
    for (int q = 0; q < 4; ++q) {
      const int c = cb + q;
      float sm[8];
#pragma unroll
      for (int e = 0; e < 8; ++e) sm[e] = 0.f;
      for (int j = 0; j < nw; ++j) {
        const u32x4 v = *(const u32x4*)(al + (tl + 15 - j) * 128 + c * 16);
        sm[0] += bflo(v.x); sm[1] += bfhi(v.x); sm[2] += bflo(v.y); sm[3] += bfhi(v.y); sm[4] += bflo(v.z); sm[5] += bfhi(v.z); sm[6] += bflo(v.w); sm[7] += bfhi(v.w);
      }
      const u32x4 a = *(const u32x4*)(al + (tl + 15) * 128 + c * 16);
      u32x4 o;
      o.x = pack2(sm[0] * inv - bflo(a.x), sm[1] * inv - bfhi(a.x)); o.y = pack2(sm[2] * inv - bflo(a.y), sm[3] * inv - bfhi(a.y));
      o.z = pack2(sm[4] * inv - bflo(a.z), sm[5] * inv - bfhi(a.z)); o.w = pack2(sm[6] * inv - bflo(a.w), sm[7] * inv - bfhi(a.w));
      *(u32x4*)(dl + tl * 128 + ((c ^ (tl & 7)) << 4)) = o;
    }
  }
  __syncthreads();
  {
    const bf16_t* wp = p.wpool_t + ((size_t)(l * 4 + g) * 64) * 64;
    f32x4 acc[2][4];
#pragma unroll
    for (int i = 0; i < 2; ++i)
#pragma unroll
      for (int j = 0; j < 4; ++j) acc[i][j] = (f32x4){0.f, 0.f, 0.f, 0.f};
#pragma unroll
    for (int ks = 0; ks < 2; ++ks) {
      bf16x8 df[2], wf[4];
#pragma unroll
      for (int i = 0; i < 2; ++i) { const int row = w * 32 + i * 16 + fr; df[i] = *(const bf16x8*)(dl + row * 128 + (((ks * 4 + fq) ^ (row & 7)) << 4)); }
#pragma unroll
      for (int j = 0; j < 4; ++j) wf[j] = *(const bf16x8*)(wp + (size_t)(j * 16 + fr) * 64 + ks * 32 + fq * 8);
#pragma unroll
      for (int i = 0; i < 2; ++i)
#pragma unroll
        for (int j = 0; j < 4; ++j) acc[i][j] = __builtin_amdgcn_mfma_f32_16x16x32_bf16(wf[j], df[i], acc[i][j], 0, 0, 0);
    }
#pragma unroll
    for (int i = 0; i < 2; ++i) {
      const int t = t0 + w * 32 + i * 16 + fr;
#pragma unroll
      for (int j = 0; j < 4; ++j) {
        const int cc = g * 64 + j * 16 + fq * 4;
        const float4 ps = *(const float4*)(p.pool_scale + l * 256 + cc);
        u32x2 o; o.x = pack2(acc[i][j][0] * ps.x, acc[i][j][1] * ps.y); o.y = pack2(acc[i][j][2] * ps.z, acc[i][j][3] * ps.w);
        *(u32x2*)(p.Y + (size_t)t * 1024 + cc) = o;
      }
    }
  }
}

DI void item_sgu(const P& p, unsigned char* smem, int l, int chunk) {
  const int tid = otid(), w = tid >> 6, lane = tid & 63, fr = lane & 15, fq = lane >> 4;
  const int t0 = chunk * 128;
  unsigned char* vn = smem;
  __syncthreads();
#pragma unroll 1
  for (int ps = 0; ps < 4; ++ps) {
    const int tl = ps * 32 + (tid >> 3), part = tid & 7;
    const bf16_t* src = p.proj + (size_t)(t0 + tl) * NIN + 512 + part * 32;
    float x[32];
#pragma unroll
    for (int q = 0; q < 4; ++q) {
      const u32x4 v = *(const u32x4*)(src + q * 8);
      x[q * 8 + 0] = gelu_tanh(bflo(v.x)); x[q * 8 + 1] = gelu_tanh(bfhi(v.x)); x[q * 8 + 2] = gelu_tanh(bflo(v.y)); x[q * 8 + 3] = gelu_tanh(bfhi(v.y));
      x[q * 8 + 4] = gelu_tanh(bflo(v.z)); x[q * 8 + 5] = gelu_tanh(bfhi(v.z)); x[q * 8 + 6] = gelu_tanh(bflo(v.w)); x[q * 8 + 7] = gelu_tanh(bfhi(v.w));
    }
    float sm = 0.f;
#pragma unroll
    for (int e = 0; e < 32; ++e) sm += x[e];
    sm += __shfl_xor(sm, 1); sm += __shfl_xor(sm, 2); sm += __shfl_xor(sm, 4);
    const float mu = sm * (1.f / 256.f);
    float vs = 0.f;
#pragma unroll
    for (int e = 0; e < 32; ++e) { x[e] -= mu; vs += x[e] * x[e]; }
    vs += __shfl_xor(vs, 1); vs += __shfl_xor(vs, 2); vs += __shfl_xor(vs, 4);
    const float rstd = rsqrtf(vs * (1.f / 256.f) + EPS);
#pragma unroll
    for (int q = 0; q < 4; ++q) {
      const int c = part * 4 + q;
      u32x4 o;
      o.x = pack2(x[q * 8 + 0] * rstd, x[q * 8 + 1] * rstd); o.y = pack2(x[q * 8 + 2] * rstd, x[q * 8 + 3] * rstd);
      o.z = pack2(x[q * 8 + 4] * rstd, x[q * 8 + 5] * rstd); o.w = pack2(x[q * 8 + 6] * rstd, x[q * 8 + 7] * rstd);
      *(u32x4*)(vn + tl * 512 + (((c >> 1) ^ (tl & 7)) << 5) + ((c & 1) << 4)) = o;
    }
  }
  __syncthreads();
  const int qq = fr >> 2, pp = fr & 3;
#pragma unroll 1
  for (int hh = 0; hh < 4; ++hh) {
    f32x4 acc[4][2];
#pragma unroll
    for (int df = 0; df < 4; ++df) { acc[df][0] = (f32x4){0.f, 0.f, 0.f, 0.f}; acc[df][1] = (f32x4){0.f, 0.f, 0.f, 0.f}; }
    const bf16_t* wb = p.wsp_b + ((size_t)(l * 4 + hh) * 128) * 128;
    for (int kb = 0; kb <= w; ++kb) {
      bf16x8 wf[2];
#pragma unroll
      for (int f = 0; f < 2; ++f) {
        const bf16_t* wr = wb + (size_t)((2 * w + f) * 16 + fr) * 128 + kb * 32 + fq * 4;
        const u32x2 lo = *(const u32x2*)wr, hi = *(const u32x2*)(wr + 16);
        u32x4 u; u.x = lo.x; u.y = lo.y; u.z = hi.x; u.w = hi.y;
        wf[f] = __builtin_bit_cast(bf16x8, u);
      }
#pragma unroll
      for (int df = 0; df < 4; ++df) {
        const int keyA = kb * 32 + fq * 4 + qq, keyB = keyA + 16;
        const int slot = hh * 4 + df;
        const s16x4 lo = __builtin_amdgcn_ds_read_tr16_b64_v4i16((LAS s16x4*)(vn + keyA * 512 + ((slot ^ (keyA & 7)) << 5) + pp * 8));
        const s16x4 hi = __builtin_amdgcn_ds_read_tr16_b64_v4i16((LAS s16x4*)(vn + keyB * 512 + ((slot ^ (keyB & 7)) << 5) + pp * 8));
        bf16x8 vf; vf[0] = lo[0]; vf[1] = lo[1]; vf[2] = lo[2]; vf[3] = lo[3]; vf[4] = hi[0]; vf[5] = hi[1]; vf[6] = hi[2]; vf[7] = hi[3];
        acc[df][0] = __builtin_amdgcn_mfma_f32_16x16x32_bf16(vf, wf[0], acc[df][0], 0, 0, 0);
        acc[df][1] = __builtin_amdgcn_mfma_f32_16x16x32_bf16(vf, wf[1], acc[df][1], 0, 0, 0);
      }
    }
#pragma unroll
    for (int f = 0; f < 2; ++f) {
      const int tl = (2 * w + f) * 16 + fr, t = t0 + tl;
      const float bias = p.b_spatial[(l * 4 + hh) * 128 + tl];
#pragma unroll
      for (int df = 0; df < 4; ++df) {
        const int d = hh * 64 + df * 16 + fq * 4;
        const u32x2 uu = *(const u32x2*)(p.proj + (size_t)t * NIN + 256 + d);
        u32x2 o;
        o.x = pack2(gelu_tanh(bflo(uu.x)) * (acc[df][f][0] + bias), gelu_tanh(bfhi(uu.x)) * (acc[df][f][1] + bias));
        o.y = pack2(gelu_tanh(bflo(uu.y)) * (acc[df][f][2] + bias), gelu_tanh(bfhi(uu.y)) * (acc[df][f][3] + bias));
        *(u32x2*)(p.Y + (size_t)t * 1024 + 256 + d) = o;
      }
    }
  }
}

DI void item_attn(const P& p, unsigned char* smem, int item) {
  const int tid = otid(), w = tid >> 6, lane = tid & 63;
  const int fr = lane & 15, fq = lane >> 4;
  const int rnd = item >> 9, blk = item & 511;
  const int qb = rnd == 0 ? 15 - (blk >> 6) : (blk >> 6);
  const int bh = blk & 63, b = bh >> 3, h = bh & 7;
  const int q0 = qb * 128;
  const int nkt = 2 * qb + 2;
  const bf16_t* Qg = p.Q + (size_t)bh * 2048 * 96;
  const bf16_t* Kg = p.Kb + (size_t)bh * 2048 * 96;
  const bf16_t* Vg = p.V + (size_t)bh * 2048 * 64;
  int kkey[3], kdst[3], kc[3];
#pragma unroll
  for (int j = 0; j < 3; ++j) { const int id = tid + 256 * j; kkey[j] = id / 12; kc[j] = id % 12; kdst[j] = kkey[j] * 256 + ((kc[j] ^ (kkey[j] & 15)) << 4); }
  int vkey[2], vdst[2], vc[2];
#pragma unroll
  for (int j = 0; j < 2; ++j) { const int id = tid + 256 * j; vkey[j] = id >> 3; vc[j] = id & 7; vdst[j] = vkey[j] * 128 + (((vc[j] >> 1) ^ ((vkey[j] >> 1) & 3)) << 5) + ((vc[j] & 1) << 4); }
  bf16x8 qf[3][2];
#pragma unroll
  for (int ks = 0; ks < 3; ++ks)
#pragma unroll
    for (int f = 0; f < 2; ++f) qf[ks][f] = *(const bf16x8*)(Qg + (size_t)(q0 + 32 * w + 16 * f + fr) * 96 + ks * 32 + fq * 8);
  f32x4 o[4][2];
#pragma unroll
  for (int f = 0; f < 4; ++f) { o[f][0] = (f32x4){0.f, 0.f, 0.f, 0.f}; o[f][1] = (f32x4){0.f, 0.f, 0.f, 0.f}; }
  float mrun[2] = {-INFINITY, -INFINITY}, lrun[2] = {0.f, 0.f};
  u32x4 rk[3], rv[2];
  __syncthreads();
#pragma unroll
  for (int j = 0; j < 3; ++j) rk[j] = *(const u32x4*)(Kg + (size_t)kkey[j] * 96 + kc[j] * 8);
#pragma unroll
  for (int j = 0; j < 2; ++j) rv[j] = *(const u32x4*)(Vg + (size_t)vkey[j] * 64 + vc[j] * 8);
#pragma unroll
  for (int j = 0; j < 3; ++j) *(u32x4*)(smem + kdst[j]) = rk[j];
#pragma unroll
  for (int j = 0; j < 2; ++j) *(u32x4*)(smem + 32768 + vdst[j]) = rv[j];
  __syncthreads();
  const int rowmin = q0 + 32 * w;
  for (int kt = 0; kt < nkt; ++kt) {
    const int cur = kt & 1;
    const bool more = kt + 1 < nkt;
    if (more) {
      const int key0n = (kt + 1) * 64;
#pragma unroll
      for (int j = 0; j < 3; ++j) rk[j] = *(const u32x4*)(Kg + (size_t)(key0n + kkey[j]) * 96 + kc[j] * 8);
#pragma unroll
      for (int j = 0; j < 2; ++j) rv[j] = *(const u32x4*)(Vg + (size_t)(key0n + vkey[j]) * 64 + vc[j] * 8);
    }
    const int key0 = kt * 64;
    if (key0 <= rowmin + 31) {
      const unsigned char* Kl = smem + cur * 16384;
      const unsigned char* Vl = smem + 32768 + cur * 8192;
      f32x4 st[4][2];
#pragma unroll
      for (int kf = 0; kf < 4; ++kf) { st[kf][0] = (f32x4){0.f, 0.f, 0.f, 0.f}; st[kf][1] = (f32x4){0.f, 0.f, 0.f, 0.f}; }
#pragma unroll
      for (int ks = 0; ks < 3; ++ks)
#pragma unroll
        for (int kf = 0; kf < 4; ++kf) {
          const int key = kf * 16 + fr;
          const bf16x8 a = *(const bf16x8*)(Kl + key * 256 + (((ks * 4 + fq) ^ (key & 15)) << 4));
          st[kf][0] = __builtin_amdgcn_mfma_f32_16x16x32_bf16(a, qf[ks][0], st[kf][0], 0, 0, 0);
          st[kf][1] = __builtin_amdgcn_mfma_f32_16x16x32_bf16(a, qf[ks][1], st[kf][1], 0, 0, 0);
        }
      const bool needmask = (key0 + 63 > rowmin);
#pragma unroll
      for (int f = 0; f < 2; ++f) {
        const int qabs = rowmin + 16 * f + fr;
        if (needmask) {
#pragma unroll
          for (int kf = 0; kf < 4; ++kf)
#pragma unroll
            for (int r = 0; r < 4; ++r) { const int kabs = key0 + kf * 16 + fq * 4 + r; if (kabs > qabs) st[kf][f][r] = -INFINITY; }
        }
        float mx = st[0][f][0];
#pragma unroll
        for (int kf = 0; kf < 4; ++kf)
#pragma unroll
          for (int r = 0; r < 4; ++r) mx = fmaxf(mx, st[kf][f][r]);
        mx = fmaxf(mx, __shfl_xor(mx, 16)); mx = fmaxf(mx, __shfl_xor(mx, 32));
        const float mnew = fmaxf(mrun[f], mx);
        const float alpha = __builtin_amdgcn_exp2f(mrun[f] - mnew);
        mrun[f] = mnew;
        float ls = 0.f;
#pragma unroll
        for (int kf = 0; kf < 4; ++kf)
#pragma unroll
          for (int r = 0; r < 4; ++r) { const float pv = __builtin_amdgcn_exp2f(st[kf][f][r] - mnew); st[kf][f][r] = pv; ls += pv; }
        lrun[f] = lrun[f] * alpha + ls;
#pragma unroll
        for (int df = 0; df < 4; ++df) o[df][f] = o[df][f] * alpha;
      }
      bf16x8 pf[2][2];
#pragma unroll
      for (int kb = 0; kb < 2; ++kb)
#pragma unroll
        for (int f = 0; f < 2; ++f) {
          u32x4 u;
          u.x = pack2(st[2 * kb][f][0], st[2 * kb][f][1]); u.y = pack2(st[2 * kb][f][2], st[2 * kb][f][3]);
          u.z = pack2(st[2 * kb + 1][f][0], st[2 * kb + 1][f][1]); u.w = pack2(st[2 * kb + 1][f][2], st[2 * kb + 1][f][3]);
          pf[kb][f] = __builtin_bit_cast(bf16x8, u);
        }
      const int qq = fr >> 2, pp = fr & 3;
#pragma unroll
      for (int kb = 0; kb < 2; ++kb)
#pragma unroll
        for (int df = 0; df < 4; ++df) {
          const int keyA = kb * 32 + fq * 4 + qq, keyB = keyA + 16;
          const int offA = keyA * 128 + ((df ^ ((keyA >> 1) & 3)) << 5) + pp * 8;
          const int offB = keyB * 128 + ((df ^ ((keyB >> 1) & 3)) << 5) + pp * 8;
          const s16x4 lo = __builtin_amdgcn_ds_read_tr16_b64_v4i16((LAS s16x4*)(Vl + offA));
          const s16x4 hi = __builtin_amdgcn_ds_read_tr16_b64_v4i16((LAS s16x4*)(Vl + offB));
          bf16x8 vf; vf[0] = lo[0]; vf[1] = lo[1]; vf[2] = lo[2]; vf[3] = lo[3]; vf[4] = hi[0]; vf[5] = hi[1]; vf[6] = hi[2]; vf[7] = hi[3];
          o[df][0] = __builtin_amdgcn_mfma_f32_16x16x32_bf16(vf, pf[kb][0], o[df][0], 0, 0, 0);
          o[df][1] = __builtin_amdgcn_mfma_f32_16x16x32_bf16(vf, pf[kb][1], o[df][1], 0, 0, 0);
        }
    }
    if (more) {
      const int nx = cur ^ 1;
#pragma unroll
      for (int j = 0; j < 3; ++j) *(u32x4*)(smem + nx * 16384 + kdst[j]) = rk[j];
#pragma unroll
      for (int j = 0; j < 2; ++j) *(u32x4*)(smem + 32768 + nx * 8192 + vdst[j]) = rv[j];
    }
    __syncthreads();
  }
#pragma unroll
  for (int f = 0; f < 2; ++f) {
    float lt = lrun[f]; lt += __shfl_xor(lt, 16); lt += __shfl_xor(lt, 32);
    const float inv = 1.f / lt;
    const int t = b * 2048 + rowmin + 16 * f + fr;
#pragma unroll
    for (int df = 0; df < 4; ++df) {
      const f32x4 x = o[df][f] * inv;
      u32x2 ov; ov.x = pack2(x[0], x[1]); ov.y = pack2(x[2], x[3]);
      *(u32x2*)(p.Y + (size_t)t * 1024 + 512 + h * 64 + df * 16 + fq * 4) = ov;
    }
  }
}

DI void item_p4(const P& p, unsigned char* smem, int l, int item) {
  const int m = item >> 3, nt = item & 7;
  const int tid = otid(), r_s = tid >> 3, c_s = tid & 7;
  const bf16_t* ap[4]; const bf16_t* bp[4];
#pragma unroll
  for (int j = 0; j < 4; ++j) {
    const int row = r_s + 32 * j;
    ap[j] = p.Y + (size_t)(m * 128 + row) * 1024 + c_s * 8;
    bp[j] = p.wout_t + (size_t)(nt * 128 + row) * 1024 + c_s * 8;
  }
  const float* xin = (l == 0) ? p.x : p.out;
  float* xout = p.out;
  const float* mod = p.mod + (size_t)l * 8 * 6144 + 2048;
  float* rowss = p.rowss;
  gemm128(smem, ap, bp, 16, [=](f32x4 (&acc)[4][4], int wm, int wn, int fr, int fq) {
#pragma unroll
    for (int i = 0; i < 4; ++i) {
      const int t = m * 128 + wm * 64 + i * 16 + fr, b = t >> 11;
      float ss = 0.f;
#pragma unroll
      for (int j = 0; j < 4; ++j) {
        const int n = nt * 128 + wn * 64 + j * 16 + fq * 4;
        const float4 xv = *(const float4*)(xin + (size_t)t * 1024 + n);
        const float4 g = *(const float4*)(mod + (size_t)b * 6144 + n);
        float4 ov = {xv.x + g.x * acc[i][j][0], xv.y + g.y * acc[i][j][1], xv.z + g.z * acc[i][j][2], xv.w + g.w * acc[i][j][3]};
        ss += ov.x * ov.x + ov.y * ov.y + ov.z * ov.z + ov.w * ov.w;
        *(float4*)(xout + (size_t)t * 1024 + n) = ov;
      }
      ss += __shfl_xor(ss, 16); ss += __shfl_xor(ss, 32);
      if (fq == 0) rowss[(size_t)t * 16 + nt * 2 + wn] = ss;
    }
  });
}

DI void item_p5(const P& p, unsigned char* smem, int l, int item) {
  const int tid = otid(), w = tid >> 6, lane = tid & 63, fr = lane & 15, fq = lane >> 4;
  const int r_s = tid >> 3, c_s = tid & 7;
  const int tb = item * 64 + w * 16;
  const int t = tb + fr, b = (item * 64) >> 11;
  const float* xr = p.out + (size_t)t * 1024 + fq * 8;
  float* mds = (float*)(smem + 32768);
  __syncthreads();
  {
    const float* md = p.mod + ((size_t)l * 8 + b) * 6144 + 3072;
    for (int i = tid; i < 512; i += NTHREADS) *(float4*)(mds + i * 4) = *(const float4*)(md + i * 4);
  }
  float rstd;
  {
    const float4* rp = (const float4*)(p.rowss + (size_t)t * 16);
    const float4 a = rp[0], c = rp[1], d = rp[2], e = rp[3];
    const float ss = ((a.x + a.y) + (a.z + a.w)) + ((c.x + c.y) + (c.z + c.w)) + ((d.x + d.y) + (d.z + d.w)) + ((e.x + e.y) + (e.z + e.w));
    rstd = rsqrtf(ss * (1.f / 1024.f) + EPS);
  }
  const bf16_t* wsrc[4];
#pragma unroll
  for (int j = 0; j < 4; ++j) {
    const int row = r_s + 32 * j;
    wsrc[j] = (row < 64 ? p.wr_hi + (size_t)l * 65536 + (size_t)row * 1024 : p.wr_lo + (size_t)l * 65536 + (size_t)(row - 64) * 1024) + c_s * 8;
  }
  const int st_off = r_s * 128 + ((c_s ^ (r_s & 7)) << 4);
  u32x4 rw[4]; float4 xa[2], xb[2];
#pragma unroll
  for (int j = 0; j < 4; ++j) rw[j] = *(const u32x4*)(wsrc[j]);
#pragma unroll
  for (int q = 0; q < 2; ++q) { xa[q] = *(const float4*)(xr + q * 32); xb[q] = *(const float4*)(xr + q * 32 + 4); }
#pragma unroll
  for (int j = 0; j < 4; ++j) *(u32x4*)(smem + st_off + j * 4096) = rw[j];
  __syncthreads();
  f32x4 acc[4];
#pragma unroll
  for (int nf = 0; nf < 4; ++nf) acc[nf] = (f32x4){0.f, 0.f, 0.f, 0.f};
  bf16_t* hdst = p.h + (size_t)t * 1024 + fq * 8;
  for (int kc = 0; kc < 16; ++kc) {
    const int cur = (kc & 1) * 16384;
    const bool more = kc + 1 < 16;
    float4 ca[2], cb[2];
#pragma unroll
    for (int q = 0; q < 2; ++q) { ca[q] = xa[q]; cb[q] = xb[q]; }
    if (more) {
#pragma unroll
      for (int j = 0; j < 4; ++j) rw[j] = *(const u32x4*)(wsrc[j] + (kc + 1) * 64);
#pragma unroll
      for (int q = 0; q < 2; ++q) { xa[q] = *(const float4*)(xr + (kc + 1) * 64 + q * 32); xb[q] = *(const float4*)(xr + (kc + 1) * 64 + q * 32 + 4); }
    }
#pragma unroll
    for (int q = 0; q < 2; ++q) {
      const int k0 = kc * 64 + q * 32 + fq * 8;
      const float4 ha = *(const float4*)(mds + k0), hb = *(const float4*)(mds + k0 + 4);
      const float4 sa = *(const float4*)(mds + 1024 + k0), sb = *(const float4*)(mds + 1024 + k0 + 4);
      float hv[8];
      hv[0] = ca[q].x * rstd * (1.f + sa.x) + ha.x; hv[1] = ca[q].y * rstd * (1.f + sa.y) + ha.y; hv[2] = ca[q].z * rstd * (1.f + sa.z) + ha.z; hv[3] = ca[q].w * rstd * (1.f + sa.w) + ha.w;
      hv[4] = cb[q].x * rstd * (1.f + sb.x) + hb.x; hv[5] = cb[q].y * rstd * (1.f + sb.y) + hb.y; hv[6] = cb[q].z * rstd * (1.f + sb.z) + hb.z; hv[7] = cb[q].w * rstd * (1.f + sb.w) + hb.w;
      u32x4 uh, ul;
      uh.x = pack2(hv[0], hv[1]); uh.y = pack2(hv[2], hv[3]); uh.z = pack2(hv[4], hv[5]); uh.w = pack2(hv[6], hv[7]);
      ul.x = pack2(hv[0] - bflo(uh.x), hv[1] - bfhi(uh.x)); ul.y = pack2(hv[2] - bflo(uh.y), hv[3] - bfhi(uh.y));
      ul.z = pack2(hv[4] - bflo(uh.z), hv[5] - bfhi(uh.z)); ul.w = pack2(hv[6] - bflo(uh.w), hv[7] - bfhi(uh.w));
      *(u32x4*)(hdst + kc * 64 + q * 32) = uh;
      const bf16x8 bh = __builtin_bit_cast(bf16x8, uh), bl = __builtin_bit_cast(bf16x8, ul);
      const int sw = ((q * 4 + fq) ^ (fr & 7)) << 4;
#pragma unroll
      for (int nf = 0; nf < 4; ++nf) {
        const bf16x8 ah = *(const bf16x8*)(smem + cur + (nf * 16 + fr) * 128 + sw), al = *(const bf16x8*)(smem + cur + (64 + nf * 16 + fr) * 128 + sw);
        acc[nf] = __builtin_amdgcn_mfma_f32_16x16x32_bf16(ah, bh, acc[nf], 0, 0, 0);
        acc[nf] = __builtin_amdgcn_mfma_f32_16x16x32_bf16(ah, bl, acc[nf], 0, 0, 0);
        acc[nf] = __builtin_amdgcn_mfma_f32_16x16x32_bf16(al, bh, acc[nf], 0, 0, 0);
      }
    }
    if (more) {
      const int nxt = 16384 - cur;
#pragma unroll
      for (int j = 0; j < 4; ++j) *(u32x4*)(smem + nxt + st_off + j * 4096) = rw[j];
    }
    __syncthreads();
  }
  float* lg = (float*)smem + w * 1024;
  int* info = (int*)(smem + 16384) + w * 1024;
#pragma unroll
  for (int nf = 0; nf < 4; ++nf) *(f32x4*)(lg + fr * 64 + nf * 16 + fq * 4) = acc[nf];
  __syncthreads();
  const float bias = p.router_bias[l * 64 + lane];
  int cnt_local = 0;
#pragma unroll 1
  for (int q = 0; q < 16; ++q) {
    const float s = 1.f / (1.f + __expf(-lg[q * 64 + lane]));
    const float sel = s + bias;
    float m1 = sel; m1 = fmaxf(m1, __shfl_xor(m1, 1)); m1 = fmaxf(m1, __shfl_xor(m1, 2)); m1 = fmaxf(m1, __shfl_xor(m1, 4));
    const unsigned long long eq = __ballot(sel == m1);
    const int gbase = lane & ~7;
    const unsigned gm = (unsigned)((eq >> gbase) & 0xffull);
    const int first = gbase + __ffs(gm) - 1;
    float m2 = (lane == first) ? -INFINITY : sel;
    m2 = fmaxf(m2, __shfl_xor(m2, 1)); m2 = fmaxf(m2, __shfl_xor(m2, 2)); m2 = fmaxf(m2, __shfl_xor(m2, 4));
    const float gs = m1 + m2;
    const int myg = lane >> 3; int rank = 0;
#pragma unroll
    for (int j = 0; j < 8; ++j) { const float gj = __shfl(gs, j * 8); rank += ((gj > gs) || (gj == gs && j < myg)) ? 1 : 0; }
    const bool gsel = rank < 4;
    const float sm = gsel ? sel : -INFINITY;
    int r = 0;
#pragma unroll 8
    for (int j = 0; j < 64; ++j) { const float sj = __shfl(sm, j); r += ((sj > sm) || (sj == sm && j < lane)) ? 1 : 0; }
    const bool ch = gsel && (r < 8);
    const float tot = wsum(ch ? s : 0.f);
    const unsigned long long cm = __ballot(ch);
    const int kidx = __popcll(cm & ((1ull << lane) - 1ull));
    info[q * 64 + lane] = ch ? kidx : -1;
    if (ch) p.topw[(size_t)(tb + q) * 8 + kidx] = s / tot * 2.5f;
    cnt_local += ch ? 1 : 0;
  }
  int base = 0;
  if (cnt_local > 0) base = atomicAdd(p.cnt + (l * 64 + lane) * CSTRIDE, cnt_local);
#pragma unroll 1
  for (int q = 0; q < 16; ++q) {
    const int k = info[q * 64 + lane];
    if (k >= 0) { p.list[(size_t)lane * LISTCAP + base] = (tb + q) * 8 + k; ++base; }
  }
}

DI void moe_table(const P& p, unsigned char* smem, int l) {
  int* start = (int*)(smem + SMEM_MAIN);
  __syncthreads();
  if (threadIdx.x == 0) {
    int s = 0;
    for (int e = 0; e < 64; ++e) { start[e] = s; s += (p.cnt[(l * 64 + e) * CSTRIDE] + 127) >> 7; }
    start[64] = s;
  }
  __syncthreads();
}
DI void moe_rows(const P& p, unsigned char* smem, int l, int mt, int& e_out) {
  const int* start = (const int*)(smem + SMEM_MAIN);
  int* rowinfo = (int*)(smem + SMEM_MAIN + 512);
  const int tid = otid();
  int e;
  if (mt >= start[64]) { e = 64; if (tid < 128) rowinfo[tid] = T_ * 8 + (mt - start[64]) * 128 + tid; }
  else {
    e = 0;
    for (int q = 1; q < 64; ++q) e = (start[q] <= mt) ? q : e;
    const int tl = mt - start[e];
    const int cnt = p.cnt[(l * 64 + e) * CSTRIDE];
    if (tid < 128) { const int idx = tl * 128 + tid; rowinfo[tid] = idx < cnt ? p.list[(size_t)e * LISTCAP + idx] : -1; }
  }
  e_out = e;
}

DI void item_p7(const P& p, unsigned char* smem, int l, int item) {
  const int mt = item >> 2, nt = item & 3;
  const int tid = otid(), r_s = tid >> 3, c_s = tid & 7;
  int* rowinfo = (int*)(smem + SMEM_MAIN + 512);
  __syncthreads();
  int e; moe_rows(p, smem, l, mt, e);
  __syncthreads();
  const bf16_t* wbase = (e == 64) ? p.wsg_t : p.wgu_t + (size_t)e * 512 * 1024;
  const bf16_t* ap[4]; const bf16_t* bp[4];
#pragma unroll
  for (int j = 0; j < 4; ++j) {
    const int row = r_s + 32 * j;
    const int slot = rowinfo[row];
    const int tok = slot < 0 ? 0 : (slot >= T_ * 8 ? slot - T_ * 8 : slot >> 3);
    ap[j] = p.h + (size_t)tok * 1024 + c_s * 8;
    bp[j] = wbase + (size_t)(nt * 128 + row) * 1024 + c_s * 8;
  }
  bf16_t* act = p.act;
  gemm128(smem, ap, bp, 16, [=](f32x4 (&acc)[4][4], int wm, int wn, int fr, int fq) {
    unsigned char* ob = smem + wm * 8192;
#pragma unroll
    for (int i = 0; i < 4; ++i) {
#pragma unroll
      for (int jj = 0; jj < 2; ++jj) {
        const f32x4 g = acc[i][2 * jj], u = acc[i][2 * jj + 1];
        u32x2 o; o.x = pack2(silu_f(g[0]) * u[0], silu_f(g[1]) * u[1]); o.y = pack2(silu_f(g[2]) * u[2], silu_f(g[3]) * u[3]);
        ot_put<128>(ob, i * 16 + fr, wn * 8 + jj * 4 + fq, o);
      }
    }
    __syncthreads();
    {
      const int tid2 = fq * 16 + fr + 64 * (wm * 2 + wn);
      const int chunk = tid2 & 7;
#pragma unroll
      for (int i = 0; i < 4; ++i) {
        const int row = (tid2 >> 3) + 32 * i;
        const int slot = rowinfo[row];
        if (slot >= 0) {
          const u32x4 v = ot_get<128>(smem + (row >> 6) * 8192, row & 63, chunk);
          *(u32x4*)(act + (size_t)slot * 256 + nt * 64 + chunk * 8) = v;
        }
      }
    }
  });
}

DI void item_p8(const P& p, unsigned char* smem, int l, int item) {
  const int mt = item >> 1, nh = item & 1;
  const int tid = otid(), r_s = tid >> 3, c_s = tid & 7;
  int* rowinfo = (int*)(smem + SMEM_MAIN + 512);
  __syncthreads();
  int e; moe_rows(p, smem, l, mt, e);
  __syncthreads();
  const bf16_t* wbase = (e == 64) ? p.wsd_t : p.wd_t + (size_t)e * 1024 * 256;
  const bf16_t* ap[4]; const bf16_t* bp[4];
#pragma unroll
  for (int j = 0; j < 4; ++j) {
    const int row = r_s + 32 * j;
    const int slot = rowinfo[row];
    ap[j] = p.act + (size_t)(slot < 0 ? 0 : slot) * 256 + c_s * 8;
    bp[j] = wbase + (size_t)(nh * 512 + row) * 256 + c_s * 8;
  }
  bf16_t* yrows = p.yrows; bf16_t* ysh = p.ysh; const float* topw = p.topw;
  gemm128_stream(smem, ap, bp, 4, 4, (size_t)128 * 256, [=](f32x4 (&acc)[4][4], int tile, int cur, int wm, int wn, int fr, int fq) {
    const int nt = nh * 4 + tile;
    unsigned char* ob = smem + cur + (wm ? 32768 : 0);
    __syncthreads();
#pragma unroll
    for (int i = 0; i < 4; ++i) {
      const int slot = rowinfo[wm * 64 + i * 16 + fr];
      const float wv = (slot < 0 || slot >= T_ * 8) ? 1.f : topw[slot];
#pragma unroll
      for (int j = 0; j < 4; ++j) {
        const f32x4 x = acc[i][j] * wv;
        u32x2 o; o.x = pack2(x[0], x[1]); o.y = pack2(x[2], x[3]);
        ot_put<256>(ob, i * 16 + fr, wn * 16 + j * 4 + fq, o);
      }
    }
    __syncthreads();
    {
      const int tid2 = fq * 16 + fr + 64 * (wm * 2 + wn);
      const int chunk = tid2 & 15;
#pragma unroll
      for (int i = 0; i < 8; ++i) {
        const int row = (tid2 >> 4) + 16 * i;
        const int slot = rowinfo[row];
        if (slot >= 0) {
          const u32x4 v = ot_get<256>(smem + cur + ((row >> 6) ? 32768 : 0), row & 63, chunk);
          bf16_t* dst = (slot >= T_ * 8) ? ysh + (size_t)(slot - T_ * 8) * 1024 : yrows + (size_t)slot * 1024;
          *(u32x4*)(dst + nt * 128 + chunk * 8) = v;
        }
      }
    }
  });
}

DI void item_p9(const P& p, int l, int item) {
  const int tid = otid(), w = tid >> 6, lane = tid & 63;
  const int t = item * 4 + w, b = t >> 11;
  const float* md = p.mod + ((size_t)l * 8 + b) * 6144;
  float4 v[4]; float ss = 0.f;
#pragma unroll
  for (int j = 0; j < 4; ++j) {
    const int idx = j * 256 + lane * 4;
    u32x2 y = *(const u32x2*)(p.ysh + (size_t)t * 1024 + idx);
    float a0 = bflo(y.x), a1 = bfhi(y.x), a2 = bflo(y.y), a3 = bfhi(y.y);
#pragma unroll
    for (int k = 0; k < 8; ++k) {
      y = *(const u32x2*)(p.yrows + ((size_t)t * 8 + k) * 1024 + idx);
      a0 += bflo(y.x); a1 += bfhi(y.x); a2 += bflo(y.y); a3 += bfhi(y.y);
    }
    const float4 xv = *(const float4*)(p.out + (size_t)t * 1024 + idx);
    const float4 g = *(const float4*)(md + 5120 + idx);
    v[j] = (float4){xv.x + g.x * a0, xv.y + g.y * a1, xv.z + g.z * a2, xv.w + g.w * a3};
    ss += v[j].x * v[j].x + v[j].y * v[j].y + v[j].z * v[j].z + v[j].w * v[j].w;
  }
  ss = wsum(ss);
  const float rstd = rsqrtf(ss * (1.f / 1024.f) + EPS);
  if (l == 0) {
    const float* md1 = p.mod + ((size_t)8 + b) * 6144;
#pragma unroll
    for (int j = 0; j < 4; ++j) {
      const int idx = j * 256 + lane * 4;
      *(float4*)(p.out + (size_t)t * 1024 + idx) = v[j];
      const float4 sh = *(const float4*)(md1 + idx), sc = *(const float4*)(md1 + 1024 + idx);
      u32x2 o;
      o.x = pack2(v[j].x * rstd * (1.f + sc.x) + sh.x, v[j].y * rstd * (1.f + sc.y) + sh.y);
      o.y = pack2(v[j].z * rstd * (1.f + sc.z) + sh.z, v[j].w * rstd * (1.f + sc.w) + sh.w);
      *(u32x2*)(p.h + (size_t)t * 1024 + idx) = o;
    }
  } else {
#pragma unroll
    for (int j = 0; j < 4; ++j) {
      const int idx = j * 256 + lane * 4;
      const float4 fg = *(const float4*)(p.final_gain + idx);
      *(float4*)(p.out + (size_t)t * 1024 + idx) = (float4){v[j].x * rstd * fg.x, v[j].y * rstd * fg.y, v[j].z * rstd * fg.z, v[j].w * rstd * fg.w};
    }
  }
}

__global__ void __launch_bounds__(NTHREADS, 2) fwd_megakernel(P p) {
  __shared__ __attribute__((aligned(16))) unsigned char smem[SMEM_MAIN + SMEM_EXTRA];
  const int G = gridDim.x, bid = blockIdx.x;
  volatile LAS unsigned* stw = (volatile LAS unsigned*)(smem + SMEM_MAIN + 2032);
  if (threadIdx.x == 0) { stw[0] = 0u; stw[1] = 0u; }
  __syncthreads();
  XcdBarrier bar = xcd_barrier_post(p.bar, stw);

  for (int it = bid; it < 192 + 1024 + MISC_ITEMS + CONV_ITEMS; it += G) {
    if (it < 192) item_mod(p, smem, it);
    else if (it < 192 + 1024) item_rope(p, it - 192);
    else if (it < 192 + 1024 + MISC_ITEMS) item_misc(p, it - 192 - 1024);
    else item_conv(p, smem, 0, it - 192 - 1024 - MISC_ITEMS);
  }
  xcd_barrier(bar);
  for (int it = bid; it < T_ / 4; it += G) item_norm0(p, it);
  xcd_barrier(bar);

  for (int l = 0; l < 2; ++l) {
    for (int it = bid; it < 1280; it += G) item_p1(p, smem, it);
    xcd_barrier(bar);
    for (int it = bid; it < 128 + 512 + 768 + 1024; it += G) {
      if (it < 128) item_sgu(p, smem, l, it);
      else if (it < 640) item_pool(p, smem, l, it - 128);
      else if (it < 1408) item_qproj(p, smem, it - 640);
      else item_kvproj(p, smem, it - 1408);
    }
    xcd_barrier(bar);
    for (int it = bid; it < 1024; it += G) item_attn(p, smem, it);
    xcd_barrier(bar);
    for (int it = bid; it < 1024; it += G) item_p4(p, smem, l, it);
    xcd_barrier(bar);
    for (int it = bid; it < 256; it += G) item_p5(p, smem, l, it);
    xcd_barrier(bar);
    moe_table(p, smem, l);
    const int nmt = ((const int*)(smem + SMEM_MAIN))[64] + 128;
    for (int it = bid; it < nmt * 4; it += G) item_p7(p, smem, l, it);
    xcd_barrier(bar);
    for (int it = bid; it < nmt * 2; it += G) item_p8(p, smem, l, it);
    xcd_barrier(bar);
    const int n9 = T_ / 4 + (l == 0 ? CONV_ITEMS : 0);
    for (int it = bid; it < n9; it += G) {
      if (it < T_ / 4) item_p9(p, l, it);
      else item_conv(p, smem, 1, it - T_ / 4);
    }
    if (l == 0) xcd_barrier(bar);
  }
}

extern "C" void kernel_launch(void* const* d_in, const int* in_sizes, int n_in, void* d_out, int out_size, void* d_ws, size_t ws_size,
                              hipStream_t stream) {
  P p{};
  p.x = (const float*)d_in[0]; p.c = (const float*)d_in[1]; p.pos = (const int*)d_in[2];
  p.w_ada = (const float*)d_in[3]; p.b_ada = (const float*)d_in[4]; p.w_in = (const float*)d_in[5]; p.w_pool = (const float*)d_in[6];
  p.pool_scale = (const float*)d_in[7]; p.w_spatial = (const float*)d_in[8]; p.b_spatial = (const float*)d_in[9]; p.g_q = (const float*)d_in[10];
  p.w_uq = (const float*)d_in[11]; p.g_kv = (const float*)d_in[12]; p.w_ukv = (const float*)d_in[13]; p.w_out = (const float*)d_in[14];
  p.w_router = (const float*)d_in[15]; p.router_bias = (const float*)d_in[16]; p.w_gate = (const float*)d_in[17]; p.w_up = (const float*)d_in[18];
  p.w_down = (const float*)d_in[19]; p.ws_gate = (const float*)d_in[20]; p.ws_up = (const float*)d_in[21]; p.ws_down = (const float*)d_in[22];
  p.final_gain = (const float*)d_in[23];
  p.out = (float*)d_out;
  unsigned char* ws = (unsigned char*)d_ws;
  size_t off = 0;
  auto take = [&](size_t bytes) { unsigned char* r = ws + off; off += (bytes + 255) & ~(size_t)255; return r; };
  const size_t ctrl_bytes = (size_t)XCD_BAR_WORDS * 4 + (size_t)2 * 64 * CSTRIDE * 4;
  p.bar = (unsigned*)take(ctrl_bytes);
  p.cnt = (int*)(p.bar + XCD_BAR_WORDS);
  p.mod = (float*)take((size_t)2 * 8 * 6144 * 4);
  p.ropec = (float*)take((size_t)T_ * 16 * 4);
  p.ropes = (float*)take((size_t)T_ * 16 * 4);
  p.win_t = (bf16_t*)take((size_t)NIN * 1024 * 2);
  p.wuq_t = (bf16_t*)take((size_t)768 * 256 * 2);
  p.wukv_t = (bf16_t*)take((size_t)1024 * 128 * 2);
  p.wout_t = (bf16_t*)take((size_t)1024 * 1024 * 2);
  p.wsg_t = (bf16_t*)take((size_t)512 * 1024 * 2);
  p.wsd_t = (bf16_t*)take((size_t)1024 * 256 * 2);
  p.wsp_b = (bf16_t*)take((size_t)2 * 4 * 128 * 128 * 2);
  p.wpool_t = (bf16_t*)take((size_t)2 * 4 * 64 * 64 * 2);
  p.wr_hi = (bf16_t*)take((size_t)2 * 64 * 1024 * 2);
  p.wr_lo = (bf16_t*)take((size_t)2 * 64 * 1024 * 2);
  p.wgu_t = (bf16_t*)take((size_t)64 * 512 * 1024 * 2);
  p.wd_t = (bf16_t*)take((size_t)64 * 1024 * 256 * 2);
  p.h = (bf16_t*)take((size_t)T_ * 1024 * 2);
  p.act = (bf16_t*)take((size_t)(T_ * 8 + T_) * 256 * 2);
  p.ysh = (bf16_t*)take((size_t)T_ * 1024 * 2);
  p.list = (int*)take((size_t)64 * LISTCAP * 4);
  p.topw = (float*)take((size_t)T_ * 8 * 4);
  p.rowss = (float*)take((size_t)T_ * 16 * 4);
  const size_t big0 = off;
  p.yrows = (bf16_t*)take((size_t)T_ * 8 * 1024 * 2);
  off = big0;
  p.proj = (bf16_t*)take((size_t)T_ * NIN * 2);
  p.Q = (bf16_t*)take((size_t)T_ * 8 * 96 * 2);
  p.Kb = (bf16_t*)take((size_t)T_ * 8 * 96 * 2);
  p.V = (bf16_t*)take((size_t)T_ * 8 * 64 * 2);
  p.Y = (bf16_t*)take((size_t)T_ * 1024 * 2);
  const size_t need = big0 + (size_t)T_ * 8 * 1024 * 2 + 256;
  if (need > ws_size) { fprintf(stderr, "workspace too small: need %zu have %zu\n", need, ws_size); return; }

  hipMemsetAsync(p.bar, 0, ctrl_bytes, stream);
  static int grid_blocks = 0;
  if (!grid_blocks) {
    int dev = 0, cus = 0, per_cu = 0;
    hipGetDevice(&dev);
    hipDeviceGetAttribute(&cus, hipDeviceAttributeMultiprocessorCount, dev);
    hipOccupancyMaxActiveBlocksPerMultiprocessor(&per_cu, fwd_megakernel, NTHREADS, 0);
    if (per_cu > 2) per_cu = 2;
    if (per_cu < 1) per_cu = 1;
    grid_blocks = cus * per_cu;
  }
  void* args[] = {&p};
  hipError_t e = hipLaunchCooperativeKernel((void*)fwd_megakernel, dim3(grid_blocks), dim3(NTHREADS), args, 0, stream);
  if (e != hipSuccess) fprintf(stderr, "cooperative launch failed: %s (grid %d)\n", hipGetErrorString(e), grid_blocks);
}
```

```cpp
#include <hip/hip_runtime.h>
#include <stdint.h>
#include <cstdio>

#define DI __device__ __forceinline__
#define LAS __attribute__((address_space(3)))

typedef unsigned short bf16_t;
typedef short bf16x8 __attribute__((ext_vector_type(8)));
typedef short s16x4 __attribute__((ext_vector_type(4)));
typedef float f32x4 __attribute__((ext_vector_type(4)));
typedef float f32x2 __attribute__((ext_vector_type(2)));
typedef unsigned u32x4 __attribute__((ext_vector_type(4)));
typedef unsigned u32x2 __attribute__((ext_vector_type(2)));
typedef __bf16 bf16x2_t __attribute__((ext_vector_type(2)));

constexpr int T_ = 16384, D_ = 1024, S_ = 2048, NIN = 1184;
constexpr int NTHREADS = 256;
constexpr int BLOCK_THREADS = 512;
constexpr int SMEM_MAIN = 65536, SMEM_EXTRA = 2048;
constexpr float EPS = 1e-6f;
constexpr int CSTRIDE = 64;
constexpr int LISTCAP = 16384;
constexpr int CONV_ITEMS = 592 + 24 + 16 + 128 + 96 + 6144;

constexpr size_t al256(size_t x) { return (x + 255) & ~(size_t)255; }
constexpr size_t CTRL_BYTES = (size_t)3456 * 4 + (size_t)2 * 64 * CSTRIDE * 4;
constexpr size_t O_BAR = 0;
constexpr size_t O_MOD = O_BAR + al256(CTRL_BYTES);
constexpr size_t O_ROPEC = O_MOD + al256((size_t)2 * 8 * 6144 * 4);
constexpr size_t O_ROPES = O_ROPEC + al256((size_t)T_ * 16 * 4);
constexpr size_t O_WIN = O_ROPES + al256((size_t)T_ * 16 * 4);
constexpr size_t O_WUQ = O_WIN + al256((size_t)1280 * 1024 * 2);
constexpr size_t O_WUKV = O_WUQ + al256((size_t)768 * 256 * 2);
constexpr size_t O_WOUT = O_WUKV + al256((size_t)1024 * 128 * 2);
constexpr size_t O_WSG = O_WOUT + al256((size_t)1024 * 1024 * 2);
constexpr size_t O_WSD = O_WSG + al256((size_t)512 * 1024 * 2);
constexpr size_t O_WSP = O_WSD + al256((size_t)1024 * 256 * 2);
constexpr size_t O_WPOOL = O_WSP + al256((size_t)2 * 4 * 128 * 128 * 2);
constexpr size_t O_WRHI = O_WPOOL + al256((size_t)2 * 4 * 64 * 64 * 2);
constexpr size_t O_WRLO = O_WRHI + al256((size_t)2 * 64 * 1024 * 2);
constexpr size_t O_WGU = O_WRLO + al256((size_t)2 * 64 * 1024 * 2);
constexpr size_t O_WD = O_WGU + al256((size_t)64 * 512 * 1024 * 2);
constexpr size_t O_H = O_WD + al256((size_t)64 * 1024 * 256 * 2);
constexpr size_t O_ACT = O_H + al256((size_t)T_ * 1024 * 2);
constexpr size_t O_YSH = O_ACT + al256((size_t)(T_ * 8 + T_) * 256 * 2);
constexpr size_t O_LIST = O_YSH + al256((size_t)T_ * 1024 * 2);
constexpr size_t O_TOPW = O_LIST + al256((size_t)64 * LISTCAP * 4);
constexpr size_t O_ROWSS = O_TOPW + al256((size_t)T_ * 8 * 4);
constexpr size_t O_BIG = O_ROWSS + al256((size_t)T_ * 16 * 4);
constexpr size_t O_YROWS = O_BIG;
constexpr size_t O_PROJ = O_BIG;
constexpr size_t O_Q = O_PROJ + al256((size_t)T_ * NIN * 2);
constexpr size_t O_KB = O_Q + al256((size_t)T_ * 8 * 96 * 2);
constexpr size_t O_V = O_KB + al256((size_t)T_ * 8 * 96 * 2);
constexpr size_t O_Y = O_V + al256((size_t)T_ * 8 * 64 * 2);
constexpr size_t WS_NEED = O_BIG + al256((size_t)T_ * 8 * 1024 * 2);

struct P {
  const float *x, *c; const int* pos;
  const float *w_ada, *b_ada, *w_in, *w_pool, *pool_scale, *w_spatial, *b_spatial, *g_q, *w_uq, *g_kv, *w_ukv, *w_out,
      *w_router, *router_bias, *w_gate, *w_up, *w_down, *ws_gate, *ws_up, *ws_down, *final_gain;
  float* out;
  unsigned char* ws;
  DI unsigned* bar() const { return (unsigned*)(ws + O_BAR); }
  DI int* cnt() const { return (int*)(ws + O_BAR) + 3456; }
  DI float* mod() const { return (float*)(ws + O_MOD); }
  DI float* ropec() const { return (float*)(ws + O_ROPEC); }
  DI float* ropes() const { return (float*)(ws + O_ROPES); }
  DI bf16_t* win_t() const { return (bf16_t*)(ws + O_WIN); }
  DI bf16_t* wuq_t() const { return (bf16_t*)(ws + O_WUQ); }
  DI bf16_t* wukv_t() const { return (bf16_t*)(ws + O_WUKV); }
  DI bf16_t* wout_t() const { return (bf16_t*)(ws + O_WOUT); }
  DI bf16_t* wsg_t() const { return (bf16_t*)(ws + O_WSG); }
  DI bf16_t* wsd_t() const { return (bf16_t*)(ws + O_WSD); }
  DI bf16_t* wsp_b() const { return (bf16_t*)(ws + O_WSP); }
  DI bf16_t* wpool_t() const { return (bf16_t*)(ws + O_WPOOL); }
  DI bf16_t* wr_hi() const { return (bf16_t*)(ws + O_WRHI); }
  DI bf16_t* wr_lo() const { return (bf16_t*)(ws + O_WRLO); }
  DI bf16_t* wgu_t() const { return (bf16_t*)(ws + O_WGU); }
  DI bf16_t* wd_t() const { return (bf16_t*)(ws + O_WD); }
  DI bf16_t* h() const { return (bf16_t*)(ws + O_H); }
  DI bf16_t* act() const { return (bf16_t*)(ws + O_ACT); }
  DI bf16_t* ysh() const { return (bf16_t*)(ws + O_YSH); }
  DI int* list() const { return (int*)(ws + O_LIST); }
  DI float* topw() const { return (float*)(ws + O_TOPW); }
  DI float* rowss() const { return (float*)(ws + O_ROWSS); }
  DI bf16_t* yrows() const { return (bf16_t*)(ws + O_YROWS); }
  DI bf16_t* proj() const { return (bf16_t*)(ws + O_PROJ); }
  DI bf16_t* Q() const { return (bf16_t*)(ws + O_Q); }
  DI bf16_t* Kb() const { return (bf16_t*)(ws + O_KB); }
  DI bf16_t* V() const { return (bf16_t*)(ws + O_V); }
  DI bf16_t* Y() const { return (bf16_t*)(ws + O_Y); }
};

DI unsigned pack2(float lo, float hi) { f32x2 f = {lo, hi}; bf16x2_t b = __builtin_convertvector(f, bf16x2_t); return __builtin_bit_cast(unsigned, b); }
DI float bf2f(unsigned short b) { return __uint_as_float(((unsigned)b) << 16); }
DI float bflo(unsigned u) { return __uint_as_float(u << 16); }
DI float bfhi(unsigned u) { return __uint_as_float(u & 0xffff0000u); }
DI int otid() { int t = threadIdx.x & 255; asm volatile("" : "+v"(t)); return t; }
DI float wsum(float v) { for (int o = 32; o; o >>= 1) v += __shfl_xor(v, o); return v; }
DI float silu_f(float x) { return x / (1.f + __expf(-x)); }
DI float gelu_tanh(float x) { float z = 0.7978845608028654f * (x + 0.044715f * x * x * x); float e = __expf(2.f * z); float t = 1.f - 2.f / (1.f + e); return 0.5f * x * (1.f + t); }

#define XB_TMO      128
#define XB_XCNT(j)  (256  + 64 * (j))
#define XB_XSUB(j)  (1280 + 64 * (j))
#define XB_XGEN(j)  (2304 + 64 * (j))
#define XB_TOP      3328
#define XB_TOPGEN   3392
#define XCD_BAR_WORDS 3456
#define XB_SPIN_CAP (1u << 20)
DI unsigned xb_ld(unsigned* p) { return __hip_atomic_load(p, __ATOMIC_RELAXED, __HIP_MEMORY_SCOPE_AGENT); }
DI unsigned xb_add(unsigned* p, unsigned v) { return __hip_atomic_fetch_add(p, v, __ATOMIC_RELAXED, __HIP_MEMORY_SCOPE_AGENT); }
DI unsigned xb_xcc_id() { return (unsigned)__builtin_amdgcn_s_getreg((3 << 11) | 20) & 0xFu; }
#define XB_SPIN(cond, bar) do { unsigned _sp = 0; while (cond) { __builtin_amdgcn_s_sleep(1); \
    if ((++_sp & 255u) == 0u) { if (xb_ld(&(bar)[XB_TMO])) break; if (_sp > XB_SPIN_CAP) { atomicAdd(&(bar)[XB_TMO], 1u); break; } } } } while (0)
struct XcdBarrier { unsigned* bar; unsigned x; volatile LAS unsigned* st; };
DI XcdBarrier xcd_barrier_post(unsigned* bar, volatile LAS unsigned* st) {
  XcdBarrier b; b.bar = bar; b.x = xb_xcc_id(); b.st = st;
  if (threadIdx.x == 0) (void)xb_add(&bar[XB_XCNT(b.x)], 1u);
  return b;
}
DI void xcd_barrier_complete(unsigned* bar, unsigned x, unsigned& nloc, unsigned& nx) {
  const unsigned G = gridDim.x * gridDim.y * gridDim.z;
  unsigned sum, cnt, mine, sp = 0u;
  for (;;) {
    sum = 0u; cnt = 0u; mine = 0u;
#pragma unroll
    for (unsigned j = 0; j < 16; ++j) { const unsigned c = xb_ld(&bar[XB_XCNT(j)]); sum += c; cnt += (c > 0u) ? 1u : 0u; mine = (j == x) ? c : mine; }
    if (sum == G) break;
    __builtin_amdgcn_s_sleep(1);
    if ((++sp & 255u) == 0u) { if (xb_ld(&bar[XB_TMO])) break; if (sp > XB_SPIN_CAP) { atomicAdd(&bar[XB_TMO], 1u); break; } }
  }
  nloc = mine > 0u ? mine : 1u; nx = cnt > 0u ? cnt : 1u;
}
DI void xcd_barrier(const XcdBarrier& b0) {
  XcdBarrier b = b0; b.x = xb_xcc_id();
  asm volatile("s_waitcnt vmcnt(0)" ::: "memory");
  __syncthreads();
  if (threadIdx.x == 0) {
    unsigned* bar = b.bar;
    __builtin_amdgcn_s_waitcnt(0);
    unsigned nloc = b.st[0], nx = b.st[1];
    if (nloc == 0u) { xcd_barrier_complete(bar, b.x, nloc, nx); b.st[0] = nloc; b.st[1] = nx; }
    const unsigned old = xb_add(&bar[XB_XSUB(b.x)], 1u);
    const unsigned gen = old / nloc;
    if (old + 1u == (gen + 1u) * nloc) {
      __builtin_amdgcn_fence(__ATOMIC_RELEASE, "agent");
      asm volatile("s_waitcnt vmcnt(0)" ::: "memory");
      const unsigned og = xb_add(&bar[XB_TOP], 1u);
      const unsigned tg = og / nx;
      if (og + 1u == (tg + 1u) * nx) xb_add(&bar[XB_TOPGEN], 1u);
      else XB_SPIN(xb_ld(&bar[XB_TOPGEN]) == tg, bar);
      __builtin_amdgcn_fence(__ATOMIC_ACQUIRE, "agent");
      xb_add(&bar[XB_XGEN(b.x)], 1u);
      asm volatile("s_waitcnt vmcnt(0)" ::: "memory");
    } else {
      XB_SPIN(xb_ld(&bar[XB_XGEN(b.x)]) == gen, bar);
      __builtin_amdgcn_fence(__ATOMIC_ACQUIRE, "agent");
      asm volatile("s_waitcnt vmcnt(0)" ::: "memory");
    }
  }
  __syncthreads();
}


template <int RB> DI void ot_put(unsigned char* base, int row, int unit, u32x2 v) { *(u32x2*)(base + row * RB + ((unit ^ (row & 15)) << 3)) = v; }
template <int RB> DI u32x4 ot_get(const unsigned char* base, int row, int chunk) {
  const u32x4 v = *(const u32x4*)(base + row * RB + ((chunk ^ ((row & 15) >> 1)) << 4));
  return (row & 1) ? (u32x4){v.z, v.w, v.x, v.y} : v;
}

template <class Epi>
DI void gemm128_stream(unsigned char* smem, const unsigned char* abase, const unsigned (&ao)[4], const unsigned char* bbase, const unsigned (&bo)[4], int nk, int ntile, size_t btile_stride, Epi&& epi) {
  const int tid = otid(), lane = tid & 63, w = tid >> 6;
  const int wm = w >> 1, wn = w & 1;
  const int r_s = tid >> 3, c_s = tid & 7;
  const int st_off = r_s * 128 + ((c_s ^ (r_s & 7)) << 4);
  const int fr = lane & 15, fq = lane >> 4;
  const int sw0 = ((0 + fq) ^ (fr & 7)) << 4, sw1 = ((4 + fq) ^ (fr & 7)) << 4;
  const int arow_off = (wm * 64 + fr) * 128, brow_off = 32768 + (wn * 64 + fr) * 128;
  u32x4 ra0[4], rb0[4], ra1[4], rb1[4];
  f32x4 acc[4][4];
#pragma unroll
  for (int i = 0; i < 4; ++i)
#pragma unroll
    for (int j = 0; j < 4; ++j) acc[i][j] = (f32x4){0.f, 0.f, 0.f, 0.f};
  const int total = nk * ntile;
  int lkt = 0, ltl = 0;
  auto load = [&](u32x4 (&ra)[4], u32x4 (&rb)[4]) {
    const unsigned char* ab = abase + lkt * 128;
    const unsigned char* bb = bbase + ((size_t)ltl * btile_stride + lkt * 64) * 2;
#pragma unroll
    for (int j = 0; j < 4; ++j) { ra[j] = *(const u32x4*)(ab + ao[j]); rb[j] = *(const u32x4*)(bb + bo[j]); }
    const bool last = (lkt == nk - 1) && (ltl == ntile - 1);
    const int nl = (lkt == nk - 1) ? 0 : lkt + 1;
    ltl = last ? ltl : ((lkt == nk - 1) ? ltl + 1 : ltl);
    lkt = last ? lkt : nl;
  };
  auto store = [&](const u32x4 (&ra)[4], const u32x4 (&rb)[4], int bufo) {
#pragma unroll
    for (int j = 0; j < 4; ++j) { *(u32x4*)(smem + bufo + st_off + j * 4096) = ra[j]; *(u32x4*)(smem + 32768 + bufo + st_off + j * 4096) = rb[j]; }
  };
  int kt = 0, tile = 0;
  auto body = [&](int s, int cur, u32x4 (&lra)[4], u32x4 (&lrb)[4], const u32x4 (&wra)[4], const u32x4 (&wrb)[4]) {
    load(lra, lrb);
#pragma unroll
    for (int ks = 0; ks < 2; ++ks) {
      const int sw = ks ? sw1 : sw0;
      bf16x8 af[4], bfr[4];
#pragma unroll
      for (int i = 0; i < 4; ++i) af[i] = *(const bf16x8*)(smem + cur + arow_off + i * 2048 + sw);
#pragma unroll
      for (int j = 0; j < 4; ++j) bfr[j] = *(const bf16x8*)(smem + cur + brow_off + j * 2048 + sw);
#pragma unroll
      for (int i = 0; i < 4; ++i)
#pragma unroll
        for (int j = 0; j < 4; ++j) acc[i][j] = __builtin_amdgcn_mfma_f32_16x16x32_bf16(bfr[j], af[i], acc[i][j], 0, 0, 0);
    }
    if (s + 1 < total) store(wra, wrb, 16384 - cur);
    if (kt == nk - 1) {
      int wm2 = wm, wn2 = wn, fr2 = fr, fq2 = fq;
      asm volatile("" : "+v"(wm2), "+v"(wn2), "+v"(fr2), "+v"(fq2));
      epi(acc, tile, cur, wm2, wn2, fr2, fq2);
#pragma unroll
      for (int i = 0; i < 4; ++i)
#pragma unroll
        for (int j = 0; j < 4; ++j) acc[i][j] = (f32x4){0.f, 0.f, 0.f, 0.f};
    }
    __syncthreads();
    if (++kt == nk) { kt = 0; ++tile; }
  };
  load(ra0, rb0);
  load(ra1, rb1);
  store(ra0, rb0, 0);
  __syncthreads();
  for (int s = 0; s < total; s += 2) {
    body(s, 0, ra0, rb0, ra1, rb1);
    if (s + 1 >= total) break;
    body(s + 1, 16384, ra1, rb1, ra0, rb0);
  }
}
template <class Epi>
DI void gemm128(unsigned char* smem, const unsigned char* abase, const unsigned (&ao)[4], const unsigned char* bbase, const unsigned (&bo)[4], int nk, Epi&& epi) {
  gemm128_stream(smem, abase, ao, bbase, bo, nk, 1, 0, [&](f32x4 (&acc)[4][4], int, int, int wm, int wn, int fr, int fq) { __syncthreads(); epi(acc, wm, wn, fr, fq); });
}


namespace t8 {
constexpr int BM = 256, BK = 64, HALF = 128, HTB = HALF * BK * 2, STAGE_BYTES = 8 * HTB;
DI int lds_byte(int r, int c) { const int st = (r >> 4) * 2 + (c >> 5), rr = r & 15, cc = c & 31, ob = rr * 64 + cc * 2; return st * 1024 + (ob ^ (((ob >> 9) & 1) << 5)); }
DI void stage_rc(int b, int& R, int& C) { const int st = b / 1024, sb = b % 1024, swz = sb ^ (((sb >> 9) & 1) << 5); R = (st >> 1) * 16 + swz / 64; C = (st & 1) * 32 + (swz % 64) / 2; }
DI int perm32(int rho) { const int n = rho >> 4, i = rho & 15; return 8 * (i >> 2) + 4 * n + (i & 3); }
struct Unit { int pm, pn, tab; const unsigned char* bbase; };
constexpr int TAB_OFF = STAGE_BYTES;
constexpr int START_OFF = STAGE_BYTES + 12288;

template <bool PERM, class Sched, class RowOff, class Epi>
DI void gemm_phase(LAS unsigned char* lds, const unsigned char* Abase, const int K, const Sched& S, const RowOff& RO, const Epi& E) {
  int tid = threadIdx.x; asm volatile("" : "+v"(tid));
  const int wid = __builtin_amdgcn_readfirstlane(tid >> 6), lane = tid & 63, wr = wid >> 2, wc = wid & 3, fr = lane & 15, fq = lane >> 4;
  const int nt = K / BK;
  unsigned voffB[2];
#pragma unroll
  for (int i = 0; i < 2; ++i) { int R, C; stage_rc(tid * 16 + i * 8192, R, C); const int Rb = PERM ? ((R & ~31) + perm32(R & 31)) : R; voffB[i] = (unsigned)(Rb * K + C) * 2u; }
  auto apiece = [&](const Unit& u, int h, int i) -> unsigned { int R, C; stage_rc(tid * 16 + i * 8192, R, C); return RO(u, h * HALF + R) + (unsigned)(C * 2); };
  const size_t kstep = (size_t)(BK * 2);
  const size_t hstep = (size_t)HALF * K * 2;
  const unsigned ldsw = (unsigned)wid * 1024u;
  const int aoff = lds_byte(wr * 64 + fr, fq * 8), boff = lds_byte(wc * 32 + fr, fq * 8);
  LAS const unsigned char* ldsA = lds + aoff; LAS const unsigned char* ldsB = lds + 4 * HTB + boff;
  asm volatile("" : "+v"(ldsA), "+v"(ldsB));
#define T8_SA(b, h) (((b) * 2 + (h)) * HTB)
#define T8_SB(b, h) ((4 + (b) * 2 + (h)) * HTB)
#define T8_STAGE(bufoff, gbase, voff) do { _Pragma("unroll") for (int _i = 0; _i < 2; ++_i) \
    __builtin_amdgcn_global_load_lds((const unsigned*)((const char*)(gbase) + (voff)[_i]), (LAS unsigned*)(lds + (bufoff) + ldsw + _i * 8192), 16, 0, 0); } while (0)
#define T8_LDA(dst, b, h) do { _Pragma("unroll") for (int m = 0; m < 4; ++m) _Pragma("unroll") for (int k = 0; k < 2; ++k) dst[m][k] = *(const LAS bf16x8*)(ldsA + T8_SA(b, h) + m * 2048 + k * 1024); } while (0)
#define T8_LDB(dst, b, h) do { _Pragma("unroll") for (int n = 0; n < 2; ++n) _Pragma("unroll") for (int k = 0; k < 2; ++k) dst[n][k] = *(const LAS bf16x8*)(ldsB + (T8_SB(b, h) - 4 * HTB) + n * 2048 + k * 1024); } while (0)
#define T8_MMA(ai, bj, At, Bt) do { __builtin_amdgcn_s_setprio(1); _Pragma("unroll") for (int m = 0; m < 4; ++m) _Pragma("unroll") for (int n = 0; n < 2; ++n) _Pragma("unroll") for (int k = 0; k < 2; ++k) \
    acc[ai][bj][m][n] = __builtin_amdgcn_mfma_f32_16x16x32_bf16(Bt[n][k], At[m][k], acc[ai][bj][m][n], 0, 0, 0); __builtin_amdgcn_s_setprio(0); } while (0)
#define T8_WAIT_V(n) asm volatile("s_waitcnt vmcnt(" #n ")" ::: "memory")
#define T8_WAIT_L(n) asm volatile("s_waitcnt lgkmcnt(" #n ")" ::: "memory")
#define T8_BAR __builtin_amdgcn_s_barrier()
#define T8_SCHED __builtin_amdgcn_sched_barrier(0)
  Unit cur, nxt; int ui = 0;
  if (!S.next(0, cur)) return;
  f32x4 acc[2][2][4][2];
#pragma unroll
  for (int a = 0; a < 2; ++a)
#pragma unroll
    for (int b = 0; b < 2; ++b)
#pragma unroll
      for (int m = 0; m < 4; ++m)
#pragma unroll
        for (int n = 0; n < 2; ++n) acc[a][b][m][n] = (f32x4){0.f, 0.f, 0.f, 0.f};
  bf16x8 At[4][2], B0[2][2], B1[2][2];
  unsigned vc[2][2];
#pragma unroll
  for (int h = 0; h < 2; ++h)
#pragma unroll
    for (int i = 0; i < 2; ++i) vc[h][i] = apiece(cur, h, i);
  const char* cB = (const char*)cur.bbase;
  const char* gA = (const char*)Abase;
  T8_STAGE(T8_SB(0, 0), cB, voffB); T8_STAGE(T8_SA(0, 0), gA, vc[0]); T8_STAGE(T8_SB(0, 1), cB + hstep, voffB); T8_STAGE(T8_SA(0, 1), gA, vc[1]);
  if (wr == 1) T8_BAR;
  T8_WAIT_V(4); T8_BAR;
  T8_STAGE(T8_SB(1, 0), cB + kstep, voffB); T8_STAGE(T8_SA(1, 0), gA + kstep, vc[0]); T8_STAGE(T8_SB(1, 1), cB + hstep + kstep, voffB);
  T8_WAIT_V(6); T8_BAR;
  for (;;) {
    const bool has_next = S.next(ui + 1, nxt);
    const char* nB = has_next ? (const char*)nxt.bbase : cB;
#pragma unroll 1
    for (int t = 0; t < nt; t += 2) {
      const bool last = (t == nt - 2);
      const char* a1 = gA + (size_t)(t + 1) * kstep;
      const char* a2 = last ? gA : gA + (size_t)(t + 2) * kstep; const char* b2 = last ? nB : cB + (size_t)(t + 2) * kstep;
      const char* a3 = a2 + kstep; const char* b3 = b2 + kstep;
      if (last && has_next) { vc[0][0] = apiece(nxt, 0, 0); vc[0][1] = apiece(nxt, 0, 1); }
      T8_LDB(B0, 0, 0); T8_SCHED; T8_LDA(At, 0, 0); T8_STAGE(T8_SA(1, 1), a1, vc[1]);
      T8_WAIT_L(8); T8_BAR; T8_WAIT_L(0); T8_MMA(0, 0, At, B0); T8_BAR; T8_SCHED;
      if (last && has_next) { vc[1][0] = apiece(nxt, 1, 0); vc[1][1] = apiece(nxt, 1, 1); }
      T8_LDB(B1, 0, 1); T8_STAGE(T8_SB(0, 0), b2, voffB);
      T8_BAR; T8_WAIT_L(0); T8_MMA(0, 1, At, B1); T8_BAR;
      T8_LDA(At, 0, 1); T8_STAGE(T8_SA(0, 0), a2, vc[0]);
      T8_BAR; T8_WAIT_L(0); T8_MMA(1, 0, At, B0); T8_BAR; T8_SCHED;
      T8_STAGE(T8_SB(0, 1), b2 + hstep, voffB);
      T8_WAIT_V(6); T8_BAR; T8_MMA(1, 1, At, B1); T8_BAR;
      T8_LDB(B0, 1, 0); T8_SCHED; T8_LDA(At, 1, 0); T8_STAGE(T8_SA(0, 1), a2, vc[1]);
      T8_WAIT_L(8); T8_BAR; T8_WAIT_L(0); T8_MMA(0, 0, At, B0); T8_BAR; T8_SCHED;
      T8_LDB(B1, 1, 1); T8_STAGE(T8_SB(1, 0), b3, voffB);
      T8_BAR; T8_WAIT_L(0); T8_MMA(0, 1, At, B1); T8_BAR;
      T8_LDA(At, 1, 1); T8_STAGE(T8_SA(1, 0), a3, vc[0]);
      T8_BAR; T8_WAIT_L(0); T8_MMA(1, 0, At, B0); T8_BAR; T8_SCHED;
      T8_STAGE(T8_SB(1, 1), b3 + hstep, voffB);
      T8_WAIT_V(6); T8_BAR; T8_MMA(1, 1, At, B1); T8_BAR;
    }
    E(acc, cur, wr, wc, fr, fq);
    if (!has_next) break;
#pragma unroll
    for (int a = 0; a < 2; ++a)
#pragma unroll
      for (int b = 0; b < 2; ++b)
#pragma unroll
        for (int m = 0; m < 4; ++m)
#pragma unroll
          for (int n = 0; n < 2; ++n) acc[a][b][m][n] = (f32x4){0.f, 0.f, 0.f, 0.f};
    cur = nxt; cB = nB; ++ui;
  }
  T8_WAIT_V(0);
  if (wr == 0) T8_BAR;
  T8_BAR;
#undef T8_SA
#undef T8_SB
#undef T8_STAGE
#undef T8_LDA
#undef T8_LDB
#undef T8_MMA
#undef T8_WAIT_V
#undef T8_WAIT_L
#undef T8_BAR
#undef T8_SCHED
}

struct DenseSched {
  int nM, nN, nwg, G, c; const unsigned char* Bt; size_t tstep;
  DI void init(int M, int N, int K, int G_, int c_, const void* Bt_) { nM = M / BM; nN = N / BM; nwg = nM * nN; G = G_; c = c_; Bt = (const unsigned char*)Bt_; tstep = (size_t)BM * K * 2; }
  DI bool next(int i, Unit& u) const {
    const long L = (long)i * G + c; if (L >= nwg) return false;
    int wgid = (int)L; { const int q = nwg / 8, r = nwg % 8, xcd = wgid % 8, off = wgid / 8; wgid = (xcd < r ? xcd * (q + 1) : r * (q + 1) + (xcd - r) * q) + off; }
    const int nig = 8 * nN, gid = wgid / nig, fm = gid * 8, gsz = (nM - fm) < 8 ? (nM - fm) : 8;
    u.pm = fm + ((wgid % nig) % gsz); u.pn = (wgid % nig) / gsz; u.tab = 0; u.bbase = Bt + (size_t)u.pn * tstep; return true;
  }
};
struct DenseRows { unsigned rowbytes; DI unsigned operator()(const Unit& u, int row) const { return (unsigned)(u.pm * BM + row) * rowbytes; } };

struct MoeSched {
  LAS const int* start; int npn, total, G, c; const unsigned char* wexp; const unsigned char* wsh; size_t estride, tstep;
  DI bool next(int i, Unit& u) const {
    const int L = i * G + c; if (L >= total) return false;
    const int mt = L / npn; u.pn = L - mt * npn; u.pm = mt; u.tab = i;
    const int e = __builtin_amdgcn_readfirstlane(start[128 + i]);
    u.bbase = (e == 64 ? wsh : wexp + (size_t)e * estride) + (size_t)u.pn * tstep; return true;
  }
};
}

DI void moe_prepare(const P& p, LAS unsigned char* lds, int l, int npn, int G, int c, int& total_units) {
  LAS int* start = (LAS int*)(lds + t8::START_OFF);
  __syncthreads();
  if (threadIdx.x == 0) {
    int s = 0;
    for (int e = 0; e < 64; ++e) { start[e] = s; s += (p.cnt()[(l * 64 + e) * CSTRIDE] + 255) >> 8; }
    start[64] = s; start[65] = s + 64;
  }
  __syncthreads();
  const int nmt = start[65];
  total_units = nmt * npn;
  int tid = threadIdx.x; asm volatile("" : "+v"(tid));
  for (int i = 0; i * G + c < total_units && i < 12; ++i) {
    const int L = i * G + c, mt = L / npn;
    int e = 64;
    if (mt < start[64]) {
      e = 0;
#pragma unroll 4
      for (int q = 1; q < 64; ++q) e = (start[q] <= mt) ? q : e;
    }
    if (tid == 0) start[128 + i] = e;
    if (tid < 256) {
      int slot;
      if (mt >= start[64]) slot = T_ * 8 + (mt - start[64]) * 256 + tid;
      else {
        const int idx = (mt - start[e]) * 256 + tid;
        slot = idx < p.cnt()[(l * 64 + e) * CSTRIDE] ? p.list()[(size_t)e * LISTCAP + idx] : -1;
      }
      ((LAS int*)(lds + t8::TAB_OFF))[i * 256 + tid] = slot;
    }
  }
  __syncthreads();
}

DI void item_mod(const P& p, unsigned char* smem, int item) {
  const int l = item / 96, cb = item % 96;
  const int tid = otid(), w = tid >> 6, lane = tid & 63;
  float* sc = (float*)smem;
  float* red = (float*)(smem + 32768);
  __syncthreads();
  for (int i = tid; i < 8192; i += NTHREADS) sc[i] = silu_f(p.c[i]);
  __syncthreads();
  const int col = cb * 64 + lane;
  const float* W = p.w_ada + (size_t)l * 1024 * 6144 + col;
  float acc[8];
#pragma unroll
  for (int b = 0; b < 8; ++b) acc[b] = 0.f;
  for (int k0 = w * 256; k0 < w * 256 + 256; k0 += 16) {
    float wv[16];
#pragma unroll
    for (int u = 0; u < 16; ++u) wv[u] = W[(size_t)(k0 + u) * 6144];
#pragma unroll
    for (int u = 0; u < 16; ++u)
#pragma unroll
      for (int b = 0; b < 8; ++b) acc[b] += sc[b * 1024 + k0 + u] * wv[u];
  }
#pragma unroll
  for (int b = 0; b < 8; ++b) red[(w * 8 + b) * 64 + lane] = acc[b];
  __syncthreads();
  for (int o = tid; o < 512; o += NTHREADS) {
    const int b = o >> 6, cc = o & 63;
    const float v = red[(0 * 8 + b) * 64 + cc] + red[(1 * 8 + b) * 64 + cc] + red[(2 * 8 + b) * 64 + cc] + red[(3 * 8 + b) * 64 + cc];
    p.mod()[((size_t)l * 8 + b) * 6144 + cb * 64 + cc] = v + p.b_ada[(size_t)l * 6144 + cb * 64 + cc];
  }
}

DI void conv_tile(unsigned char* smem, const float* src, int ldsrc, int k0, int n0, bf16_t* dst, int lddst, int mode, const float* kscale) {
  float* t = (float*)smem;
  const int tid = otid();
  __syncthreads();
  {
    const int kk = tid >> 3, nq = tid & 7;
#pragma unroll
    for (int hh = 0; hh < 2; ++hh) {
      const int k = kk + 32 * hh;
      const float4 v = *(const float4*)(src + (size_t)(k0 + k) * ldsrc + n0 + nq * 4);
      const float s = kscale ? kscale[k0 + k] : 1.f;
      t[k * 33 + nq * 4 + 0] = v.x * s; t[k * 33 + nq * 4 + 1] = v.y * s; t[k * 33 + nq * 4 + 2] = v.z * s; t[k * 33 + nq * 4 + 3] = v.w * s;
    }
  }
  __syncthreads();
  {
    const int n = tid >> 3, kc = tid & 7;
    u32x4 wv;
    wv.x = pack2(t[(kc * 8 + 0) * 33 + n], t[(kc * 8 + 1) * 33 + n]);
    wv.y = pack2(t[(kc * 8 + 2) * 33 + n], t[(kc * 8 + 3) * 33 + n]);
    wv.z = pack2(t[(kc * 8 + 4) * 33 + n], t[(kc * 8 + 5) * 33 + n]);
    wv.w = pack2(t[(kc * 8 + 6) * 33 + n], t[(kc * 8 + 7) * 33 + n]);
    const int nn = n0 + n;
    const int orow = (mode == 0) ? nn : (256 * (nn >> 7) + (nn & 127) + (mode == 2 ? 128 : 0));
    *(u32x4*)(dst + (size_t)orow * lddst + k0 + kc * 8) = wv;
  }
}

DI void conv_big(unsigned char* smem, const float* src, int ldsrc, int k0, int n0, bf16_t* dst, int lddst, int mode, const float* kscale) {
  float* t = (float*)smem;
  const int tid = otid();
  __syncthreads();
  {
    const int c4 = tid & 31, r0 = tid >> 5;
    float4 v[8];
#pragma unroll
    for (int hh = 0; hh < 8; ++hh) v[hh] = *(const float4*)(src + (size_t)(k0 + r0 + 8 * hh) * ldsrc + n0 + c4 * 4);
#pragma unroll
    for (int hh = 0; hh < 8; ++hh) {
      const int k = r0 + 8 * hh;
      const float sc = kscale ? kscale[k0 + k] : 1.f;
      *(float4*)(t + k * 132 + c4 * 4) = (float4){v[hh].x * sc, v[hh].y * sc, v[hh].z * sc, v[hh].w * sc};
    }
  }
  __syncthreads();
  {
    const int n = tid >> 1, kh = tid & 1;
    const int nn = n0 + n;
    const int orow = (mode == 0) ? nn : (256 * (nn >> 7) + (nn & 127) + (mode == 2 ? 128 : 0));
    bf16_t* d = dst + (size_t)orow * lddst + k0 + kh * 32;
#pragma unroll
    for (int c = 0; c < 4; ++c) {
      const float* tp = t + (kh * 32 + c * 8) * 132 + n;
      u32x4 wv;
      wv.x = pack2(tp[0 * 132], tp[1 * 132]); wv.y = pack2(tp[2 * 132], tp[3 * 132]); wv.z = pack2(tp[4 * 132], tp[5 * 132]); wv.w = pack2(tp[6 * 132], tp[7 * 132]);
      *(u32x4*)(d + c * 8) = wv;
    }
  }
}

DI void item_conv(const P& p, unsigned char* smem, int l, int idx) {
  if (idx < 592) { conv_tile(smem, p.w_in + (size_t)l * 1024 * NIN, NIN, (idx / 37) * 64, (idx % 37) * 32, p.win_t(), 1024, 0, nullptr); return; }
  idx -= 592;
  if (idx < 24) { conv_big(smem, p.w_uq + (size_t)l * 256 * 768, 768, (idx / 6) * 64, (idx % 6) * 128, p.wuq_t(), 256, 0, p.g_q + l * 256); return; }
  idx -= 24;
  if (idx < 16) { conv_big(smem, p.w_ukv + (size_t)l * 128 * 1024, 1024, (idx / 8) * 64, (idx % 8) * 128, p.wukv_t(), 128, 0, p.g_kv + l * 128); return; }
  idx -= 16;
  if (idx < 128) { conv_big(smem, p.w_out + (size_t)l * 1024 * 1024, 1024, (idx / 8) * 64, (idx % 8) * 128, p.wout_t(), 1024, 0, nullptr); return; }
  idx -= 128;
  if (idx < 32) { conv_big(smem, p.ws_gate + (size_t)l * 1024 * 256, 256, (idx / 2) * 64, (idx % 2) * 128, p.wsg_t(), 1024, 1, nullptr); return; }
  idx -= 32;
  if (idx < 32) { conv_big(smem, p.ws_up + (size_t)l * 1024 * 256, 256, (idx / 2) * 64, (idx % 2) * 128, p.wsg_t(), 1024, 2, nullptr); return; }
  idx -= 32;
  if (idx < 32) { conv_big(smem, p.ws_down + (size_t)l * 256 * 1024, 1024, (idx / 8) * 64, (idx % 8) * 128, p.wsd_t(), 256, 0, nullptr); return; }
  idx -= 32;
  const int e = idx / 96, r = idx % 96;
  if (r < 32) conv_big(smem, p.w_gate + ((size_t)l * 64 + e) * 1024 * 256, 256, (r / 2) * 64, (r % 2) * 128, p.wgu_t() + (size_t)e * 512 * 1024, 1024, 1, nullptr);
  else if (r < 64) conv_big(smem, p.w_up + ((size_t)l * 64 + e) * 1024 * 256, 256, ((r - 32) / 2) * 64, ((r - 32) % 2) * 128, p.wgu_t() + (size_t)e * 512 * 1024, 1024, 2, nullptr);
  else conv_big(smem, p.w_down + ((size_t)l * 64 + e) * 256 * 1024, 1024, ((r - 64) / 8) * 64, ((r - 64) % 8) * 128, p.wd_t() + (size_t)e * 1024 * 256, 256, 0, nullptr);
}

constexpr int MISC_ITEMS = 64 + 128 + 512;
DI void item_misc(const P& p, int item) {
  const int tid = otid();
  if (item < 64) {
    const int i = (item * NTHREADS + tid) * 8;
    const int k0 = i & 127, t = (i >> 7) & 127;
    const float4 a = *(const float4*)(p.w_spatial + i), c = *(const float4*)(p.w_spatial + i + 4);
    u32x4 o;
    o.x = pack2(k0 + 0 <= t ? a.x : 0.f, k0 + 1 <= t ? a.y : 0.f); o.y = pack2(k0 + 2 <= t ? a.z : 0.f, k0 + 3 <= t ? a.w : 0.f);
    o.z = pack2(k0 + 4 <= t ? c.x : 0.f, k0 + 5 <= t ? c.y : 0.f); o.w = pack2(k0 + 6 <= t ? c.z : 0.f, k0 + 7 <= t ? c.w : 0.f);
    *(u32x4*)(p.wsp_b() + i) = o;
  } else if (item < 64 + 128) {
    const int i = (item - 64) * NTHREADS + tid;
    const int c = i & 63, dd = (i >> 6) & 63, lg = i >> 12;
    const f32x2 f = {p.w_pool[((size_t)lg * 64 + c) * 64 + dd], 0.f}; const bf16x2_t bb = __builtin_convertvector(f, bf16x2_t);
    p.wpool_t()[i] = (bf16_t)(__builtin_bit_cast(unsigned, bb) & 0xffffu);
  } else {
    const int i = (item - 192) * NTHREADS + tid;
    const int e = i & 63, k = (i >> 6) & 1023, l = i >> 16;
    const float v = p.w_router[i];
    const unsigned hi = pack2(v, 0.f) & 0xffffu;
    const unsigned lo = pack2(v - bflo(hi), 0.f) & 0xffffu;
    p.wr_hi()[(size_t)l * 65536 + e * 1024 + k] = (bf16_t)hi;
    p.wr_lo()[(size_t)l * 65536 + e * 1024 + k] = (bf16_t)lo;
  }
}

DI void item_rope(const P& p, int item) {
  const int i = item * NTHREADS + otid();
  const int t = i >> 4, f = i & 15;
  const float inv = exp2f(-(float)(2 * f) * (13.287712379549449f / 32.f));
  const float ang = (float)p.pos[t] * inv;
  const double rev = (double)ang * 0.15915494309189535;
  const float fr = (float)(rev - floor(rev));
  p.ropec()[i] = __builtin_amdgcn_cosf(fr);
  p.ropes()[i] = __builtin_amdgcn_sinf(fr);
}

DI void item_norm0(const P& p, int item) {
  const int tid = otid(), w = tid >> 6, lane = tid & 63;
  const int t = item * 4 + w, b = t >> 11;
  const float* xr = p.x + (size_t)t * 1024;
  const float* md = p.mod() + (size_t)b * 6144;
  float4 v[4]; float ss = 0.f;
#pragma unroll
  for (int j = 0; j < 4; ++j) { v[j] = *(const float4*)(xr + j * 256 + lane * 4); ss += v[j].x * v[j].x + v[j].y * v[j].y + v[j].z * v[j].z + v[j].w * v[j].w; }
  ss = wsum(ss);
  const float rstd = rsqrtf(ss * (1.f / 1024.f) + EPS);
#pragma unroll
  for (int j = 0; j < 4; ++j) {
    const int idx = j * 256 + lane * 4;
    const float4 sh = *(const float4*)(md + idx), sc = *(const float4*)(md + 1024 + idx);
    u32x2 o;
    o.x = pack2(v[j].x * rstd * (1.f + sc.x) + sh.x, v[j].y * rstd * (1.f + sc.y) + sh.y);
    o.y = pack2(v[j].z * rstd * (1.f + sc.z) + sh.z, v[j].w * rstd * (1.f + sc.w) + sh.w);
    *(u32x2*)(p.h() + (size_t)t * 1024 + idx) = o;
  }
}

DI void item_p1(const P& p, unsigned char* smem, int item) {
  const int m = item / 10, nt = item % 10;
  const int tid = otid(), r_s = tid >> 3, c_s = tid & 7;
  __syncthreads();
  unsigned ao[4], bo[4];
#pragma unroll
  for (int j = 0; j < 4; ++j) {
    const int row = r_s + 32 * j;
    ao[j] = (unsigned)(((m * 128 + row) * 1024 + c_s * 8) * 2);
    int n = nt * 128 + row; n = n < NIN ? n : NIN - 1;
    bo[j] = (unsigned)((n * 1024 + c_s * 8) * 2);
  }
  bf16_t* proj = p.proj();
  gemm128(smem, (const unsigned char*)p.h(), ao, (const unsigned char*)p.win_t(), bo, 16, [=](f32x4 (&acc)[4][4], int wm, int wn, int fr, int fq) {
    unsigned char* ob = smem + wm * 16384;
#pragma unroll
    for (int i = 0; i < 4; ++i)
#pragma unroll
      for (int j = 0; j < 4; ++j) {
        u32x2 o; o.x = pack2(acc[i][j][0], acc[i][j][1]); o.y = pack2(acc[i][j][2], acc[i][j][3]);
        ot_put<256>(ob, i * 16 + fr, wn * 16 + j * 4 + fq, o);
      }
    __syncthreads();
    {
      const int tid2 = fq * 16 + fr + 64 * (wm * 2 + wn);
      const int chunk = tid2 & 15;
      if (nt * 128 + chunk * 8 < NIN) {
#pragma unroll
        for (int i = 0; i < 8; ++i) {
          const int row = (tid2 >> 4) + 16 * i;
          const u32x4 v = ot_get<256>(smem + (row >> 6) * 16384, row & 63, chunk);
          *(u32x4*)(proj + (size_t)(m * 128 + row) * NIN + nt * 128 + chunk * 8) = v;
        }
      }
    }
  });
}

DI void item_qproj(const P& p, unsigned char* smem, int item) {
  const int m = item / 6, nt = item % 6;
  const int tid = otid(), r_s = tid >> 3, c_s = tid & 7;
  float* rowf = (float*)(smem + SMEM_MAIN + 1024);
  __syncthreads();
  {
    const int row = tid >> 1, half = tid & 1;
    const bf16_t* src = p.proj() + (size_t)(m * 128 + row) * NIN + 768 + half * 128;
    float ss = 0.f;
#pragma unroll
    for (int q = 0; q < 16; ++q) {
      const u32x4 v = *(const u32x4*)(src + q * 8);
      ss += bflo(v.x) * bflo(v.x) + bfhi(v.x) * bfhi(v.x) + bflo(v.y) * bflo(v.y) + bfhi(v.y) * bfhi(v.y) + bflo(v.z) * bflo(v.z) + bfhi(v.z) * bfhi(v.z) + bflo(v.w) * bflo(v.w) + bfhi(v.w) * bfhi(v.w);
    }
    ss += __shfl_xor(ss, 1);
    if (half == 0) rowf[row] = rsqrtf(ss * (1.f / 256.f) + EPS);
  }
  unsigned ao[4], bo[4];
#pragma unroll
  for (int j = 0; j < 4; ++j) {
    const int row = r_s + 32 * j;
    ao[j] = (unsigned)(((m * 128 + row) * NIN + 768 + c_s * 8) * 2);
    bo[j] = (unsigned)(((nt * 128 + row) * 256 + c_s * 8) * 2);
  }
  bf16_t* Q = p.Q(); const float* ropec = p.ropec(); const float* ropes = p.ropes();
  const float QS = 0.10206207261596577f * 1.4426950408889634f;
  gemm128(smem, (const unsigned char*)p.proj(), ao, (const unsigned char*)p.wuq_t(), bo, 4, [=](f32x4 (&acc)[4][4], int wm, int wn, int fr, int fq) {
#pragma unroll
    for (int i = 0; i < 4; ++i) {
      const int tl = wm * 64 + i * 16 + fr, t = m * 128 + tl;
      const int b = t >> 11, s = t & 2047;
      const float rs = rowf[tl] * QS;
#pragma unroll
      for (int j = 0; j < 4; ++j) {
        const int c0 = nt * 128 + wn * 64 + j * 16;
        const int head = c0 / 96, d0 = c0 % 96;
        bf16_t* dst = Q + ((size_t)((b * 8 + head) * 2048 + s)) * 96 + d0 + fq * 4;
        if (d0 == 64) {
          if (j < 3) {
            const float4 cs = *(const float4*)(ropec + (size_t)t * 16 + fq * 4), sn = *(const float4*)(ropes + (size_t)t * 16 + fq * 4);
            const f32x4 x1 = acc[i][j] * rs, x2 = acc[i][j + 1 < 4 ? j + 1 : 3] * rs;
            u32x2 o1, o2;
            o1.x = pack2(x1[0] * cs.x - x2[0] * sn.x, x1[1] * cs.y - x2[1] * sn.y);
            o1.y = pack2(x1[2] * cs.z - x2[2] * sn.z, x1[3] * cs.w - x2[3] * sn.w);
            o2.x = pack2(x2[0] * cs.x + x1[0] * sn.x, x2[1] * cs.y + x1[1] * sn.y);
            o2.y = pack2(x2[2] * cs.z + x1[2] * sn.z, x2[3] * cs.w + x1[3] * sn.w);
            *(u32x2*)dst = o1; *(u32x2*)(dst + 16) = o2;
          }
        } else if (d0 != 80) {
          const f32x4 x = acc[i][j] * rs;
          u32x2 o; o.x = pack2(x[0], x[1]); o.y = pack2(x[2], x[3]);
          *(u32x2*)dst = o;
        }
      }
    }
  });
}

DI void item_kvproj(const P& p, unsigned char* smem, int item) {
  const int m = item >> 3, head = item & 7;
  const int tid = otid(), r_s = tid >> 3, c_s = tid & 7;
  float* rowf = (float*)(smem + SMEM_MAIN + 1024);
  __syncthreads();
  {
    const int row = tid >> 1, half = tid & 1;
    const int t = m * 128 + row, b = t >> 11, s = t & 2047;
    const bf16_t* src = p.proj() + (size_t)t * NIN + 1024 + half * 64;
    float ss = 0.f;
#pragma unroll
    for (int q = 0; q < 8; ++q) {
      const u32x4 v = *(const u32x4*)(src + q * 8);
      ss += bflo(v.x) * bflo(v.x) + bfhi(v.x) * bfhi(v.x) + bflo(v.y) * bflo(v.y) + bfhi(v.y) * bfhi(v.y) + bflo(v.z) * bflo(v.z) + bfhi(v.z) * bfhi(v.z) + bflo(v.w) * bflo(v.w) + bfhi(v.w) * bfhi(v.w);
    }
    ss += __shfl_xor(ss, 1);
    if (half == 0) rowf[row] = rsqrtf(ss * (1.f / 128.f) + EPS);
    const bf16_t* kp = p.proj() + (size_t)t * NIN + 1152 + half * 8;
    const u32x4 a1 = *(const u32x4*)kp, a2 = *(const u32x4*)(kp + 16);
    const float* cp = p.ropec() + (size_t)t * 16 + half * 8; const float* sp = p.ropes() + (size_t)t * 16 + half * 8;
    const float4 c0 = *(const float4*)cp, c1 = *(const float4*)(cp + 4), s0 = *(const float4*)sp, s1 = *(const float4*)(sp + 4);
    const float x1[8] = {bflo(a1.x), bfhi(a1.x), bflo(a1.y), bfhi(a1.y), bflo(a1.z), bfhi(a1.z), bflo(a1.w), bfhi(a1.w)};
    const float x2[8] = {bflo(a2.x), bfhi(a2.x), bflo(a2.y), bfhi(a2.y), bflo(a2.z), bfhi(a2.z), bflo(a2.w), bfhi(a2.w)};
    const float cc[8] = {c0.x, c0.y, c0.z, c0.w, c1.x, c1.y, c1.z, c1.w};
    const float sn[8] = {s0.x, s0.y, s0.z, s0.w, s1.x, s1.y, s1.z, s1.w};
    u32x4 o1, o2;
    o1.x = pack2(x1[0] * cc[0] - x2[0] * sn[0], x1[1] * cc[1] - x2[1] * sn[1]);
    o1.y = pack2(x1[2] * cc[2] - x2[2] * sn[2], x1[3] * cc[3] - x2[3] * sn[3]);
    o1.z = pack2(x1[4] * cc[4] - x2[4] * sn[4], x1[5] * cc[5] - x2[5] * sn[5]);
    o1.w = pack2(x1[6] * cc[6] - x2[6] * sn[6], x1[7] * cc[7] - x2[7] * sn[7]);
    o2.x = pack2(x2[0] * cc[0] + x1[0] * sn[0], x2[1] * cc[1] + x1[1] * sn[1]);
    o2.y = pack2(x2[2] * cc[2] + x1[2] * sn[2], x2[3] * cc[3] + x1[3] * sn[3]);
    o2.z = pack2(x2[4] * cc[4] + x1[4] * sn[4], x2[5] * cc[5] + x1[5] * sn[5]);
    o2.w = pack2(x2[6] * cc[6] + x1[6] * sn[6], x2[7] * cc[7] + x1[7] * sn[7]);
    bf16_t* kd = p.Kb() + ((size_t)((b * 8 + head) * 2048 + s)) * 96 + 64 + half * 8;
    *(u32x4*)kd = o1; *(u32x4*)(kd + 16) = o2;
  }
  unsigned ao[4], bo[4];
#pragma unroll
  for (int j = 0; j < 4; ++j) {
    const int row = r_s + 32 * j;
    ao[j] = (unsigned)(((m * 128 + row) * NIN + 1024 + c_s * 8) * 2);
    bo[j] = (unsigned)(((head * 128 + row) * 128 + c_s * 8) * 2);
  }
  bf16_t* Kb = p.Kb(); bf16_t* V = p.V();
  gemm128(smem, (const unsigned char*)p.proj(), ao, (const unsigned char*)p.wukv_t(), bo, 2, [=](f32x4 (&acc)[4][4], int wm, int wn, int fr, int fq) {
#pragma unroll
    for (int i = 0; i < 4; ++i) {
      const int tl = wm * 64 + i * 16 + fr, t = m * 128 + tl;
      const int b = t >> 11, s = t & 2047;
      const float rs = rowf[tl];
      const size_t rowi = (size_t)((b * 8 + head) * 2048 + s);
#pragma unroll
      for (int j = 0; j < 4; ++j) {
        const int d = j * 16 + fq * 4;
        const f32x4 x = acc[i][j] * rs;
        u32x2 o; o.x = pack2(x[0], x[1]); o.y = pack2(x[2], x[3]);
        if (wn == 0) *(u32x2*)(Kb + rowi * 96 + d) = o; else *(u32x2*)(V + rowi * 64 + d) = o;
      }
    }
  });
}

DI void item_pool(const P& p, unsigned char* smem, int l, int item) {
  const int tid = otid(), w = tid >> 6, lane = tid & 63, fr = lane & 15, fq = lane >> 4;
  const int tile = item >> 2, g = item & 3;
  const int t0 = tile * 128, s0 = t0 & 2047;
  const int wdw = 2 << g;
  unsigned char* al = smem;
  unsigned char* dl = smem + 20480;
  __syncthreads();
  for (int id = tid; id < 143 * 8; id += NTHREADS) {
    const int row = id >> 3, c = id & 7;
    const int srel = s0 - 15 + row;
    u32x4 v = (u32x4){0u, 0u, 0u, 0u};
    if (srel >= 0) v = *(const u32x4*)(p.proj() + (size_t)(t0 - 15 + row) * NIN + g * 64 + c * 8);
    *(u32x4*)(al + row * 128 + c * 16) = v;
  }
  __syncthreads();
  {
    const int tl = tid >> 1, cb = (tid & 1) * 4;
    const int pos = s0 + tl;
    const int nw = (pos + 1 < wdw) ? pos + 1 : wdw;
    const float inv = 1.f / (float)nw;
#pragma unroll
    for (int q = 0; q < 4; ++q) {
      const int c = cb + q;
      float sm[8];
#pragma unroll
      for (int e = 0; e < 8; ++e) sm[e] = 0.f;
      for (int j = 0; j < nw; ++j) {
        const u32x4 v = *(const u32x4*)(al + (tl + 15 - j) * 128 + c * 16);
        sm[0] += bflo(v.x); sm[1] += bfhi(v.x); sm[2] += bflo(v.y); sm[3] += bfhi(v.y); sm[4] += bflo(v.z); sm[5] += bfhi(v.z); sm[6] += bflo(v.w); sm[7] += bfhi(v.w);
      }
      const u32x4 a = *(const u32x4*)(al + (tl + 15) * 128 + c * 16);
      u32x4 o;
      o.x = pack2(sm[0] * inv - bflo(a.x), sm[1] * inv - bfhi(a.x)); o.y = pack2(sm[2] * inv - bflo(a.y), sm[3] * inv - bfhi(a.y));
      o.z = pack2(sm[4] * inv - bflo(a.z), sm[5] * inv - bfhi(a.z)); o.w = pack2(sm[6] * inv - bflo(a.w), sm[7] * inv - bfhi(a.w));
      *(u32x4*)(dl + tl * 128 + ((c ^ (tl & 7)) << 4)) = o;
    }
  }
  __syncthreads();
  {
    const bf16_t* wp = p.wpool_t() + ((size_t)(l * 4 + g) * 64) * 64;
    f32x4 acc[2][4];
#pragma unroll
    for (int i = 0; i < 2; ++i)
#pragma unroll
      for (int j = 0; j < 4; ++j) acc[i][j] = (f32x4){0.f, 0.f, 0.f, 0.f};
#pragma unroll
    for (int ks = 0; ks < 2; ++ks) {
      bf16x8 df[2], wf[4];
#pragma unroll
      for (int i = 0; i < 2; ++i) { const int row = w * 32 + i * 16 + fr; df[i] = *(const bf16x8*)(dl + row * 128 + (((ks * 4 + fq) ^ (row & 7)) << 4)); }
#pragma unroll
      for (int j = 0; j < 4; ++j) wf[j] = *(const bf16x8*)(wp + (size_t)(j * 16 + fr) * 64 + ks * 32 + fq * 8);
#pragma unroll
      for (int i = 0; i < 2; ++i)
#pragma unroll
        for (int j = 0; j < 4; ++j) acc[i][j] = __builtin_amdgcn_mfma_f32_16x16x32_bf16(wf[j], df[i], acc[i][j], 0, 0, 0);
    }
#pragma unroll
    for (int i = 0; i < 2; ++i) {
      const int t = t0 + w * 32 + i * 16 + fr;
#pragma unroll
      for (int j = 0; j < 4; ++j) {
        const int cc = g * 64 + j * 16 + fq * 4;
        const float4 ps = *(const float4*)(p.pool_scale + l * 256 + cc);
        u32x2 o; o.x = pack2(acc[i][j][0] * ps.x, acc[i][j][1] * ps.y); o.y = pack2(acc[i][j][2] * ps.z, acc[i][j][3] * ps.w);
        *(u32x2*)(p.Y() + (size_t)t * 1024 + cc) = o;
      }
    }
  }
}

DI void item_sgu(const P& p, unsigned char* smem, int l, int chunk) {
  const int tid = otid(), w = tid >> 6, lane = tid & 63, fr = lane & 15, fq = lane >> 4;
  const int t0 = chunk * 128;
  unsigned char* vn = smem;
  __syncthreads();
#pragma unroll 1
  for (int ps = 0; ps < 4; ++ps) {
    const int tl = ps * 32 + (tid >> 3), part = tid & 7;
    const bf16_t* src = p.proj() + (size_t)(t0 + tl) * NIN + 512 + part * 32;
    float x[32];
#pragma unroll
    for (int q = 0; q < 4; ++q) {
      const u32x4 v = *(const u32x4*)(src + q * 8);
      x[q * 8 + 0] = gelu_tanh(bflo(v.x)); x[q * 8 + 1] = gelu_tanh(bfhi(v.x)); x[q * 8 + 2] = gelu_tanh(bflo(v.y)); x[q * 8 + 3] = gelu_tanh(bfhi(v.y));
      x[q * 8 + 4] = gelu_tanh(bflo(v.z)); x[q * 8 + 5] = gelu_tanh(bfhi(v.z)); x[q * 8 + 6] = gelu_tanh(bflo(v.w)); x[q * 8 + 7] = gelu_tanh(bfhi(v.w));
    }
    float sm = 0.f;
#pragma unroll
    for (int e = 0; e < 32; ++e) sm += x[e];
    sm += __shfl_xor(sm, 1); sm += __shfl_xor(sm, 2); sm += __shfl_xor(sm, 4);
    const float mu = sm * (1.f / 256.f);
    float vs = 0.f;
#pragma unroll
    for (int e = 0; e < 32; ++e) { x[e] -= mu; vs += x[e] * x[e]; }
    vs += __shfl_xor(vs, 1); vs += __shfl_xor(vs, 2); vs += __shfl_xor(vs, 4);
    const float rstd = rsqrtf(vs * (1.f / 256.f) + EPS);
#pragma unroll
    for (int q = 0; q < 4; ++q) {
      const int c = part * 4 + q;
      u32x4 o;
      o.x = pack2(x[q * 8 + 0] * rstd, x[q * 8 + 1] * rstd); o.y = pack2(x[q * 8 + 2] * rstd, x[q * 8 + 3] * rstd);
      o.z = pack2(x[q * 8 + 4] * rstd, x[q * 8 + 5] * rstd); o.w = pack2(x[q * 8 + 6] * rstd, x[q * 8 + 7] * rstd);
      *(u32x4*)(vn + tl * 512 + (((c >> 1) ^ (tl & 7)) << 5) + ((c & 1) << 4)) = o;
    }
  }
  __syncthreads();
  const int qq = fr >> 2, pp = fr & 3;
#pragma unroll 1
  for (int hh = 0; hh < 4; ++hh) {
    f32x4 acc[4][2];
#pragma unroll
    for (int df = 0; df < 4; ++df) { acc[df][0] = (f32x4){0.f, 0.f, 0.f, 0.f}; acc[df][1] = (f32x4){0.f, 0.f, 0.f, 0.f}; }
    const bf16_t* wb = p.wsp_b() + ((size_t)(l * 4 + hh) * 128) * 128;
    for (int kb = 0; kb <= w; ++kb) {
      bf16x8 wf[2];
#pragma unroll
      for (int f = 0; f < 2; ++f) {
        const bf16_t* wr = wb + (size_t)((2 * w + f) * 16 + fr) * 128 + kb * 32 + fq * 4;
        const u32x2 lo = *(const u32x2*)wr, hi = *(const u32x2*)(wr + 16);
        u32x4 u; u.x = lo.x; u.y = lo.y; u.z = hi.x; u.w = hi.y;
        wf[f] = __builtin_bit_cast(bf16x8, u);
      }
#pragma unroll
      for (int df = 0; df < 4; ++df) {
        const int keyA = kb * 32 + fq * 4 + qq, keyB = keyA + 16;
        const int slot = hh * 4 + df;
        const s16x4 lo = __builtin_amdgcn_ds_read_tr16_b64_v4i16((LAS s16x4*)(vn + keyA * 512 + ((slot ^ (keyA & 7)) << 5) + pp * 8));
        const s16x4 hi = __builtin_amdgcn_ds_read_tr16_b64_v4i16((LAS s16x4*)(vn + keyB * 512 + ((slot ^ (keyB & 7)) << 5) + pp * 8));
        bf16x8 vf; vf[0] = lo[0]; vf[1] = lo[1]; vf[2] = lo[2]; vf[3] = lo[3]; vf[4] = hi[0]; vf[5] = hi[1]; vf[6] = hi[2]; vf[7] = hi[3];
        acc[df][0] = __builtin_amdgcn_mfma_f32_16x16x32_bf16(vf, wf[0], acc[df][0], 0, 0, 0);
        acc[df][1] = __builtin_amdgcn_mfma_f32_16x16x32_bf16(vf, wf[1], acc[df][1], 0, 0, 0);
      }
    }
#pragma unroll
    for (int f = 0; f < 2; ++f) {
      const int tl = (2 * w + f) * 16 + fr, t = t0 + tl;
      const float bias = p.b_spatial[(l * 4 + hh) * 128 + tl];
#pragma unroll
      for (int df = 0; df < 4; ++df) {
        const int d = hh * 64 + df * 16 + fq * 4;
        const u32x2 uu = *(const u32x2*)(p.proj() + (size_t)t * NIN + 256 + d);
        u32x2 o;
        o.x = pack2(gelu_tanh(bflo(uu.x)) * (acc[df][f][0] + bias), gelu_tanh(bfhi(uu.x)) * (acc[df][f][1] + bias));
        o.y = pack2(gelu_tanh(bflo(uu.y)) * (acc[df][f][2] + bias), gelu_tanh(bfhi(uu.y)) * (acc[df][f][3] + bias));
        *(u32x2*)(p.Y() + (size_t)t * 1024 + 256 + d) = o;
      }
    }
  }
}

DI void item_attn(const P& p, unsigned char* smem, int item) {
  const int tid = otid(), w = tid >> 6, lane = tid & 63;
  const int fr = lane & 15, fq = lane >> 4;
  const int rnd = item >> 9, blk = item & 511;
  const int qb = rnd == 0 ? 15 - (blk >> 6) : (blk >> 6);
  const int bh = blk & 63, b = bh >> 3, h = bh & 7;
  const int q0 = qb * 128;
  const int nkt = 2 * qb + 2;
  const bf16_t* Qg = p.Q() + (size_t)bh * 2048 * 96;
  const bf16_t* Kg = p.Kb() + (size_t)bh * 2048 * 96;
  const bf16_t* Vg = p.V() + (size_t)bh * 2048 * 64;
  int kkey[3], kdst[3], kc[3];
#pragma unroll
  for (int j = 0; j < 3; ++j) { const int id = tid + 256 * j; kkey[j] = id / 12; kc[j] = id % 12; kdst[j] = kkey[j] * 256 + ((kc[j] ^ (kkey[j] & 15)) << 4); }
  int vkey[2], vdst[2], vc[2];
#pragma unroll
  for (int j = 0; j < 2; ++j) { const int id = tid + 256 * j; vkey[j] = id >> 3; vc[j] = id & 7; vdst[j] = vkey[j] * 128 + (((vc[j] >> 1) ^ ((vkey[j] >> 1) & 3)) << 5) + ((vc[j] & 1) << 4); }
  bf16x8 qf[3][2];
#pragma unroll
  for (int ks = 0; ks < 3; ++ks)
#pragma unroll
    for (int f = 0; f < 2; ++f) qf[ks][f] = *(const bf16x8*)(Qg + (size_t)(q0 + 32 * w + 16 * f + fr) * 96 + ks * 32 + fq * 8);
  f32x4 o[4][2];
#pragma unroll
  for (int f = 0; f < 4; ++f) { o[f][0] = (f32x4){0.f, 0.f, 0.f, 0.f}; o[f][1] = (f32x4){0.f, 0.f, 0.f, 0.f}; }
  float mrun[2] = {-INFINITY, -INFINITY}, lrun[2] = {0.f, 0.f};
  u32x4 rk[3], rv[2];
  __syncthreads();
#pragma unroll
  for (int j = 0; j < 3; ++j) rk[j] = *(const u32x4*)(Kg + (size_t)kkey[j] * 96 + kc[j] * 8);
#pragma unroll
  for (int j = 0; j < 2; ++j) rv[j] = *(const u32x4*)(Vg + (size_t)vkey[j] * 64 + vc[j] * 8);
#pragma unroll
  for (int j = 0; j < 3; ++j) *(u32x4*)(smem + kdst[j]) = rk[j];
#pragma unroll
  for (int j = 0; j < 2; ++j) *(u32x4*)(smem + 32768 + vdst[j]) = rv[j];
  __syncthreads();
  const int rowmin = q0 + 32 * w;
  for (int kt = 0; kt < nkt; ++kt) {
    const int cur = kt & 1;
    const bool more = kt + 1 < nkt;
    if (more) {
      const int key0n = (kt + 1) * 64;
#pragma unroll
      for (int j = 0; j < 3; ++j) rk[j] = *(const u32x4*)(Kg + (size_t)(key0n + kkey[j]) * 96 + kc[j] * 8);
#pragma unroll
      for (int j = 0; j < 2; ++j) rv[j] = *(const u32x4*)(Vg + (size_t)(key0n + vkey[j]) * 64 + vc[j] * 8);
    }
    const int key0 = kt * 64;
    if (key0 <= rowmin + 31) {
      const unsigned char* Kl = smem + cur * 16384;
      const unsigned char* Vl = smem + 32768 + cur * 8192;
      f32x4 st[4][2];
#pragma unroll
      for (int kf = 0; kf < 4; ++kf) { st[kf][0] = (f32x4){0.f, 0.f, 0.f, 0.f}; st[kf][1] = (f32x4){0.f, 0.f, 0.f, 0.f}; }
#pragma unroll
      for (int ks = 0; ks < 3; ++ks)
#pragma unroll
        for (int kf = 0; kf < 4; ++kf) {
          const int key = kf * 16 + fr;
          const bf16x8 a = *(const bf16x8*)(Kl + key * 256 + (((ks * 4 + fq) ^ (key & 15)) << 4));
          st[kf][0] = __builtin_amdgcn_mfma_f32_16x16x32_bf16(a, qf[ks][0], st[kf][0], 0, 0, 0);
          st[kf][1] = __builtin_amdgcn_mfma_f32_16x16x32_bf16(a, qf[ks][1], st[kf][1], 0, 0, 0);
        }
      const bool needmask = (key0 + 63 > rowmin);
#pragma unroll
      for (int f = 0; f < 2; ++f) {
        const int qabs = rowmin + 16 * f + fr;
        if (needmask) {
#pragma unroll
          for (int kf = 0; kf < 4; ++kf)
#pragma unroll
            for (int r = 0; r < 4; ++r) { const int kabs = key0 + kf * 16 + fq * 4 + r; if (kabs > qabs) st[kf][f][r] = -INFINITY; }
        }
        float mx = st[0][f][0];
#pragma unroll
        for (int kf = 0; kf < 4; ++kf)
#pragma unroll
          for (int r = 0; r < 4; ++r) mx = fmaxf(mx, st[kf][f][r]);
        mx = fmaxf(mx, __shfl_xor(mx, 16)); mx = fmaxf(mx, __shfl_xor(mx, 32));
        const float mnew = fmaxf(mrun[f], mx);
        const float alpha = __builtin_amdgcn_exp2f(mrun[f] - mnew);
        mrun[f] = mnew;
        float ls = 0.f;
#pragma unroll
        for (int kf = 0; kf < 4; ++kf)
#pragma unroll
          for (int r = 0; r < 4; ++r) { const float pv = __builtin_amdgcn_exp2f(st[kf][f][r] - mnew); st[kf][f][r] = pv; ls += pv; }
        lrun[f] = lrun[f] * alpha + ls;
#pragma unroll
        for (int df = 0; df < 4; ++df) o[df][f] = o[df][f] * alpha;
      }
      bf16x8 pf[2][2];
#pragma unroll
      for (int kb = 0; kb < 2; ++kb)
#pragma unroll
        for (int f = 0; f < 2; ++f) {
          u32x4 u;
          u.x = pack2(st[2 * kb][f][0], st[2 * kb][f][1]); u.y = pack2(st[2 * kb][f][2], st[2 * kb][f][3]);
          u.z = pack2(st[2 * kb + 1][f][0], st[2 * kb + 1][f][1]); u.w = pack2(st[2 * kb + 1][f][2], st[2 * kb + 1][f][3]);
          pf[kb][f] = __builtin_bit_cast(bf16x8, u);
        }
      const int qq = fr >> 2, pp = fr & 3;
#pragma unroll
      for (int kb = 0; kb < 2; ++kb)
#pragma unroll
        for (int df = 0; df < 4; ++df) {
          const int keyA = kb * 32 + fq * 4 + qq, keyB = keyA + 16;
          const int offA = keyA * 128 + ((df ^ ((keyA >> 1) & 3)) << 5) + pp * 8;
          const int offB = keyB * 128 + ((df ^ ((keyB >> 1) & 3)) << 5) + pp * 8;
          const s16x4 lo = __builtin_amdgcn_ds_read_tr16_b64_v4i16((LAS s16x4*)(Vl + offA));
          const s16x4 hi = __builtin_amdgcn_ds_read_tr16_b64_v4i16((LAS s16x4*)(Vl + offB));
          bf16x8 vf; vf[0] = lo[0]; vf[1] = lo[1]; vf[2] = lo[2]; vf[3] = lo[3]; vf[4] = hi[0]; vf[5] = hi[1]; vf[6] = hi[2]; vf[7] = hi[3];
          o[df][0] = __builtin_amdgcn_mfma_f32_16x16x32_bf16(vf, pf[kb][0], o[df][0], 0, 0, 0);
          o[df][1] = __builtin_amdgcn_mfma_f32_16x16x32_bf16(vf, pf[kb][1], o[df][1], 0, 0, 0);
        }
    }
    if (more) {
      const int nx = cur ^ 1;
#pragma unroll
      for (int j = 0; j < 3; ++j) *(u32x4*)(smem + nx * 16384 + kdst[j]) = rk[j];
#pragma unroll
      for (int j = 0; j < 2; ++j) *(u32x4*)(smem + 32768 + nx * 8192 + vdst[j]) = rv[j];
    }
    __syncthreads();
  }
#pragma unroll
  for (int f = 0; f < 2; ++f) {
    float lt = lrun[f]; lt += __shfl_xor(lt, 16); lt += __shfl_xor(lt, 32);
    const float inv = 1.f / lt;
    const int t = b * 2048 + rowmin + 16 * f + fr;
#pragma unroll
    for (int df = 0; df < 4; ++df) {
      const f32x4 x = o[df][f] * inv;
      u32x2 ov; ov.x = pack2(x[0], x[1]); ov.y = pack2(x[2], x[3]);
      *(u32x2*)(p.Y() + (size_t)t * 1024 + 512 + h * 64 + df * 16 + fq * 4) = ov;
    }
  }
}

DI void item_p4(const P& p, unsigned char* smem, int l, int item) {
  const int m = item >> 3, nt = item & 7;
  const int tid = otid(), r_s = tid >> 3, c_s = tid & 7;
  unsigned ao[4], bo[4];
#pragma unroll
  for (int j = 0; j < 4; ++j) {
    const int row = r_s + 32 * j;
    ao[j] = (unsigned)(((m * 128 + row) * 1024 + c_s * 8) * 2);
    bo[j] = (unsigned)(((nt * 128 + row) * 1024 + c_s * 8) * 2);
  }
  const float* xin = (l == 0) ? p.x : p.out;
  float* xout = p.out;
  const float* mod = p.mod() + (size_t)l * 8 * 6144 + 2048;
  float* rowss = p.rowss();
  gemm128(smem, (const unsigned char*)p.Y(), ao, (const unsigned char*)p.wout_t(), bo, 16, [=](f32x4 (&acc)[4][4], int wm, int wn, int fr, int fq) {
#pragma unroll
    for (int i = 0; i < 4; ++i) {
      const int t = m * 128 + wm * 64 + i * 16 + fr, b = t >> 11;
      float ss = 0.f;
#pragma unroll
      for (int j = 0; j < 4; ++j) {
        const int n = nt * 128 + wn * 64 + j * 16 + fq * 4;
        const float4 xv = *(const float4*)(xin + (size_t)t * 1024 + n);
        const float4 g = *(const float4*)(mod + (size_t)b * 6144 + n);
        float4 ov = {xv.x + g.x * acc[i][j][0], xv.y + g.y * acc[i][j][1], xv.z + g.z * acc[i][j][2], xv.w + g.w * acc[i][j][3]};
        ss += ov.x * ov.x + ov.y * ov.y + ov.z * ov.z + ov.w * ov.w;
        *(float4*)(xout + (size_t)t * 1024 + n) = ov;
      }
      ss += __shfl_xor(ss, 16); ss += __shfl_xor(ss, 32);
      if (fq == 0) rowss[(size_t)t * 16 + nt * 2 + wn] = ss;
    }
  });
}

DI void item_p5(const P& p, unsigned char* smem, int l, int item) {
  const int tid = otid(), w = tid >> 6, lane = tid & 63, fr = lane & 15, fq = lane >> 4;
  const int r_s = tid >> 3, c_s = tid & 7;
  const int tb = item * 64 + w * 16;
  const int t = tb + fr, b = (item * 64) >> 11;
  const float* xr = p.out + (size_t)t * 1024 + fq * 8;
  float* mds = (float*)(smem + 32768);
  __syncthreads();
  {
    const float* md = p.mod() + ((size_t)l * 8 + b) * 6144 + 3072;
    for (int i = tid; i < 512; i += NTHREADS) *(float4*)(mds + i * 4) = *(const float4*)(md + i * 4);
  }
  float rstd;
  {
    const float4* rp = (const float4*)(p.rowss() + (size_t)t * 16);
    const float4 a = rp[0], c = rp[1], d = rp[2], e = rp[3];
    const float ss = ((a.x + a.y) + (a.z + a.w)) + ((c.x + c.y) + (c.z + c.w)) + ((d.x + d.y) + (d.z + d.w)) + ((e.x + e.y) + (e.z + e.w));
    rstd = rsqrtf(ss * (1.f / 1024.f) + EPS);
  }
  const bf16_t* wsrc[4];
#pragma unroll
  for (int j = 0; j < 4; ++j) {
    const int row = r_s + 32 * j;
    wsrc[j] = (row < 64 ? p.wr_hi() + (size_t)l * 65536 + (size_t)row * 1024 : p.wr_lo() + (size_t)l * 65536 + (size_t)(row - 64) * 1024) + c_s * 8;
  }
  const int st_off = r_s * 128 + ((c_s ^ (r_s & 7)) << 4);
  u32x4 rw[4]; float4 xa[2], xb[2];
#pragma unroll
  for (int j = 0; j < 4; ++j) rw[j] = *(const u32x4*)(wsrc[j]);
#pragma unroll
  for (int q = 0; q < 2; ++q) { xa[q] = *(const float4*)(xr + q * 32); xb[q] = *(const float4*)(xr + q * 32 + 4); }
#pragma unroll
  for (int j = 0; j < 4; ++j) *(u32x4*)(smem + st_off + j * 4096) = rw[j];
  __syncthreads();
  f32x4 acc[4];
#pragma unroll
  for (int nf = 0; nf < 4; ++nf) acc[nf] = (f32x4){0.f, 0.f, 0.f, 0.f};
  bf16_t* hdst = p.h() + (size_t)t * 1024 + fq * 8;
  for (int kc = 0; kc < 16; ++kc) {
    const int cur = (kc & 1) * 16384;
    const bool more = kc + 1 < 16;
    float4 ca[2], cb[2];
#pragma unroll
    for (int q = 0; q < 2; ++q) { ca[q] = xa[q]; cb[q] = xb[q]; }
    if (more) {
#pragma unroll
      for (int j = 0; j < 4; ++j) rw[j] = *(const u32x4*)(wsrc[j] + (kc + 1) * 64);
#pragma unroll
      for (int q = 0; q < 2; ++q) { xa[q] = *(const float4*)(xr + (kc + 1) * 64 + q * 32); xb[q] = *(const float4*)(xr + (kc + 1) * 64 + q * 32 + 4); }
    }
#pragma unroll
    for (int q = 0; q < 2; ++q) {
      const int k0 = kc * 64 + q * 32 + fq * 8;
      const float4 ha = *(const float4*)(mds + k0), hb = *(const float4*)(mds + k0 + 4);
      const float4 sa = *(const float4*)(mds + 1024 + k0), sb = *(const float4*)(mds + 1024 + k0 + 4);
      float hv[8];
      hv[0] = ca[q].x * rstd * (1.f + sa.x) + ha.x; hv[1] = ca[q].y * rstd * (1.f + sa.y) + ha.y; hv[2] = ca[q].z * rstd * (1.f + sa.z) + ha.z; hv[3] = ca[q].w * rstd * (1.f + sa.w) + ha.w;
      hv[4] = cb[q].x * rstd * (1.f + sb.x) + hb.x; hv[5] = cb[q].y * rstd * (1.f + sb.y) + hb.y; hv[6] = cb[q].z * rstd * (1.f + sb.z) + hb.z; hv[7] = cb[q].w * rstd * (1.f + sb.w) + hb.w;
      u32x4 uh, ul;
      uh.x = pack2(hv[0], hv[1]); uh.y = pack2(hv[2], hv[3]); uh.z = pack2(hv[4], hv[5]); uh.w = pack2(hv[6], hv[7]);
      ul.x = pack2(hv[0] - bflo(uh.x), hv[1] - bfhi(uh.x)); ul.y = pack2(hv[2] - bflo(uh.y), hv[3] - bfhi(uh.y));
      ul.z = pack2(hv[4] - bflo(uh.z), hv[5] - bfhi(uh.z)); ul.w = pack2(hv[6] - bflo(uh.w), hv[7] - bfhi(uh.w));
      *(u32x4*)(hdst + kc * 64 + q * 32) = uh;
      const bf16x8 bh = __builtin_bit_cast(bf16x8, uh), bl = __builtin_bit_cast(bf16x8, ul);
      const int sw = ((q * 4 + fq) ^ (fr & 7)) << 4;
#pragma unroll
      for (int nf = 0; nf < 4; ++nf) {
        const bf16x8 ah = *(const bf16x8*)(smem + cur + (nf * 16 + fr) * 128 + sw), al = *(const bf16x8*)(smem + cur + (64 + nf * 16 + fr) * 128 + sw);
        acc[nf] = __builtin_amdgcn_mfma_f32_16x16x32_bf16(ah, bh, acc[nf], 0, 0, 0);
        acc[nf] = __builtin_amdgcn_mfma_f32_16x16x32_bf16(ah, bl, acc[nf], 0, 0, 0);
        acc[nf] = __builtin_amdgcn_mfma_f32_16x16x32_bf16(al, bh, acc[nf], 0, 0, 0);
      }
    }
    if (more) {
      const int nxt = 16384 - cur;
#pragma unroll
      for (int j = 0; j < 4; ++j) *(u32x4*)(smem + nxt + st_off + j * 4096) = rw[j];
    }
    __syncthreads();
  }
  float* lg = (float*)smem + w * 1024;
  int* info = (int*)(smem + 16384) + w * 1024;
#pragma unroll
  for (int nf = 0; nf < 4; ++nf) *(f32x4*)(lg + fr * 64 + nf * 16 + fq * 4) = acc[nf];
  __syncthreads();
  const float bias = p.router_bias[l * 64 + lane];
  int cnt_local = 0;
#pragma unroll 1
  for (int q = 0; q < 16; ++q) {
    const float s = 1.f / (1.f + __expf(-lg[q * 64 + lane]));
    const float sel = s + bias;
    float m1 = sel; m1 = fmaxf(m1, __shfl_xor(m1, 1)); m1 = fmaxf(m1, __shfl_xor(m1, 2)); m1 = fmaxf(m1, __shfl_xor(m1, 4));
    const unsigned long long eq = __ballot(sel == m1);
    const int gbase = lane & ~7;
    const unsigned gm = (unsigned)((eq >> gbase) & 0xffull);
    const int first = gbase + __ffs(gm) - 1;
    float m2 = (lane == first) ? -INFINITY : sel;
    m2 = fmaxf(m2, __shfl_xor(m2, 1)); m2 = fmaxf(m2, __shfl_xor(m2, 2)); m2 = fmaxf(m2, __shfl_xor(m2, 4));
    const float gs = m1 + m2;
    const int myg = lane >> 3; int rank = 0;
#pragma unroll
    for (int j = 0; j < 8; ++j) { const float gj = __shfl(gs, j * 8); rank += ((gj > gs) || (gj == gs && j < myg)) ? 1 : 0; }
    const bool gsel = rank < 4;
    const float sm = gsel ? sel : -INFINITY;
    int r = 0;
#pragma unroll 8
    for (int j = 0; j < 64; ++j) { const float sj = __shfl(sm, j); r += ((sj > sm) || (sj == sm && j < lane)) ? 1 : 0; }
    const bool ch = gsel && (r < 8);
    const float tot = wsum(ch ? s : 0.f);
    const unsigned long long cm = __ballot(ch);
    const int kidx = __popcll(cm & ((1ull << lane) - 1ull));
    info[q * 64 + lane] = ch ? kidx : -1;
    if (ch) p.topw()[(size_t)(tb + q) * 8 + kidx] = s / tot * 2.5f;
    cnt_local += ch ? 1 : 0;
  }
  int base = 0;
  if (cnt_local > 0) base = atomicAdd(p.cnt() + (l * 64 + lane) * CSTRIDE, cnt_local);
#pragma unroll 1
  for (int q = 0; q < 16; ++q) {
    const int k = info[q * 64 + lane];
    if (k >= 0) { p.list()[(size_t)lane * LISTCAP + base] = (tb + q) * 8 + k; ++base; }
  }
}

DI void moe_table(const P& p, unsigned char* smem, int l) {
  int* start = (int*)(smem + SMEM_MAIN);
  __syncthreads();
  if (otid() == 0) {
    int s = 0;
    for (int e = 0; e < 64; ++e) { start[e] = s; s += (p.cnt()[(l * 64 + e) * CSTRIDE] + 127) >> 7; }
    start[64] = s;
  }
  __syncthreads();
}
DI void moe_rows(const P& p, unsigned char* smem, int l, int mt, int& e_out) {
  const int* start = (const int*)(smem + SMEM_MAIN);
  int* rowinfo = (int*)(smem + SMEM_MAIN + 512);
  const int tid = otid();
  int e;
  if (mt >= start[64]) { e = 64; if (tid < 128) rowinfo[tid] = T_ * 8 + (mt - start[64]) * 128 + tid; }
  else {
    e = 0;
    for (int q = 1; q < 64; ++q) e = (start[q] <= mt) ? q : e;
    const int tl = mt - start[e];
    const int cnt = p.cnt()[(l * 64 + e) * CSTRIDE];
    if (tid < 128) { const int idx = tl * 128 + tid; rowinfo[tid] = idx < cnt ? p.list()[(size_t)e * LISTCAP + idx] : -1; }
  }
  e_out = e;
}

DI void item_p7(const P& p, unsigned char* smem, int l, int item) {
  const int mt = item >> 2, nt = item & 3;
  const int tid = otid(), r_s = tid >> 3, c_s = tid & 7;
  int* rowinfo = (int*)(smem + SMEM_MAIN + 512);
  __syncthreads();
  int e; moe_rows(p, smem, l, mt, e);
  __syncthreads();
  const bf16_t* wbase = (e == 64) ? p.wsg_t() : p.wgu_t() + (size_t)e * 512 * 1024;
  unsigned ao[4], bo[4];
#pragma unroll
  for (int j = 0; j < 4; ++j) {
    const int row = r_s + 32 * j;
    const int slot = rowinfo[row];
    const int tok = slot < 0 ? 0 : (slot >= T_ * 8 ? slot - T_ * 8 : slot >> 3);
    ao[j] = (unsigned)((tok * 1024 + c_s * 8) * 2);
    bo[j] = (unsigned)(((nt * 128 + row) * 1024 + c_s * 8) * 2);
  }
  bf16_t* act = p.act();
  gemm128(smem, (const unsigned char*)p.h(), ao, (const unsigned char*)wbase, bo, 16, [=](f32x4 (&acc)[4][4], int wm, int wn, int fr, int fq) {
    unsigned char* ob = smem + wm * 8192;
#pragma unroll
    for (int i = 0; i < 4; ++i) {
#pragma unroll
      for (int jj = 0; jj < 2; ++jj) {
        const f32x4 g = acc[i][2 * jj], u = acc[i][2 * jj + 1];
        u32x2 o; o.x = pack2(silu_f(g[0]) * u[0], silu_f(g[1]) * u[1]); o.y = pack2(silu_f(g[2]) * u[2], silu_f(g[3]) * u[3]);
        ot_put<128>(ob, i * 16 + fr, wn * 8 + jj * 4 + fq, o);
      }
    }
    __syncthreads();
    {
      const int tid2 = fq * 16 + fr + 64 * (wm * 2 + wn);
      const int chunk = tid2 & 7;
#pragma unroll
      for (int i = 0; i < 4; ++i) {
        const int row = (tid2 >> 3) + 32 * i;
        const int slot = rowinfo[row];
        if (slot >= 0) {
          const u32x4 v = ot_get<128>(smem + (row >> 6) * 8192, row & 63, chunk);
          *(u32x4*)(act + (size_t)slot * 256 + nt * 64 + chunk * 8) = v;
        }
      }
    }
  });
}

DI void item_p8(const P& p, unsigned char* smem, int l, int item) {
  const int mt = item >> 1, nh = item & 1;
  const int tid = otid(), r_s = tid >> 3, c_s = tid & 7;
  int* rowinfo = (int*)(smem + SMEM_MAIN + 512);
  __syncthreads();
  int e; moe_rows(p, smem, l, mt, e);
  __syncthreads();
  const bf16_t* wbase = (e == 64) ? p.wsd_t() : p.wd_t() + (size_t)e * 1024 * 256;
  unsigned ao[4], bo[4];
#pragma unroll
  for (int j = 0; j < 4; ++j) {
    const int row = r_s + 32 * j;
    const int slot = rowinfo[row];
    ao[j] = (unsigned)(((slot < 0 ? 0 : slot) * 256 + c_s * 8) * 2);
    bo[j] = (unsigned)(((nh * 512 + row) * 256 + c_s * 8) * 2);
  }
  bf16_t* yrows = p.yrows(); bf16_t* ysh = p.ysh(); const float* topw = p.topw();
  gemm128_stream(smem, (const unsigned char*)p.act(), ao, (const unsigned char*)wbase, bo, 4, 4, (size_t)128 * 256, [=](f32x4 (&acc)[4][4], int tile, int cur, int wm, int wn, int fr, int fq) {
    const int nt = nh * 4 + tile;
    unsigned char* ob = smem + cur + (wm ? 32768 : 0);
    __syncthreads();
#pragma unroll
    for (int i = 0; i < 4; ++i) {
      const int slot = rowinfo[wm * 64 + i * 16 + fr];
      const float wv = (slot < 0 || slot >= T_ * 8) ? 1.f : topw[slot];
#pragma unroll
      for (int j = 0; j < 4; ++j) {
        const f32x4 x = acc[i][j] * wv;
        u32x2 o; o.x = pack2(x[0], x[1]); o.y = pack2(x[2], x[3]);
        ot_put<256>(ob, i * 16 + fr, wn * 16 + j * 4 + fq, o);
      }
    }
    __syncthreads();
    {
      const int tid2 = fq * 16 + fr + 64 * (wm * 2 + wn);
      const int chunk = tid2 & 15;
#pragma unroll
      for (int i = 0; i < 8; ++i) {
        const int row = (tid2 >> 4) + 16 * i;
        const int slot = rowinfo[row];
        if (slot >= 0) {
          const u32x4 v = ot_get<256>(smem + cur + ((row >> 6) ? 32768 : 0), row & 63, chunk);
          bf16_t* dst = (slot >= T_ * 8) ? ysh + (size_t)(slot - T_ * 8) * 1024 : yrows + (size_t)slot * 1024;
          *(u32x4*)(dst + nt * 128 + chunk * 8) = v;
        }
      }
    }
  });
}

DI void item_p9(const P& p, int l, int item) {
  const int tid = otid(), w = tid >> 6, lane = tid & 63;
  const int t = item * 4 + w, b = t >> 11;
  const float* md = p.mod() + ((size_t)l * 8 + b) * 6144;
  float4 v[4]; float ss = 0.f;
#pragma unroll
  for (int j = 0; j < 4; ++j) {
    const int idx = j * 256 + lane * 4;
    u32x2 y = *(const u32x2*)(p.ysh() + (size_t)t * 1024 + idx);
    float a0 = bflo(y.x), a1 = bfhi(y.x), a2 = bflo(y.y), a3 = bfhi(y.y);
#pragma unroll
    for (int k = 0; k < 8; ++k) {
      y = *(const u32x2*)(p.yrows() + ((size_t)t * 8 + k) * 1024 + idx);
      a0 += bflo(y.x); a1 += bfhi(y.x); a2 += bflo(y.y); a3 += bfhi(y.y);
    }
    const float4 xv = *(const float4*)(p.out + (size_t)t * 1024 + idx);
    const float4 g = *(const float4*)(md + 5120 + idx);
    v[j] = (float4){xv.x + g.x * a0, xv.y + g.y * a1, xv.z + g.z * a2, xv.w + g.w * a3};
    ss += v[j].x * v[j].x + v[j].y * v[j].y + v[j].z * v[j].z + v[j].w * v[j].w;
  }
  ss = wsum(ss);
  const float rstd = rsqrtf(ss * (1.f / 1024.f) + EPS);
  if (l == 0) {
    const float* md1 = p.mod() + ((size_t)8 + b) * 6144;
#pragma unroll
    for (int j = 0; j < 4; ++j) {
      const int idx = j * 256 + lane * 4;
      *(float4*)(p.out + (size_t)t * 1024 + idx) = v[j];
      const float4 sh = *(const float4*)(md1 + idx), sc = *(const float4*)(md1 + 1024 + idx);
      u32x2 o;
      o.x = pack2(v[j].x * rstd * (1.f + sc.x) + sh.x, v[j].y * rstd * (1.f + sc.y) + sh.y);
      o.y = pack2(v[j].z * rstd * (1.f + sc.z) + sh.z, v[j].w * rstd * (1.f + sc.w) + sh.w);
      *(u32x2*)(p.h() + (size_t)t * 1024 + idx) = o;
    }
  } else {
#pragma unroll
    for (int j = 0; j < 4; ++j) {
      const int idx = j * 256 + lane * 4;
      const float4 fg = *(const float4*)(p.final_gain + idx);
      *(float4*)(p.out + (size_t)t * 1024 + idx) = (float4){v[j].x * rstd * fg.x, v[j].y * rstd * fg.y, v[j].z * rstd * fg.z, v[j].w * rstd * fg.w};
    }
  }
}


DI int xcd_vb(int bid, int G) { return ((G & 7) == 0) ? (bid & 7) * (G >> 3) + (bid >> 3) : bid; }

DI void phase_p1(const P& p, LAS unsigned char* lds, int G, int bid) {
  t8::DenseSched S; S.init(T_, 1280, 1024, G, bid, p.win_t());
  t8::DenseRows RO{2048u};
  bf16_t* proj = p.proj();
  t8::gemm_phase<true>(lds, (const unsigned char*)p.h(), 1024, S, RO, [=](const f32x4 (&acc)[2][2][4][2], const t8::Unit& u, int wr, int wc, int fr, int fq) {
#pragma unroll
    for (int ai = 0; ai < 2; ++ai)
#pragma unroll
      for (int m = 0; m < 4; ++m) {
        const int r = u.pm * 256 + ai * 128 + wr * 64 + m * 16 + fr;
#pragma unroll
        for (int bj = 0; bj < 2; ++bj) {
          const int c0 = u.pn * 256 + bj * 128 + wc * 32 + fq * 8;
          if (c0 < NIN) {
            const f32x4 v0 = acc[ai][bj][m][0], v1 = acc[ai][bj][m][1];
            u32x4 o; o.x = pack2(v0[0], v0[1]); o.y = pack2(v0[2], v0[3]); o.z = pack2(v1[0], v1[1]); o.w = pack2(v1[2], v1[3]);
            *(u32x4*)(proj + (size_t)r * NIN + c0) = o;
          }
        }
        asm volatile("" ::: "memory");
      }
  });
}

DI void phase_p4(const P& p, LAS unsigned char* lds, int l, int G, int bid) {
  t8::DenseSched S; S.init(T_, 1024, 1024, G, bid, p.wout_t());
  t8::DenseRows RO{2048u};
  const float* xin = (l == 0) ? p.x : p.out; float* xout = p.out;
  const float* mod = p.mod() + (size_t)l * 8 * 6144 + 2048;
  float* rowss = p.rowss();
  t8::gemm_phase<false>(lds, (const unsigned char*)p.Y(), 1024, S, RO, [=](const f32x4 (&acc)[2][2][4][2], const t8::Unit& u, int wr, int wc, int fr, int fq) {
    float4 xq[2][4];
    const int cbase = u.pn * 256 + wc * 32 + fq * 4;
    {
      const int r0 = u.pm * 256 + wr * 64 + fr;
#pragma unroll
      for (int q = 0; q < 4; ++q) xq[0][q] = *(const float4*)(xin + (size_t)r0 * 1024 + cbase + (q >> 1) * 128 + (q & 1) * 16);
    }
#pragma unroll
    for (int ai = 0; ai < 2; ++ai)
#pragma unroll
      for (int m = 0; m < 4; ++m) {
        const int it = ai * 4 + m;
        const int r = u.pm * 256 + ai * 128 + wr * 64 + m * 16 + fr, b = r >> 11;
        if (it < 7) {
          const int rn = u.pm * 256 + ((it + 1) >> 2) * 128 + wr * 64 + ((it + 1) & 3) * 16 + fr;
#pragma unroll
          for (int q = 0; q < 4; ++q) xq[(it + 1) & 1][q] = *(const float4*)(xin + (size_t)rn * 1024 + cbase + (q >> 1) * 128 + (q & 1) * 16);
        }
        float ss = 0.f;
#pragma unroll
        for (int bj = 0; bj < 2; ++bj)
#pragma unroll
          for (int n = 0; n < 2; ++n) {
            const int c0 = u.pn * 256 + bj * 128 + wc * 32 + n * 16 + fq * 4;
            const float4 xv = xq[it & 1][bj * 2 + n];
            const float4 g = *(const float4*)(mod + (size_t)b * 6144 + c0);
            const f32x4 a = acc[ai][bj][m][n];
            float4 ov = {xv.x + g.x * a[0], xv.y + g.y * a[1], xv.z + g.z * a[2], xv.w + g.w * a[3]};
            ss += ov.x * ov.x + ov.y * ov.y + ov.z * ov.z + ov.w * ov.w;
            *(float4*)(xout + (size_t)r * 1024 + c0) = ov;
          }
        ss += __shfl_xor(ss, 16); ss += __shfl_xor(ss, 32);
        if (fq == 0) rowss[(size_t)r * 16 + u.pn * 4 + wc] = ss;
      }
  });
}

struct RowsP7 { LAS const int* tab; DI unsigned operator()(const t8::Unit& u, int row) const { const int slot = tab[u.tab * 256 + row]; const int tok = slot < 0 ? 0 : (slot >= T_ * 8 ? slot - T_ * 8 : slot >> 3); return (unsigned)tok * 2048u; } };
struct RowsP8 { LAS const int* tab; DI unsigned operator()(const t8::Unit& u, int row) const { const int slot = tab[u.tab * 256 + row]; return (unsigned)(slot < 0 ? 0 : slot) * 512u; } };

DI void phase_p7(const P& p, LAS unsigned char* lds, int l, int G, int bid) {
  int total; const int c = xcd_vb(bid, G);
  moe_prepare(p, lds, l, 2, G, c, total);
  t8::MoeSched S{(LAS const int*)(lds + t8::START_OFF), 2, total, G, c, (const unsigned char*)p.wgu_t(), (const unsigned char*)p.wsg_t(), (size_t)512 * 1024 * 2, (size_t)256 * 1024 * 2};
  RowsP7 RO{(LAS const int*)(lds + t8::TAB_OFF)};
  LAS const int* tab = (LAS const int*)(lds + t8::TAB_OFF);
  bf16_t* act = p.act();
  t8::gemm_phase<true>(lds, (const unsigned char*)p.h(), 1024, S, RO, [=](const f32x4 (&acc)[2][2][4][2], const t8::Unit& u, int wr, int wc, int fr, int fq) {
#pragma unroll
    for (int ai = 0; ai < 2; ++ai)
#pragma unroll
      for (int m = 0; m < 4; ++m) {
        const int slot = tab[u.tab * 256 + ai * 128 + wr * 64 + m * 16 + fr];
        if (slot >= 0) {
          const f32x4 g0 = acc[ai][0][m][0], g1 = acc[ai][0][m][1], u0 = acc[ai][1][m][0], u1 = acc[ai][1][m][1];
          u32x4 o;
          o.x = pack2(silu_f(g0[0]) * u0[0], silu_f(g0[1]) * u0[1]); o.y = pack2(silu_f(g0[2]) * u0[2], silu_f(g0[3]) * u0[3]);
          o.z = pack2(silu_f(g1[0]) * u1[0], silu_f(g1[1]) * u1[1]); o.w = pack2(silu_f(g1[2]) * u1[2], silu_f(g1[3]) * u1[3]);
          *(u32x4*)(act + (size_t)slot * 256 + u.pn * 128 + wc * 32 + fq * 8) = o;
        }
        asm volatile("" ::: "memory");
      }
  });
}

DI void phase_p8(const P& p, LAS unsigned char* lds, int l, int G, int bid) {
  int total; const int c = xcd_vb(bid, G);
  moe_prepare(p, lds, l, 4, G, c, total);
  t8::MoeSched S{(LAS const int*)(lds + t8::START_OFF), 4, total, G, c, (const unsigned char*)p.wd_t(), (const unsigned char*)p.wsd_t(), (size_t)1024 * 256 * 2, (size_t)256 * 256 * 2};
  RowsP8 RO{(LAS const int*)(lds + t8::TAB_OFF)};
  LAS const int* tab = (LAS const int*)(lds + t8::TAB_OFF);
  bf16_t* yrows = p.yrows(); bf16_t* ysh = p.ysh(); const float* topw = p.topw();
  t8::gemm_phase<true>(lds, (const unsigned char*)p.act(), 256, S, RO, [=](const f32x4 (&acc)[2][2][4][2], const t8::Unit& u, int wr, int wc, int fr, int fq) {
    int slots[2][4]; float wvs[2][4];
#pragma unroll
    for (int ai = 0; ai < 2; ++ai)
#pragma unroll
      for (int m = 0; m < 4; ++m) slots[ai][m] = tab[u.tab * 256 + ai * 128 + wr * 64 + m * 16 + fr];
#pragma unroll
    for (int ai = 0; ai < 2; ++ai)
#pragma unroll
      for (int m = 0; m < 4; ++m) wvs[ai][m] = (slots[ai][m] < 0 || slots[ai][m] >= T_ * 8) ? 1.f : topw[slots[ai][m]];
#pragma unroll
    for (int ai = 0; ai < 2; ++ai)
#pragma unroll
      for (int m = 0; m < 4; ++m) {
        const int slot = slots[ai][m];
        if (slot >= 0) {
          const bool shared = slot >= T_ * 8;
          const float wv = wvs[ai][m];
          bf16_t* dst = (shared ? ysh + (size_t)(slot - T_ * 8) * 1024 : yrows + (size_t)slot * 1024) + u.pn * 256 + wc * 32 + fq * 8;
#pragma unroll
          for (int bj = 0; bj < 2; ++bj) {
            const f32x4 v0 = acc[ai][bj][m][0] * wv, v1 = acc[ai][bj][m][1] * wv;
            u32x4 o; o.x = pack2(v0[0], v0[1]); o.y = pack2(v0[2], v0[3]); o.z = pack2(v1[0], v1[1]); o.w = pack2(v1[2], v1[3]);
            *(u32x4*)(dst + bj * 128) = o;
          }
        }
        asm volatile("" ::: "memory");
      }
  });
}

constexpr int HALF_LDS = SMEM_MAIN + SMEM_EXTRA;
#define PHASE_LOOP(n, ...) for (int base_ = 2 * bid; base_ < (n); base_ += 2 * G) { int it = base_ + half; it = it < (n) ? it : (n) - 1; __VA_ARGS__ }
__global__ void __launch_bounds__(BLOCK_THREADS, 2) fwd_megakernel(P p) {
  __shared__ __attribute__((aligned(16))) unsigned char smem_all[t8::STAGE_BYTES + 16384 + 16];
  const int G = gridDim.x, bid = blockIdx.x;
  const int half = __builtin_amdgcn_readfirstlane((int)(threadIdx.x >> 8));
  unsigned char* smem = smem_all + half * HALF_LDS;
  volatile LAS unsigned* stw = (volatile LAS unsigned*)(smem_all + t8::STAGE_BYTES + 16384);
  LAS unsigned char* lds8 = (LAS unsigned char*)smem_all;
  if (threadIdx.x == 0) { stw[0] = 0u; stw[1] = 0u; }
  __syncthreads();
  XcdBarrier bar = xcd_barrier_post(p.bar(), stw);

  PHASE_LOOP(192 + 1024 + MISC_ITEMS + CONV_ITEMS,
    if (it < 192) item_mod(p, smem, it);
    else if (it < 192 + 1024) item_rope(p, it - 192);
    else if (it < 192 + 1024 + MISC_ITEMS) item_misc(p, it - 192 - 1024);
    else item_conv(p, smem, 0, it - 192 - 1024 - MISC_ITEMS);
  )
  xcd_barrier(bar);
  PHASE_LOOP(T_ / 4, item_norm0(p, it);)
  xcd_barrier(bar);

  for (int l = 0; l < 2; ++l) {
    phase_p1(p, lds8, G, bid);
    xcd_barrier(bar);
    PHASE_LOOP(128 + 512 + 768 + 1024,
      if (it < 128) item_sgu(p, smem, l, it);
      else if (it < 640) item_pool(p, smem, l, it - 128);
      else if (it < 1408) item_qproj(p, smem, it - 640);
      else item_kvproj(p, smem, it - 1408);
    )
    xcd_barrier(bar);
    PHASE_LOOP(1024, item_attn(p, smem, it);)
    xcd_barrier(bar);
    phase_p4(p, lds8, l, G, bid);
    xcd_barrier(bar);
    PHASE_LOOP(256, item_p5(p, smem, l, it);)
    xcd_barrier(bar);
    phase_p7(p, lds8, l, G, bid);
    xcd_barrier(bar);
    phase_p8(p, lds8, l, G, bid);
    xcd_barrier(bar);
    const int n9 = T_ / 4 + (l == 0 ? CONV_ITEMS : 0);
    PHASE_LOOP(n9,
      if (it < T_ / 4) item_p9(p, l, it);
      else item_conv(p, smem, 1, it - T_ / 4);
    )
    if (l == 0) xcd_barrier(bar);
  }
}

extern "C" void kernel_launch(void* const* d_in, const int* in_sizes, int n_in, void* d_out, int out_size, void* d_ws, size_t ws_size,
                              hipStream_t stream) {
  P p{};
  p.x = (const float*)d_in[0]; p.c = (const float*)d_in[1]; p.pos = (const int*)d_in[2];
  p.w_ada = (const float*)d_in[3]; p.b_ada = (const float*)d_in[4]; p.w_in = (const float*)d_in[5]; p.w_pool = (const float*)d_in[6];
  p.pool_scale = (const float*)d_in[7]; p.w_spatial = (const float*)d_in[8]; p.b_spatial = (const float*)d_in[9]; p.g_q = (const float*)d_in[10];
  p.w_uq = (const float*)d_in[11]; p.g_kv = (const float*)d_in[12]; p.w_ukv = (const float*)d_in[13]; p.w_out = (const float*)d_in[14];
  p.w_router = (const float*)d_in[15]; p.router_bias = (const float*)d_in[16]; p.w_gate = (const float*)d_in[17]; p.w_up = (const float*)d_in[18];
  p.w_down = (const float*)d_in[19]; p.ws_gate = (const float*)d_in[20]; p.ws_up = (const float*)d_in[21]; p.ws_down = (const float*)d_in[22];
  p.final_gain = (const float*)d_in[23];
  p.out = (float*)d_out;
  p.ws = (unsigned char*)d_ws;
  if (WS_NEED > ws_size) { fprintf(stderr, "workspace too small: need %zu have %zu\n", WS_NEED, ws_size); return; }
  hipMemsetAsync(p.ws + O_BAR, 0, CTRL_BYTES, stream);
  static int grid_blocks = 0;
  if (!grid_blocks) {
    int dev = 0, cus = 0, per_cu = 0;
    hipGetDevice(&dev);
    hipDeviceGetAttribute(&cus, hipDeviceAttributeMultiprocessorCount, dev);
    hipOccupancyMaxActiveBlocksPerMultiprocessor(&per_cu, fwd_megakernel, BLOCK_THREADS, 0);
    if (per_cu > 1) per_cu = 1;
    if (per_cu < 1) per_cu = 1;
    grid_blocks = cus * per_cu;
  }
  void* args[] = {&p};
  hipError_t e = hipLaunchCooperativeKernel((void*)fwd_megakernel, dim3(grid_blocks), dim3(BLOCK_THREADS), args, 0, stream);
  if (e != hipSuccess) fprintf(stderr, "cooperative launch failed: %s (grid %d)\n", hipGetErrorString(e), grid_blocks);
}
```

```cpp
#include <hip/hip_runtime.h>
#include <stdint.h>
#include <cstdio>

#define DI __device__ __forceinline__
#define LAS __attribute__((address_space(3)))

typedef unsigned short bf16_t;
typedef short bf16x8 __attribute__((ext_vector_type(8)));
typedef short s16x4 __attribute__((ext_vector_type(4)));
typedef float f32x4 __attribute__((ext_vector_type(4)));
typedef float f32x2 __attribute__((ext_vector_type(2)));
typedef unsigned u32x4 __attribute__((ext_vector_type(4)));
typedef unsigned u32x2 __attribute__((ext_vector_type(2)));
typedef __bf16 bf16x2_t __attribute__((ext_vector_type(2)));

constexpr int T_ = 16384, D_ = 1024, S_ = 2048, NIN = 1184;
constexpr int NTHREADS = 256;
constexpr int BLOCK_THREADS = 512;
constexpr int SMEM_MAIN = 65536, SMEM_EXTRA = 2048;
constexpr float EPS = 1e-6f;
constexpr int CSTRIDE = 64;
constexpr int LISTCAP = 16384;
constexpr int CONV_ITEMS = 592 + 24 + 16 + 128 + 96 + 6144;

constexpr size_t al256(size_t x) { return (x + 255) & ~(size_t)255; }
constexpr size_t CTRL_BYTES = (size_t)3456 * 4 + (size_t)2 * 64 * CSTRIDE * 4;
constexpr size_t O_BAR = 0;
constexpr size_t O_MOD = O_BAR + al256(CTRL_BYTES);
constexpr size_t O_ROPEC = O_MOD + al256((size_t)2 * 8 * 6144 * 4);
constexpr size_t O_ROPES = O_ROPEC + al256((size_t)T_ * 16 * 4);
constexpr size_t O_WIN = O_ROPES + al256((size_t)T_ * 16 * 4);
constexpr size_t O_WUQ = O_WIN + al256((size_t)1280 * 1024 * 2);
constexpr size_t O_WUKV = O_WUQ + al256((size_t)768 * 256 * 2);
constexpr size_t O_WOUT = O_WUKV + al256((size_t)1024 * 128 * 2);
constexpr size_t O_WSG = O_WOUT + al256((size_t)1024 * 1024 * 2);
constexpr size_t O_WSD = O_WSG + al256((size_t)512 * 1024 * 2);
constexpr size_t O_WSP = O_WSD + al256((size_t)1024 * 256 * 2);
constexpr size_t O_WPOOL = O_WSP + al256((size_t)2 * 4 * 128 * 128 * 2);
constexpr size_t O_WRHI = O_WPOOL + al256((size_t)2 * 4 * 64 * 64 * 2);
constexpr size_t O_WRLO = O_WRHI + al256((size_t)2 * 64 * 1024 * 2);
constexpr size_t O_WGU = O_WRLO + al256((size_t)2 * 64 * 1024 * 2);
constexpr size_t O_WD = O_WGU + al256((size_t)64 * 512 * 1024 * 2);
constexpr size_t O_H = O_WD + al256((size_t)64 * 1024 * 256 * 2);
constexpr size_t O_ACT = O_H + al256((size_t)T_ * 1024 * 2);
constexpr size_t O_YSH = O_ACT + al256((size_t)(T_ * 8 + T_) * 256 * 2);
constexpr size_t O_LIST = O_YSH + al256((size_t)T_ * 1024 * 2);
constexpr size_t O_TOPW = O_LIST + al256((size_t)64 * LISTCAP * 4);
constexpr size_t O_ROWSS = O_TOPW + al256((size_t)T_ * 8 * 4);
constexpr size_t O_BIG = O_ROWSS + al256((size_t)T_ * 16 * 4);
constexpr size_t O_YROWS = O_BIG;
constexpr size_t O_PROJ = O_BIG;
constexpr size_t O_Q = O_PROJ + al256((size_t)T_ * NIN * 2);
constexpr size_t O_KB = O_Q + al256((size_t)T_ * 8 * 96 * 2);
constexpr size_t O_V = O_KB + al256((size_t)T_ * 8 * 96 * 2);
constexpr size_t O_Y = O_V + al256((size_t)T_ * 8 * 64 * 2);
constexpr size_t WS_NEED = O_BIG + al256((size_t)T_ * 8 * 1024 * 2);

struct P {
  const float *x, *c; const int* pos;
  const float *w_ada, *b_ada, *w_in, *w_pool, *pool_scale, *w_spatial, *b_spatial, *g_q, *w_uq, *g_kv, *w_ukv, *w_out,
      *w_router, *router_bias, *w_gate, *w_up, *w_down, *ws_gate, *ws_up, *ws_down, *final_gain;
  float* out;
  unsigned char* ws;
  DI unsigned* bar() const { return (unsigned*)(ws + O_BAR); }
  DI int* cnt() const { return (int*)(ws + O_BAR) + 3456; }
  DI float* mod() const { return (float*)(ws + O_MOD); }
  DI float* ropec() const { return (float*)(ws + O_ROPEC); }
  DI float* ropes() const { return (float*)(ws + O_ROPES); }
  DI bf16_t* win_t() const { return (bf16_t*)(ws + O_WIN); }
  DI bf16_t* wuq_t() const { return (bf16_t*)(ws + O_WUQ); }
  DI bf16_t* wukv_t() const { return (bf16_t*)(ws + O_WUKV); }
  DI bf16_t* wout_t() const { return (bf16_t*)(ws + O_WOUT); }
  DI bf16_t* wsg_t() const { return (bf16_t*)(ws + O_WSG); }
  DI bf16_t* wsd_t() const { return (bf16_t*)(ws + O_WSD); }
  DI bf16_t* wsp_b() const { return (bf16_t*)(ws + O_WSP); }
  DI bf16_t* wpool_t() const { return (bf16_t*)(ws + O_WPOOL); }
  DI bf16_t* wr_hi() const { return (bf16_t*)(ws + O_WRHI); }
  DI bf16_t* wr_lo() const { return (bf16_t*)(ws + O_WRLO); }
  DI bf16_t* wgu_t() const { return (bf16_t*)(ws + O_WGU); }
  DI bf16_t* wd_t() const { return (bf16_t*)(ws + O_WD); }
  DI bf16_t* h() const { return (bf16_t*)(ws + O_H); }
  DI bf16_t* act() const { return (bf16_t*)(ws + O_ACT); }
  DI bf16_t* ysh() const { return (bf16_t*)(ws + O_YSH); }
  DI int* list() const { return (int*)(ws + O_LIST); }
  DI float* topw() const { return (float*)(ws + O_TOPW); }
  DI float* rowss() const { return (float*)(ws + O_ROWSS); }
  DI bf16_t* yrows() const { return (bf16_t*)(ws + O_YROWS); }
  DI bf16_t* proj() const { return (bf16_t*)(ws + O_PROJ); }
  DI bf16_t* Q() const { return (bf16_t*)(ws + O_Q); }
  DI bf16_t* Kb() const { return (bf16_t*)(ws + O_KB); }
  DI bf16_t* V() const { return (bf16_t*)(ws + O_V); }
  DI bf16_t* Y() const { return (bf16_t*)(ws + O_Y); }
};

DI unsigned pack2(float lo, float hi) { f32x2 f = {lo, hi}; bf16x2_t b = __builtin_convertvector(f, bf16x2_t); return __builtin_bit_cast(unsigned, b); }
DI float bf2f(unsigned short b) { return __uint_as_float(((unsigned)b) << 16); }
DI float bflo(unsigned u) { return __uint_as_float(u << 16); }
DI float bfhi(unsigned u) { return __uint_as_float(u & 0xffff0000u); }
DI int otid() { int t = threadIdx.x & 255; asm volatile("" : "+v"(t)); return t; }
constexpr float YSCALE = 16.f;
DI unsigned pack4_fp8(f32x4 v) {
  const float a = __builtin_amdgcn_fmed3f(v[0], -448.f, 448.f), b = __builtin_amdgcn_fmed3f(v[1], -448.f, 448.f), c = __builtin_amdgcn_fmed3f(v[2], -448.f, 448.f), d = __builtin_amdgcn_fmed3f(v[3], -448.f, 448.f);
  int w = 0; w = __builtin_amdgcn_cvt_pk_fp8_f32(a, b, w, false); w = __builtin_amdgcn_cvt_pk_fp8_f32(c, d, w, true); return (unsigned)w;
}
DI float wsum(float v) { for (int o = 32; o; o >>= 1) v += __shfl_xor(v, o); return v; }
DI float silu_f(float x) { return x / (1.f + __expf(-x)); }
DI float gelu_tanh(float x) { float z = 0.7978845608028654f * (x + 0.044715f * x * x * x); float e = __expf(2.f * z); float t = 1.f - 2.f / (1.f + e); return 0.5f * x * (1.f + t); }

#define XB_TMO      128
#define XB_XCNT(j)  (256  + 64 * (j))
#define XB_XSUB(j)  (1280 + 64 * (j))
#define XB_XGEN(j)  (2304 + 64 * (j))
#define XB_TOP      3328
#define XB_TOPGEN   3392
#define XCD_BAR_WORDS 3456
#define XB_SPIN_CAP (1u << 20)
DI unsigned xb_ld(unsigned* p) { return __hip_atomic_load(p, __ATOMIC_RELAXED, __HIP_MEMORY_SCOPE_AGENT); }
DI unsigned xb_add(unsigned* p, unsigned v) { return __hip_atomic_fetch_add(p, v, __ATOMIC_RELAXED, __HIP_MEMORY_SCOPE_AGENT); }
DI unsigned xb_xcc_id() { return (unsigned)__builtin_amdgcn_s_getreg((3 << 11) | 20) & 0xFu; }
#define XB_SPIN(cond, bar) do { unsigned _sp = 0; while (cond) { __builtin_amdgcn_s_sleep(1); \
    if ((++_sp & 255u) == 0u) { if (xb_ld(&(bar)[XB_TMO])) break; if (_sp > XB_SPIN_CAP) { atomicAdd(&(bar)[XB_TMO], 1u); break; } } } } while (0)
struct XcdBarrier { unsigned* bar; unsigned x; volatile LAS unsigned* st; };
DI XcdBarrier xcd_barrier_post(unsigned* bar, volatile LAS unsigned* st) {
  XcdBarrier b; b.bar = bar; b.x = xb_xcc_id(); b.st = st;
  if (threadIdx.x == 0) (void)xb_add(&bar[XB_XCNT(b.x)], 1u);
  return b;
}
DI void xcd_barrier_complete(unsigned* bar, unsigned x, unsigned& nloc, unsigned& nx) {
  const unsigned G = gridDim.x * gridDim.y * gridDim.z;
  unsigned sum, cnt, mine, sp = 0u;
  for (;;) {
    sum = 0u; cnt = 0u; mine = 0u;
#pragma unroll
    for (unsigned j = 0; j < 16; ++j) { const unsigned c = xb_ld(&bar[XB_XCNT(j)]); sum += c; cnt += (c > 0u) ? 1u : 0u; mine = (j == x) ? c : mine; }
    if (sum == G) break;
    __builtin_amdgcn_s_sleep(1);
    if ((++sp & 255u) == 0u) { if (xb_ld(&bar[XB_TMO])) break; if (sp > XB_SPIN_CAP) { atomicAdd(&bar[XB_TMO], 1u); break; } }
  }
  nloc = mine > 0u ? mine : 1u; nx = cnt > 0u ? cnt : 1u;
}
DI void xcd_barrier(const XcdBarrier& b0) {
  XcdBarrier b = b0; b.x = xb_xcc_id();
  asm volatile("s_waitcnt vmcnt(0)" ::: "memory");
  __syncthreads();
  if (threadIdx.x == 0) {
    unsigned* bar = b.bar;
    __builtin_amdgcn_s_waitcnt(0);
    unsigned nloc = b.st[0], nx = b.st[1];
    if (nloc == 0u) { xcd_barrier_complete(bar, b.x, nloc, nx); b.st[0] = nloc; b.st[1] = nx; }
    const unsigned old = xb_add(&bar[XB_XSUB(b.x)], 1u);
    const unsigned gen = old / nloc;
    if (old + 1u == (gen + 1u) * nloc) {
      __builtin_amdgcn_fence(__ATOMIC_RELEASE, "agent");
      asm volatile("s_waitcnt vmcnt(0)" ::: "memory");
      const unsigned og = xb_add(&bar[XB_TOP], 1u);
      const unsigned tg = og / nx;
      if (og + 1u == (tg + 1u) * nx) xb_add(&bar[XB_TOPGEN], 1u);
      else XB_SPIN(xb_ld(&bar[XB_TOPGEN]) == tg, bar);
      __builtin_amdgcn_fence(__ATOMIC_ACQUIRE, "agent");
      xb_add(&bar[XB_XGEN(b.x)], 1u);
      asm volatile("s_waitcnt vmcnt(0)" ::: "memory");
    } else {
      XB_SPIN(xb_ld(&bar[XB_XGEN(b.x)]) == gen, bar);
      __builtin_amdgcn_fence(__ATOMIC_ACQUIRE, "agent");
      asm volatile("s_waitcnt vmcnt(0)" ::: "memory");
    }
  }
  __syncthreads();
}


template <int RB> DI void ot_put(unsigned char* base, int row, int unit, u32x2 v) { *(u32x2*)(base + row * RB + ((unit ^ (row & 15)) << 3)) = v; }
template <int RB> DI u32x4 ot_get(const unsigned char* base, int row, int chunk) {
  const u32x4 v = *(const u32x4*)(base + row * RB + ((chunk ^ ((row & 15) >> 1)) << 4));
  return (row & 1) ? (u32x4){v.z, v.w, v.x, v.y} : v;
}

template <class Epi>
DI void gemm128_stream(unsigned char* smem, const unsigned char* abase, const unsigned (&ao)[4], const unsigned char* bbase, const unsigned (&bo)[4], int nk, int ntile, size_t btile_stride, Epi&& epi) {
  const int tid = otid(), lane = tid & 63, w = tid >> 6;
  const int wm = w >> 1, wn = w & 1;
  const int r_s = tid >> 3, c_s = tid & 7;
  const int st_off = r_s * 128 + ((c_s ^ (r_s & 7)) << 4);
  const int fr = lane & 15, fq = lane >> 4;
  const int sw0 = ((0 + fq) ^ (fr & 7)) << 4, sw1 = ((4 + fq) ^ (fr & 7)) << 4;
  const int arow_off = (wm * 64 + fr) * 128, brow_off = 32768 + (wn * 64 + fr) * 128;
  u32x4 ra0[4], rb0[4], ra1[4], rb1[4];
  f32x4 acc[4][4];
#pragma unroll
  for (int i = 0; i < 4; ++i)
#pragma unroll
    for (int j = 0; j < 4; ++j) acc[i][j] = (f32x4){0.f, 0.f, 0.f, 0.f};
  const int total = nk * ntile;
  int lkt = 0, ltl = 0;
  auto load = [&](u32x4 (&ra)[4], u32x4 (&rb)[4]) {
    const unsigned char* ab = abase + lkt * 128;
    const unsigned char* bb = bbase + ((size_t)ltl * btile_stride + lkt * 64) * 2;
#pragma unroll
    for (int j = 0; j < 4; ++j) { ra[j] = *(const u32x4*)(ab + ao[j]); rb[j] = *(const u32x4*)(bb + bo[j]); }
    const bool last = (lkt == nk - 1) && (ltl == ntile - 1);
    const int nl = (lkt == nk - 1) ? 0 : lkt + 1;
    ltl = last ? ltl : ((lkt == nk - 1) ? ltl + 1 : ltl);
    lkt = last ? lkt : nl;
  };
  auto store = [&](const u32x4 (&ra)[4], const u32x4 (&rb)[4], int bufo) {
#pragma unroll
    for (int j = 0; j < 4; ++j) { *(u32x4*)(smem + bufo + st_off + j * 4096) = ra[j]; *(u32x4*)(smem + 32768 + bufo + st_off + j * 4096) = rb[j]; }
  };
  int kt = 0, tile = 0;
  auto body = [&](int s, int cur, u32x4 (&lra)[4], u32x4 (&lrb)[4], const u32x4 (&wra)[4], const u32x4 (&wrb)[4]) {
    load(lra, lrb);
#pragma unroll
    for (int ks = 0; ks < 2; ++ks) {
      const int sw = ks ? sw1 : sw0;
      bf16x8 af[4], bfr[4];
#pragma unroll
      for (int i = 0; i < 4; ++i) af[i] = *(const bf16x8*)(smem + cur + arow_off + i * 2048 + sw);
#pragma unroll
      for (int j = 0; j < 4; ++j) bfr[j] = *(const bf16x8*)(smem + cur + brow_off + j * 2048 + sw);
#pragma unroll
      for (int i = 0; i < 4; ++i)
#pragma unroll
        for (int j = 0; j < 4; ++j) acc[i][j] = __builtin_amdgcn_mfma_f32_16x16x32_bf16(bfr[j], af[i], acc[i][j], 0, 0, 0);
    }
    if (s + 1 < total) store(wra, wrb, 16384 - cur);
    if (kt == nk - 1) {
      int wm2 = wm, wn2 = wn, fr2 = fr, fq2 = fq;
      asm volatile("" : "+v"(wm2), "+v"(wn2), "+v"(fr2), "+v"(fq2));
      epi(acc, tile, cur, wm2, wn2, fr2, fq2);
#pragma unroll
      for (int i = 0; i < 4; ++i)
#pragma unroll
        for (int j = 0; j < 4; ++j) acc[i][j] = (f32x4){0.f, 0.f, 0.f, 0.f};
    }
    __syncthreads();
    if (++kt == nk) { kt = 0; ++tile; }
  };
  load(ra0, rb0);
  load(ra1, rb1);
  store(ra0, rb0, 0);
  __syncthreads();
  for (int s = 0; s < total; s += 2) {
    body(s, 0, ra0, rb0, ra1, rb1);
    if (s + 1 >= total) break;
    body(s + 1, 16384, ra1, rb1, ra0, rb0);
  }
}
template <class Epi>
DI void gemm128(unsigned char* smem, const unsigned char* abase, const unsigned (&ao)[4], const unsigned char* bbase, const unsigned (&bo)[4], int nk, Epi&& epi) {
  gemm128_stream(smem, abase, ao, bbase, bo, nk, 1, 0, [&](f32x4 (&acc)[4][4], int, int, int wm, int wn, int fr, int fq) { __syncthreads(); epi(acc, wm, wn, fr, fq); });
}


namespace t8 {
constexpr int BM = 256, BK = 64, HALF = 128, HTB = HALF * BK * 2, STAGE_BYTES = 8 * HTB;
DI int lds_byte(int r, int c) { const int st = (r >> 4) * 2 + (c >> 5), rr = r & 15, cc = c & 31, ob = rr * 64 + cc * 2; return st * 1024 + (ob ^ (((ob >> 9) & 1) << 5)); }
DI void stage_rc(int b, int& R, int& C) { const int st = b / 1024, sb = b % 1024, swz = sb ^ (((sb >> 9) & 1) << 5); R = (st >> 1) * 16 + swz / 64; C = (st & 1) * 32 + (swz % 64) / 2; }
DI int perm32(int rho) { const int n = rho >> 4, i = rho & 15; return 8 * (i >> 2) + 4 * n + (i & 3); }
struct Unit { int pm, pn, tab; const unsigned char* bbase; };
constexpr int TAB_OFF = STAGE_BYTES;
constexpr int START_OFF = STAGE_BYTES + 12288;

template <bool PERM, class Sched, class RowOff, class Epi>
DI void gemm_phase(LAS unsigned char* lds, const unsigned char* Abase, const int K, const Sched& S, const RowOff& RO, const Epi& E) {
  int tid = threadIdx.x; asm volatile("" : "+v"(tid));
  const int wid = __builtin_amdgcn_readfirstlane(tid >> 6), lane = tid & 63, wr = wid >> 2, wc = wid & 3, fr = lane & 15, fq = lane >> 4;
  const int nt = K / BK;
  unsigned voffB[2][2];
#pragma unroll
  for (int h = 0; h < 2; ++h)
#pragma unroll
    for (int i = 0; i < 2; ++i) { int R, C; stage_rc(tid * 16 + i * 8192, R, C); const int rho = h * HALF + R;
      const int Rb = PERM ? (((rho >> 5) & 3) * 64 + ((rho >> 2) & 3) * 16 + (rho >> 7) * 8 + ((rho >> 4) & 1) * 4 + (rho & 3)) : rho; voffB[h][i] = (unsigned)(Rb * K + C) * 2u; }
  auto apiece = [&](const Unit& u, int h, int i) -> unsigned { int R, C; stage_rc(tid * 16 + i * 8192, R, C); return RO(u, h * HALF + R) + (unsigned)(C * 2); };
  const size_t kstep = (size_t)(BK * 2);
  const unsigned ldsw = (unsigned)wid * 1024u;
  const int aoff = lds_byte(wr * 64 + fr, fq * 8), boff = lds_byte(wc * 32 + fr, fq * 8);
  LAS const unsigned char* ldsA = lds + aoff; LAS const unsigned char* ldsB = lds + 4 * HTB + boff;
  asm volatile("" : "+v"(ldsA), "+v"(ldsB));
#define T8_SA(b, h) (((b) * 2 + (h)) * HTB)
#define T8_SB(b, h) ((4 + (b) * 2 + (h)) * HTB)
#define T8_STAGE(bufoff, gbase, voff) do { _Pragma("unroll") for (int _i = 0; _i < 2; ++_i) \
    __builtin_amdgcn_global_load_lds((const unsigned*)((const char*)(gbase) + (voff)[_i]), (LAS unsigned*)(lds + (bufoff) + ldsw + _i * 8192), 16, 0, 0); } while (0)
#define T8_LDA(dst, b, h) do { _Pragma("unroll") for (int m = 0; m < 4; ++m) _Pragma("unroll") for (int k = 0; k < 2; ++k) dst[m][k] = *(const LAS bf16x8*)(ldsA + T8_SA(b, h) + m * 2048 + k * 1024); } while (0)
#define T8_LDB(dst, b, h) do { _Pragma("unroll") for (int n = 0; n < 2; ++n) _Pragma("unroll") for (int k = 0; k < 2; ++k) dst[n][k] = *(const LAS bf16x8*)(ldsB + (T8_SB(b, h) - 4 * HTB) + n * 2048 + k * 1024); } while (0)
#define T8_MMA(ai, bj, At, Bt) do { __builtin_amdgcn_s_setprio(1); _Pragma("unroll") for (int m = 0; m < 4; ++m) _Pragma("unroll") for (int n = 0; n < 2; ++n) _Pragma("unroll") for (int k = 0; k < 2; ++k) \
    acc[ai][bj][m][n] = __builtin_amdgcn_mfma_f32_16x16x32_bf16(Bt[n][k], At[m][k], acc[ai][bj][m][n], 0, 0, 0); __builtin_amdgcn_s_setprio(0); } while (0)
#define T8_WAIT_V(n) asm volatile("s_waitcnt vmcnt(" #n ")" ::: "memory")
#define T8_WAIT_L(n) asm volatile("s_waitcnt lgkmcnt(" #n ")" ::: "memory")
#define T8_BAR __builtin_amdgcn_s_barrier()
#define T8_SCHED __builtin_amdgcn_sched_barrier(0)
  Unit cur, nxt; int ui = 0;
  if (!S.next(0, cur)) return;
  f32x4 acc[2][2][4][2];
#pragma unroll
  for (int a = 0; a < 2; ++a)
#pragma unroll
    for (int b = 0; b < 2; ++b)
#pragma unroll
      for (int m = 0; m < 4; ++m)
#pragma unroll
        for (int n = 0; n < 2; ++n) acc[a][b][m][n] = (f32x4){0.f, 0.f, 0.f, 0.f};
  bf16x8 At[4][2], B0[2][2], B1[2][2];
  unsigned vc[2][2];
#pragma unroll
  for (int h = 0; h < 2; ++h)
#pragma unroll
    for (int i = 0; i < 2; ++i) vc[h][i] = apiece(cur, h, i);
  const char* cB = (const char*)cur.bbase;
  const char* gA = (const char*)Abase;
  T8_STAGE(T8_SB(0, 0), cB, voffB[0]); T8_STAGE(T8_SA(0, 0), gA, vc[0]); T8_STAGE(T8_SB(0, 1), cB, voffB[1]); T8_STAGE(T8_SA(0, 1), gA, vc[1]);
  if (wr == 1) T8_BAR;
  T8_WAIT_V(4); T8_BAR;
  T8_STAGE(T8_SB(1, 0), cB + kstep, voffB[0]); T8_STAGE(T8_SA(1, 0), gA + kstep, vc[0]); T8_STAGE(T8_SB(1, 1), cB + kstep, voffB[1]);
  T8_WAIT_V(6); T8_BAR;
  for (;;) {
    const bool has_next = S.next(ui + 1, nxt);
    const char* nB = has_next ? (const char*)nxt.bbase : cB;
#pragma unroll 1
    for (int t = 0; t < nt; t += 2) {
      const bool last = (t == nt - 2);
      const char* a1 = gA + (size_t)(t + 1) * kstep;
      const char* a2 = last ? gA : gA + (size_t)(t + 2) * kstep; const char* b2 = last ? nB : cB + (size_t)(t + 2) * kstep;
      const char* a3 = a2 + kstep; const char* b3 = b2 + kstep;
      if (last && has_next) { vc[0][0] = apiece(nxt, 0, 0); vc[0][1] = apiece(nxt, 0, 1); }
      T8_LDB(B0, 0, 0); T8_SCHED; T8_LDA(At, 0, 0); T8_STAGE(T8_SA(1, 1), a1, vc[1]);
      T8_WAIT_L(8); T8_BAR; T8_WAIT_L(0); T8_MMA(0, 0, At, B0); T8_BAR; T8_SCHED;
      if (last && has_next) { vc[1][0] = apiece(nxt, 1, 0); vc[1][1] = apiece(nxt, 1, 1); }
      T8_LDB(B1, 0, 1); T8_STAGE(T8_SB(0, 0), b2, voffB[0]);
      T8_BAR; T8_WAIT_L(0); T8_MMA(0, 1, At, B1); T8_BAR;
      T8_LDA(At, 0, 1); T8_STAGE(T8_SA(0, 0), a2, vc[0]);
      T8_BAR; T8_WAIT_L(0); T8_MMA(1, 0, At, B0); T8_BAR; T8_SCHED;
      T8_STAGE(T8_SB(0, 1), b2, voffB[1]);
      T8_WAIT_V(6); T8_BAR; T8_MMA(1, 1, At, B1); T8_BAR;
      T8_LDB(B0, 1, 0); T8_SCHED; T8_LDA(At, 1, 0); T8_STAGE(T8_SA(0, 1), a2, vc[1]);
      T8_WAIT_L(8); T8_BAR; T8_WAIT_L(0); T8_MMA(0, 0, At, B0); T8_BAR; T8_SCHED;
      T8_LDB(B1, 1, 1); T8_STAGE(T8_SB(1, 0), b3, voffB[0]);
      T8_BAR; T8_WAIT_L(0); T8_MMA(0, 1, At, B1); T8_BAR;
      T8_LDA(At, 1, 1); T8_STAGE(T8_SA(1, 0), a3, vc[0]);
      T8_BAR; T8_WAIT_L(0); T8_MMA(1, 0, At, B0); T8_BAR; T8_SCHED;
      T8_STAGE(T8_SB(1, 1), b3, voffB[1]);
      T8_WAIT_V(6); T8_BAR; T8_MMA(1, 1, At, B1); T8_BAR;
    }
    E(acc, cur, wr, wc, fr, fq);
    if (!has_next) break;
#pragma unroll
    for (int a = 0; a < 2; ++a)
#pragma unroll
      for (int b = 0; b < 2; ++b)
#pragma unroll
        for (int m = 0; m < 4; ++m)
#pragma unroll
          for (int n = 0; n < 2; ++n) acc[a][b][m][n] = (f32x4){0.f, 0.f, 0.f, 0.f};
    cur = nxt; cB = nB; ++ui;
  }
  T8_WAIT_V(0);
  if (wr == 0) T8_BAR;
  T8_BAR;
#undef T8_SA
#undef T8_SB
#undef T8_STAGE
#undef T8_LDA
#undef T8_LDB
#undef T8_MMA
#undef T8_WAIT_V
#undef T8_WAIT_L
#undef T8_BAR
#undef T8_SCHED
}

struct DenseSched {
  int nM, nN, nwg, G, c; const unsigned char* Bt; size_t tstep;
  DI void init(int M, int N, int K, int G_, int c_, const void* Bt_) { nM = M / BM; nN = N / BM; nwg = nM * nN; G = G_; c = c_; Bt = (const unsigned char*)Bt_; tstep = (size_t)BM * K * 2; }
  DI bool next(int i, Unit& u) const {
    const long L = (long)i * G + c; if (L >= nwg) return false;
    int wgid = (int)L; { const int q = nwg / 8, r = nwg % 8, xcd = wgid % 8, off = wgid / 8; wgid = (xcd < r ? xcd * (q + 1) : r * (q + 1) + (xcd - r) * q) + off; }
    const int nig = 8 * nN, gid = wgid / nig, fm = gid * 8, gsz = (nM - fm) < 8 ? (nM - fm) : 8;
    u.pm = fm + ((wgid % nig) % gsz); u.pn = (wgid % nig) / gsz; u.tab = 0; u.bbase = Bt + (size_t)u.pn * tstep; return true;
  }
};
struct DenseRows { unsigned rowbytes; DI unsigned operator()(const Unit& u, int row) const { return (unsigned)(u.pm * BM + row) * rowbytes; } };

struct MoeSched {
  LAS const int* start; int npn, nmt, G, c; const unsigned char* wexp; const unsigned char* wsh; size_t estride, tstep;
  DI bool locate(int i, int& mt, int& pn, int& tab) const {
    const int R = nmt / G;
    if (i < R * npn) { const int r = i / npn; pn = i - r * npn; mt = r * G + c; tab = r; return true; }
    const int j = i - R * npn, L = j * G + c, rem = (nmt - R * G) * npn;
    if (L >= rem) return false;
    const int q = L / npn; pn = L - q * npn; mt = R * G + q; tab = R + j; return true;
  }
  DI bool next(int i, Unit& u) const {
    int mt, pn, tab;
    if (!locate(i, mt, pn, tab)) return false;
    u.pm = mt; u.pn = pn; u.tab = tab;
    const int e = __builtin_amdgcn_readfirstlane(start[128 + tab]);
    u.bbase = (e == 64 ? wsh : wexp + (size_t)e * estride) + (size_t)pn * tstep; return true;
  }
};
}

DI void moe_prepare(const P& p, LAS unsigned char* lds, int l, int npn, int G, int c, int& total_units) {
  LAS int* start = (LAS int*)(lds + t8::START_OFF);
  __syncthreads();
  if (threadIdx.x == 0) {
    int s = 0;
    for (int e = 0; e < 64; ++e) { start[e] = s; s += (p.cnt()[(l * 64 + e) * CSTRIDE] + 255) >> 8; }
    start[64] = s; start[65] = s + 64;
  }
  __syncthreads();
  const int nmt = start[65];
  total_units = nmt;
  int tid = threadIdx.x; asm volatile("" : "+v"(tid));
  t8::MoeSched S{start, npn, nmt, G, c, nullptr, nullptr, 0, 0};
  int last_tab = -1;
  for (int i = 0; i < 16; ++i) {
    int mt, pn, tab;
    if (!S.locate(i, mt, pn, tab)) break;
    if (tab == last_tab) continue;
    last_tab = tab;
    int e = 64;
    if (mt < start[64]) {
      e = 0;
#pragma unroll 4
      for (int q = 1; q < 64; ++q) e = (start[q] <= mt) ? q : e;
    }
    if (tid == 0) start[128 + tab] = e;
    if (tid < 256) {
      int slot;
      if (mt >= start[64]) slot = T_ * 8 + (mt - start[64]) * 256 + tid;
      else {
        const int idx = (mt - start[e]) * 256 + tid;
        slot = idx < p.cnt()[(l * 64 + e) * CSTRIDE] ? p.list()[(size_t)e * LISTCAP + idx] : -1;
      }
      ((LAS int*)(lds + t8::TAB_OFF))[tab * 256 + tid] = slot;
    }
  }
  __syncthreads();
}

DI void item_mod(const P& p, unsigned char* smem, int item) {
  const int l = item / 96, cb = item % 96;
  const int tid = otid(), w = tid >> 6, lane = tid & 63;
  float* sc = (float*)smem;
  float* red = (float*)(smem + 32768);
  __syncthreads();
  for (int i = tid; i < 8192; i += NTHREADS) sc[i] = silu_f(p.c[i]);
  __syncthreads();
  const int col = cb * 64 + lane;
  const float* W = p.w_ada + (size_t)l * 1024 * 6144 + col;
  float acc[8];
#pragma unroll
  for (int b = 0; b < 8; ++b) acc[b] = 0.f;
  for (int k0 = w * 256; k0 < w * 256 + 256; k0 += 16) {
    float wv[16];
#pragma unroll
    for (int u = 0; u < 16; ++u) wv[u] = W[(size_t)(k0 + u) * 6144];
#pragma unroll
    for (int u = 0; u < 16; ++u)
#pragma unroll
      for (int b = 0; b < 8; ++b) acc[b] += sc[b * 1024 + k0 + u] * wv[u];
  }
#pragma unroll
  for (int b = 0; b < 8; ++b) red[(w * 8 + b) * 64 + lane] = acc[b];
  __syncthreads();
  for (int o = tid; o < 512; o += NTHREADS) {
    const int b = o >> 6, cc = o & 63;
    const float v = red[(0 * 8 + b) * 64 + cc] + red[(1 * 8 + b) * 64 + cc] + red[(2 * 8 + b) * 64 + cc] + red[(3 * 8 + b) * 64 + cc];
    p.mod()[((size_t)l * 8 + b) * 6144 + cb * 64 + cc] = v + p.b_ada[(size_t)l * 6144 + cb * 64 + cc];
  }
}

DI void conv_tile(unsigned char* smem, const float* src, int ldsrc, int k0, int n0, bf16_t* dst, int lddst, int mode, const float* kscale) {
  float* t = (float*)smem;
  const int tid = otid();
  __syncthreads();
  {
    const int kk = tid >> 3, nq = tid & 7;
#pragma unroll
    for (int hh = 0; hh < 2; ++hh) {
      const int k = kk + 32 * hh;
      const float4 v = *(const float4*)(src + (size_t)(k0 + k) * ldsrc + n0 + nq * 4);
      const float s = kscale ? kscale[k0 + k] : 1.f;
      t[k * 33 + nq * 4 + 0] = v.x * s; t[k * 33 + nq * 4 + 1] = v.y * s; t[k * 33 + nq * 4 + 2] = v.z * s; t[k * 33 + nq * 4 + 3] = v.w * s;
    }
  }
  __syncthreads();
  {
    const int n = tid >> 3, kc = tid & 7;
    u32x4 wv;
    wv.x = pack2(t[(kc * 8 + 0) * 33 + n], t[(kc * 8 + 1) * 33 + n]);
    wv.y = pack2(t[(kc * 8 + 2) * 33 + n], t[(kc * 8 + 3) * 33 + n]);
    wv.z = pack2(t[(kc * 8 + 4) * 33 + n], t[(kc * 8 + 5) * 33 + n]);
    wv.w = pack2(t[(kc * 8 + 6) * 33 + n], t[(kc * 8 + 7) * 33 + n]);
    const int nn = n0 + n;
    const int orow = (mode == 0) ? nn : (256 * (nn >> 7) + 16 * ((nn & 127) >> 3) + (mode == 2 ? 8 : 0) + (nn & 7));
    *(u32x4*)(dst + (size_t)orow * lddst + k0 + kc * 8) = wv;
  }
}

DI void conv_big(unsigned char* smem, const float* src, int ldsrc, int k0, int n0, bf16_t* dst, int lddst, int mode, const float* kscale) {
  float* t = (float*)smem;
  const int tid = otid();
  __syncthreads();
  {
    const int c4 = tid & 31, r0 = tid >> 5;
    float4 v[8];
#pragma unroll
    for (int hh = 0; hh < 8; ++hh) v[hh] = *(const float4*)(src + (size_t)(k0 + r0 + 8 * hh) * ldsrc + n0 + c4 * 4);
#pragma unroll
    for (int hh = 0; hh < 8; ++hh) {
      const int k = r0 + 8 * hh;
      const float sc = kscale ? kscale[k0 + k] : 1.f;
      *(float4*)(t + k * 132 + c4 * 4) = (float4){v[hh].x * sc, v[hh].y * sc, v[hh].z * sc, v[hh].w * sc};
    }
  }
  __syncthreads();
  {
    const int n = tid >> 1, kh = tid & 1;
    const int nn = n0 + n;
    const int orow = (mode == 0) ? nn : (256 * (nn >> 7) + 16 * ((nn & 127) >> 3) + (mode == 2 ? 8 : 0) + (nn & 7));
    bf16_t* d = dst + (size_t)orow * lddst + k0 + kh * 32;
#pragma unroll
    for (int c = 0; c < 4; ++c) {
      const float* tp = t + (kh * 32 + c * 8) * 132 + n;
      u32x4 wv;
      wv.x = pack2(tp[0 * 132], tp[1 * 132]); wv.y = pack2(tp[2 * 132], tp[3 * 132]); wv.z = pack2(tp[4 * 132], tp[5 * 132]); wv.w = pack2(tp[6 * 132], tp[7 * 132]);
      *(u32x4*)(d + c * 8) = wv;
    }
  }
}

DI void item_conv(const P& p, unsigned char* smem, int l, int idx) {
  if (idx < 592) { conv_tile(smem, p.w_in + (size_t)l * 1024 * NIN, NIN, (idx / 37) * 64, (idx % 37) * 32, p.win_t(), 1024, 0, nullptr); return; }
  idx -= 592;
  if (idx < 24) { conv_big(smem, p.w_uq + (size_t)l * 256 * 768, 768, (idx / 6) * 64, (idx % 6) * 128, p.wuq_t(), 256, 0, p.g_q + l * 256); return; }
  idx -= 24;
  if (idx < 16) { conv_big(smem, p.w_ukv + (size_t)l * 128 * 1024, 1024, (idx / 8) * 64, (idx % 8) * 128, p.wukv_t(), 128, 0, p.g_kv + l * 128); return; }
  idx -= 16;
  if (idx < 128) { conv_big(smem, p.w_out + (size_t)l * 1024 * 1024, 1024, (idx / 8) * 64, (idx % 8) * 128, p.wout_t(), 1024, 0, nullptr); return; }
  idx -= 128;
  if (idx < 32) { conv_big(smem, p.ws_gate + (size_t)l * 1024 * 256, 256, (idx / 2) * 64, (idx % 2) * 128, p.wsg_t(), 1024, 1, nullptr); return; }
  idx -= 32;
  if (idx < 32) { conv_big(smem, p.ws_up + (size_t)l * 1024 * 256, 256, (idx / 2) * 64, (idx % 2) * 128, p.wsg_t(), 1024, 2, nullptr); return; }
  idx -= 32;
  if (idx < 32) { conv_big(smem, p.ws_down + (size_t)l * 256 * 1024, 1024, (idx / 8) * 64, (idx % 8) * 128, p.wsd_t(), 256, 0, nullptr); return; }
  idx -= 32;
  const int e = idx / 96, r = idx % 96;
  if (r < 32) conv_big(smem, p.w_gate + ((size_t)l * 64 + e) * 1024 * 256, 256, (r / 2) * 64, (r % 2) * 128, p.wgu_t() + (size_t)e * 512 * 1024, 1024, 1, nullptr);
  else if (r < 64) conv_big(smem, p.w_up + ((size_t)l * 64 + e) * 1024 * 256, 256, ((r - 32) / 2) * 64, ((r - 32) % 2) * 128, p.wgu_t() + (size_t)e * 512 * 1024, 1024, 2, nullptr);
  else conv_big(smem, p.w_down + ((size_t)l * 64 + e) * 256 * 1024, 1024, ((r - 64) / 8) * 64, ((r - 64) % 8) * 128, p.wd_t() + (size_t)e * 1024 * 256, 256, 0, nullptr);
}

constexpr int MISC_ITEMS = 64 + 128 + 512;
DI void item_misc(const P& p, int item) {
  const int tid = otid();
  if (item < 64) {
    const int i = (item * NTHREADS + tid) * 8;
    const int k0 = i & 127, t = (i >> 7) & 127;
    const float4 a = *(const float4*)(p.w_spatial + i), c = *(const float4*)(p.w_spatial + i + 4);
    u32x4 o;
    o.x = pack2(k0 + 0 <= t ? a.x : 0.f, k0 + 1 <= t ? a.y : 0.f); o.y = pack2(k0 + 2 <= t ? a.z : 0.f, k0 + 3 <= t ? a.w : 0.f);
    o.z = pack2(k0 + 4 <= t ? c.x : 0.f, k0 + 5 <= t ? c.y : 0.f); o.w = pack2(k0 + 6 <= t ? c.z : 0.f, k0 + 7 <= t ? c.w : 0.f);
    *(u32x4*)(p.wsp_b() + i) = o;
  } else if (item < 64 + 128) {
    const int i = (item - 64) * NTHREADS + tid;
    const int c = i & 63, dd = (i >> 6) & 63, lg = i >> 12;
    const f32x2 f = {p.w_pool[((size_t)lg * 64 + c) * 64 + dd], 0.f}; const bf16x2_t bb = __builtin_convertvector(f, bf16x2_t);
    p.wpool_t()[i] = (bf16_t)(__builtin_bit_cast(unsigned, bb) & 0xffffu);
  } else {
    const int i = (item - 192) * NTHREADS + tid;
    const int e = i & 63, k = (i >> 6) & 1023, l = i >> 16;
    const float v = p.w_router[i];
    const unsigned hi = pack2(v, 0.f) & 0xffffu;
    const unsigned lo = pack2(v - bflo(hi), 0.f) & 0xffffu;
    p.wr_hi()[(size_t)l * 65536 + e * 1024 + k] = (bf16_t)hi;
    p.wr_lo()[(size_t)l * 65536 + e * 1024 + k] = (bf16_t)lo;
  }
}

DI void item_rope(const P& p, int item) {
  const int i = item * NTHREADS + otid();
  const int t = i >> 4, f = i & 15;
  const float inv = exp2f(-(float)(2 * f) * (13.287712379549449f / 32.f));
  const float ang = (float)p.pos[t] * inv;
  const double rev = (double)ang * 0.15915494309189535;
  const float fr = (float)(rev - floor(rev));
  p.ropec()[i] = __builtin_amdgcn_cosf(fr);
  p.ropes()[i] = __builtin_amdgcn_sinf(fr);
}

DI void item_norm0(const P& p, int item) {
  const int tid = otid(), w = tid >> 6, lane = tid & 63;
  const int t = item * 4 + w, b = t >> 11;
  const float* xr = p.x + (size_t)t * 1024;
  const float* md = p.mod() + (size_t)b * 6144;
  float4 v[4]; float ss = 0.f;
#pragma unroll
  for (int j = 0; j < 4; ++j) { v[j] = *(const float4*)(xr + j * 256 + lane * 4); ss += v[j].x * v[j].x + v[j].y * v[j].y + v[j].z * v[j].z + v[j].w * v[j].w; }
  ss = wsum(ss);
  const float rstd = rsqrtf(ss * (1.f / 1024.f) + EPS);
#pragma unroll
  for (int j = 0; j < 4; ++j) {
    const int idx = j * 256 + lane * 4;
    const float4 sh = *(const float4*)(md + idx), sc = *(const float4*)(md + 1024 + idx);
    u32x2 o;
    o.x = pack2(v[j].x * rstd * (1.f + sc.x) + sh.x, v[j].y * rstd * (1.f + sc.y) + sh.y);
    o.y = pack2(v[j].z * rstd * (1.f + sc.z) + sh.z, v[j].w * rstd * (1.f + sc.w) + sh.w);
    *(u32x2*)(p.h() + (size_t)t * 1024 + idx) = o;
  }
}

DI void item_p1(const P& p, unsigned char* smem, int item) {
  const int m = item / 10, nt = item % 10;
  const int tid = otid(), r_s = tid >> 3, c_s = tid & 7;
  __syncthreads();
  unsigned ao[4], bo[4];
#pragma unroll
  for (int j = 0; j < 4; ++j) {
    const int row = r_s + 32 * j;
    ao[j] = (unsigned)(((m * 128 + row) * 1024 + c_s * 8) * 2);
    int n = nt * 128 + row; n = n < NIN ? n : NIN - 1;
    bo[j] = (unsigned)((n * 1024 + c_s * 8) * 2);
  }
  bf16_t* proj = p.proj();
  gemm128(smem, (const unsigned char*)p.h(), ao, (const unsigned char*)p.win_t(), bo, 16, [=](f32x4 (&acc)[4][4], int wm, int wn, int fr, int fq) {
    unsigned char* ob = smem + wm * 16384;
#pragma unroll
    for (int i = 0; i < 4; ++i)
#pragma unroll
      for (int j = 0; j < 4; ++j) {
        u32x2 o; o.x = pack2(acc[i][j][0], acc[i][j][1]); o.y = pack2(acc[i][j][2], acc[i][j][3]);
        ot_put<256>(ob, i * 16 + fr, wn * 16 + j * 4 + fq, o);
      }
    __syncthreads();
    {
      const int tid2 = fq * 16 + fr + 64 * (wm * 2 + wn);
      const int chunk = tid2 & 15;
      if (nt * 128 + chunk * 8 < NIN) {
#pragma unroll
        for (int i = 0; i < 8; ++i) {
          const int row = (tid2 >> 4) + 16 * i;
          const u32x4 v = ot_get<256>(smem + (row >> 6) * 16384, row & 63, chunk);
          *(u32x4*)(proj + (size_t)(m * 128 + row) * NIN + nt * 128 + chunk * 8) = v;
        }
      }
    }
  });
}

DI void item_qproj(const P& p, unsigned char* smem, int item) {
  const int m = item / 6, nt = item % 6;
  const int tid = otid(), r_s = tid >> 3, c_s = tid & 7;
  float* rowf = (float*)(smem + SMEM_MAIN + 1024);
  __syncthreads();
  {
    const int row = tid >> 1, half = tid & 1;
    const bf16_t* src = p.proj() + (size_t)(m * 128 + row) * NIN + 768 + half * 128;
    float ss = 0.f;
#pragma unroll
    for (int q = 0; q < 16; ++q) {
      const u32x4 v = *(const u32x4*)(src + q * 8);
      ss += bflo(v.x) * bflo(v.x) + bfhi(v.x) * bfhi(v.x) + bflo(v.y) * bflo(v.y) + bfhi(v.y) * bfhi(v.y) + bflo(v.z) * bflo(v.z) + bfhi(v.z) * bfhi(v.z) + bflo(v.w) * bflo(v.w) + bfhi(v.w) * bfhi(v.w);
    }
    ss += __shfl_xor(ss, 1);
    if (half == 0) rowf[row] = rsqrtf(ss * (1.f / 256.f) + EPS);
  }
  unsigned ao[4], bo[4];
#pragma unroll
  for (int j = 0; j < 4; ++j) {
    const int row = r_s + 32 * j;
    ao[j] = (unsigned)(((m * 128 + row) * NIN + 768 + c_s * 8) * 2);
    bo[j] = (unsigned)(((nt * 128 + row) * 256 + c_s * 8) * 2);
  }
  bf16_t* Q = p.Q(); const float* ropec = p.ropec(); const float* ropes = p.ropes();
  const float QS = 0.10206207261596577f * 1.4426950408889634f;
  gemm128(smem, (const unsigned char*)p.proj(), ao, (const unsigned char*)p.wuq_t(), bo, 4, [=](f32x4 (&acc)[4][4], int wm, int wn, int fr, int fq) {
#pragma unroll
    for (int i = 0; i < 4; ++i) {
      const int tl = wm * 64 + i * 16 + fr, t = m * 128 + tl;
      const int b = t >> 11, s = t & 2047;
      const float rs = rowf[tl] * QS;
#pragma unroll
      for (int j = 0; j < 4; ++j) {
        const int c0 = nt * 128 + wn * 64 + j * 16;
        const int head = c0 / 96, d0 = c0 % 96;
        bf16_t* dst = Q + ((size_t)((b * 8 + head) * 2048 + s)) * 96 + d0 + fq * 4;
        if (d0 == 64) {
          if (j < 3) {
            const float4 cs = *(const float4*)(ropec + (size_t)t * 16 + fq * 4), sn = *(const float4*)(ropes + (size_t)t * 16 + fq * 4);
            const f32x4 x1 = acc[i][j] * rs, x2 = acc[i][j + 1 < 4 ? j + 1 : 3] * rs;
            u32x2 o1, o2;
            o1.x = pack2(x1[0] * cs.x - x2[0] * sn.x, x1[1] * cs.y - x2[1] * sn.y);
            o1.y = pack2(x1[2] * cs.z - x2[2] * sn.z, x1[3] * cs.w - x2[3] * sn.w);
            o2.x = pack2(x2[0] * cs.x + x1[0] * sn.x, x2[1] * cs.y + x1[1] * sn.y);
            o2.y = pack2(x2[2] * cs.z + x1[2] * sn.z, x2[3] * cs.w + x1[3] * sn.w);
            *(u32x2*)dst = o1; *(u32x2*)(dst + 16) = o2;
          }
        } else if (d0 != 80) {
          const f32x4 x = acc[i][j] * rs;
          u32x2 o; o.x = pack2(x[0], x[1]); o.y = pack2(x[2], x[3]);
          *(u32x2*)dst = o;
        }
      }
    }
  });
}

DI void item_kvproj(const P& p, unsigned char* smem, int item) {
  const int m = item >> 3, head = item & 7;
  const int tid = otid(), r_s = tid >> 3, c_s = tid & 7;
  float* rowf = (float*)(smem + SMEM_MAIN + 1024);
  __syncthreads();
  {
    const int row = tid >> 1, half = tid & 1;
    const int t = m * 128 + row, b = t >> 11, s = t & 2047;
    const bf16_t* src = p.proj() + (size_t)t * NIN + 1024 + half * 64;
    float ss = 0.f;
#pragma unroll
    for (int q = 0; q < 8; ++q) {
      const u32x4 v = *(const u32x4*)(src + q * 8);
      ss += bflo(v.x) * bflo(v.x) + bfhi(v.x) * bfhi(v.x) + bflo(v.y) * bflo(v.y) + bfhi(v.y) * bfhi(v.y) + bflo(v.z) * bflo(v.z) + bfhi(v.z) * bfhi(v.z) + bflo(v.w) * bflo(v.w) + bfhi(v.w) * bfhi(v.w);
    }
    ss += __shfl_xor(ss, 1);
    if (half == 0) rowf[row] = rsqrtf(ss * (1.f / 128.f) + EPS);
    const bf16_t* kp = p.proj() + (size_t)t * NIN + 1152 + half * 8;
    const u32x4 a1 = *(const u32x4*)kp, a2 = *(const u32x4*)(kp + 16);
    const float* cp = p.ropec() + (size_t)t * 16 + half * 8; const float* sp = p.ropes() + (size_t)t * 16 + half * 8;
    const float4 c0 = *(const float4*)cp, c1 = *(const float4*)(cp + 4), s0 = *(const float4*)sp, s1 = *(const float4*)(sp + 4);
    const float x1[8] = {bflo(a1.x), bfhi(a1.x), bflo(a1.y), bfhi(a1.y), bflo(a1.z), bfhi(a1.z), bflo(a1.w), bfhi(a1.w)};
    const float x2[8] = {bflo(a2.x), bfhi(a2.x), bflo(a2.y), bfhi(a2.y), bflo(a2.z), bfhi(a2.z), bflo(a2.w), bfhi(a2.w)};
    const float cc[8] = {c0.x, c0.y, c0.z, c0.w, c1.x, c1.y, c1.z, c1.w};
    const float sn[8] = {s0.x, s0.y, s0.z, s0.w, s1.x, s1.y, s1.z, s1.w};
    u32x4 o1, o2;
    o1.x = pack2(x1[0] * cc[0] - x2[0] * sn[0], x1[1] * cc[1] - x2[1] * sn[1]);
    o1.y = pack2(x1[2] * cc[2] - x2[2] * sn[2], x1[3] * cc[3] - x2[3] * sn[3]);
    o1.z = pack2(x1[4] * cc[4] - x2[4] * sn[4], x1[5] * cc[5] - x2[5] * sn[5]);
    o1.w = pack2(x1[6] * cc[6] - x2[6] * sn[6], x1[7] * cc[7] - x2[7] * sn[7]);
    o2.x = pack2(x2[0] * cc[0] + x1[0] * sn[0], x2[1] * cc[1] + x1[1] * sn[1]);
    o2.y = pack2(x2[2] * cc[2] + x1[2] * sn[2], x2[3] * cc[3] + x1[3] * sn[3]);
    o2.z = pack2(x2[4] * cc[4] + x1[4] * sn[4], x2[5] * cc[5] + x1[5] * sn[5]);
    o2.w = pack2(x2[6] * cc[6] + x1[6] * sn[6], x2[7] * cc[7] + x1[7] * sn[7]);
    bf16_t* kd = p.Kb() + ((size_t)((b * 8 + head) * 2048 + s)) * 96 + 64 + half * 8;
    *(u32x4*)kd = o1; *(u32x4*)(kd + 16) = o2;
  }
  unsigned ao[4], bo[4];
#pragma unroll
  for (int j = 0; j < 4; ++j) {
    const int row = r_s + 32 * j;
    ao[j] = (unsigned)(((m * 128 + row) * NIN + 1024 + c_s * 8) * 2);
    bo[j] = (unsigned)(((head * 128 + row) * 128 + c_s * 8) * 2);
  }
  bf16_t* Kb = p.Kb(); bf16_t* V = p.V();
  gemm128(smem, (const unsigned char*)p.proj(), ao, (const unsigned char*)p.wukv_t(), bo, 2, [=](f32x4 (&acc)[4][4], int wm, int wn, int fr, int fq) {
#pragma unroll
    for (int i = 0; i < 4; ++i) {
      const int tl = wm * 64 + i * 16 + fr, t = m * 128 + tl;
      const int b = t >> 11, s = t & 2047;
      const float rs = rowf[tl];
      const size_t rowi = (size_t)((b * 8 + head) * 2048 + s);
#pragma unroll
      for (int j = 0; j < 4; ++j) {
        const int d = j * 16 + fq * 4;
        const f32x4 x = acc[i][j] * rs;
        u32x2 o; o.x = pack2(x[0], x[1]); o.y = pack2(x[2], x[3]);
        if (wn == 0) *(u32x2*)(Kb + rowi * 96 + d) = o; else *(u32x2*)(V + rowi * 64 + d) = o;
      }
    }
  });
}

DI void item_pool(const P& p, unsigned char* smem, int l, int item) {
  const int tid = otid(), w = tid >> 6, lane = tid & 63, fr = lane & 15, fq = lane >> 4;
  const int tile = item >> 2, g = item & 3;
  const int t0 = tile * 128, s0 = t0 & 2047;
  const int wdw = 2 << g;
  unsigned char* al = smem;
  unsigned char* dl = smem + 20480;
  __syncthreads();
  for (int id = tid; id < 143 * 8; id += NTHREADS) {
    const int row = id >> 3, c = id & 7;
    const int srel = s0 - 15 + row;
    u32x4 v = (u32x4){0u, 0u, 0u, 0u};
    if (srel >= 0) v = *(const u32x4*)(p.proj() + (size_t)(t0 - 15 + row) * NIN + g * 64 + c * 8);
    *(u32x4*)(al + row * 128 + c * 16) = v;
  }
  __syncthreads();
  {
    const int tl = tid >> 1, cb = (tid & 1) * 4;
    const int pos = s0 + tl;
    const int nw = (pos + 1 < wdw) ? pos + 1 : wdw;
    const float inv = 1.f / (float)nw;
#pragma unroll
    for (int q = 0; q < 4; ++q) {
      const int c = cb + q;
      float sm[8];
#pragma unroll
      for (int e = 0; e < 8; ++e) sm[e] = 0.f;
      for (int j = 0; j < nw; ++j) {
        const u32x4 v = *(const u32x4*)(al + (tl + 15 - j) * 128 + c * 16);
        sm[0] += bflo(v.x); sm[1] += bfhi(v.x); sm[2] += bflo(v.y); sm[3] += bfhi(v.y); sm[4] += bflo(v.z); sm[5] += bfhi(v.z); sm[6] += bflo(v.w); sm[7] += bfhi(v.w);
      }
      const u32x4 a = *(const u32x4*)(al + (tl + 15) * 128 + c * 16);
      u32x4 o;
      o.x = pack2(sm[0] * inv - bflo(a.x), sm[1] * inv - bfhi(a.x)); o.y = pack2(sm[2] * inv - bflo(a.y), sm[3] * inv - bfhi(a.y));
      o.z = pack2(sm[4] * inv - bflo(a.z), sm[5] * inv - bfhi(a.z)); o.w = pack2(sm[6] * inv - bflo(a.w), sm[7] * inv - bfhi(a.w));
      *(u32x4*)(dl + tl * 128 + ((c ^ (tl & 7)) << 4)) = o;
    }
  }
  __syncthreads();
  {
    const bf16_t* wp = p.wpool_t() + ((size_t)(l * 4 + g) * 64) * 64;
    f32x4 acc[2][4];
#pragma unroll
    for (int i = 0; i < 2; ++i)
#pragma unroll
      for (int j = 0; j < 4; ++j) acc[i][j] = (f32x4){0.f, 0.f, 0.f, 0.f};
#pragma unroll
    for (int ks = 0; ks < 2; ++ks) {
      bf16x8 df[2], wf[4];
#pragma unroll
      for (int i = 0; i < 2; ++i) { const int row = w * 32 + i * 16 + fr; df[i] = *(const bf16x8*)(dl + row * 128 + (((ks * 4 + fq) ^ (row & 7)) << 4)); }
#pragma unroll
      for (int j = 0; j < 4; ++j) wf[j] = *(const bf16x8*)(wp + (size_t)(j * 16 + fr) * 64 + ks * 32 + fq * 8);
#pragma unroll
      for (int i = 0; i < 2; ++i)
#pragma unroll
        for (int j = 0; j < 4; ++j) acc[i][j] = __builtin_amdgcn_mfma_f32_16x16x32_bf16(wf[j], df[i], acc[i][j], 0, 0, 0);
    }
#pragma unroll
    for (int i = 0; i < 2; ++i) {
      const int t = t0 + w * 32 + i * 16 + fr;
#pragma unroll
      for (int j = 0; j < 4; ++j) {
        const int cc = g * 64 + j * 16 + fq * 4;
        const float4 ps = *(const float4*)(p.pool_scale + l * 256 + cc);
        u32x2 o; o.x = pack2(acc[i][j][0] * ps.x, acc[i][j][1] * ps.y); o.y = pack2(acc[i][j][2] * ps.z, acc[i][j][3] * ps.w);
        *(u32x2*)(p.Y() + (size_t)t * 1024 + cc) = o;
      }
    }
  }
}

DI void item_sgu(const P& p, unsigned char* smem, int l, int chunk) {
  const int tid = otid(), w = tid >> 6, lane = tid & 63, fr = lane & 15, fq = lane >> 4;
  const int t0 = chunk * 128;
  unsigned char* vn = smem;
  __syncthreads();
#pragma unroll 1
  for (int ps = 0; ps < 4; ++ps) {
    const int tl = ps * 32 + (tid >> 3), part = tid & 7;
    const bf16_t* src = p.proj() + (size_t)(t0 + tl) * NIN + 512 + part * 32;
    float x[32];
#pragma unroll
    for (int q = 0; q < 4; ++q) {
      const u32x4 v = *(const u32x4*)(src + q * 8);
      x[q * 8 + 0] = gelu_tanh(bflo(v.x)); x[q * 8 + 1] = gelu_tanh(bfhi(v.x)); x[q * 8 + 2] = gelu_tanh(bflo(v.y)); x[q * 8 + 3] = gelu_tanh(bfhi(v.y));
      x[q * 8 + 4] = gelu_tanh(bflo(v.z)); x[q * 8 + 5] = gelu_tanh(bfhi(v.z)); x[q * 8 + 6] = gelu_tanh(bflo(v.w)); x[q * 8 + 7] = gelu_tanh(bfhi(v.w));
    }
    float sm = 0.f;
#pragma unroll
    for (int e = 0; e < 32; ++e) sm += x[e];
    sm += __shfl_xor(sm, 1); sm += __shfl_xor(sm, 2); sm += __shfl_xor(sm, 4);
    const float mu = sm * (1.f / 256.f);
    float vs = 0.f;
#pragma unroll
    for (int e = 0; e < 32; ++e) { x[e] -= mu; vs += x[e] * x[e]; }
    vs += __shfl_xor(vs, 1); vs += __shfl_xor(vs, 2); vs += __shfl_xor(vs, 4);
    const float rstd = rsqrtf(vs * (1.f / 256.f) + EPS);
#pragma unroll
    for (int q = 0; q < 4; ++q) {
      const int c = part * 4 + q;
      u32x4 o;
      o.x = pack2(x[q * 8 + 0] * rstd, x[q * 8 + 1] * rstd); o.y = pack2(x[q * 8 + 2] * rstd, x[q * 8 + 3] * rstd);
      o.z = pack2(x[q * 8 + 4] * rstd, x[q * 8 + 5] * rstd); o.w = pack2(x[q * 8 + 6] * rstd, x[q * 8 + 7] * rstd);
      *(u32x4*)(vn + tl * 512 + (((c >> 1) ^ (tl & 7)) << 5) + ((c & 1) << 4)) = o;
    }
  }
  __syncthreads();
  const int qq = fr >> 2, pp = fr & 3;
#pragma unroll 1
  for (int hh = 0; hh < 4; ++hh) {
    f32x4 acc[4][2];
#pragma unroll
    for (int df = 0; df < 4; ++df) { acc[df][0] = (f32x4){0.f, 0.f, 0.f, 0.f}; acc[df][1] = (f32x4){0.f, 0.f, 0.f, 0.f}; }
    const bf16_t* wb = p.wsp_b() + ((size_t)(l * 4 + hh) * 128) * 128;
    for (int kb = 0; kb <= w; ++kb) {
      bf16x8 wf[2];
#pragma unroll
      for (int f = 0; f < 2; ++f) {
        const bf16_t* wr = wb + (size_t)((2 * w + f) * 16 + fr) * 128 + kb * 32 + fq * 4;
        const u32x2 lo = *(const u32x2*)wr, hi = *(const u32x2*)(wr + 16);
        u32x4 u; u.x = lo.x; u.y = lo.y; u.z = hi.x; u.w = hi.y;
        wf[f] = __builtin_bit_cast(bf16x8, u);
      }
#pragma unroll
      for (int df = 0; df < 4; ++df) {
        const int keyA = kb * 32 + fq * 4 + qq, keyB = keyA + 16;
        const int slot = hh * 4 + df;
        const s16x4 lo = __builtin_amdgcn_ds_read_tr16_b64_v4i16((LAS s16x4*)(vn + keyA * 512 + ((slot ^ (keyA & 7)) << 5) + pp * 8));
        const s16x4 hi = __builtin_amdgcn_ds_read_tr16_b64_v4i16((LAS s16x4*)(vn + keyB * 512 + ((slot ^ (keyB & 7)) << 5) + pp * 8));
        bf16x8 vf; vf[0] = lo[0]; vf[1] = lo[1]; vf[2] = lo[2]; vf[3] = lo[3]; vf[4] = hi[0]; vf[5] = hi[1]; vf[6] = hi[2]; vf[7] = hi[3];
        acc[df][0] = __builtin_amdgcn_mfma_f32_16x16x32_bf16(vf, wf[0], acc[df][0], 0, 0, 0);
        acc[df][1] = __builtin_amdgcn_mfma_f32_16x16x32_bf16(vf, wf[1], acc[df][1], 0, 0, 0);
      }
    }
#pragma unroll
    for (int f = 0; f < 2; ++f) {
      const int tl = (2 * w + f) * 16 + fr, t = t0 + tl;
      const float bias = p.b_spatial[(l * 4 + hh) * 128 + tl];
#pragma unroll
      for (int df = 0; df < 4; ++df) {
        const int d = hh * 64 + df * 16 + fq * 4;
        const u32x2 uu = *(const u32x2*)(p.proj() + (size_t)t * NIN + 256 + d);
        u32x2 o;
        o.x = pack2(gelu_tanh(bflo(uu.x)) * (acc[df][f][0] + bias), gelu_tanh(bfhi(uu.x)) * (acc[df][f][1] + bias));
        o.y = pack2(gelu_tanh(bflo(uu.y)) * (acc[df][f][2] + bias), gelu_tanh(bfhi(uu.y)) * (acc[df][f][3] + bias));
        *(u32x2*)(p.Y() + (size_t)t * 1024 + 256 + d) = o;
      }
    }
  }
}

DI void item_attn(const P& p, unsigned char* smem, int item) {
  const int tid = otid(), w = tid >> 6, lane = tid & 63;
  const int fr = lane & 15, fq = lane >> 4;
  const int rnd = item >> 9, blk = item & 511;
  const int qb = rnd == 0 ? 15 - (blk >> 6) : (blk >> 6);
  const int bh = blk & 63, b = bh >> 3, h = bh & 7;
  const int q0 = qb * 128;
  const int nkt = 2 * qb + 2;
  const bf16_t* Qg = p.Q() + (size_t)bh * 2048 * 96;
  const bf16_t* Kg = p.Kb() + (size_t)bh * 2048 * 96;
  const bf16_t* Vg = p.V() + (size_t)bh * 2048 * 64;
  int kkey[3], kdst[3], kc[3];
#pragma unroll
  for (int j = 0; j < 3; ++j) { const int id = tid + 256 * j; kkey[j] = id / 12; kc[j] = id % 12; kdst[j] = kkey[j] * 256 + ((kc[j] ^ (kkey[j] & 15)) << 4); }
  int vkey[2], vdst[2], vc[2];
#pragma unroll
  for (int j = 0; j < 2; ++j) { const int id = tid + 256 * j; vkey[j] = id >> 3; vc[j] = id & 7; vdst[j] = vkey[j] * 128 + (((vc[j] >> 1) ^ ((vkey[j] >> 1) & 3)) << 5) + ((vc[j] & 1) << 4); }
  bf16x8 qf[3][2];
#pragma unroll
  for (int ks = 0; ks < 3; ++ks)
#pragma unroll
    for (int f = 0; f < 2; ++f) qf[ks][f] = *(const bf16x8*)(Qg + (size_t)(q0 + 32 * w + 16 * f + fr) * 96 + ks * 32 + fq * 8);
  f32x4 o[4][2];
#pragma unroll
  for (int f = 0; f < 4; ++f) { o[f][0] = (f32x4){0.f, 0.f, 0.f, 0.f}; o[f][1] = (f32x4){0.f, 0.f, 0.f, 0.f}; }
  float mrun[2] = {-INFINITY, -INFINITY}, lrun[2] = {0.f, 0.f};
  u32x4 rk[3], rv[2];
  __syncthreads();
#pragma unroll
  for (int j = 0; j < 3; ++j) rk[j] = *(const u32x4*)(Kg + (size_t)kkey[j] * 96 + kc[j] * 8);
#pragma unroll
  for (int j = 0; j < 2; ++j) rv[j] = *(const u32x4*)(Vg + (size_t)vkey[j] * 64 + vc[j] * 8);
#pragma unroll
  for (int j = 0; j < 3; ++j) *(u32x4*)(smem + kdst[j]) = rk[j];
#pragma unroll
  for (int j = 0; j < 2; ++j) *(u32x4*)(smem + 32768 + vdst[j]) = rv[j];
  __syncthreads();
  const int rowmin = q0 + 32 * w;
  for (int kt = 0; kt < nkt; ++kt) {
    const int cur = kt & 1;
    const bool more = kt + 1 < nkt;
    if (more) {
      const int key0n = (kt + 1) * 64;
#pragma unroll
      for (int j = 0; j < 3; ++j) rk[j] = *(const u32x4*)(Kg + (size_t)(key0n + kkey[j]) * 96 + kc[j] * 8);
#pragma unroll
      for (int j = 0; j < 2; ++j) rv[j] = *(const u32x4*)(Vg + (size_t)(key0n + vkey[j]) * 64 + vc[j] * 8);
    }
    const int key0 = kt * 64;
    if (key0 <= rowmin + 31) {
      const unsigned char* Kl = smem + cur * 16384;
      const unsigned char* Vl = smem + 32768 + cur * 8192;
      f32x4 st[4][2];
#pragma unroll
      for (int kf = 0; kf < 4; ++kf) { st[kf][0] = (f32x4){0.f, 0.f, 0.f, 0.f}; st[kf][1] = (f32x4){0.f, 0.f, 0.f, 0.f}; }
#pragma unroll
      for (int ks = 0; ks < 3; ++ks)
#pragma unroll
        for (int kf = 0; kf < 4; ++kf) {
          const int key = kf * 16 + fr;
          const bf16x8 a = *(const bf16x8*)(Kl + key * 256 + (((ks * 4 + fq) ^ (key & 15)) << 4));
          st[kf][0] = __builtin_amdgcn_mfma_f32_16x16x32_bf16(a, qf[ks][0], st[kf][0], 0, 0, 0);
          st[kf][1] = __builtin_amdgcn_mfma_f32_16x16x32_bf16(a, qf[ks][1], st[kf][1], 0, 0, 0);
        }
      const bool needmask = (key0 + 63 > rowmin);
#pragma unroll
      for (int f = 0; f < 2; ++f) {
        const int qabs = rowmin + 16 * f + fr;
        if (needmask) {
#pragma unroll
          for (int kf = 0; kf < 4; ++kf)
#pragma unroll
            for (int r = 0; r < 4; ++r) { const int kabs = key0 + kf * 16 + fq * 4 + r; if (kabs > qabs) st[kf][f][r] = -INFINITY; }
        }
        float mx = st[0][f][0];
#pragma unroll
        for (int kf = 0; kf < 4; ++kf)
#pragma unroll
          for (int r = 0; r < 4; ++r) mx = fmaxf(mx, st[kf][f][r]);
        mx = fmaxf(mx, __shfl_xor(mx, 16)); mx = fmaxf(mx, __shfl_xor(mx, 32));
        const float mnew = fmaxf(mrun[f], mx);
        const float alpha = __builtin_amdgcn_exp2f(mrun[f] - mnew);
        mrun[f] = mnew;
        float ls = 0.f;
#pragma unroll
        for (int kf = 0; kf < 4; ++kf)
#pragma unroll
          for (int r = 0; r < 4; ++r) { const float pv = __builtin_amdgcn_exp2f(st[kf][f][r] - mnew); st[kf][f][r] = pv; ls += pv; }
        lrun[f] = lrun[f] * alpha + ls;
#pragma unroll
        for (int df = 0; df < 4; ++df) o[df][f] = o[df][f] * alpha;
      }
      bf16x8 pf[2][2];
#pragma unroll
      for (int kb = 0; kb < 2; ++kb)
#pragma unroll
        for (int f = 0; f < 2; ++f) {
          u32x4 u;
          u.x = pack2(st[2 * kb][f][0], st[2 * kb][f][1]); u.y = pack2(st[2 * kb][f][2], st[2 * kb][f][3]);
          u.z = pack2(st[2 * kb + 1][f][0], st[2 * kb + 1][f][1]); u.w = pack2(st[2 * kb + 1][f][2], st[2 * kb + 1][f][3]);
          pf[kb][f] = __builtin_bit_cast(bf16x8, u);
        }
      const int qq = fr >> 2, pp = fr & 3;
#pragma unroll
      for (int kb = 0; kb < 2; ++kb)
#pragma unroll
        for (int df = 0; df < 4; ++df) {
          const int keyA = kb * 32 + fq * 4 + qq, keyB = keyA + 16;
          const int offA = keyA * 128 + ((df ^ ((keyA >> 1) & 3)) << 5) + pp * 8;
          const int offB = keyB * 128 + ((df ^ ((keyB >> 1) & 3)) << 5) + pp * 8;
          const s16x4 lo = __builtin_amdgcn_ds_read_tr16_b64_v4i16((LAS s16x4*)(Vl + offA));
          const s16x4 hi = __builtin_amdgcn_ds_read_tr16_b64_v4i16((LAS s16x4*)(Vl + offB));
          bf16x8 vf; vf[0] = lo[0]; vf[1] = lo[1]; vf[2] = lo[2]; vf[3] = lo[3]; vf[4] = hi[0]; vf[5] = hi[1]; vf[6] = hi[2]; vf[7] = hi[3];
          o[df][0] = __builtin_amdgcn_mfma_f32_16x16x32_bf16(vf, pf[kb][0], o[df][0], 0, 0, 0);
          o[df][1] = __builtin_amdgcn_mfma_f32_16x16x32_bf16(vf, pf[kb][1], o[df][1], 0, 0, 0);
        }
    }
    if (more) {
      const int nx = cur ^ 1;
#pragma unroll
      for (int j = 0; j < 3; ++j) *(u32x4*)(smem + nx * 16384 + kdst[j]) = rk[j];
#pragma unroll
      for (int j = 0; j < 2; ++j) *(u32x4*)(smem + 32768 + nx * 8192 + vdst[j]) = rv[j];
    }
    __syncthreads();
  }
#pragma unroll
  for (int f = 0; f < 2; ++f) {
    float lt = lrun[f]; lt += __shfl_xor(lt, 16); lt += __shfl_xor(lt, 32);
    const float inv = 1.f / lt;
    const int t = b * 2048 + rowmin + 16 * f + fr;
#pragma unroll
    for (int df = 0; df < 4; ++df) {
      const f32x4 x = o[df][f] * inv;
      u32x2 ov; ov.x = pack2(x[0], x[1]); ov.y = pack2(x[2], x[3]);
      *(u32x2*)(p.Y() + (size_t)t * 1024 + 512 + h * 64 + df * 16 + fq * 4) = ov;
    }
  }
}

DI void item_p4(const P& p, unsigned char* smem, int l, int item) {
  const int m = item >> 3, nt = item & 7;
  const int tid = otid(), r_s = tid >> 3, c_s = tid & 7;
  unsigned ao[4], bo[4];
#pragma unroll
  for (int j = 0; j < 4; ++j) {
    const int row = r_s + 32 * j;
    ao[j] = (unsigned)(((m * 128 + row) * 1024 + c_s * 8) * 2);
    bo[j] = (unsigned)(((nt * 128 + row) * 1024 + c_s * 8) * 2);
  }
  const float* xin = (l == 0) ? p.x : p.out;
  float* xout = p.out;
  const float* mod = p.mod() + (size_t)l * 8 * 6144 + 2048;
  float* rowss = p.rowss();
  gemm128(smem, (const unsigned char*)p.Y(), ao, (const unsigned char*)p.wout_t(), bo, 16, [=](f32x4 (&acc)[4][4], int wm, int wn, int fr, int fq) {
#pragma unroll
    for (int i = 0; i < 4; ++i) {
      const int t = m * 128 + wm * 64 + i * 16 + fr, b = t >> 11;
      float ss = 0.f;
#pragma unroll
      for (int j = 0; j < 4; ++j) {
        const int n = nt * 128 + wn * 64 + j * 16 + fq * 4;
        const float4 xv = *(const float4*)(xin + (size_t)t * 1024 + n);
        const float4 g = *(const float4*)(mod + (size_t)b * 6144 + n);
        float4 ov = {xv.x + g.x * acc[i][j][0], xv.y + g.y * acc[i][j][1], xv.z + g.z * acc[i][j][2], xv.w + g.w * acc[i][j][3]};
        ss += ov.x * ov.x + ov.y * ov.y + ov.z * ov.z + ov.w * ov.w;
        *(float4*)(xout + (size_t)t * 1024 + n) = ov;
      }
      ss += __shfl_xor(ss, 16); ss += __shfl_xor(ss, 32);
      if (fq == 0) rowss[(size_t)t * 16 + nt * 2 + wn] = ss;
    }
  });
}

DI void item_p5(const P& p, unsigned char* smem, int l, int item) {
  const int tid = otid(), w = tid >> 6, lane = tid & 63, fr = lane & 15, fq = lane >> 4;
  const int tf = w >> 1, kh = w & 1;
  const int tb = item * 32 + tf * 16;
  const int t = tb + fr, b = (item * 32) >> 11;
  const float* xr = p.out + (size_t)t * 1024 + kh * 512 + fq * 8;
  float* mds = (float*)(smem + 32768);
  __syncthreads();
  {
    const float* md = p.mod() + ((size_t)l * 8 + b) * 6144 + 3072;
    for (int i = tid; i < 512; i += NTHREADS) *(float4*)(mds + i * 4) = *(const float4*)(md + i * 4);
  }
  float rstd;
  {
    const float4* rp = (const float4*)(p.rowss() + (size_t)t * 16);
    const float4 a = rp[0], c = rp[1], d = rp[2], e = rp[3];
    const float ss = ((a.x + a.y) + (a.z + a.w)) + ((c.x + c.y) + (c.z + c.w)) + ((d.x + d.y) + (d.z + d.w)) + ((e.x + e.y) + (e.z + e.w));
    rstd = rsqrtf(ss * (1.f / 1024.f) + EPS);
  }
  const bf16_t* whi = p.wr_hi() + (size_t)l * 65536 + (size_t)fr * 1024 + kh * 512 + fq * 8;
  const bf16_t* wlo = p.wr_lo() + (size_t)l * 65536 + (size_t)fr * 1024 + kh * 512 + fq * 8;
  bf16_t* hdst = p.h() + (size_t)t * 1024 + kh * 512 + fq * 8;
  f32x4 acc[4];
#pragma unroll
  for (int nf = 0; nf < 4; ++nf) acc[nf] = (f32x4){0.f, 0.f, 0.f, 0.f};
  bf16x8 wh0[4], wl0[4], wh1[4], wl1[4]; float4 xa0, xb0, xa1, xb1;
#pragma unroll
  for (int nf = 0; nf < 4; ++nf) { wh0[nf] = *(const bf16x8*)(whi + (size_t)nf * 16384); wl0[nf] = *(const bf16x8*)(wlo + (size_t)nf * 16384); }
  xa0 = *(const float4*)(xr); xb0 = *(const float4*)(xr + 4);
  __syncthreads();
  auto step = [&](int ks, const bf16x8 (&wh)[4], const bf16x8 (&wl)[4], const float4& xa, const float4& xb) {
    const int k0 = kh * 512 + ks * 32 + fq * 8;
    const float4 ha = *(const float4*)(mds + k0), hb = *(const float4*)(mds + k0 + 4);
    const float4 sa = *(const float4*)(mds + 1024 + k0), sb = *(const float4*)(mds + 1024 + k0 + 4);
    float hv[8];
    hv[0] = xa.x * rstd * (1.f + sa.x) + ha.x; hv[1] = xa.y * rstd * (1.f + sa.y) + ha.y; hv[2] = xa.z * rstd * (1.f + sa.z) + ha.z; hv[3] = xa.w * rstd * (1.f + sa.w) + ha.w;
    hv[4] = xb.x * rstd * (1.f + sb.x) + hb.x; hv[5] = xb.y * rstd * (1.f + sb.y) + hb.y; hv[6] = xb.z * rstd * (1.f + sb.z) + hb.z; hv[7] = xb.w * rstd * (1.f + sb.w) + hb.w;
    u32x4 uh, ul;
    uh.x = pack2(hv[0], hv[1]); uh.y = pack2(hv[2], hv[3]); uh.z = pack2(hv[4], hv[5]); uh.w = pack2(hv[6], hv[7]);
    ul.x = pack2(hv[0] - bflo(uh.x), hv[1] - bfhi(uh.x)); ul.y = pack2(hv[2] - bflo(uh.y), hv[3] - bfhi(uh.y));
    ul.z = pack2(hv[4] - bflo(uh.z), hv[5] - bfhi(uh.z)); ul.w = pack2(hv[6] - bflo(uh.w), hv[7] - bfhi(uh.w));
    *(u32x4*)(hdst + ks * 32) = uh;
    const bf16x8 bh = __builtin_bit_cast(bf16x8, uh), bl = __builtin_bit_cast(bf16x8, ul);
#pragma unroll
    for (int nf = 0; nf < 4; ++nf) {
      acc[nf] = __builtin_amdgcn_mfma_f32_16x16x32_bf16(wh[nf], bh, acc[nf], 0, 0, 0);
      acc[nf] = __builtin_amdgcn_mfma_f32_16x16x32_bf16(wh[nf], bl, acc[nf], 0, 0, 0);
      acc[nf] = __builtin_amdgcn_mfma_f32_16x16x32_bf16(wl[nf], bh, acc[nf], 0, 0, 0);
    }
  };
#pragma unroll 1
  for (int ks = 0; ks < 16; ks += 2) {
    {
#pragma unroll
      for (int nf = 0; nf < 4; ++nf) { wh1[nf] = *(const bf16x8*)(whi + (size_t)nf * 16384 + (ks + 1) * 32); wl1[nf] = *(const bf16x8*)(wlo + (size_t)nf * 16384 + (ks + 1) * 32); }
      xa1 = *(const float4*)(xr + (ks + 1) * 32); xb1 = *(const float4*)(xr + (ks + 1) * 32 + 4);
    }
    step(ks, wh0, wl0, xa0, xb0);
    {
      const int kn = (ks + 2 < 16) ? ks + 2 : 15;
#pragma unroll
      for (int nf = 0; nf < 4; ++nf) { wh0[nf] = *(const bf16x8*)(whi + (size_t)nf * 16384 + kn * 32); wl0[nf] = *(const bf16x8*)(wlo + (size_t)nf * 16384 + kn * 32); }
      xa0 = *(const float4*)(xr + kn * 32); xb0 = *(const float4*)(xr + kn * 32 + 4);
    }
    step(ks + 1, wh1, wl1, xa1, xb1);
  }
  float* red = (float*)smem;
  int* info = (int*)(smem + 16384) + w * 512;
#pragma unroll
  for (int nf = 0; nf < 4; ++nf) *(f32x4*)(red + w * 1024 + fr * 64 + nf * 16 + fq * 4) = acc[nf];
  __syncthreads();
  const float bias = p.router_bias[l * 64 + lane];
  int cnt_local = 0;
  const int tq0 = kh * 8;
#pragma unroll 1
  for (int q = 0; q < 8; ++q) {
    const float lgt = red[(tf * 2) * 1024 + (tq0 + q) * 64 + lane] + red[(tf * 2 + 1) * 1024 + (tq0 + q) * 64 + lane];
    const float s = 1.f / (1.f + __expf(-lgt));
    const float sel = s + bias;
    float m1 = sel; m1 = fmaxf(m1, __shfl_xor(m1, 1)); m1 = fmaxf(m1, __shfl_xor(m1, 2)); m1 = fmaxf(m1, __shfl_xor(m1, 4));
    const unsigned long long eq = __ballot(sel == m1);
    const int gbase = lane & ~7;
    const unsigned gm = (unsigned)((eq >> gbase) & 0xffull);
    const int first = gbase + __ffs(gm) - 1;
    float m2 = (lane == first) ? -INFINITY : sel;
    m2 = fmaxf(m2, __shfl_xor(m2, 1)); m2 = fmaxf(m2, __shfl_xor(m2, 2)); m2 = fmaxf(m2, __shfl_xor(m2, 4));
    const float gs = m1 + m2;
    const int myg = lane >> 3; int rank = 0;
#pragma unroll
    for (int j = 0; j < 8; ++j) { const float gj = __shfl(gs, j * 8); rank += ((gj > gs) || (gj == gs && j < myg)) ? 1 : 0; }
    const bool gsel = rank < 4;
    const float sm = gsel ? sel : -INFINITY;
    int r = 0;
#pragma unroll 8
    for (int j = 0; j < 64; ++j) { const float sj = __shfl(sm, j); r += ((sj > sm) || (sj == sm && j < lane)) ? 1 : 0; }
    const bool ch = gsel && (r < 8);
    const float tot = wsum(ch ? s : 0.f);
    const unsigned long long cm = __ballot(ch);
    const int kidx = __popcll(cm & ((1ull << lane) - 1ull));
    info[q * 64 + lane] = ch ? kidx : -1;
    if (ch) p.topw()[(size_t)(tb + tq0 + q) * 8 + kidx] = s / tot * 2.5f;
    cnt_local += ch ? 1 : 0;
  }
  int base = 0;
  if (cnt_local > 0) base = atomicAdd(p.cnt() + (l * 64 + lane) * CSTRIDE, cnt_local);
#pragma unroll 1
  for (int q = 0; q < 8; ++q) {
    const int k = info[q * 64 + lane];
    if (k >= 0) { p.list()[(size_t)lane * LISTCAP + base] = (tb + tq0 + q) * 8 + k; ++base; }
  }
}

DI void moe_table(const P& p, unsigned char* smem, int l) {
  int* start = (int*)(smem + SMEM_MAIN);
  __syncthreads();
  if (otid() == 0) {
    int s = 0;
    for (int e = 0; e < 64; ++e) { start[e] = s; s += (p.cnt()[(l * 64 + e) * CSTRIDE] + 127) >> 7; }
    start[64] = s;
  }
  __syncthreads();
}
DI void moe_rows(const P& p, unsigned char* smem, int l, int mt, int& e_out) {
  const int* start = (const int*)(smem + SMEM_MAIN);
  int* rowinfo = (int*)(smem + SMEM_MAIN + 512);
  const int tid = otid();
  int e;
  if (mt >= start[64]) { e = 64; if (tid < 128) rowinfo[tid] = T_ * 8 + (mt - start[64]) * 128 + tid; }
  else {
    e = 0;
    for (int q = 1; q < 64; ++q) e = (start[q] <= mt) ? q : e;
    const int tl = mt - start[e];
    const int cnt = p.cnt()[(l * 64 + e) * CSTRIDE];
    if (tid < 128) { const int idx = tl * 128 + tid; rowinfo[tid] = idx < cnt ? p.list()[(size_t)e * LISTCAP + idx] : -1; }
  }
  e_out = e;
}

DI void item_p7(const P& p, unsigned char* smem, int l, int item) {
  const int mt = item >> 2, nt = item & 3;
  const int tid = otid(), r_s = tid >> 3, c_s = tid & 7;
  int* rowinfo = (int*)(smem + SMEM_MAIN + 512);
  __syncthreads();
  int e; moe_rows(p, smem, l, mt, e);
  __syncthreads();
  const bf16_t* wbase = (e == 64) ? p.wsg_t() : p.wgu_t() + (size_t)e * 512 * 1024;
  unsigned ao[4], bo[4];
#pragma unroll
  for (int j = 0; j < 4; ++j) {
    const int row = r_s + 32 * j;
    const int slot = rowinfo[row];
    const int tok = slot < 0 ? 0 : (slot >= T_ * 8 ? slot - T_ * 8 : slot >> 3);
    ao[j] = (unsigned)((tok * 1024 + c_s * 8) * 2);
    bo[j] = (unsigned)(((nt * 128 + row) * 1024 + c_s * 8) * 2);
  }
  bf16_t* act = p.act();
  gemm128(smem, (const unsigned char*)p.h(), ao, (const unsigned char*)wbase, bo, 16, [=](f32x4 (&acc)[4][4], int wm, int wn, int fr, int fq) {
    unsigned char* ob = smem + wm * 8192;
#pragma unroll
    for (int i = 0; i < 4; ++i) {
#pragma unroll
      for (int jj = 0; jj < 2; ++jj) {
        const f32x4 g = acc[i][2 * jj], u = acc[i][2 * jj + 1];
        u32x2 o; o.x = pack2(silu_f(g[0]) * u[0], silu_f(g[1]) * u[1]); o.y = pack2(silu_f(g[2]) * u[2], silu_f(g[3]) * u[3]);
        ot_put<128>(ob, i * 16 + fr, wn * 8 + jj * 4 + fq, o);
      }
    }
    __syncthreads();
    {
      const int tid2 = fq * 16 + fr + 64 * (wm * 2 + wn);
      const int chunk = tid2 & 7;
#pragma unroll
      for (int i = 0; i < 4; ++i) {
        const int row = (tid2 >> 3) + 32 * i;
        const int slot = rowinfo[row];
        if (slot >= 0) {
          const u32x4 v = ot_get<128>(smem + (row >> 6) * 8192, row & 63, chunk);
          *(u32x4*)(act + (size_t)slot * 256 + nt * 64 + chunk * 8) = v;
        }
      }
    }
  });
}

DI void item_p8(const P& p, unsigned char* smem, int l, int item) {
  const int mt = item >> 1, nh = item & 1;
  const int tid = otid(), r_s = tid >> 3, c_s = tid & 7;
  int* rowinfo = (int*)(smem + SMEM_MAIN + 512);
  __syncthreads();
  int e; moe_rows(p, smem, l, mt, e);
  __syncthreads();
  const bf16_t* wbase = (e == 64) ? p.wsd_t() : p.wd_t() + (size_t)e * 1024 * 256;
  unsigned ao[4], bo[4];
#pragma unroll
  for (int j = 0; j < 4; ++j) {
    const int row = r_s + 32 * j;
    const int slot = rowinfo[row];
    ao[j] = (unsigned)(((slot < 0 ? 0 : slot) * 256 + c_s * 8) * 2);
    bo[j] = (unsigned)(((nh * 512 + row) * 256 + c_s * 8) * 2);
  }
  bf16_t* yrows = p.yrows(); bf16_t* ysh = p.ysh(); const float* topw = p.topw();
  gemm128_stream(smem, (const unsigned char*)p.act(), ao, (const unsigned char*)wbase, bo, 4, 4, (size_t)128 * 256, [=](f32x4 (&acc)[4][4], int tile, int cur, int wm, int wn, int fr, int fq) {
    const int nt = nh * 4 + tile;
    unsigned char* ob = smem + cur + (wm ? 32768 : 0);
    __syncthreads();
#pragma unroll
    for (int i = 0; i < 4; ++i) {
      const int slot = rowinfo[wm * 64 + i * 16 + fr];
      const float wv = (slot < 0 || slot >= T_ * 8) ? 1.f : topw[slot];
#pragma unroll
      for (int j = 0; j < 4; ++j) {
        const f32x4 x = acc[i][j] * wv;
        u32x2 o; o.x = pack2(x[0], x[1]); o.y = pack2(x[2], x[3]);
        ot_put<256>(ob, i * 16 + fr, wn * 16 + j * 4 + fq, o);
      }
    }
    __syncthreads();
    {
      const int tid2 = fq * 16 + fr + 64 * (wm * 2 + wn);
      const int chunk = tid2 & 15;
#pragma unroll
      for (int i = 0; i < 8; ++i) {
        const int row = (tid2 >> 4) + 16 * i;
        const int slot = rowinfo[row];
        if (slot >= 0) {
          const u32x4 v = ot_get<256>(smem + cur + ((row >> 6) ? 32768 : 0), row & 63, chunk);
          bf16_t* dst = (slot >= T_ * 8) ? ysh + (size_t)(slot - T_ * 8) * 1024 : yrows + (size_t)slot * 1024;
          *(u32x4*)(dst + nt * 128 + chunk * 8) = v;
        }
      }
    }
  });
}

DI void item_p9(const P& p, int l, int item) {
  const int tid = otid(), w = tid >> 6, lane = tid & 63;
  const int t = item * 4 + w, b = t >> 11;
  const float* md = p.mod() + ((size_t)l * 8 + b) * 6144;
  const int c0 = lane * 16;
  float a[16];
  {
    const u32x4 y0 = *(const u32x4*)(p.ysh() + (size_t)t * 1024 + c0), y1 = *(const u32x4*)(p.ysh() + (size_t)t * 1024 + c0 + 8);
    a[0] = bflo(y0.x); a[1] = bfhi(y0.x); a[2] = bflo(y0.y); a[3] = bfhi(y0.y); a[4] = bflo(y0.z); a[5] = bfhi(y0.z); a[6] = bflo(y0.w); a[7] = bfhi(y0.w);
    a[8] = bflo(y1.x); a[9] = bfhi(y1.x); a[10] = bflo(y1.y); a[11] = bfhi(y1.y); a[12] = bflo(y1.z); a[13] = bfhi(y1.z); a[14] = bflo(y1.w); a[15] = bfhi(y1.w);
  }
  float r[16];
#pragma unroll
  for (int e = 0; e < 16; ++e) r[e] = 0.f;
  const unsigned char* yr = (const unsigned char*)p.yrows() + (size_t)t * 8 * 1024 + c0;
  u32x4 yk[8];
#pragma unroll
  for (int k = 0; k < 8; ++k) yk[k] = *(const u32x4*)(yr + k * 1024);
#pragma unroll
  for (int k = 0; k < 8; ++k) {
#pragma unroll
    for (int q = 0; q < 4; ++q) {
      const f32x2 lo = __builtin_amdgcn_cvt_pk_f32_fp8((int)yk[k][q], false), hi = __builtin_amdgcn_cvt_pk_f32_fp8((int)yk[k][q], true);
      r[q * 4 + 0] += lo.x; r[q * 4 + 1] += lo.y; r[q * 4 + 2] += hi.x; r[q * 4 + 3] += hi.y;
    }
  }
  float v[16]; float ss = 0.f;
#pragma unroll
  for (int q = 0; q < 4; ++q) {
    const float4 xv = *(const float4*)(p.out + (size_t)t * 1024 + c0 + q * 4);
    const float4 g = *(const float4*)(md + 5120 + c0 + q * 4);
    v[q * 4 + 0] = xv.x + g.x * (a[q * 4 + 0] + r[q * 4 + 0] * (1.f / YSCALE));
    v[q * 4 + 1] = xv.y + g.y * (a[q * 4 + 1] + r[q * 4 + 1] * (1.f / YSCALE));
    v[q * 4 + 2] = xv.z + g.z * (a[q * 4 + 2] + r[q * 4 + 2] * (1.f / YSCALE));
    v[q * 4 + 3] = xv.w + g.w * (a[q * 4 + 3] + r[q * 4 + 3] * (1.f / YSCALE));
    ss += v[q * 4 + 0] * v[q * 4 + 0] + v[q * 4 + 1] * v[q * 4 + 1] + v[q * 4 + 2] * v[q * 4 + 2] + v[q * 4 + 3] * v[q * 4 + 3];
  }
  ss = wsum(ss);
  const float rstd = rsqrtf(ss * (1.f / 1024.f) + EPS);
  if (l == 0) {
    const float* md1 = p.mod() + ((size_t)8 + b) * 6144;
    unsigned hw[8];
#pragma unroll
    for (int q = 0; q < 4; ++q) {
      *(float4*)(p.out + (size_t)t * 1024 + c0 + q * 4) = (float4){v[q * 4 + 0], v[q * 4 + 1], v[q * 4 + 2], v[q * 4 + 3]};
      const float4 sh = *(const float4*)(md1 + c0 + q * 4), sc = *(const float4*)(md1 + 1024 + c0 + q * 4);
      hw[q * 2 + 0] = pack2(v[q * 4 + 0] * rstd * (1.f + sc.x) + sh.x, v[q * 4 + 1] * rstd * (1.f + sc.y) + sh.y);
      hw[q * 2 + 1] = pack2(v[q * 4 + 2] * rstd * (1.f + sc.z) + sh.z, v[q * 4 + 3] * rstd * (1.f + sc.w) + sh.w);
    }
    *(u32x4*)(p.h() + (size_t)t * 1024 + c0) = (u32x4){hw[0], hw[1], hw[2], hw[3]};
    *(u32x4*)(p.h() + (size_t)t * 1024 + c0 + 8) = (u32x4){hw[4], hw[5], hw[6], hw[7]};
  } else {
#pragma unroll
    for (int q = 0; q < 4; ++q) {
      const float4 fg = *(const float4*)(p.final_gain + c0 + q * 4);
      *(float4*)(p.out + (size_t)t * 1024 + c0 + q * 4) = (float4){v[q * 4 + 0] * rstd * fg.x, v[q * 4 + 1] * rstd * fg.y, v[q * 4 + 2] * rstd * fg.z, v[q * 4 + 3] * rstd * fg.w};
    }
  }
}

DI int xcd_vb(int bid, int G) { return ((G & 7) == 0) ? (bid & 7) * (G >> 3) + (bid >> 3) : bid; }

DI void phase_p1(const P& p, LAS unsigned char* lds, int G, int bid) {
  t8::DenseSched S; S.init(T_, 1280, 1024, G, bid, p.win_t());
  t8::DenseRows RO{2048u};
  bf16_t* proj = p.proj();
  t8::gemm_phase<true>(lds, (const unsigned char*)p.h(), 1024, S, RO, [=](const f32x4 (&acc)[2][2][4][2], const t8::Unit& u, int wr, int wc, int fr, int fq) {
    const int c0 = u.pn * 256 + wc * 64 + fq * 16;
#pragma unroll
    for (int ai = 0; ai < 2; ++ai)
#pragma unroll
      for (int m = 0; m < 4; ++m) {
        const int r = u.pm * 256 + ai * 128 + wr * 64 + m * 16 + fr;
        if (c0 < NIN) {
#pragma unroll
          for (int bj = 0; bj < 2; ++bj) {
            const f32x4 v0 = acc[ai][bj][m][0], v1 = acc[ai][bj][m][1];
            u32x4 o; o.x = pack2(v0[0], v0[1]); o.y = pack2(v0[2], v0[3]); o.z = pack2(v1[0], v1[1]); o.w = pack2(v1[2], v1[3]);
            *(u32x4*)(proj + (size_t)r * NIN + c0 + bj * 8) = o;
          }
        }
        asm volatile("" ::: "memory");
      }
  });
}

DI void phase_p4(const P& p, LAS unsigned char* lds, int l, int G, int bid) {
  t8::DenseSched S; S.init(T_, 1024, 1024, G, bid, p.wout_t());
  t8::DenseRows RO{2048u};
  const float* xin = (l == 0) ? p.x : p.out; float* xout = p.out;
  const float* mod = p.mod() + (size_t)l * 8 * 6144 + 2048;
  float* rowss = p.rowss();
  t8::gemm_phase<true>(lds, (const unsigned char*)p.Y(), 1024, S, RO, [=](const f32x4 (&acc)[2][2][4][2], const t8::Unit& u, int wr, int wc, int fr, int fq) {
    float4 xq[2][4];
    const int cbase = u.pn * 256 + wc * 64 + fq * 16;
    {
      const int r0 = u.pm * 256 + wr * 64 + fr;
#pragma unroll
      for (int q = 0; q < 4; ++q) xq[0][q] = *(const float4*)(xin + (size_t)r0 * 1024 + cbase + q * 4);
    }
#pragma unroll
    for (int ai = 0; ai < 2; ++ai)
#pragma unroll
      for (int m = 0; m < 4; ++m) {
        const int it = ai * 4 + m;
        const int r = u.pm * 256 + ai * 128 + wr * 64 + m * 16 + fr, b = r >> 11;
        if (it < 7) {
          const int rn = u.pm * 256 + ((it + 1) >> 2) * 128 + wr * 64 + ((it + 1) & 3) * 16 + fr;
#pragma unroll
          for (int q = 0; q < 4; ++q) xq[(it + 1) & 1][q] = *(const float4*)(xin + (size_t)rn * 1024 + cbase + q * 4);
        }
        float ss = 0.f;
#pragma unroll
        for (int bj = 0; bj < 2; ++bj)
#pragma unroll
          for (int n = 0; n < 2; ++n) {
            const int c0 = cbase + bj * 8 + n * 4;
            const float4 xv = xq[it & 1][bj * 2 + n];
            const float4 g = *(const float4*)(mod + (size_t)b * 6144 + c0);
            const f32x4 a = acc[ai][bj][m][n];
            float4 ov = {xv.x + g.x * a[0], xv.y + g.y * a[1], xv.z + g.z * a[2], xv.w + g.w * a[3]};
            ss += ov.x * ov.x + ov.y * ov.y + ov.z * ov.z + ov.w * ov.w;
            *(float4*)(xout + (size_t)r * 1024 + c0) = ov;
          }
        ss += __shfl_xor(ss, 16); ss += __shfl_xor(ss, 32);
        if (fq == 0) rowss[(size_t)r * 16 + u.pn * 4 + wc] = ss;
      }
  });
}

struct RowsP7 { LAS const int* tab; DI unsigned operator()(const t8::Unit& u, int row) const { const int slot = tab[u.tab * 256 + row]; const int tok = slot < 0 ? 0 : (slot >= T_ * 8 ? slot - T_ * 8 : slot >> 3); return (unsigned)tok * 2048u; } };
struct RowsP8 { LAS const int* tab; DI unsigned operator()(const t8::Unit& u, int row) const { const int slot = tab[u.tab * 256 + row]; return (unsigned)(slot < 0 ? 0 : slot) * 512u; } };

DI void phase_p7(const P& p, LAS unsigned char* lds, int l, int G, int bid) {
  int total; const int c = xcd_vb(bid, G);
  moe_prepare(p, lds, l, 2, G, c, total);
  t8::MoeSched S{(LAS const int*)(lds + t8::START_OFF), 2, total, G, c, (const unsigned char*)p.wgu_t(), (const unsigned char*)p.wsg_t(), (size_t)512 * 1024 * 2, (size_t)256 * 1024 * 2};
  RowsP7 RO{(LAS const int*)(lds + t8::TAB_OFF)};
  LAS const int* tab = (LAS const int*)(lds + t8::TAB_OFF);
  bf16_t* act = p.act();
  t8::gemm_phase<true>(lds, (const unsigned char*)p.h(), 1024, S, RO, [=](const f32x4 (&acc)[2][2][4][2], const t8::Unit& u, int wr, int wc, int fr, int fq) {
#pragma unroll
    for (int ai = 0; ai < 2; ++ai)
#pragma unroll
      for (int m = 0; m < 4; ++m) {
        const int slot = tab[u.tab * 256 + ai * 128 + wr * 64 + m * 16 + fr];
        if (slot >= 0) {
          const f32x4 g0 = acc[ai][0][m][0], g1 = acc[ai][0][m][1], u0 = acc[ai][1][m][0], u1 = acc[ai][1][m][1];
          u32x4 o;
          o.x = pack2(silu_f(g0[0]) * u0[0], silu_f(g0[1]) * u0[1]); o.y = pack2(silu_f(g0[2]) * u0[2], silu_f(g0[3]) * u0[3]);
          o.z = pack2(silu_f(g1[0]) * u1[0], silu_f(g1[1]) * u1[1]); o.w = pack2(silu_f(g1[2]) * u1[2], silu_f(g1[3]) * u1[3]);
          *(u32x4*)(act + (size_t)slot * 256 + u.pn * 128 + wc * 32 + fq * 8) = o;
        }
        asm volatile("" ::: "memory");
      }
  });
}

DI void phase_p8(const P& p, LAS unsigned char* lds, int l, int G, int bid) {
  int total; const int c = xcd_vb(bid, G);
  moe_prepare(p, lds, l, 4, G, c, total);
  t8::MoeSched S{(LAS const int*)(lds + t8::START_OFF), 4, total, G, c, (const unsigned char*)p.wd_t(), (const unsigned char*)p.wsd_t(), (size_t)1024 * 256 * 2, (size_t)256 * 256 * 2};
  RowsP8 RO{(LAS const int*)(lds + t8::TAB_OFF)};
  LAS const int* tab = (LAS const int*)(lds + t8::TAB_OFF);
  unsigned char* yrows = (unsigned char*)p.yrows(); bf16_t* ysh = p.ysh(); const float* topw = p.topw();
  t8::gemm_phase<true>(lds, (const unsigned char*)p.act(), 256, S, RO, [=](const f32x4 (&acc)[2][2][4][2], const t8::Unit& u, int wr, int wc, int fr, int fq) {
    int slots[2][4]; float wvs[2][4];
#pragma unroll
    for (int ai = 0; ai < 2; ++ai)
#pragma unroll
      for (int m = 0; m < 4; ++m) slots[ai][m] = tab[u.tab * 256 + ai * 128 + wr * 64 + m * 16 + fr];
#pragma unroll
    for (int ai = 0; ai < 2; ++ai)
#pragma unroll
      for (int m = 0; m < 4; ++m) wvs[ai][m] = (slots[ai][m] < 0 || slots[ai][m] >= T_ * 8) ? 1.f : topw[slots[ai][m]] * YSCALE;
    const int c0 = u.pn * 256 + wc * 64 + fq * 16;
#pragma unroll
    for (int ai = 0; ai < 2; ++ai)
#pragma unroll
      for (int m = 0; m < 4; ++m) {
        const int slot = slots[ai][m];
        if (slot >= 0) {
          const float wv = wvs[ai][m];
          if (slot >= T_ * 8) {
            bf16_t* dst = ysh + (size_t)(slot - T_ * 8) * 1024 + c0;
#pragma unroll
            for (int bj = 0; bj < 2; ++bj) {
              const f32x4 v0 = acc[ai][bj][m][0], v1 = acc[ai][bj][m][1];
              u32x4 o; o.x = pack2(v0[0], v0[1]); o.y = pack2(v0[2], v0[3]); o.z = pack2(v1[0], v1[1]); o.w = pack2(v1[2], v1[3]);
              *(u32x4*)(dst + bj * 8) = o;
            }
          } else {
            u32x4 o;
            o.x = pack4_fp8(acc[ai][0][m][0] * wv); o.y = pack4_fp8(acc[ai][0][m][1] * wv); o.z = pack4_fp8(acc[ai][1][m][0] * wv); o.w = pack4_fp8(acc[ai][1][m][1] * wv);
            *(u32x4*)(yrows + (size_t)slot * 1024 + c0) = o;
          }
        }
        asm volatile("" ::: "memory");
      }
  });
}

constexpr int HALF_LDS = SMEM_MAIN + SMEM_EXTRA;
#define PHASE_LOOP(n, ...) for (int base_ = 2 * bid; base_ < (n); base_ += 2 * G) { int it = base_ + half; it = it < (n) ? it : (n) - 1; __VA_ARGS__ }
__global__ void __launch_bounds__(BLOCK_THREADS, 2) fwd_megakernel(P p) {
  __shared__ __attribute__((aligned(16))) unsigned char smem_all[t8::STAGE_BYTES + 16384 + 16];
  const int G = gridDim.x, bid = blockIdx.x;
  const int half = __builtin_amdgcn_readfirstlane((int)(threadIdx.x >> 8));
  unsigned char* smem = smem_all + half * HALF_LDS;
  volatile LAS unsigned* stw = (volatile LAS unsigned*)(smem_all + t8::STAGE_BYTES + 16384);
  LAS unsigned char* lds8 = (LAS unsigned char*)smem_all;
  if (threadIdx.x == 0) { stw[0] = 0u; stw[1] = 0u; }
  __syncthreads();
  XcdBarrier bar = xcd_barrier_post(p.bar(), stw);

  PHASE_LOOP(192 + 1024 + MISC_ITEMS + CONV_ITEMS,
    if (it < 192) item_mod(p, smem, it);
    else if (it < 192 + 1024) item_rope(p, it - 192);
    else if (it < 192 + 1024 + MISC_ITEMS) item_misc(p, it - 192 - 1024);
    else item_conv(p, smem, 0, it - 192 - 1024 - MISC_ITEMS);
  )
  xcd_barrier(bar);
  PHASE_LOOP(T_ / 4, item_norm0(p, it);)
  xcd_barrier(bar);

  for (int l = 0; l < 2; ++l) {
    phase_p1(p, lds8, G, bid);
    xcd_barrier(bar);
    PHASE_LOOP(128 + 512 + 768 + 1024,
      if (it < 128) item_sgu(p, smem, l, it);
      else if (it < 640) item_pool(p, smem, l, it - 128);
      else if (it < 1408) item_qproj(p, smem, it - 640);
      else item_kvproj(p, smem, it - 1408);
    )
    xcd_barrier(bar);
    PHASE_LOOP(1024, item_attn(p, smem, it);)
    xcd_barrier(bar);
    phase_p4(p, lds8, l, G, bid);
    xcd_barrier(bar);
    PHASE_LOOP(512, item_p5(p, smem, l, it);)
    xcd_barrier(bar);
    phase_p7(p, lds8, l, G, bid);
    xcd_barrier(bar);
    phase_p8(p, lds8, l, G, bid);
    xcd_barrier(bar);
    const int n9 = T_ / 4 + (l == 0 ? CONV_ITEMS : 0);
    PHASE_LOOP(n9,
      if (it < T_ / 4) item_p9(p, l, it);
      else item_conv(p, smem, 1, it - T_ / 4);
    )
    if (l == 0) xcd_barrier(bar);
  }
}

extern "C" void kernel_launch(void* const* d_in, const int* in_sizes, int n_in, void* d_out, int out_size, void* d_ws, size_t ws_size,
                              hipStream_t stream) {
  P p{};
  p.x = (const float*)d_in[0]; p.c = (const float*)d_in[1]; p.pos = (const int*)d_in[2];
  p.w_ada = (const float*)d_in[3]; p.b_ada = (const float*)d_in[4]; p.w_in = (const float*)d_in[5]; p.w_pool = (const float*)d_in[6];
  p.pool_scale = (const float*)d_in[7]; p.w_spatial = (const float*)d_in[8]; p.b_spatial = (const float*)d_in[9]; p.g_q = (const float*)d_in[10];
  p.w_uq = (const float*)d_in[11]; p.g_kv = (const float*)d_in[12]; p.w_ukv = (const float*)d_in[13]; p.w_out = (const float*)d_in[14];
  p.w_router = (const float*)d_in[15]; p.router_bias = (const float*)d_in[16]; p.w_gate = (const float*)d_in[17]; p.w_up = (const float*)d_in[18];
  p.w_down = (const float*)d_in[19]; p.ws_gate = (const float*)d_in[20]; p.ws_up = (const float*)d_in[21]; p.ws_down = (const float*)d_in[22];
  p.final_gain = (const float*)d_in[23];
  p.out = (float*)d_out;
  p.ws = (unsigned char*)d_ws;
  if (WS_NEED > ws_size) { fprintf(stderr, "workspace too small: need %zu have %zu\n", WS_NEED, ws_size); return; }
  hipMemsetAsync(p.ws + O_BAR, 0, CTRL_BYTES, stream);
  static int grid_blocks = 0;
  if (!grid_blocks) {
    int dev = 0, cus = 0, per_cu = 0;
    hipGetDevice(&dev);
    hipDeviceGetAttribute(&cus, hipDeviceAttributeMultiprocessorCount, dev);
    hipOccupancyMaxActiveBlocksPerMultiprocessor(&per_cu, fwd_megakernel, BLOCK_THREADS, 0);
    if (per_cu > 1) per_cu = 1;
    if (per_cu < 1) per_cu = 1;
    grid_blocks = cus * per_cu;
  }
  void* args[] = {&p};
  hipError_t e = hipLaunchCooperativeKernel((void*)fwd_megakernel, dim3(grid_blocks), dim3(BLOCK_THREADS), args, 0, stream);
  if (e != hipSuccess) fprintf(stderr, "cooperative launch failed: %s (grid %d)\n", hipGetErrorString(e), grid_blocks);
}
```

```cpp
#include <hip/hip_runtime.h>
#include <stdint.h>
#include <cstdio>

#define DI __device__ __forceinline__
#define LAS __attribute__((address_space(3)))

typedef unsigned short bf16_t;
typedef short bf16x8 __attribute__((ext_vector_type(8)));
typedef short s16x4 __attribute__((ext_vector_type(4)));
typedef float f32x4 __attribute__((ext_vector_type(4)));
typedef float f32x2 __attribute__((ext_vector_type(2)));
typedef unsigned u32x4 __attribute__((ext_vector_type(4)));
typedef unsigned u32x2 __attribute__((ext_vector_type(2)));
typedef __bf16 bf16x2_t __attribute__((ext_vector_type(2)));

constexpr int T_ = 16384, D_ = 1024, S_ = 2048, NIN = 1184;
constexpr int NTHREADS = 256;
constexpr int BLOCK_THREADS = 512;
constexpr int SMEM_MAIN = 65536, SMEM_EXTRA = 2048;
constexpr float EPS = 1e-6f;
constexpr int CSTRIDE = 64;
constexpr int LISTCAP = 16384;
constexpr int CONV_SMALL = 592 + 24 + 16 + 128;
constexpr int CONV_BIG = 96 + 6144;
constexpr int CONV_ITEMS = CONV_SMALL + CONV_BIG;

constexpr size_t al256(size_t x) { return (x + 255) & ~(size_t)255; }
constexpr size_t CTRL_BYTES = (size_t)3456 * 4 + (size_t)2 * 64 * CSTRIDE * 4;
constexpr size_t O_BAR = 0;
constexpr size_t O_MOD = O_BAR + al256(CTRL_BYTES);
constexpr size_t O_ROPEC = O_MOD + al256((size_t)2 * 8 * 6144 * 4);
constexpr size_t O_ROPES = O_ROPEC + al256((size_t)T_ * 16 * 4);
constexpr size_t O_WIN = O_ROPES + al256((size_t)T_ * 16 * 4);
constexpr size_t O_WUQ = O_WIN + al256((size_t)1280 * 1024 * 2);
constexpr size_t O_WUKV = O_WUQ + al256((size_t)768 * 256 * 2);
constexpr size_t O_WOUT = O_WUKV + al256((size_t)1024 * 128 * 2);
constexpr size_t O_WSG = O_WOUT + al256((size_t)1024 * 1024 * 2);
constexpr size_t O_WSD = O_WSG + al256((size_t)512 * 1024 * 2);
constexpr size_t O_WSP = O_WSD + al256((size_t)1024 * 256 * 2);
constexpr size_t O_WPOOL = O_WSP + al256((size_t)2 * 4 * 128 * 128 * 2);
constexpr size_t O_WRHI = O_WPOOL + al256((size_t)2 * 4 * 64 * 64 * 2);
constexpr size_t O_WRLO = O_WRHI + al256((size_t)2 * 64 * 1024 * 2);
constexpr size_t O_WGU = O_WRLO + al256((size_t)2 * 64 * 1024 * 2);
constexpr size_t O_WD = O_WGU + al256((size_t)64 * 512 * 1024 * 2);
constexpr size_t O_H = O_WD + al256((size_t)64 * 1024 * 256 * 2);
constexpr size_t O_ACT = O_H + al256((size_t)T_ * 1024 * 2);
constexpr size_t O_YSH = O_ACT + al256((size_t)(T_ * 8 + T_) * 256 * 2);
constexpr size_t O_LIST = O_YSH + al256((size_t)T_ * 1024 * 2);
constexpr size_t O_TOPW = O_LIST + al256((size_t)64 * LISTCAP * 4);
constexpr size_t O_ROWSS = O_TOPW + al256((size_t)T_ * 8 * 4);
constexpr size_t O_BIG = O_ROWSS + al256((size_t)T_ * 16 * 4);
constexpr size_t O_YROWS = O_BIG;
constexpr size_t O_PROJ = O_BIG;
constexpr size_t O_Q = O_PROJ + al256((size_t)T_ * NIN * 2);
constexpr size_t O_KB = O_Q + al256((size_t)T_ * 8 * 96 * 2);
constexpr size_t O_V = O_KB + al256((size_t)T_ * 8 * 96 * 2);
constexpr size_t O_Y = O_V + al256((size_t)T_ * 8 * 64 * 2);
constexpr size_t WS_NEED = O_BIG + al256((size_t)T_ * 8 * 1024 * 2);

struct P {
  const float *x, *c; const int* pos;
  const float *w_ada, *b_ada, *w_in, *w_pool, *pool_scale, *w_spatial, *b_spatial, *g_q, *w_uq, *g_kv, *w_ukv, *w_out,
      *w_router, *router_bias, *w_gate, *w_up, *w_down, *ws_gate, *ws_up, *ws_down, *final_gain;
  float* out;
  unsigned char* ws;
  DI unsigned* bar() const { return (unsigned*)(ws + O_BAR); }
  DI int* cnt() const { return (int*)(ws + O_BAR) + 3456; }
  DI float* mod() const { return (float*)(ws + O_MOD); }
  DI float* ropec() const { return (float*)(ws + O_ROPEC); }
  DI float* ropes() const { return (float*)(ws + O_ROPES); }
  DI bf16_t* win_t() const { return (bf16_t*)(ws + O_WIN); }
  DI bf16_t* wuq_t() const { return (bf16_t*)(ws + O_WUQ); }
  DI bf16_t* wukv_t() const { return (bf16_t*)(ws + O_WUKV); }
  DI bf16_t* wout_t() const { return (bf16_t*)(ws + O_WOUT); }
  DI bf16_t* wsg_t() const { return (bf16_t*)(ws + O_WSG); }
  DI bf16_t* wsd_t() const { return (bf16_t*)(ws + O_WSD); }
  DI bf16_t* wsp_b() const { return (bf16_t*)(ws + O_WSP); }
  DI bf16_t* wpool_t() const { return (bf16_t*)(ws + O_WPOOL); }
  DI bf16_t* wr_hi() const { return (bf16_t*)(ws + O_WRHI); }
  DI bf16_t* wr_lo() const { return (bf16_t*)(ws + O_WRLO); }
  DI bf16_t* wgu_t() const { return (bf16_t*)(ws + O_WGU); }
  DI bf16_t* wd_t() const { return (bf16_t*)(ws + O_WD); }
  DI bf16_t* h() const { return (bf16_t*)(ws + O_H); }
  DI bf16_t* act() const { return (bf16_t*)(ws + O_ACT); }
  DI bf16_t* ysh() const { return (bf16_t*)(ws + O_YSH); }
  DI int* list() const { return (int*)(ws + O_LIST); }
  DI float* topw() const { return (float*)(ws + O_TOPW); }
  DI float* rowss() const { return (float*)(ws + O_ROWSS); }
  DI bf16_t* yrows() const { return (bf16_t*)(ws + O_YROWS); }
  DI bf16_t* proj() const { return (bf16_t*)(ws + O_PROJ); }
  DI bf16_t* Q() const { return (bf16_t*)(ws + O_Q); }
  DI bf16_t* Kb() const { return (bf16_t*)(ws + O_KB); }
  DI bf16_t* V() const { return (bf16_t*)(ws + O_V); }
  DI bf16_t* Y() const { return (bf16_t*)(ws + O_Y); }
};

DI unsigned pack2(float lo, float hi) { f32x2 f = {lo, hi}; bf16x2_t b = __builtin_convertvector(f, bf16x2_t); return __builtin_bit_cast(unsigned, b); }
DI float bf2f(unsigned short b) { return __uint_as_float(((unsigned)b) << 16); }
DI float bflo(unsigned u) { return __uint_as_float(u << 16); }
DI float bfhi(unsigned u) { return __uint_as_float(u & 0xffff0000u); }
DI int otid() { int t = threadIdx.x & 255; asm volatile("" : "+v"(t)); return t; }
constexpr float YSCALE = 16.f;
DI unsigned pack4_fp8(f32x4 v) {
  const float a = __builtin_amdgcn_fmed3f(v[0], -448.f, 448.f), b = __builtin_amdgcn_fmed3f(v[1], -448.f, 448.f), c = __builtin_amdgcn_fmed3f(v[2], -448.f, 448.f), d = __builtin_amdgcn_fmed3f(v[3], -448.f, 448.f);
  int w = 0; w = __builtin_amdgcn_cvt_pk_fp8_f32(a, b, w, false); w = __builtin_amdgcn_cvt_pk_fp8_f32(c, d, w, true); return (unsigned)w;
}
DI float wsum(float v) { for (int o = 32; o; o >>= 1) v += __shfl_xor(v, o); return v; }
DI float silu_f(float x) { return x / (1.f + __expf(-x)); }
DI float gelu_tanh(float x) { float z = 0.7978845608028654f * (x + 0.044715f * x * x * x); float e = __expf(2.f * z); float t = 1.f - 2.f / (1.f + e); return 0.5f * x * (1.f + t); }

#define XB_TMO      128
#define XB_XCNT(j)  (256  + 64 * (j))
#define XB_XSUB(j)  (1280 + 64 * (j))
#define XB_XGEN(j)  (2304 + 64 * (j))
#define XB_TOP      3328
#define XB_TOPGEN   3392
#define XCD_BAR_WORDS 3456
#define XB_SPIN_CAP (1u << 20)
DI unsigned xb_ld(unsigned* p) { return __hip_atomic_load(p, __ATOMIC_RELAXED, __HIP_MEMORY_SCOPE_AGENT); }
DI unsigned xb_add(unsigned* p, unsigned v) { return __hip_atomic_fetch_add(p, v, __ATOMIC_RELAXED, __HIP_MEMORY_SCOPE_AGENT); }
DI unsigned xb_xcc_id() { return (unsigned)__builtin_amdgcn_s_getreg((3 << 11) | 20) & 0xFu; }
#define XB_SPIN(cond, bar) do { unsigned _sp = 0; while (cond) { __builtin_amdgcn_s_sleep(1); \
    if ((++_sp & 255u) == 0u) { if (xb_ld(&(bar)[XB_TMO])) break; if (_sp > XB_SPIN_CAP) { atomicAdd(&(bar)[XB_TMO], 1u); break; } } } } while (0)
struct XcdBarrier { unsigned* bar; unsigned x; volatile LAS unsigned* st; };
DI XcdBarrier xcd_barrier_post(unsigned* bar, volatile LAS unsigned* st) {
  XcdBarrier b; b.bar = bar; b.x = xb_xcc_id(); b.st = st;
  if (threadIdx.x == 0) (void)xb_add(&bar[XB_XCNT(b.x)], 1u);
  return b;
}
DI void xcd_barrier_complete(unsigned* bar, unsigned x, unsigned& nloc, unsigned& nx) {
  const unsigned G = gridDim.x * gridDim.y * gridDim.z;
  unsigned sum, cnt, mine, sp = 0u;
  for (;;) {
    sum = 0u; cnt = 0u; mine = 0u;
#pragma unroll
    for (unsigned j = 0; j < 16; ++j) { const unsigned c = xb_ld(&bar[XB_XCNT(j)]); sum += c; cnt += (c > 0u) ? 1u : 0u; mine = (j == x) ? c : mine; }
    if (sum == G) break;
    __builtin_amdgcn_s_sleep(1);
    if ((++sp & 255u) == 0u) { if (xb_ld(&bar[XB_TMO])) break; if (sp > XB_SPIN_CAP) { atomicAdd(&bar[XB_TMO], 1u); break; } }
  }
  nloc = mine > 0u ? mine : 1u; nx = cnt > 0u ? cnt : 1u;
}
DI void xcd_barrier(const XcdBarrier& b0) {
  XcdBarrier b = b0; b.x = xb_xcc_id();
  asm volatile("s_waitcnt vmcnt(0)" ::: "memory");
  __syncthreads();
  if (threadIdx.x == 0) {
    unsigned* bar = b.bar;
    __builtin_amdgcn_s_waitcnt(0);
    unsigned nloc = b.st[0], nx = b.st[1];
    if (nloc == 0u) { xcd_barrier_complete(bar, b.x, nloc, nx); b.st[0] = nloc; b.st[1] = nx; }
    const unsigned old = xb_add(&bar[XB_XSUB(b.x)], 1u);
    const unsigned gen = old / nloc;
    if (old + 1u == (gen + 1u) * nloc) {
      __builtin_amdgcn_fence(__ATOMIC_RELEASE, "agent");
      asm volatile("s_waitcnt vmcnt(0)" ::: "memory");
      const unsigned og = xb_add(&bar[XB_TOP], 1u);
      const unsigned tg = og / nx;
      if (og + 1u == (tg + 1u) * nx) xb_add(&bar[XB_TOPGEN], 1u);
      else XB_SPIN(xb_ld(&bar[XB_TOPGEN]) == tg, bar);
      __builtin_amdgcn_fence(__ATOMIC_ACQUIRE, "agent");
      xb_add(&bar[XB_XGEN(b.x)], 1u);
      asm volatile("s_waitcnt vmcnt(0)" ::: "memory");
    } else {
      XB_SPIN(xb_ld(&bar[XB_XGEN(b.x)]) == gen, bar);
      __builtin_amdgcn_fence(__ATOMIC_ACQUIRE, "agent");
      asm volatile("s_waitcnt vmcnt(0)" ::: "memory");
    }
  }
  __syncthreads();
}


template <int RB> DI void ot_put(unsigned char* base, int row, int unit, u32x2 v) { *(u32x2*)(base + row * RB + ((unit ^ (row & 15)) << 3)) = v; }
template <int RB> DI u32x4 ot_get(const unsigned char* base, int row, int chunk) {
  const u32x4 v = *(const u32x4*)(base + row * RB + ((chunk ^ ((row & 15) >> 1)) << 4));
  return (row & 1) ? (u32x4){v.z, v.w, v.x, v.y} : v;
}

template <class Epi>
DI void gemm128_stream(unsigned char* smem, const unsigned char* abase, const unsigned (&ao)[4], const unsigned char* bbase, const unsigned (&bo)[4], int nk, int ntile, size_t btile_stride, Epi&& epi) {
  const int tid = otid(), lane = tid & 63, w = tid >> 6;
  const int wm = w >> 1, wn = w & 1;
  const int r_s = tid >> 3, c_s = tid & 7;
  const int st_off = r_s * 128 + ((c_s ^ (r_s & 7)) << 4);
  const int fr = lane & 15, fq = lane >> 4;
  const int sw0 = ((0 + fq) ^ (fr & 7)) << 4, sw1 = ((4 + fq) ^ (fr & 7)) << 4;
  const int arow_off = (wm * 64 + fr) * 128, brow_off = 32768 + (wn * 64 + fr) * 128;
  u32x4 ra0[4], rb0[4], ra1[4], rb1[4];
  f32x4 acc[4][4];
#pragma unroll
  for (int i = 0; i < 4; ++i)
#pragma unroll
    for (int j = 0; j < 4; ++j) acc[i][j] = (f32x4){0.f, 0.f, 0.f, 0.f};
  const int total = nk * ntile;
  int lkt = 0, ltl = 0;
  auto load = [&](u32x4 (&ra)[4], u32x4 (&rb)[4]) {
    const unsigned char* ab = abase + lkt * 128;
    const unsigned char* bb = bbase + ((size_t)ltl * btile_stride + lkt * 64) * 2;
#pragma unroll
    for (int j = 0; j < 4; ++j) { ra[j] = *(const u32x4*)(ab + ao[j]); rb[j] = *(const u32x4*)(bb + bo[j]); }
    const bool last = (lkt == nk - 1) && (ltl == ntile - 1);
    const int nl = (lkt == nk - 1) ? 0 : lkt + 1;
    ltl = last ? ltl : ((lkt == nk - 1) ? ltl + 1 : ltl);
    lkt = last ? lkt : nl;
  };
  auto store = [&](const u32x4 (&ra)[4], const u32x4 (&rb)[4], int bufo) {
#pragma unroll
    for (int j = 0; j < 4; ++j) { *(u32x4*)(smem + bufo + st_off + j * 4096) = ra[j]; *(u32x4*)(smem + 32768 + bufo + st_off + j * 4096) = rb[j]; }
  };
  int kt = 0, tile = 0;
  auto body = [&](int s, int cur, u32x4 (&lra)[4], u32x4 (&lrb)[4], const u32x4 (&wra)[4], const u32x4 (&wrb)[4]) {
    load(lra, lrb);
#pragma unroll
    for (int ks = 0; ks < 2; ++ks) {
      const int sw = ks ? sw1 : sw0;
      bf16x8 af[4], bfr[4];
#pragma unroll
      for (int i = 0; i < 4; ++i) af[i] = *(const bf16x8*)(smem + cur + arow_off + i * 2048 + sw);
#pragma unroll
      for (int j = 0; j < 4; ++j) bfr[j] = *(const bf16x8*)(smem + cur + brow_off + j * 2048 + sw);
#pragma unroll
      for (int i = 0; i < 4; ++i)
#pragma unroll
        for (int j = 0; j < 4; ++j) acc[i][j] = __builtin_amdgcn_mfma_f32_16x16x32_bf16(bfr[j], af[i], acc[i][j], 0, 0, 0);
    }
    if (s + 1 < total) store(wra, wrb, 16384 - cur);
    if (kt == nk - 1) {
      int wm2 = wm, wn2 = wn, fr2 = fr, fq2 = fq;
      asm volatile("" : "+v"(wm2), "+v"(wn2), "+v"(fr2), "+v"(fq2));
      epi(acc, tile, cur, wm2, wn2, fr2, fq2);
#pragma unroll
      for (int i = 0; i < 4; ++i)
#pragma unroll
        for (int j = 0; j < 4; ++j) acc[i][j] = (f32x4){0.f, 0.f, 0.f, 0.f};
    }
    __syncthreads();
    if (++kt == nk) { kt = 0; ++tile; }
  };
  load(ra0, rb0);
  load(ra1, rb1);
  store(ra0, rb0, 0);
  __syncthreads();
  for (int s = 0; s < total; s += 2) {
    body(s, 0, ra0, rb0, ra1, rb1);
    if (s + 1 >= total) break;
    body(s + 1, 16384, ra1, rb1, ra0, rb0);
  }
}
template <class Epi>
DI void gemm128(unsigned char* smem, const unsigned char* abase, const unsigned (&ao)[4], const unsigned char* bbase, const unsigned (&bo)[4], int nk, Epi&& epi) {
  gemm128_stream(smem, abase, ao, bbase, bo, nk, 1, 0, [&](f32x4 (&acc)[4][4], int, int, int wm, int wn, int fr, int fq) { __syncthreads(); epi(acc, wm, wn, fr, fq); });
}


namespace t8 {
constexpr int BM = 256, BK = 64, HALF = 128, HTB = HALF * BK * 2, STAGE_BYTES = 8 * HTB;
DI int lds_byte(int r, int c) { const int st = (r >> 4) * 2 + (c >> 5), rr = r & 15, cc = c & 31, ob = rr * 64 + cc * 2; return st * 1024 + (ob ^ (((ob >> 9) & 1) << 5)); }
DI void stage_rc(int b, int& R, int& C) { const int st = b / 1024, sb = b % 1024, swz = sb ^ (((sb >> 9) & 1) << 5); R = (st >> 1) * 16 + swz / 64; C = (st & 1) * 32 + (swz % 64) / 2; }
DI int perm32(int rho) { const int n = rho >> 4, i = rho & 15; return 8 * (i >> 2) + 4 * n + (i & 3); }
struct Unit { int pm, pn, tab; const unsigned char* bbase; };
constexpr int TAB_OFF = STAGE_BYTES;
constexpr int START_OFF = STAGE_BYTES + 12288;

template <bool PERM, class Sched, class RowOff, class Epi>
DI void gemm_phase(LAS unsigned char* lds, const unsigned char* Abase, const int K, const Sched& S, const RowOff& RO, const Epi& E) {
  int tid = threadIdx.x; asm volatile("" : "+v"(tid));
  const int wid = __builtin_amdgcn_readfirstlane(tid >> 6), lane = tid & 63, wr = wid >> 2, wc = wid & 3, fr = lane & 15, fq = lane >> 4;
  const int nt = K / BK;
  unsigned voffB[2][2];
#pragma unroll
  for (int h = 0; h < 2; ++h)
#pragma unroll
    for (int i = 0; i < 2; ++i) { int R, C; stage_rc(tid * 16 + i * 8192, R, C); const int rho = h * HALF + R;
      const int Rb = PERM ? (((rho >> 5) & 3) * 64 + ((rho >> 2) & 3) * 16 + (rho >> 7) * 8 + ((rho >> 4) & 1) * 4 + (rho & 3)) : rho; voffB[h][i] = (unsigned)(Rb * K + C) * 2u; }
  auto apiece = [&](const Unit& u, int h, int i) -> unsigned { int R, C; stage_rc(tid * 16 + i * 8192, R, C); return RO(u, h * HALF + R) + (unsigned)(C * 2); };
  const size_t kstep = (size_t)(BK * 2);
  const unsigned ldsw = (unsigned)wid * 1024u;
  const int aoff = lds_byte(wr * 64 + fr, fq * 8), boff = lds_byte(wc * 32 + fr, fq * 8);
  LAS const unsigned char* ldsA = lds + aoff; LAS const unsigned char* ldsB = lds + 4 * HTB + boff;
  asm volatile("" : "+v"(ldsA), "+v"(ldsB));
#define T8_SA(b, h) (((b) * 2 + (h)) * HTB)
#define T8_SB(b, h) ((4 + (b) * 2 + (h)) * HTB)
#define T8_STAGE(bufoff, gbase, voff) do { _Pragma("unroll") for (int _i = 0; _i < 2; ++_i) \
    __builtin_amdgcn_global_load_lds((const unsigned*)((const char*)(gbase) + (voff)[_i]), (LAS unsigned*)(lds + (bufoff) + ldsw + _i * 8192), 16, 0, 0); } while (0)
#define T8_LDA(dst, b, h) do { _Pragma("unroll") for (int m = 0; m < 4; ++m) _Pragma("unroll") for (int k = 0; k < 2; ++k) dst[m][k] = *(const LAS bf16x8*)(ldsA + T8_SA(b, h) + m * 2048 + k * 1024); } while (0)
#define T8_LDB(dst, b, h) do { _Pragma("unroll") for (int n = 0; n < 2; ++n) _Pragma("unroll") for (int k = 0; k < 2; ++k) dst[n][k] = *(const LAS bf16x8*)(ldsB + (T8_SB(b, h) - 4 * HTB) + n * 2048 + k * 1024); } while (0)
#define T8_MMA(ai, bj, At, Bt) do { __builtin_amdgcn_s_setprio(1); _Pragma("unroll") for (int m = 0; m < 4; ++m) _Pragma("unroll") for (int n = 0; n < 2; ++n) _Pragma("unroll") for (int k = 0; k < 2; ++k) \
    acc[ai][bj][m][n] = __builtin_amdgcn_mfma_f32_16x16x32_bf16(Bt[n][k], At[m][k], acc[ai][bj][m][n], 0, 0, 0); __builtin_amdgcn_s_setprio(0); } while (0)
#define T8_WAIT_V(n) asm volatile("s_waitcnt vmcnt(" #n ")" ::: "memory")
#define T8_WAIT_L(n) asm volatile("s_waitcnt lgkmcnt(" #n ")" ::: "memory")
#define T8_BAR __builtin_amdgcn_s_barrier()
#define T8_SCHED __builtin_amdgcn_sched_barrier(0)
  Unit cur, nxt; int ui = 0;
  if (!S.next(0, cur)) return;
  f32x4 acc[2][2][4][2];
#pragma unroll
  for (int a = 0; a < 2; ++a)
#pragma unroll
    for (int b = 0; b < 2; ++b)
#pragma unroll
      for (int m = 0; m < 4; ++m)
#pragma unroll
        for (int n = 0; n < 2; ++n) acc[a][b][m][n] = (f32x4){0.f, 0.f, 0.f, 0.f};
  bf16x8 At[4][2], B0[2][2], B1[2][2];
  unsigned vc[2][2];
#pragma unroll
  for (int h = 0; h < 2; ++h)
#pragma unroll
    for (int i = 0; i < 2; ++i) vc[h][i] = apiece(cur, h, i);
  const char* cB = (const char*)cur.bbase;
  const char* gA = (const char*)Abase;
  T8_STAGE(T8_SB(0, 0), cB, voffB[0]); T8_STAGE(T8_SA(0, 0), gA, vc[0]); T8_STAGE(T8_SB(0, 1), cB, voffB[1]); T8_STAGE(T8_SA(0, 1), gA, vc[1]);
  if (wr == 1) T8_BAR;
  T8_WAIT_V(4); T8_BAR;
  T8_STAGE(T8_SB(1, 0), cB + kstep, voffB[0]); T8_STAGE(T8_SA(1, 0), gA + kstep, vc[0]); T8_STAGE(T8_SB(1, 1), cB + kstep, voffB[1]);
  T8_WAIT_V(6); T8_BAR;
  for (;;) {
    const bool has_next = S.next(ui + 1, nxt);
    const char* nB = has_next ? (const char*)nxt.bbase : cB;
#pragma unroll 1
    for (int t = 0; t < nt; t += 2) {
      const bool last = (t == nt - 2);
      const char* a1 = gA + (size_t)(t + 1) * kstep;
      const char* a2 = last ? gA : gA + (size_t)(t + 2) * kstep; const char* b2 = last ? nB : cB + (size_t)(t + 2) * kstep;
      const char* a3 = a2 + kstep; const char* b3 = b2 + kstep;
      if (last && has_next) { vc[0][0] = apiece(nxt, 0, 0); vc[0][1] = apiece(nxt, 0, 1); }
      T8_LDB(B0, 0, 0); T8_SCHED; T8_LDA(At, 0, 0); T8_STAGE(T8_SA(1, 1), a1, vc[1]);
      T8_WAIT_L(8); T8_BAR; T8_WAIT_L(0); T8_MMA(0, 0, At, B0); T8_BAR; T8_SCHED;
      if (last && has_next) { vc[1][0] = apiece(nxt, 1, 0); vc[1][1] = apiece(nxt, 1, 1); }
      T8_LDB(B1, 0, 1); T8_STAGE(T8_SB(0, 0), b2, voffB[0]);
      T8_BAR; T8_WAIT_L(0); T8_MMA(0, 1, At, B1); T8_BAR;
      T8_LDA(At, 0, 1); T8_STAGE(T8_SA(0, 0), a2, vc[0]);
      T8_BAR; T8_WAIT_L(0); T8_MMA(1, 0, At, B0); T8_BAR; T8_SCHED;
      T8_STAGE(T8_SB(0, 1), b2, voffB[1]);
      T8_WAIT_V(6); T8_BAR; T8_MMA(1, 1, At, B1); T8_BAR;
      T8_LDB(B0, 1, 0); T8_SCHED; T8_LDA(At, 1, 0); T8_STAGE(T8_SA(0, 1), a2, vc[1]);
      T8_WAIT_L(8); T8_BAR; T8_WAIT_L(0); T8_MMA(0, 0, At, B0); T8_BAR; T8_SCHED;
      T8_LDB(B1, 1, 1); T8_STAGE(T8_SB(1, 0), b3, voffB[0]);
      T8_BAR; T8_WAIT_L(0); T8_MMA(0, 1, At, B1); T8_BAR;
      T8_LDA(At, 1, 1); T8_STAGE(T8_SA(1, 0), a3, vc[0]);
      T8_BAR; T8_WAIT_L(0); T8_MMA(1, 0, At, B0); T8_BAR; T8_SCHED;
      T8_STAGE(T8_SB(1, 1), b3, voffB[1]);
      T8_WAIT_V(6); T8_BAR; T8_MMA(1, 1, At, B1); T8_BAR;
    }
    E(acc, cur, wr, wc, fr, fq);
    if (!has_next) break;
#pragma unroll
    for (int a = 0; a < 2; ++a)
#pragma unroll
      for (int b = 0; b < 2; ++b)
#pragma unroll
        for (int m = 0; m < 4; ++m)
#pragma unroll
          for (int n = 0; n < 2; ++n) acc[a][b][m][n] = (f32x4){0.f, 0.f, 0.f, 0.f};
    cur = nxt; cB = nB; ++ui;
  }
  T8_WAIT_V(0);
  if (wr == 0) T8_BAR;
  T8_BAR;
#undef T8_SA
#undef T8_SB
#undef T8_STAGE
#undef T8_LDA
#undef T8_LDB
#undef T8_MMA
#undef T8_WAIT_V
#undef T8_WAIT_L
#undef T8_BAR
#undef T8_SCHED
}

struct DenseSched {
  int nM, nN, nwg, G, c; const unsigned char* Bt; size_t tstep;
  DI void init(int M, int N, int K, int G_, int c_, const void* Bt_) { nM = M / BM; nN = N / BM; nwg = nM * nN; G = G_; c = c_; Bt = (const unsigned char*)Bt_; tstep = (size_t)BM * K * 2; }
  DI bool next(int i, Unit& u) const {
    const long L = (long)i * G + c; if (L >= nwg) return false;
    int wgid = (int)L; { const int q = nwg / 8, r = nwg % 8, xcd = wgid % 8, off = wgid / 8; wgid = (xcd < r ? xcd * (q + 1) : r * (q + 1) + (xcd - r) * q) + off; }
    const int nig = 8 * nN, gid = wgid / nig, fm = gid * 8, gsz = (nM - fm) < 8 ? (nM - fm) : 8;
    u.pm = fm + ((wgid % nig) % gsz); u.pn = (wgid % nig) / gsz; u.tab = 0; u.bbase = Bt + (size_t)u.pn * tstep; return true;
  }
};
struct DenseRows { unsigned rowbytes; DI unsigned operator()(const Unit& u, int row) const { return (unsigned)(u.pm * BM + row) * rowbytes; } };

struct MoeSched {
  LAS const int* start; int npn, nmt, G, c; const unsigned char* wexp; const unsigned char* wsh; size_t estride, tstep;
  DI bool locate(int i, int& mt, int& pn, int& tab) const {
    const int R = nmt / G;
    if (i < R * npn) { const int r = i / npn; pn = i - r * npn; mt = r * G + c; tab = r; return true; }
    const int j = i - R * npn, L = j * G + c, rem = (nmt - R * G) * npn;
    if (L >= rem) return false;
    const int q = L / npn; pn = L - q * npn; mt = R * G + q; tab = R + j; return true;
  }
  DI bool next(int i, Unit& u) const {
    int mt, pn, tab;
    if (!locate(i, mt, pn, tab)) return false;
    u.pm = mt; u.pn = pn; u.tab = tab;
    const int e = __builtin_amdgcn_readfirstlane(start[128 + tab]);
    u.bbase = (e == 64 ? wsh : wexp + (size_t)e * estride) + (size_t)pn * tstep; return true;
  }
};
}

DI void moe_prepare(const P& p, LAS unsigned char* lds, int l, int npn, int G, int c, int& total_units) {
  LAS int* start = (LAS int*)(lds + t8::START_OFF);
  __syncthreads();
  if (threadIdx.x == 0) {
    int s = 0;
    for (int e = 0; e < 64; ++e) { start[e] = s; s += (p.cnt()[(l * 64 + e) * CSTRIDE] + 255) >> 8; }
    start[64] = s; start[65] = s + 64;
  }
  __syncthreads();
  const int nmt = start[65];
  total_units = nmt;
  int tid = threadIdx.x; asm volatile("" : "+v"(tid));
  t8::MoeSched S{start, npn, nmt, G, c, nullptr, nullptr, 0, 0};
  int last_tab = -1;
  for (int i = 0; i < 16; ++i) {
    int mt, pn, tab;
    if (!S.locate(i, mt, pn, tab)) break;
    if (tab == last_tab) continue;
    last_tab = tab;
    int e = 64;
    if (mt < start[64]) {
      e = 0;
#pragma unroll 4
      for (int q = 1; q < 64; ++q) e = (start[q] <= mt) ? q : e;
    }
    if (tid == 0) start[128 + tab] = e;
    if (tid < 256) {
      int slot;
      if (mt >= start[64]) slot = T_ * 8 + (mt - start[64]) * 256 + tid;
      else {
        const int idx = (mt - start[e]) * 256 + tid;
        slot = idx < p.cnt()[(l * 64 + e) * CSTRIDE] ? p.list()[(size_t)e * LISTCAP + idx] : -1;
      }
      ((LAS int*)(lds + t8::TAB_OFF))[tab * 256 + tid] = slot;
    }
  }
  __syncthreads();
}

DI void item_mod(const P& p, unsigned char* smem, int item) {
  const int l = item / 96, cb = item % 96;
  const int tid = otid(), w = tid >> 6, lane = tid & 63;
  float* sc = (float*)smem;
  float* red = (float*)(smem + 32768);
  __syncthreads();
  for (int i = tid; i < 8192; i += NTHREADS) sc[i] = silu_f(p.c[i]);
  __syncthreads();
  const int col = cb * 64 + lane;
  const float* W = p.w_ada + (size_t)l * 1024 * 6144 + col;
  float acc[8];
#pragma unroll
  for (int b = 0; b < 8; ++b) acc[b] = 0.f;
  for (int k0 = w * 256; k0 < w * 256 + 256; k0 += 16) {
    float wv[16];
#pragma unroll
    for (int u = 0; u < 16; ++u) wv[u] = W[(size_t)(k0 + u) * 6144];
#pragma unroll
    for (int u = 0; u < 16; ++u)
#pragma unroll
      for (int b = 0; b < 8; ++b) acc[b] += sc[b * 1024 + k0 + u] * wv[u];
  }
#pragma unroll
  for (int b = 0; b < 8; ++b) red[(w * 8 + b) * 64 + lane] = acc[b];
  __syncthreads();
  for (int o = tid; o < 512; o += NTHREADS) {
    const int b = o >> 6, cc = o & 63;
    const float v = red[(0 * 8 + b) * 64 + cc] + red[(1 * 8 + b) * 64 + cc] + red[(2 * 8 + b) * 64 + cc] + red[(3 * 8 + b) * 64 + cc];
    p.mod()[((size_t)l * 8 + b) * 6144 + cb * 64 + cc] = v + p.b_ada[(size_t)l * 6144 + cb * 64 + cc];
  }
}

DI void conv_tile(unsigned char* smem, const float* src, int ldsrc, int k0, int n0, bf16_t* dst, int lddst, int mode, const float* kscale) {
  float* t = (float*)smem;
  const int tid = otid();
  __syncthreads();
  {
    const int kk = tid >> 3, nq = tid & 7;
#pragma unroll
    for (int hh = 0; hh < 2; ++hh) {
      const int k = kk + 32 * hh;
      const float4 v = *(const float4*)(src + (size_t)(k0 + k) * ldsrc + n0 + nq * 4);
      const float s = kscale ? kscale[k0 + k] : 1.f;
      t[k * 33 + nq * 4 + 0] = v.x * s; t[k * 33 + nq * 4 + 1] = v.y * s; t[k * 33 + nq * 4 + 2] = v.z * s; t[k * 33 + nq * 4 + 3] = v.w * s;
    }
  }
  __syncthreads();
  {
    const int n = tid >> 3, kc = tid & 7;
    u32x4 wv;
    wv.x = pack2(t[(kc * 8 + 0) * 33 + n], t[(kc * 8 + 1) * 33 + n]);
    wv.y = pack2(t[(kc * 8 + 2) * 33 + n], t[(kc * 8 + 3) * 33 + n]);
    wv.z = pack2(t[(kc * 8 + 4) * 33 + n], t[(kc * 8 + 5) * 33 + n]);
    wv.w = pack2(t[(kc * 8 + 6) * 33 + n], t[(kc * 8 + 7) * 33 + n]);
    const int nn = n0 + n;
    const int orow = (mode == 0) ? nn : (256 * (nn >> 7) + 16 * ((nn & 127) >> 3) + (mode == 2 ? 8 : 0) + (nn & 7));
    *(u32x4*)(dst + (size_t)orow * lddst + k0 + kc * 8) = wv;
  }
}

DI void conv_big(unsigned char* smem, const float* src, int ldsrc, int k0, int n0, bf16_t* dst, int lddst, int mode, const float* kscale) {
  float* t = (float*)smem;
  const int tid = otid();
  __syncthreads();
  {
    const int c4 = tid & 31, r0 = tid >> 5;
    float4 v[8];
#pragma unroll
    for (int hh = 0; hh < 8; ++hh) v[hh] = *(const float4*)(src + (size_t)(k0 + r0 + 8 * hh) * ldsrc + n0 + c4 * 4);
#pragma unroll
    for (int hh = 0; hh < 8; ++hh) {
      const int k = r0 + 8 * hh;
      const float sc = kscale ? kscale[k0 + k] : 1.f;
      *(float4*)(t + k * 132 + c4 * 4) = (float4){v[hh].x * sc, v[hh].y * sc, v[hh].z * sc, v[hh].w * sc};
    }
  }
  __syncthreads();
  {
    const int n = tid >> 1, kh = tid & 1;
    const int nn = n0 + n;
    const int orow = (mode == 0) ? nn : (256 * (nn >> 7) + 16 * ((nn & 127) >> 3) + (mode == 2 ? 8 : 0) + (nn & 7));
    bf16_t* d = dst + (size_t)orow * lddst + k0 + kh * 32;
#pragma unroll
    for (int c = 0; c < 4; ++c) {
      const float* tp = t + (kh * 32 + c * 8) * 132 + n;
      u32x4 wv;
      wv.x = pack2(tp[0 * 132], tp[1 * 132]); wv.y = pack2(tp[2 * 132], tp[3 * 132]); wv.z = pack2(tp[4 * 132], tp[5 * 132]); wv.w = pack2(tp[6 * 132], tp[7 * 132]);
      *(u32x4*)(d + c * 8) = wv;
    }
  }
}

DI void item_conv(const P& p, unsigned char* smem, int l, int idx) {
  if (idx < 592) { conv_tile(smem, p.w_in + (size_t)l * 1024 * NIN, NIN, (idx / 37) * 64, (idx % 37) * 32, p.win_t(), 1024, 0, nullptr); return; }
  idx -= 592;
  if (idx < 24) { conv_big(smem, p.w_uq + (size_t)l * 256 * 768, 768, (idx / 6) * 64, (idx % 6) * 128, p.wuq_t(), 256, 0, p.g_q + l * 256); return; }
  idx -= 24;
  if (idx < 16) { conv_big(smem, p.w_ukv + (size_t)l * 128 * 1024, 1024, (idx / 8) * 64, (idx % 8) * 128, p.wukv_t(), 128, 0, p.g_kv + l * 128); return; }
  idx -= 16;
  if (idx < 128) { conv_big(smem, p.w_out + (size_t)l * 1024 * 1024, 1024, (idx / 8) * 64, (idx % 8) * 128, p.wout_t(), 1024, 0, nullptr); return; }
  idx -= 128;
  if (idx < 32) { conv_big(smem, p.ws_gate + (size_t)l * 1024 * 256, 256, (idx / 2) * 64, (idx % 2) * 128, p.wsg_t(), 1024, 1, nullptr); return; }
  idx -= 32;
  if (idx < 32) { conv_big(smem, p.ws_up + (size_t)l * 1024 * 256, 256, (idx / 2) * 64, (idx % 2) * 128, p.wsg_t(), 1024, 2, nullptr); return; }
  idx -= 32;
  if (idx < 32) { conv_big(smem, p.ws_down + (size_t)l * 256 * 1024, 1024, (idx / 8) * 64, (idx % 8) * 128, p.wsd_t(), 256, 0, nullptr); return; }
  idx -= 32;
  const int e = idx / 96, r = idx % 96;
  if (r < 32) conv_big(smem, p.w_gate + ((size_t)l * 64 + e) * 1024 * 256, 256, (r / 2) * 64, (r % 2) * 128, p.wgu_t() + (size_t)e * 512 * 1024, 1024, 1, nullptr);
  else if (r < 64) conv_big(smem, p.w_up + ((size_t)l * 64 + e) * 1024 * 256, 256, ((r - 32) / 2) * 64, ((r - 32) % 2) * 128, p.wgu_t() + (size_t)e * 512 * 1024, 1024, 2, nullptr);
  else conv_big(smem, p.w_down + ((size_t)l * 64 + e) * 256 * 1024, 1024, ((r - 64) / 8) * 64, ((r - 64) % 8) * 128, p.wd_t() + (size_t)e * 1024 * 256, 256, 0, nullptr);
}


DI void conv_big_desc(const P& p, int l, int idx, const float*& src, int& ldsrc, int& k0, int& n0, bf16_t*& dst, int& lddst, int& mode) {
  if (idx < 32) { src = p.ws_gate + (size_t)l * 1024 * 256; ldsrc = 256; k0 = (idx / 2) * 64; n0 = (idx % 2) * 128; dst = p.wsg_t(); lddst = 1024; mode = 1; return; }
  idx -= 32;
  if (idx < 32) { src = p.ws_up + (size_t)l * 1024 * 256; ldsrc = 256; k0 = (idx / 2) * 64; n0 = (idx % 2) * 128; dst = p.wsg_t(); lddst = 1024; mode = 2; return; }
  idx -= 32;
  if (idx < 32) { src = p.ws_down + (size_t)l * 256 * 1024; ldsrc = 1024; k0 = (idx / 8) * 64; n0 = (idx % 8) * 128; dst = p.wsd_t(); lddst = 256; mode = 0; return; }
  idx -= 32;
  const int e = idx / 96, r = idx % 96;
  if (r < 32) { src = p.w_gate + ((size_t)l * 64 + e) * 1024 * 256; ldsrc = 256; k0 = (r / 2) * 64; n0 = (r % 2) * 128; dst = p.wgu_t() + (size_t)e * 512 * 1024; lddst = 1024; mode = 1; }
  else if (r < 64) { src = p.w_up + ((size_t)l * 64 + e) * 1024 * 256; ldsrc = 256; k0 = ((r - 32) / 2) * 64; n0 = ((r - 32) % 2) * 128; dst = p.wgu_t() + (size_t)e * 512 * 1024; lddst = 1024; mode = 2; }
  else { src = p.w_down + ((size_t)l * 64 + e) * 256 * 1024; ldsrc = 1024; k0 = ((r - 64) / 8) * 64; n0 = ((r - 64) % 8) * 128; dst = p.wd_t() + (size_t)e * 1024 * 256; lddst = 256; mode = 0; }
}
DI void conv_big_load(const P& p, int l, int idx, int tid, f32x4 (&v)[8]) {
  idx = idx < CONV_BIG ? idx : CONV_BIG - 1;
  const float* src; int ldsrc, k0, n0; bf16_t* dst; int lddst, mode;
  conv_big_desc(p, l, idx, src, ldsrc, k0, n0, dst, lddst, mode);
  const int c4 = tid & 31, r0 = tid >> 5;
#pragma unroll
  for (int hh = 0; hh < 8; ++hh) v[hh] = *(const f32x4*)(src + (size_t)(k0 + r0 + 8 * hh) * ldsrc + n0 + c4 * 4);
}
DI void conv_big_finish(const P& p, unsigned char* smem, int l, int idx, int tid, const f32x4 (&v)[8]) {
  const float* src; int ldsrc, k0, n0; bf16_t* dst; int lddst, mode;
  conv_big_desc(p, l, idx, src, ldsrc, k0, n0, dst, lddst, mode);
  float* t = (float*)smem;
  const int c4 = tid & 31, r0 = tid >> 5;
  __syncthreads();
#pragma unroll
  for (int hh = 0; hh < 8; ++hh) *(f32x4*)(t + (r0 + 8 * hh) * 132 + c4 * 4) = v[hh];
  __syncthreads();
  const int n = tid >> 1, kh = tid & 1;
  const int nn = n0 + n;
  const int orow = (mode == 0) ? nn : (256 * (nn >> 7) + 16 * ((nn & 127) >> 3) + (mode == 2 ? 8 : 0) + (nn & 7));
  bf16_t* d = dst + (size_t)orow * lddst + k0 + kh * 32;
#pragma unroll
  for (int c = 0; c < 4; ++c) {
    const float* tp = t + (kh * 32 + c * 8) * 132 + n;
    u32x4 wv;
    wv.x = pack2(tp[0 * 132], tp[1 * 132]); wv.y = pack2(tp[2 * 132], tp[3 * 132]); wv.z = pack2(tp[4 * 132], tp[5 * 132]); wv.w = pack2(tp[6 * 132], tp[7 * 132]);
    *(u32x4*)(d + c * 8) = wv;
  }
}
DI void conv_big_loop(const P& p, unsigned char* smem, int l, int first, int step) {
  if (first >= CONV_BIG) return;
  const int tid = otid();
  f32x4 va[8], vb[8];
  conv_big_load(p, l, first, tid, va); conv_big_load(p, l, first + step, tid, vb);
  for (int it = first; it < CONV_BIG; it += 2 * step) {
    conv_big_finish(p, smem, l, it, tid, va);
    conv_big_load(p, l, it + 2 * step, tid, va);
    if (it + step >= CONV_BIG) break;
    conv_big_finish(p, smem, l, it + step, tid, vb);
    conv_big_load(p, l, it + 3 * step, tid, vb);
  }
}

constexpr int MISC_ITEMS = 64 + 128 + 512;
DI void item_misc(const P& p, int item) {
  const int tid = otid();
  if (item < 64) {
    const int i = (item * NTHREADS + tid) * 8;
    const int k0 = i & 127, t = (i >> 7) & 127;
    const float4 a = *(const float4*)(p.w_spatial + i), c = *(const float4*)(p.w_spatial + i + 4);
    u32x4 o;
    o.x = pack2(k0 + 0 <= t ? a.x : 0.f, k0 + 1 <= t ? a.y : 0.f); o.y = pack2(k0 + 2 <= t ? a.z : 0.f, k0 + 3 <= t ? a.w : 0.f);
    o.z = pack2(k0 + 4 <= t ? c.x : 0.f, k0 + 5 <= t ? c.y : 0.f); o.w = pack2(k0 + 6 <= t ? c.z : 0.f, k0 + 7 <= t ? c.w : 0.f);
    *(u32x4*)(p.wsp_b() + i) = o;
  } else if (item < 64 + 128) {
    const int i = (item - 64) * NTHREADS + tid;
    const int c = i & 63, dd = (i >> 6) & 63, lg = i >> 12;
    const f32x2 f = {p.w_pool[((size_t)lg * 64 + c) * 64 + dd], 0.f}; const bf16x2_t bb = __builtin_convertvector(f, bf16x2_t);
    p.wpool_t()[i] = (bf16_t)(__builtin_bit_cast(unsigned, bb) & 0xffffu);
  } else {
    const int i = (item - 192) * NTHREADS + tid;
    const int e = i & 63, k = (i >> 6) & 1023, l = i >> 16;
    const float v = p.w_router[i];
    const unsigned hi = pack2(v, 0.f) & 0xffffu;
    const unsigned lo = pack2(v - bflo(hi), 0.f) & 0xffffu;
    p.wr_hi()[(size_t)l * 65536 + e * 1024 + k] = (bf16_t)hi;
    p.wr_lo()[(size_t)l * 65536 + e * 1024 + k] = (bf16_t)lo;
  }
}

DI void item_rope(const P& p, int item) {
  const int i = item * NTHREADS + otid();
  const int t = i >> 4, f = i & 15;
  const float inv = exp2f(-(float)(2 * f) * (13.287712379549449f / 32.f));
  const float ang = (float)p.pos[t] * inv;
  const double rev = (double)ang * 0.15915494309189535;
  const float fr = (float)(rev - floor(rev));
  p.ropec()[i] = __builtin_amdgcn_cosf(fr);
  p.ropes()[i] = __builtin_amdgcn_sinf(fr);
}

DI void item_norm0(const P& p, int item) {
  const int tid = otid(), w = tid >> 6, lane = tid & 63;
  const int t = item * 4 + w, b = t >> 11;
  const float* xr = p.x + (size_t)t * 1024;
  const float* md = p.mod() + (size_t)b * 6144;
  float4 v[4]; float ss = 0.f;
#pragma unroll
  for (int j = 0; j < 4; ++j) { v[j] = *(const float4*)(xr + j * 256 + lane * 4); ss += v[j].x * v[j].x + v[j].y * v[j].y + v[j].z * v[j].z + v[j].w * v[j].w; }
  ss = wsum(ss);
  const float rstd = rsqrtf(ss * (1.f / 1024.f) + EPS);
#pragma unroll
  for (int j = 0; j < 4; ++j) {
    const int idx = j * 256 + lane * 4;
    const float4 sh = *(const float4*)(md + idx), sc = *(const float4*)(md + 1024 + idx);
    u32x2 o;
    o.x = pack2(v[j].x * rstd * (1.f + sc.x) + sh.x, v[j].y * rstd * (1.f + sc.y) + sh.y);
    o.y = pack2(v[j].z * rstd * (1.f + sc.z) + sh.z, v[j].w * rstd * (1.f + sc.w) + sh.w);
    *(u32x2*)(p.h() + (size_t)t * 1024 + idx) = o;
  }
}

DI void item_p1(const P& p, unsigned char* smem, int item) {
  const int m = item / 10, nt = item % 10;
  const int tid = otid(), r_s = tid >> 3, c_s = tid & 7;
  __syncthreads();
  unsigned ao[4], bo[4];
#pragma unroll
  for (int j = 0; j < 4; ++j) {
    const int row = r_s + 32 * j;
    ao[j] = (unsigned)(((m * 128 + row) * 1024 + c_s * 8) * 2);
    int n = nt * 128 + row; n = n < NIN ? n : NIN - 1;
    bo[j] = (unsigned)((n * 1024 + c_s * 8) * 2);
  }
  bf16_t* proj = p.proj();
  gemm128(smem, (const unsigned char*)p.h(), ao, (const unsigned char*)p.win_t(), bo, 16, [=](f32x4 (&acc)[4][4], int wm, int wn, int fr, int fq) {
    unsigned char* ob = smem + wm * 16384;
#pragma unroll
    for (int i = 0; i < 4; ++i)
#pragma unroll
      for (int j = 0; j < 4; ++j) {
        u32x2 o; o.x = pack2(acc[i][j][0], acc[i][j][1]); o.y = pack2(acc[i][j][2], acc[i][j][3]);
        ot_put<256>(ob, i * 16 + fr, wn * 16 + j * 4 + fq, o);
      }
    __syncthreads();
    {
      const int tid2 = fq * 16 + fr + 64 * (wm * 2 + wn);
      const int chunk = tid2 & 15;
      if (nt * 128 + chunk * 8 < NIN) {
#pragma unroll
        for (int i = 0; i < 8; ++i) {
          const int row = (tid2 >> 4) + 16 * i;
          const u32x4 v = ot_get<256>(smem + (row >> 6) * 16384, row & 63, chunk);
          *(u32x4*)(proj + (size_t)(m * 128 + row) * NIN + nt * 128 + chunk * 8) = v;
        }
      }
    }
  });
}

DI void item_qproj(const P& p, unsigned char* smem, int item) {
  const int m = item / 6, nt = item % 6;
  const int tid = otid(), r_s = tid >> 3, c_s = tid & 7;
  float* rowf = (float*)(smem + SMEM_MAIN + 1024);
  __syncthreads();
  {
    const int row = tid >> 1, half = tid & 1;
    const bf16_t* src = p.proj() + (size_t)(m * 128 + row) * NIN + 768 + half * 128;
    float ss = 0.f;
#pragma unroll
    for (int q = 0; q < 16; ++q) {
      const u32x4 v = *(const u32x4*)(src + q * 8);
      ss += bflo(v.x) * bflo(v.x) + bfhi(v.x) * bfhi(v.x) + bflo(v.y) * bflo(v.y) + bfhi(v.y) * bfhi(v.y) + bflo(v.z) * bflo(v.z) + bfhi(v.z) * bfhi(v.z) + bflo(v.w) * bflo(v.w) + bfhi(v.w) * bfhi(v.w);
    }
    ss += __shfl_xor(ss, 1);
    if (half == 0) rowf[row] = rsqrtf(ss * (1.f / 256.f) + EPS);
  }
  unsigned ao[4], bo[4];
#pragma unroll
  for (int j = 0; j < 4; ++j) {
    const int row = r_s + 32 * j;
    ao[j] = (unsigned)(((m * 128 + row) * NIN + 768 + c_s * 8) * 2);
    bo[j] = (unsigned)(((nt * 128 + row) * 256 + c_s * 8) * 2);
  }
  bf16_t* Q = p.Q(); const float* ropec = p.ropec(); const float* ropes = p.ropes();
  const float QS = 0.10206207261596577f * 1.4426950408889634f;
  gemm128(smem, (const unsigned char*)p.proj(), ao, (const unsigned char*)p.wuq_t(), bo, 4, [=](f32x4 (&acc)[4][4], int wm, int wn, int fr, int fq) {
#pragma unroll
    for (int i = 0; i < 4; ++i) {
      const int tl = wm * 64 + i * 16 + fr, t = m * 128 + tl;
      const int b = t >> 11, s = t & 2047;
      const float rs = rowf[tl] * QS;
#pragma unroll
      for (int j = 0; j < 4; ++j) {
        const int c0 = nt * 128 + wn * 64 + j * 16;
        const int head = c0 / 96, d0 = c0 % 96;
        bf16_t* dst = Q + ((size_t)((b * 8 + head) * 2048 + s)) * 96 + d0 + fq * 4;
        if (d0 == 64) {
          if (j < 3) {
            const float4 cs = *(const float4*)(ropec + (size_t)t * 16 + fq * 4), sn = *(const float4*)(ropes + (size_t)t * 16 + fq * 4);
            const f32x4 x1 = acc[i][j] * rs, x2 = acc[i][j + 1 < 4 ? j + 1 : 3] * rs;
            u32x2 o1, o2;
            o1.x = pack2(x1[0] * cs.x - x2[0] * sn.x, x1[1] * cs.y - x2[1] * sn.y);
            o1.y = pack2(x1[2] * cs.z - x2[2] * sn.z, x1[3] * cs.w - x2[3] * sn.w);
            o2.x = pack2(x2[0] * cs.x + x1[0] * sn.x, x2[1] * cs.y + x1[1] * sn.y);
            o2.y = pack2(x2[2] * cs.z + x1[2] * sn.z, x2[3] * cs.w + x1[3] * sn.w);
            *(u32x2*)dst = o1; *(u32x2*)(dst + 16) = o2;
          }
        } else if (d0 != 80) {
          const f32x4 x = acc[i][j] * rs;
          u32x2 o; o.x = pack2(x[0], x[1]); o.y = pack2(x[2], x[3]);
          *(u32x2*)dst = o;
        }
      }
    }
  });
}

DI void item_kvproj(const P& p, unsigned char* smem, int item) {
  const int m = item >> 3, head = item & 7;
  const int tid = otid(), r_s = tid >> 3, c_s = tid & 7;
  float* rowf = (float*)(smem + SMEM_MAIN + 1024);
  __syncthreads();
  {
    const int row = tid >> 1, half = tid & 1;
    const int t = m * 128 + row, b = t >> 11, s = t & 2047;
    const bf16_t* src = p.proj() + (size_t)t * NIN + 1024 + half * 64;
    float ss = 0.f;
#pragma unroll
    for (int q = 0; q < 8; ++q) {
      const u32x4 v = *(const u32x4*)(src + q * 8);
      ss += bflo(v.x) * bflo(v.x) + bfhi(v.x) * bfhi(v.x) + bflo(v.y) * bflo(v.y) + bfhi(v.y) * bfhi(v.y) + bflo(v.z) * bflo(v.z) + bfhi(v.z) * bfhi(v.z) + bflo(v.w) * bflo(v.w) + bfhi(v.w) * bfhi(v.w);
    }
    ss += __shfl_xor(ss, 1);
    if (half == 0) rowf[row] = rsqrtf(ss * (1.f / 128.f) + EPS);
    const bf16_t* kp = p.proj() + (size_t)t * NIN + 1152 + half * 8;
    const u32x4 a1 = *(const u32x4*)kp, a2 = *(const u32x4*)(kp + 16);
    const float* cp = p.ropec() + (size_t)t * 16 + half * 8; const float* sp = p.ropes() + (size_t)t * 16 + half * 8;
    const float4 c0 = *(const float4*)cp, c1 = *(const float4*)(cp + 4), s0 = *(const float4*)sp, s1 = *(const float4*)(sp + 4);
    const float x1[8] = {bflo(a1.x), bfhi(a1.x), bflo(a1.y), bfhi(a1.y), bflo(a1.z), bfhi(a1.z), bflo(a1.w), bfhi(a1.w)};
    const float x2[8] = {bflo(a2.x), bfhi(a2.x), bflo(a2.y), bfhi(a2.y), bflo(a2.z), bfhi(a2.z), bflo(a2.w), bfhi(a2.w)};
    const float cc[8] = {c0.x, c0.y, c0.z, c0.w, c1.x, c1.y, c1.z, c1.w};
    const float sn[8] = {s0.x, s0.y, s0.z, s0.w, s1.x, s1.y, s1.z, s1.w};
    u32x4 o1, o2;
    o1.x = pack2(x1[0] * cc[0] - x2[0] * sn[0], x1[1] * cc[1] - x2[1] * sn[1]);
    o1.y = pack2(x1[2] * cc[2] - x2[2] * sn[2], x1[3] * cc[3] - x2[3] * sn[3]);
    o1.z = pack2(x1[4] * cc[4] - x2[4] * sn[4], x1[5] * cc[5] - x2[5] * sn[5]);
    o1.w = pack2(x1[6] * cc[6] - x2[6] * sn[6], x1[7] * cc[7] - x2[7] * sn[7]);
    o2.x = pack2(x2[0] * cc[0] + x1[0] * sn[0], x2[1] * cc[1] + x1[1] * sn[1]);
    o2.y = pack2(x2[2] * cc[2] + x1[2] * sn[2], x2[3] * cc[3] + x1[3] * sn[3]);
    o2.z = pack2(x2[4] * cc[4] + x1[4] * sn[4], x2[5] * cc[5] + x1[5] * sn[5]);
    o2.w = pack2(x2[6] * cc[6] + x1[6] * sn[6], x2[7] * cc[7] + x1[7] * sn[7]);
    bf16_t* kd = p.Kb() + ((size_t)((b * 8 + head) * 2048 + s)) * 96 + 64 + half * 8;
    *(u32x4*)kd = o1; *(u32x4*)(kd + 16) = o2;
  }
  unsigned ao[4], bo[4];
#pragma unroll
  for (int j = 0; j < 4; ++j) {
    const int row = r_s + 32 * j;
    ao[j] = (unsigned)(((m * 128 + row) * NIN + 1024 + c_s * 8) * 2);
    bo[j] = (unsigned)(((head * 128 + row) * 128 + c_s * 8) * 2);
  }
  bf16_t* Kb = p.Kb(); bf16_t* V = p.V();
  gemm128(smem, (const unsigned char*)p.proj(), ao, (const unsigned char*)p.wukv_t(), bo, 2, [=](f32x4 (&acc)[4][4], int wm, int wn, int fr, int fq) {
#pragma unroll
    for (int i = 0; i < 4; ++i) {
      const int tl = wm * 64 + i * 16 + fr, t = m * 128 + tl;
      const int b = t >> 11, s = t & 2047;
      const float rs = rowf[tl];
      const size_t rowi = (size_t)((b * 8 + head) * 2048 + s);
#pragma unroll
      for (int j = 0; j < 4; ++j) {
        const int d = j * 16 + fq * 4;
        const f32x4 x = acc[i][j] * rs;
        u32x2 o; o.x = pack2(x[0], x[1]); o.y = pack2(x[2], x[3]);
        if (wn == 0) *(u32x2*)(Kb + rowi * 96 + d) = o; else *(u32x2*)(V + rowi * 64 + d) = o;
      }
    }
  });
}

DI void item_pool(const P& p, unsigned char* smem, int l, int item) {
  const int tid = otid(), w = tid >> 6, lane = tid & 63, fr = lane & 15, fq = lane >> 4;
  const int tile = item >> 2, g = item & 3;
  const int t0 = tile * 128, s0 = t0 & 2047;
  const int wdw = 2 << g;
  unsigned char* al = smem;
  unsigned char* dl = smem + 20480;
  __syncthreads();
  for (int id = tid; id < 143 * 8; id += NTHREADS) {
    const int row = id >> 3, c = id & 7;
    const int srel = s0 - 15 + row;
    u32x4 v = (u32x4){0u, 0u, 0u, 0u};
    if (srel >= 0) v = *(const u32x4*)(p.proj() + (size_t)(t0 - 15 + row) * NIN + g * 64 + c * 8);
    *(u32x4*)(al + row * 128 + c * 16) = v;
  }
  __syncthreads();
  {
    const int tl = tid >> 1, cb = (tid & 1) * 4;
    const int pos = s0 + tl;
    const int nw = (pos + 1 < wdw) ? pos + 1 : wdw;
    const float inv = 1.f / (float)nw;
#pragma unroll
    for (int q = 0; q < 4; ++q) {
      const int c = cb + q;
      float sm[8];
#pragma unroll
      for (int e = 0; e < 8; ++e) sm[e] = 0.f;
      for (int j = 0; j < nw; ++j) {
        const u32x4 v = *(const u32x4*)(al + (tl + 15 - j) * 128 + c * 16);
        sm[0] += bflo(v.x); sm[1] += bfhi(v.x); sm[2] += bflo(v.y); sm[3] += bfhi(v.y); sm[4] += bflo(v.z); sm[5] += bfhi(v.z); sm[6] += bflo(v.w); sm[7] += bfhi(v.w);
      }
      const u32x4 a = *(const u32x4*)(al + (tl + 15) * 128 + c * 16);
      u32x4 o;
      o.x = pack2(sm[0] * inv - bflo(a.x), sm[1] * inv - bfhi(a.x)); o.y = pack2(sm[2] * inv - bflo(a.y), sm[3] * inv - bfhi(a.y));
      o.z = pack2(sm[4] * inv - bflo(a.z), sm[5] * inv - bfhi(a.z)); o.w = pack2(sm[6] * inv - bflo(a.w), sm[7] * inv - bfhi(a.w));
      *(u32x4*)(dl + tl * 128 + ((c ^ (tl & 7)) << 4)) = o;
    }
  }
  __syncthreads();
  {
    const bf16_t* wp = p.wpool_t() + ((size_t)(l * 4 + g) * 64) * 64;
    f32x4 acc[2][4];
#pragma unroll
    for (int i = 0; i < 2; ++i)
#pragma unroll
      for (int j = 0; j < 4; ++j) acc[i][j] = (f32x4){0.f, 0.f, 0.f, 0.f};
#pragma unroll
    for (int ks = 0; ks < 2; ++ks) {
      bf16x8 df[2], wf[4];
#pragma unroll
      for (int i = 0; i < 2; ++i) { const int row = w * 32 + i * 16 + fr; df[i] = *(const bf16x8*)(dl + row * 128 + (((ks * 4 + fq) ^ (row & 7)) << 4)); }
#pragma unroll
      for (int j = 0; j < 4; ++j) wf[j] = *(const bf16x8*)(wp + (size_t)(j * 16 + fr) * 64 + ks * 32 + fq * 8);
#pragma unroll
      for (int i = 0; i < 2; ++i)
#pragma unroll
        for (int j = 0; j < 4; ++j) acc[i][j] = __builtin_amdgcn_mfma_f32_16x16x32_bf16(wf[j], df[i], acc[i][j], 0, 0, 0);
    }
#pragma unroll
    for (int i = 0; i < 2; ++i) {
      const int t = t0 + w * 32 + i * 16 + fr;
#pragma unroll
      for (int j = 0; j < 4; ++j) {
        const int cc = g * 64 + j * 16 + fq * 4;
        const float4 ps = *(const float4*)(p.pool_scale + l * 256 + cc);
        u32x2 o; o.x = pack2(acc[i][j][0] * ps.x, acc[i][j][1] * ps.y); o.y = pack2(acc[i][j][2] * ps.z, acc[i][j][3] * ps.w);
        *(u32x2*)(p.Y() + (size_t)t * 1024 + cc) = o;
      }
    }
  }
}

DI void item_sgu(const P& p, unsigned char* smem, int l, int chunk) {
  const int tid = otid(), w = tid >> 6, lane = tid & 63, fr = lane & 15, fq = lane >> 4;
  const int t0 = chunk * 128;
  unsigned char* vn = smem;
  __syncthreads();
#pragma unroll 1
  for (int ps = 0; ps < 4; ++ps) {
    const int tl = ps * 32 + (tid >> 3), part = tid & 7;
    const bf16_t* src = p.proj() + (size_t)(t0 + tl) * NIN + 512 + part * 32;
    float x[32];
#pragma unroll
    for (int q = 0; q < 4; ++q) {
      const u32x4 v = *(const u32x4*)(src + q * 8);
      x[q * 8 + 0] = gelu_tanh(bflo(v.x)); x[q * 8 + 1] = gelu_tanh(bfhi(v.x)); x[q * 8 + 2] = gelu_tanh(bflo(v.y)); x[q * 8 + 3] = gelu_tanh(bfhi(v.y));
      x[q * 8 + 4] = gelu_tanh(bflo(v.z)); x[q * 8 + 5] = gelu_tanh(bfhi(v.z)); x[q * 8 + 6] = gelu_tanh(bflo(v.w)); x[q * 8 + 7] = gelu_tanh(bfhi(v.w));
    }
    float sm = 0.f;
#pragma unroll
    for (int e = 0; e < 32; ++e) sm += x[e];
    sm += __shfl_xor(sm, 1); sm += __shfl_xor(sm, 2); sm += __shfl_xor(sm, 4);
    const float mu = sm * (1.f / 256.f);
    float vs = 0.f;
#pragma unroll
    for (int e = 0; e < 32; ++e) { x[e] -= mu; vs += x[e] * x[e]; }
    vs += __shfl_xor(vs, 1); vs += __shfl_xor(vs, 2); vs += __shfl_xor(vs, 4);
    const float rstd = rsqrtf(vs * (1.f / 256.f) + EPS);
#pragma unroll
    for (int q = 0; q < 4; ++q) {
      const int c = part * 4 + q;
      u32x4 o;
      o.x = pack2(x[q * 8 + 0] * rstd, x[q * 8 + 1] * rstd); o.y = pack2(x[q * 8 + 2] * rstd, x[q * 8 + 3] * rstd);
      o.z = pack2(x[q * 8 + 4] * rstd, x[q * 8 + 5] * rstd); o.w = pack2(x[q * 8 + 6] * rstd, x[q * 8 + 7] * rstd);
      *(u32x4*)(vn + tl * 512 + (((c >> 1) ^ (tl & 7)) << 5) + ((c & 1) << 4)) = o;
    }
  }
  __syncthreads();
  const int qq = fr >> 2, pp = fr & 3;
#pragma unroll 1
  for (int hh = 0; hh < 4; ++hh) {
    f32x4 acc[4][2];
#pragma unroll
    for (int df = 0; df < 4; ++df) { acc[df][0] = (f32x4){0.f, 0.f, 0.f, 0.f}; acc[df][1] = (f32x4){0.f, 0.f, 0.f, 0.f}; }
    const bf16_t* wb = p.wsp_b() + ((size_t)(l * 4 + hh) * 128) * 128;
    for (int kb = 0; kb <= w; ++kb) {
      bf16x8 wf[2];
#pragma unroll
      for (int f = 0; f < 2; ++f) {
        const bf16_t* wr = wb + (size_t)((2 * w + f) * 16 + fr) * 128 + kb * 32 + fq * 4;
        const u32x2 lo = *(const u32x2*)wr, hi = *(const u32x2*)(wr + 16);
        u32x4 u; u.x = lo.x; u.y = lo.y; u.z = hi.x; u.w = hi.y;
        wf[f] = __builtin_bit_cast(bf16x8, u);
      }
#pragma unroll
      for (int df = 0; df < 4; ++df) {
        const int keyA = kb * 32 + fq * 4 + qq, keyB = keyA + 16;
        const int slot = hh * 4 + df;
        const s16x4 lo = __builtin_amdgcn_ds_read_tr16_b64_v4i16((LAS s16x4*)(vn + keyA * 512 + ((slot ^ (keyA & 7)) << 5) + pp * 8));
        const s16x4 hi = __builtin_amdgcn_ds_read_tr16_b64_v4i16((LAS s16x4*)(vn + keyB * 512 + ((slot ^ (keyB & 7)) << 5) + pp * 8));
        bf16x8 vf; vf[0] = lo[0]; vf[1] = lo[1]; vf[2] = lo[2]; vf[3] = lo[3]; vf[4] = hi[0]; vf[5] = hi[1]; vf[6] = hi[2]; vf[7] = hi[3];
        acc[df][0] = __builtin_amdgcn_mfma_f32_16x16x32_bf16(vf, wf[0], acc[df][0], 0, 0, 0);
        acc[df][1] = __builtin_amdgcn_mfma_f32_16x16x32_bf16(vf, wf[1], acc[df][1], 0, 0, 0);
      }
    }
#pragma unroll
    for (int f = 0; f < 2; ++f) {
      const int tl = (2 * w + f) * 16 + fr, t = t0 + tl;
      const float bias = p.b_spatial[(l * 4 + hh) * 128 + tl];
#pragma unroll
      for (int df = 0; df < 4; ++df) {
        const int d = hh * 64 + df * 16 + fq * 4;
        const u32x2 uu = *(const u32x2*)(p.proj() + (size_t)t * NIN + 256 + d);
        u32x2 o;
        o.x = pack2(gelu_tanh(bflo(uu.x)) * (acc[df][f][0] + bias), gelu_tanh(bfhi(uu.x)) * (acc[df][f][1] + bias));
        o.y = pack2(gelu_tanh(bflo(uu.y)) * (acc[df][f][2] + bias), gelu_tanh(bfhi(uu.y)) * (acc[df][f][3] + bias));
        *(u32x2*)(p.Y() + (size_t)t * 1024 + 256 + d) = o;
      }
    }
  }
}

DI void item_attn(const P& p, unsigned char* smem, int item) {
  const int tid = otid(), w = tid >> 6, lane = tid & 63;
  const int fr = lane & 15, fq = lane >> 4;
  const int rnd = item >> 9, blk = item & 511;
  const int qb = rnd == 0 ? 15 - (blk >> 6) : (blk >> 6);
  const int bh = blk & 63, b = bh >> 3, h = bh & 7;
  const int q0 = qb * 128;
  const int nkt = 2 * qb + 2;
  const bf16_t* Qg = p.Q() + (size_t)bh * 2048 * 96;
  const bf16_t* Kg = p.Kb() + (size_t)bh * 2048 * 96;
  const bf16_t* Vg = p.V() + (size_t)bh * 2048 * 64;
  int kkey[3], kdst[3], kc[3];
#pragma unroll
  for (int j = 0; j < 3; ++j) { const int id = tid + 256 * j; kkey[j] = id / 12; kc[j] = id % 12; kdst[j] = kkey[j] * 256 + ((kc[j] ^ (kkey[j] & 15)) << 4); }
  int vkey[2], vdst[2], vc[2];
#pragma unroll
  for (int j = 0; j < 2; ++j) { const int id = tid + 256 * j; vkey[j] = id >> 3; vc[j] = id & 7; vdst[j] = vkey[j] * 128 + (((vc[j] >> 1) ^ ((vkey[j] >> 1) & 3)) << 5) + ((vc[j] & 1) << 4); }
  bf16x8 qf[3][2];
#pragma unroll
  for (int ks = 0; ks < 3; ++ks)
#pragma unroll
    for (int f = 0; f < 2; ++f) qf[ks][f] = *(const bf16x8*)(Qg + (size_t)(q0 + 32 * w + 16 * f + fr) * 96 + ks * 32 + fq * 8);
  f32x4 o[4][2];
#pragma unroll
  for (int f = 0; f < 4; ++f) { o[f][0] = (f32x4){0.f, 0.f, 0.f, 0.f}; o[f][1] = (f32x4){0.f, 0.f, 0.f, 0.f}; }
  float mrun[2] = {-INFINITY, -INFINITY}, lrun[2] = {0.f, 0.f};
  u32x4 rk[3], rv[2];
  __syncthreads();
#pragma unroll
  for (int j = 0; j < 3; ++j) rk[j] = *(const u32x4*)(Kg + (size_t)kkey[j] * 96 + kc[j] * 8);
#pragma unroll
  for (int j = 0; j < 2; ++j) rv[j] = *(const u32x4*)(Vg + (size_t)vkey[j] * 64 + vc[j] * 8);
#pragma unroll
  for (int j = 0; j < 3; ++j) *(u32x4*)(smem + kdst[j]) = rk[j];
#pragma unroll
  for (int j = 0; j < 2; ++j) *(u32x4*)(smem + 32768 + vdst[j]) = rv[j];
  __syncthreads();
  const int rowmin = q0 + 32 * w;
  for (int kt = 0; kt < nkt; ++kt) {
    const int cur = kt & 1;
    const bool more = kt + 1 < nkt;
    if (more) {
      const int key0n = (kt + 1) * 64;
#pragma unroll
      for (int j = 0; j < 3; ++j) rk[j] = *(const u32x4*)(Kg + (size_t)(key0n + kkey[j]) * 96 + kc[j] * 8);
#pragma unroll
      for (int j = 0; j < 2; ++j) rv[j] = *(const u32x4*)(Vg + (size_t)(key0n + vkey[j]) * 64 + vc[j] * 8);
    }
    const int key0 = kt * 64;
    if (key0 <= rowmin + 31) {
      const unsigned char* Kl = smem + cur * 16384;
      const unsigned char* Vl = smem + 32768 + cur * 8192;
      f32x4 st[4][2];
#pragma unroll
      for (int kf = 0; kf < 4; ++kf) { st[kf][0] = (f32x4){0.f, 0.f, 0.f, 0.f}; st[kf][1] = (f32x4){0.f, 0.f, 0.f, 0.f}; }
#pragma unroll
      for (int ks = 0; ks < 3; ++ks)
#pragma unroll
        for (int kf = 0; kf < 4; ++kf) {
          const int key = kf * 16 + fr;
          const bf16x8 a = *(const bf16x8*)(Kl + key * 256 + (((ks * 4 + fq) ^ (key & 15)) << 4));
          st[kf][0] = __builtin_amdgcn_mfma_f32_16x16x32_bf16(a, qf[ks][0], st[kf][0], 0, 0, 0);
          st[kf][1] = __builtin_amdgcn_mfma_f32_16x16x32_bf16(a, qf[ks][1], st[kf][1], 0, 0, 0);
        }
      const bool needmask = (key0 + 63 > rowmin);
#pragma unroll
      for (int f = 0; f < 2; ++f) {
        const int qabs = rowmin + 16 * f + fr;
        if (needmask) {
#pragma unroll
          for (int kf = 0; kf < 4; ++kf)
#pragma unroll
            for (int r = 0; r < 4; ++r) { const int kabs = key0 + kf * 16 + fq * 4 + r; if (kabs > qabs) st[kf][f][r] = -INFINITY; }
        }
        float mx = st[0][f][0];
#pragma unroll
        for (int kf = 0; kf < 4; ++kf)
#pragma unroll
          for (int r = 0; r < 4; ++r) mx = fmaxf(mx, st[kf][f][r]);
        mx = fmaxf(mx, __shfl_xor(mx, 16)); mx = fmaxf(mx, __shfl_xor(mx, 32));
        const float mnew = fmaxf(mrun[f], mx);
        const float alpha = __builtin_amdgcn_exp2f(mrun[f] - mnew);
        mrun[f] = mnew;
        float ls = 0.f;
#pragma unroll
        for (int kf = 0; kf < 4; ++kf)
#pragma unroll
          for (int r = 0; r < 4; ++r) { const float pv = __builtin_amdgcn_exp2f(st[kf][f][r] - mnew); st[kf][f][r] = pv; ls += pv; }
        lrun[f] = lrun[f] * alpha + ls;
#pragma unroll
        for (int df = 0; df < 4; ++df) o[df][f] = o[df][f] * alpha;
      }
      bf16x8 pf[2][2];
#pragma unroll
      for (int kb = 0; kb < 2; ++kb)
#pragma unroll
        for (int f = 0; f < 2; ++f) {
          u32x4 u;
          u.x = pack2(st[2 * kb][f][0], st[2 * kb][f][1]); u.y = pack2(st[2 * kb][f][2], st[2 * kb][f][3]);
          u.z = pack2(st[2 * kb + 1][f][0], st[2 * kb + 1][f][1]); u.w = pack2(st[2 * kb + 1][f][2], st[2 * kb + 1][f][3]);
          pf[kb][f] = __builtin_bit_cast(bf16x8, u);
        }
      const int qq = fr >> 2, pp = fr & 3;
#pragma unroll
      for (int kb = 0; kb < 2; ++kb)
#pragma unroll
        for (int df = 0; df < 4; ++df) {
          const int keyA = kb * 32 + fq * 4 + qq, keyB = keyA + 16;
          const int offA = keyA * 128 + ((df ^ ((keyA >> 1) & 3)) << 5) + pp * 8;
          const int offB = keyB * 128 + ((df ^ ((keyB >> 1) & 3)) << 5) + pp * 8;
          const s16x4 lo = __builtin_amdgcn_ds_read_tr16_b64_v4i16((LAS s16x4*)(Vl + offA));
          const s16x4 hi = __builtin_amdgcn_ds_read_tr16_b64_v4i16((LAS s16x4*)(Vl + offB));
          bf16x8 vf; vf[0] = lo[0]; vf[1] = lo[1]; vf[2] = lo[2]; vf[3] = lo[3]; vf[4] = hi[0]; vf[5] = hi[1]; vf[6] = hi[2]; vf[7] = hi[3];
          o[df][0] = __builtin_amdgcn_mfma_f32_16x16x32_bf16(vf, pf[kb][0], o[df][0], 0, 0, 0);
          o[df][1] = __builtin_amdgcn_mfma_f32_16x16x32_bf16(vf, pf[kb][1], o[df][1], 0, 0, 0);
        }
    }
    if (more) {
      const int nx = cur ^ 1;
#pragma unroll
      for (int j = 0; j < 3; ++j) *(u32x4*)(smem + nx * 16384 + kdst[j]) = rk[j];
#pragma unroll
      for (int j = 0; j < 2; ++j) *(u32x4*)(smem + 32768 + nx * 8192 + vdst[j]) = rv[j];
    }
    __syncthreads();
  }
#pragma unroll
  for (int f = 0; f < 2; ++f) {
    float lt = lrun[f]; lt += __shfl_xor(lt, 16); lt += __shfl_xor(lt, 32);
    const float inv = 1.f / lt;
    const int t = b * 2048 + rowmin + 16 * f + fr;
#pragma unroll
    for (int df = 0; df < 4; ++df) {
      const f32x4 x = o[df][f] * inv;
      u32x2 ov; ov.x = pack2(x[0], x[1]); ov.y = pack2(x[2], x[3]);
      *(u32x2*)(p.Y() + (size_t)t * 1024 + 512 + h * 64 + df * 16 + fq * 4) = ov;
    }
  }
}

DI void item_p4(const P& p, unsigned char* smem, int l, int item) {
  const int m = item >> 3, nt = item & 7;
  const int tid = otid(), r_s = tid >> 3, c_s = tid & 7;
  unsigned ao[4], bo[4];
#pragma unroll
  for (int j = 0; j < 4; ++j) {
    const int row = r_s + 32 * j;
    ao[j] = (unsigned)(((m * 128 + row) * 1024 + c_s * 8) * 2);
    bo[j] = (unsigned)(((nt * 128 + row) * 1024 + c_s * 8) * 2);
  }
  const float* xin = (l == 0) ? p.x : p.out;
  float* xout = p.out;
  const float* mod = p.mod() + (size_t)l * 8 * 6144 + 2048;
  float* rowss = p.rowss();
  gemm128(smem, (const unsigned char*)p.Y(), ao, (const unsigned char*)p.wout_t(), bo, 16, [=](f32x4 (&acc)[4][4], int wm, int wn, int fr, int fq) {
#pragma unroll
    for (int i = 0; i < 4; ++i) {
      const int t = m * 128 + wm * 64 + i * 16 + fr, b = t >> 11;
      float ss = 0.f;
#pragma unroll
      for (int j = 0; j < 4; ++j) {
        const int n = nt * 128 + wn * 64 + j * 16 + fq * 4;
        const float4 xv = *(const float4*)(xin + (size_t)t * 1024 + n);
        const float4 g = *(const float4*)(mod + (size_t)b * 6144 + n);
        float4 ov = {xv.x + g.x * acc[i][j][0], xv.y + g.y * acc[i][j][1], xv.z + g.z * acc[i][j][2], xv.w + g.w * acc[i][j][3]};
        ss += ov.x * ov.x + ov.y * ov.y + ov.z * ov.z + ov.w * ov.w;
        *(float4*)(xout + (size_t)t * 1024 + n) = ov;
      }
      ss += __shfl_xor(ss, 16); ss += __shfl_xor(ss, 32);
      if (fq == 0) rowss[(size_t)t * 16 + nt * 2 + wn] = ss;
    }
  });
}

DI void item_p5(const P& p, unsigned char* smem, int l, int item) {
  const int tid = otid(), w = tid >> 6, lane = tid & 63, fr = lane & 15, fq = lane >> 4;
  const int tf = w >> 1, kh = w & 1;
  const int tb = item * 32 + tf * 16;
  const int t = tb + fr, b = (item * 32) >> 11;
  const float* xr = p.out + (size_t)t * 1024 + kh * 512 + fq * 8;
  float* mds = (float*)(smem + 32768);
  __syncthreads();
  {
    const float* md = p.mod() + ((size_t)l * 8 + b) * 6144 + 3072;
    for (int i = tid; i < 512; i += NTHREADS) *(float4*)(mds + i * 4) = *(const float4*)(md + i * 4);
  }
  float rstd;
  {
    const float4* rp = (const float4*)(p.rowss() + (size_t)t * 16);
    const float4 a = rp[0], c = rp[1], d = rp[2], e = rp[3];
    const float ss = ((a.x + a.y) + (a.z + a.w)) + ((c.x + c.y) + (c.z + c.w)) + ((d.x + d.y) + (d.z + d.w)) + ((e.x + e.y) + (e.z + e.w));
    rstd = rsqrtf(ss * (1.f / 1024.f) + EPS);
  }
  const bf16_t* whi = p.wr_hi() + (size_t)l * 65536 + (size_t)fr * 1024 + kh * 512 + fq * 8;
  bf16_t* hdst = p.h() + (size_t)t * 1024 + kh * 512 + fq * 8;
  f32x4 acc[4];
#pragma unroll
  for (int nf = 0; nf < 4; ++nf) acc[nf] = (f32x4){0.f, 0.f, 0.f, 0.f};
  bf16x8 w0[4], w1[4], w2[4]; f32x4 xa0, xb0, xa1, xb1, xa2, xb2;
#pragma unroll
  for (int nf = 0; nf < 4; ++nf) { w0[nf] = *(const bf16x8*)(whi + (size_t)nf * 16384); w1[nf] = *(const bf16x8*)(whi + (size_t)nf * 16384 + 32); }
  xa0 = *(const f32x4*)(xr); xb0 = *(const f32x4*)(xr + 4); xa1 = *(const f32x4*)(xr + 32); xb1 = *(const f32x4*)(xr + 36);
  __syncthreads();
#define P5_LOAD(W, XA, XB, ks_) do { const int kn_ = (ks_) < 16 ? (ks_) : 15; _Pragma("unroll") for (int nf = 0; nf < 4; ++nf) W[nf] = *(const bf16x8*)(whi + (size_t)nf * 16384 + kn_ * 32); \
    XA = *(const f32x4*)(xr + kn_ * 32); XB = *(const f32x4*)(xr + kn_ * 32 + 4); } while (0)
#define P5_STEP(W, XA, XB, ks_) do { const int k0 = kh * 512 + (ks_) * 32 + fq * 8; \
    const f32x4 ha = *(const f32x4*)(mds + k0), hb = *(const f32x4*)(mds + k0 + 4), sa = *(const f32x4*)(mds + 1024 + k0), sb = *(const f32x4*)(mds + 1024 + k0 + 4); \
    const f32x4 va = XA * rstd * (sa + 1.f) + ha, vb = XB * rstd * (sb + 1.f) + hb; \
    u32x4 uh, ul; uh.x = pack2(va[0], va[1]); uh.y = pack2(va[2], va[3]); uh.z = pack2(vb[0], vb[1]); uh.w = pack2(vb[2], vb[3]); \
    ul.x = pack2(va[0] - bflo(uh.x), va[1] - bfhi(uh.x)); ul.y = pack2(va[2] - bflo(uh.y), va[3] - bfhi(uh.y)); \
    ul.z = pack2(vb[0] - bflo(uh.z), vb[1] - bfhi(uh.z)); ul.w = pack2(vb[2] - bflo(uh.w), vb[3] - bfhi(uh.w)); \
    *(u32x4*)(hdst + (ks_) * 32) = uh; \
    const bf16x8 bh = __builtin_bit_cast(bf16x8, uh), bl = __builtin_bit_cast(bf16x8, ul); \
    _Pragma("unroll") for (int nf = 0; nf < 4; ++nf) { acc[nf] = __builtin_amdgcn_mfma_f32_16x16x32_bf16(W[nf], bh, acc[nf], 0, 0, 0); acc[nf] = __builtin_amdgcn_mfma_f32_16x16x32_bf16(W[nf], bl, acc[nf], 0, 0, 0); } } while (0)
#pragma unroll 1
  for (int ks = 0; ks < 15; ks += 3) {
    P5_LOAD(w2, xa2, xb2, ks + 2); P5_STEP(w0, xa0, xb0, ks);
    P5_LOAD(w0, xa0, xb0, ks + 3); P5_STEP(w1, xa1, xb1, ks + 1);
    P5_LOAD(w1, xa1, xb1, ks + 4); P5_STEP(w2, xa2, xb2, ks + 2);
  }
  P5_STEP(w0, xa0, xb0, 15);
#undef P5_LOAD
#undef P5_STEP
  float* red = (float*)smem;
  int* info = (int*)(smem + 16384) + w * 512;
  int* cntw = (int*)(smem + 24576);
#pragma unroll
  for (int nf = 0; nf < 4; ++nf) *(f32x4*)(red + w * 1024 + fr * 64 + nf * 16 + fq * 4) = acc[nf];
  __syncthreads();
  const float bias = p.router_bias[l * 64 + lane];
  int cnt_local = 0;
  const int tq0 = kh * 8;
#pragma unroll 1
  for (int q = 0; q < 8; ++q) {
    const float lgt = red[(tf * 2) * 1024 + (tq0 + q) * 64 + lane] + red[(tf * 2 + 1) * 1024 + (tq0 + q) * 64 + lane];
    const float s = 1.f / (1.f + __expf(-lgt));
    const float sel = s + bias;
    float m1 = sel; m1 = fmaxf(m1, __shfl_xor(m1, 1)); m1 = fmaxf(m1, __shfl_xor(m1, 2)); m1 = fmaxf(m1, __shfl_xor(m1, 4));
    const unsigned long long eq = __ballot(sel == m1);
    const int gbase = lane & ~7;
    const unsigned gm = (unsigned)((eq >> gbase) & 0xffull);
    const int first = gbase + __ffs(gm) - 1;
    float m2 = (lane == first) ? -INFINITY : sel;
    m2 = fmaxf(m2, __shfl_xor(m2, 1)); m2 = fmaxf(m2, __shfl_xor(m2, 2)); m2 = fmaxf(m2, __shfl_xor(m2, 4));
    const float gs = m1 + m2;
    const int myg = lane >> 3; int rank = 0;
#pragma unroll
    for (int j = 0; j < 8; ++j) { const float gj = __int_as_float(__builtin_amdgcn_readlane(__float_as_int(gs), j * 8)); rank += ((gj > gs) || (gj == gs && j < myg)) ? 1 : 0; }
    const bool gsel = rank < 4;
    const unsigned sb = (unsigned)__float_as_int(sel);
    const unsigned okey = (sb & 0x80000000u) ? ~sb : (sb | 0x80000000u);
    const unsigned key = gsel ? ((okey & ~63u) | (unsigned)(63 - lane)) : 0u;
    int r = 0;
#pragma unroll
    for (int j = 0; j < 64; ++j) { const unsigned kj = (unsigned)__builtin_amdgcn_readlane((int)key, j); r += (kj > key) ? 1 : 0; }
    const bool ch = gsel && (r < 8);
    const float tot = wsum(ch ? s : 0.f);
    const unsigned long long cm = __ballot(ch);
    const int kidx = __popcll(cm & ((1ull << lane) - 1ull));
    info[q * 64 + lane] = ch ? kidx : -1;
    if (ch) p.topw()[(size_t)(tb + tq0 + q) * 8 + kidx] = s / tot * 2.5f;
    cnt_local += ch ? 1 : 0;
  }
  cntw[w * 64 + lane] = cnt_local;
  __syncthreads();
  if (w == 0) {
    const int tot = cntw[lane] + cntw[64 + lane] + cntw[128 + lane] + cntw[192 + lane];
    int bs = 0;
    if (tot > 0) bs = atomicAdd(p.cnt() + (l * 64 + lane) * CSTRIDE, tot);
    cntw[256 + lane] = bs;
  }
  __syncthreads();
  int base = cntw[256 + lane];
#pragma unroll
  for (int ww = 0; ww < 3; ++ww) base += (ww < w) ? cntw[ww * 64 + lane] : 0;
#pragma unroll 1
  for (int q = 0; q < 8; ++q) {
    const int k = info[q * 64 + lane];
    if (k >= 0) { p.list()[(size_t)lane * LISTCAP + base] = (tb + tq0 + q) * 8 + k; ++base; }
  }
}

DI void moe_table(const P& p, unsigned char* smem, int l) {
  int* start = (int*)(smem + SMEM_MAIN);
  __syncthreads();
  if (otid() == 0) {
    int s = 0;
    for (int e = 0; e < 64; ++e) { start[e] = s; s += (p.cnt()[(l * 64 + e) * CSTRIDE] + 127) >> 7; }
    start[64] = s;
  }
  __syncthreads();
}
DI void moe_rows(const P& p, unsigned char* smem, int l, int mt, int& e_out) {
  const int* start = (const int*)(smem + SMEM_MAIN);
  int* rowinfo = (int*)(smem + SMEM_MAIN + 512);
  const int tid = otid();
  int e;
  if (mt >= start[64]) { e = 64; if (tid < 128) rowinfo[tid] = T_ * 8 + (mt - start[64]) * 128 + tid; }
  else {
    e = 0;
    for (int q = 1; q < 64; ++q) e = (start[q] <= mt) ? q : e;
    const int tl = mt - start[e];
    const int cnt = p.cnt()[(l * 64 + e) * CSTRIDE];
    if (tid < 128) { const int idx = tl * 128 + tid; rowinfo[tid] = idx < cnt ? p.list()[(size_t)e * LISTCAP + idx] : -1; }
  }
  e_out = e;
}

DI void item_p7(const P& p, unsigned char* smem, int l, int item) {
  const int mt = item >> 2, nt = item & 3;
  const int tid = otid(), r_s = tid >> 3, c_s = tid & 7;
  int* rowinfo = (int*)(smem + SMEM_MAIN + 512);
  __syncthreads();
  int e; moe_rows(p, smem, l, mt, e);
  __syncthreads();
  const bf16_t* wbase = (e == 64) ? p.wsg_t() : p.wgu_t() + (size_t)e * 512 * 1024;
  unsigned ao[4], bo[4];
#pragma unroll
  for (int j = 0; j < 4; ++j) {
    const int row = r_s + 32 * j;
    const int slot = rowinfo[row];
    const int tok = slot < 0 ? 0 : (slot >= T_ * 8 ? slot - T_ * 8 : slot >> 3);
    ao[j] = (unsigned)((tok * 1024 + c_s * 8) * 2);
    bo[j] = (unsigned)(((nt * 128 + row) * 1024 + c_s * 8) * 2);
  }
  bf16_t* act = p.act();
  gemm128(smem, (const unsigned char*)p.h(), ao, (const unsigned char*)wbase, bo, 16, [=](f32x4 (&acc)[4][4], int wm, int wn, int fr, int fq) {
    unsigned char* ob = smem + wm * 8192;
#pragma unroll
    for (int i = 0; i < 4; ++i) {
#pragma unroll
      for (int jj = 0; jj < 2; ++jj) {
        const f32x4 g = acc[i][2 * jj], u = acc[i][2 * jj + 1];
        u32x2 o; o.x = pack2(silu_f(g[0]) * u[0], silu_f(g[1]) * u[1]); o.y = pack2(silu_f(g[2]) * u[2], silu_f(g[3]) * u[3]);
        ot_put<128>(ob, i * 16 + fr, wn * 8 + jj * 4 + fq, o);
      }
    }
    __syncthreads();
    {
      const int tid2 = fq * 16 + fr + 64 * (wm * 2 + wn);
      const int chunk = tid2 & 7;
#pragma unroll
      for (int i = 0; i < 4; ++i) {
        const int row = (tid2 >> 3) + 32 * i;
        const int slot = rowinfo[row];
        if (slot >= 0) {
          const u32x4 v = ot_get<128>(smem + (row >> 6) * 8192, row & 63, chunk);
          *(u32x4*)(act + (size_t)slot * 256 + nt * 64 + chunk * 8) = v;
        }
      }
    }
  });
}

DI void item_p8(const P& p, unsigned char* smem, int l, int item) {
  const int mt = item >> 1, nh = item & 1;
  const int tid = otid(), r_s = tid >> 3, c_s = tid & 7;
  int* rowinfo = (int*)(smem + SMEM_MAIN + 512);
  __syncthreads();
  int e; moe_rows(p, smem, l, mt, e);
  __syncthreads();
  const bf16_t* wbase = (e == 64) ? p.wsd_t() : p.wd_t() + (size_t)e * 1024 * 256;
  unsigned ao[4], bo[4];
#pragma unroll
  for (int j = 0; j < 4; ++j) {
    const int row = r_s + 32 * j;
    const int slot = rowinfo[row];
    ao[j] = (unsigned)(((slot < 0 ? 0 : slot) * 256 + c_s * 8) * 2);
    bo[j] = (unsigned)(((nh * 512 + row) * 256 + c_s * 8) * 2);
  }
  bf16_t* yrows = p.yrows(); bf16_t* ysh = p.ysh(); const float* topw = p.topw();
  gemm128_stream(smem, (const unsigned char*)p.act(), ao, (const unsigned char*)wbase, bo, 4, 4, (size_t)128 * 256, [=](f32x4 (&acc)[4][4], int tile, int cur, int wm, int wn, int fr, int fq) {
    const int nt = nh * 4 + tile;
    unsigned char* ob = smem + cur + (wm ? 32768 : 0);
    __syncthreads();
#pragma unroll
    for (int i = 0; i < 4; ++i) {
      const int slot = rowinfo[wm * 64 + i * 16 + fr];
      const float wv = (slot < 0 || slot >= T_ * 8) ? 1.f : topw[slot];
#pragma unroll
      for (int j = 0; j < 4; ++j) {
        const f32x4 x = acc[i][j] * wv;
        u32x2 o; o.x = pack2(x[0], x[1]); o.y = pack2(x[2], x[3]);
        ot_put<256>(ob, i * 16 + fr, wn * 16 + j * 4 + fq, o);
      }
    }
    __syncthreads();
    {
      const int tid2 = fq * 16 + fr + 64 * (wm * 2 + wn);
      const int chunk = tid2 & 15;
#pragma unroll
      for (int i = 0; i < 8; ++i) {
        const int row = (tid2 >> 4) + 16 * i;
        const int slot = rowinfo[row];
        if (slot >= 0) {
          const u32x4 v = ot_get<256>(smem + cur + ((row >> 6) ? 32768 : 0), row & 63, chunk);
          bf16_t* dst = (slot >= T_ * 8) ? ysh + (size_t)(slot - T_ * 8) * 1024 : yrows + (size_t)slot * 1024;
          *(u32x4*)(dst + nt * 128 + chunk * 8) = v;
        }
      }
    }
  });
}

DI void item_p9(const P& p, int l, int item) {
  const int tid = otid(), w = tid >> 6, lane = tid & 63;
  const int t = item * 4 + w, b = t >> 11;
  const float* md = p.mod() + ((size_t)l * 8 + b) * 6144;
  const int c0 = lane * 16;
  float a[16];
  {
    const u32x4 y0 = *(const u32x4*)(p.ysh() + (size_t)t * 1024 + c0), y1 = *(const u32x4*)(p.ysh() + (size_t)t * 1024 + c0 + 8);
    a[0] = bflo(y0.x); a[1] = bfhi(y0.x); a[2] = bflo(y0.y); a[3] = bfhi(y0.y); a[4] = bflo(y0.z); a[5] = bfhi(y0.z); a[6] = bflo(y0.w); a[7] = bfhi(y0.w);
    a[8] = bflo(y1.x); a[9] = bfhi(y1.x); a[10] = bflo(y1.y); a[11] = bfhi(y1.y); a[12] = bflo(y1.z); a[13] = bfhi(y1.z); a[14] = bflo(y1.w); a[15] = bfhi(y1.w);
  }
  float r[16];
#pragma unroll
  for (int e = 0; e < 16; ++e) r[e] = 0.f;
  const unsigned char* yr = (const unsigned char*)p.yrows() + (size_t)t * 8 * 1024 + c0;
  u32x4 yk[8];
#pragma unroll
  for (int k = 0; k < 8; ++k) yk[k] = *(const u32x4*)(yr + k * 1024);
#pragma unroll
  for (int k = 0; k < 8; ++k) {
#pragma unroll
    for (int q = 0; q < 4; ++q) {
      const f32x2 lo = __builtin_amdgcn_cvt_pk_f32_fp8((int)yk[k][q], false), hi = __builtin_amdgcn_cvt_pk_f32_fp8((int)yk[k][q], true);
      r[q * 4 + 0] += lo.x; r[q * 4 + 1] += lo.y; r[q * 4 + 2] += hi.x; r[q * 4 + 3] += hi.y;
    }
  }
  float v[16]; float ss = 0.f;
#pragma unroll
  for (int q = 0; q < 4; ++q) {
    const float4 xv = *(const float4*)(p.out + (size_t)t * 1024 + c0 + q * 4);
    const float4 g = *(const float4*)(md + 5120 + c0 + q * 4);
    v[q * 4 + 0] = xv.x + g.x * (a[q * 4 + 0] + r[q * 4 + 0] * (1.f / YSCALE));
    v[q * 4 + 1] = xv.y + g.y * (a[q * 4 + 1] + r[q * 4 + 1] * (1.f / YSCALE));
    v[q * 4 + 2] = xv.z + g.z * (a[q * 4 + 2] + r[q * 4 + 2] * (1.f / YSCALE));
    v[q * 4 + 3] = xv.w + g.w * (a[q * 4 + 3] + r[q * 4 + 3] * (1.f / YSCALE));
    ss += v[q * 4 + 0] * v[q * 4 + 0] + v[q * 4 + 1] * v[q * 4 + 1] + v[q * 4 + 2] * v[q * 4 + 2] + v[q * 4 + 3] * v[q * 4 + 3];
  }
  ss = wsum(ss);
  const float rstd = rsqrtf(ss * (1.f / 1024.f) + EPS);
  if (l == 0) {
    const float* md1 = p.mod() + ((size_t)8 + b) * 6144;
    unsigned hw[8];
#pragma unroll
    for (int q = 0; q < 4; ++q) {
      *(float4*)(p.out + (size_t)t * 1024 + c0 + q * 4) = (float4){v[q * 4 + 0], v[q * 4 + 1], v[q * 4 + 2], v[q * 4 + 3]};
      const float4 sh = *(const float4*)(md1 + c0 + q * 4), sc = *(const float4*)(md1 + 1024 + c0 + q * 4);
      hw[q * 2 + 0] = pack2(v[q * 4 + 0] * rstd * (1.f + sc.x) + sh.x, v[q * 4 + 1] * rstd * (1.f + sc.y) + sh.y);
      hw[q * 2 + 1] = pack2(v[q * 4 + 2] * rstd * (1.f + sc.z) + sh.z, v[q * 4 + 3] * rstd * (1.f + sc.w) + sh.w);
    }
    *(u32x4*)(p.h() + (size_t)t * 1024 + c0) = (u32x4){hw[0], hw[1], hw[2], hw[3]};
    *(u32x4*)(p.h() + (size_t)t * 1024 + c0 + 8) = (u32x4){hw[4], hw[5], hw[6], hw[7]};
  } else {
#pragma unroll
    for (int q = 0; q < 4; ++q) {
      const float4 fg = *(const float4*)(p.final_gain + c0 + q * 4);
      *(float4*)(p.out + (size_t)t * 1024 + c0 + q * 4) = (float4){v[q * 4 + 0] * rstd * fg.x, v[q * 4 + 1] * rstd * fg.y, v[q * 4 + 2] * rstd * fg.z, v[q * 4 + 3] * rstd * fg.w};
    }
  }
}

DI int xcd_vb(int bid, int G) { return ((G & 7) == 0) ? (bid & 7) * (G >> 3) + (bid >> 3) : bid; }

DI void phase_p1(const P& p, LAS unsigned char* lds, int G, int bid) {
  t8::DenseSched S; S.init(T_, 1280, 1024, G, bid, p.win_t());
  t8::DenseRows RO{2048u};
  bf16_t* proj = p.proj();
  t8::gemm_phase<true>(lds, (const unsigned char*)p.h(), 1024, S, RO, [=](const f32x4 (&acc)[2][2][4][2], const t8::Unit& u, int wr, int wc, int fr, int fq) {
    const int c0 = u.pn * 256 + wc * 64 + fq * 16;
#pragma unroll
    for (int ai = 0; ai < 2; ++ai)
#pragma unroll
      for (int m = 0; m < 4; ++m) {
        const int r = u.pm * 256 + ai * 128 + wr * 64 + m * 16 + fr;
        if (c0 < NIN) {
#pragma unroll
          for (int bj = 0; bj < 2; ++bj) {
            const f32x4 v0 = acc[ai][bj][m][0], v1 = acc[ai][bj][m][1];
            u32x4 o; o.x = pack2(v0[0], v0[1]); o.y = pack2(v0[2], v0[3]); o.z = pack2(v1[0], v1[1]); o.w = pack2(v1[2], v1[3]);
            *(u32x4*)(proj + (size_t)r * NIN + c0 + bj * 8) = o;
          }
        }
        asm volatile("" ::: "memory");
      }
  });
}

DI void phase_p4(const P& p, LAS unsigned char* lds, int l, int G, int bid) {
  t8::DenseSched S; S.init(T_, 1024, 1024, G, bid, p.wout_t());
  t8::DenseRows RO{2048u};
  const float* xin = (l == 0) ? p.x : p.out; float* xout = p.out;
  const float* mod = p.mod() + (size_t)l * 8 * 6144 + 2048;
  float* rowss = p.rowss();
  t8::gemm_phase<true>(lds, (const unsigned char*)p.Y(), 1024, S, RO, [=](const f32x4 (&acc)[2][2][4][2], const t8::Unit& u, int wr, int wc, int fr, int fq) {
    float4 xq[2][4];
    const int cbase = u.pn * 256 + wc * 64 + fq * 16;
    {
      const int r0 = u.pm * 256 + wr * 64 + fr;
#pragma unroll
      for (int q = 0; q < 4; ++q) xq[0][q] = *(const float4*)(xin + (size_t)r0 * 1024 + cbase + q * 4);
    }
#pragma unroll
    for (int ai = 0; ai < 2; ++ai)
#pragma unroll
      for (int m = 0; m < 4; ++m) {
        const int it = ai * 4 + m;
        const int r = u.pm * 256 + ai * 128 + wr * 64 + m * 16 + fr, b = r >> 11;
        if (it < 7) {
          const int rn = u.pm * 256 + ((it + 1) >> 2) * 128 + wr * 64 + ((it + 1) & 3) * 16 + fr;
#pragma unroll
          for (int q = 0; q < 4; ++q) xq[(it + 1) & 1][q] = *(const float4*)(xin + (size_t)rn * 1024 + cbase + q * 4);
        }
        float ss = 0.f;
#pragma unroll
        for (int bj = 0; bj < 2; ++bj)
#pragma unroll
          for (int n = 0; n < 2; ++n) {
            const int c0 = cbase + bj * 8 + n * 4;
            const float4 xv = xq[it & 1][bj * 2 + n];
            const float4 g = *(const float4*)(mod + (size_t)b * 6144 + c0);
            const f32x4 a = acc[ai][bj][m][n];
            float4 ov = {xv.x + g.x * a[0], xv.y + g.y * a[1], xv.z + g.z * a[2], xv.w + g.w * a[3]};
            ss += ov.x * ov.x + ov.y * ov.y + ov.z * ov.z + ov.w * ov.w;
            *(float4*)(xout + (size_t)r * 1024 + c0) = ov;
          }
        ss += __shfl_xor(ss, 16); ss += __shfl_xor(ss, 32);
        if (fq == 0) rowss[(size_t)r * 16 + u.pn * 4 + wc] = ss;
      }
  });
}

struct RowsP7 { LAS const int* tab; DI unsigned operator()(const t8::Unit& u, int row) const { const int slot = tab[u.tab * 256 + row]; const int tok = slot < 0 ? 0 : (slot >= T_ * 8 ? slot - T_ * 8 : slot >> 3); return (unsigned)tok * 2048u; } };
struct RowsP8 { LAS const int* tab; DI unsigned operator()(const t8::Unit& u, int row) const { const int slot = tab[u.tab * 256 + row]; return (unsigned)(slot < 0 ? 0 : slot) * 512u; } };

DI void phase_p7(const P& p, LAS unsigned char* lds, int l, int G, int bid) {
  int total; const int c = xcd_vb(bid, G);
  moe_prepare(p, lds, l, 2, G, c, total);
  t8::MoeSched S{(LAS const int*)(lds + t8::START_OFF), 2, total, G, c, (const unsigned char*)p.wgu_t(), (const unsigned char*)p.wsg_t(), (size_t)512 * 1024 * 2, (size_t)256 * 1024 * 2};
  RowsP7 RO{(LAS const int*)(lds + t8::TAB_OFF)};
  LAS const int* tab = (LAS const int*)(lds + t8::TAB_OFF);
  bf16_t* act = p.act();
  t8::gemm_phase<true>(lds, (const unsigned char*)p.h(), 1024, S, RO, [=](const f32x4 (&acc)[2][2][4][2], const t8::Unit& u, int wr, int wc, int fr, int fq) {
#pragma unroll
    for (int ai = 0; ai < 2; ++ai)
#pragma unroll
      for (int m = 0; m < 4; ++m) {
        const int slot = tab[u.tab * 256 + ai * 128 + wr * 64 + m * 16 + fr];
        if (slot >= 0) {
          const f32x4 g0 = acc[ai][0][m][0], g1 = acc[ai][0][m][1], u0 = acc[ai][1][m][0], u1 = acc[ai][1][m][1];
          u32x4 o;
          o.x = pack2(silu_f(g0[0]) * u0[0], silu_f(g0[1]) * u0[1]); o.y = pack2(silu_f(g0[2]) * u0[2], silu_f(g0[3]) * u0[3]);
          o.z = pack2(silu_f(g1[0]) * u1[0], silu_f(g1[1]) * u1[1]); o.w = pack2(silu_f(g1[2]) * u1[2], silu_f(g1[3]) * u1[3]);
          *(u32x4*)(act + (size_t)slot * 256 + u.pn * 128 + wc * 32 + fq * 8) = o;
        }
        asm volatile("" ::: "memory");
      }
  });
}

DI void phase_p8(const P& p, LAS unsigned char* lds, int l, int G, int bid) {
  int total; const int c = xcd_vb(bid, G);
  moe_prepare(p, lds, l, 4, G, c, total);
  t8::MoeSched S{(LAS const int*)(lds + t8::START_OFF), 4, total, G, c, (const unsigned char*)p.wd_t(), (const unsigned char*)p.wsd_t(), (size_t)1024 * 256 * 2, (size_t)256 * 256 * 2};
  RowsP8 RO{(LAS const int*)(lds + t8::TAB_OFF)};
  LAS const int* tab = (LAS const int*)(lds + t8::TAB_OFF);
  unsigned char* yrows = (unsigned char*)p.yrows(); bf16_t* ysh = p.ysh(); const float* topw = p.topw();
  t8::gemm_phase<true>(lds, (const unsigned char*)p.act(), 256, S, RO, [=](const f32x4 (&acc)[2][2][4][2], const t8::Unit& u, int wr, int wc, int fr, int fq) {
    int slots[2][4]; float wvs[2][4];
#pragma unroll
    for (int ai = 0; ai < 2; ++ai)
#pragma unroll
      for (int m = 0; m < 4; ++m) slots[ai][m] = tab[u.tab * 256 + ai * 128 + wr * 64 + m * 16 + fr];
#pragma unroll
    for (int ai = 0; ai < 2; ++ai)
#pragma unroll
      for (int m = 0; m < 4; ++m) wvs[ai][m] = (slots[ai][m] < 0 || slots[ai][m] >= T_ * 8) ? 1.f : topw[slots[ai][m]] * YSCALE;
    const int c0 = u.pn * 256 + wc * 64 + fq * 16;
#pragma unroll
    for (int ai = 0; ai < 2; ++ai)
#pragma unroll
      for (int m = 0; m < 4; ++m) {
        const int slot = slots[ai][m];
        if (slot >= 0) {
          const float wv = wvs[ai][m];
          if (slot >= T_ * 8) {
            bf16_t* dst = ysh + (size_t)(slot - T_ * 8) * 1024 + c0;
#pragma unroll
            for (int bj = 0; bj < 2; ++bj) {
              const f32x4 v0 = acc[ai][bj][m][0], v1 = acc[ai][bj][m][1];
              u32x4 o; o.x = pack2(v0[0], v0[1]); o.y = pack2(v0[2], v0[3]); o.z = pack2(v1[0], v1[1]); o.w = pack2(v1[2], v1[3]);
              *(u32x4*)(dst + bj * 8) = o;
            }
          } else {
            u32x4 o;
            o.x = pack4_fp8(acc[ai][0][m][0] * wv); o.y = pack4_fp8(acc[ai][0][m][1] * wv); o.z = pack4_fp8(acc[ai][1][m][0] * wv); o.w = pack4_fp8(acc[ai][1][m][1] * wv);
            *(u32x4*)(yrows + (size_t)slot * 1024 + c0) = o;
          }
        }
        asm volatile("" ::: "memory");
      }
  });
}

constexpr int HALF_LDS = SMEM_MAIN + SMEM_EXTRA;
#define PHASE_LOOP(n, ...) for (int base_ = 2 * bid; base_ < (n); base_ += 2 * G) { int it = base_ + half; it = it < (n) ? it : (n) - 1; __VA_ARGS__ }
__global__ void __launch_bounds__(BLOCK_THREADS, 2) fwd_megakernel(P p) {
  __shared__ __attribute__((aligned(16))) unsigned char smem_all[t8::STAGE_BYTES + 16384 + 16];
  const int G = gridDim.x, bid = blockIdx.x;
  const int half = __builtin_amdgcn_readfirstlane((int)(threadIdx.x >> 8));
  unsigned char* smem = smem_all + half * HALF_LDS;
  volatile LAS unsigned* stw = (volatile LAS unsigned*)(smem_all + t8::STAGE_BYTES + 16384);
  LAS unsigned char* lds8 = (LAS unsigned char*)smem_all;
  if (threadIdx.x == 0) { stw[0] = 0u; stw[1] = 0u; }
  __syncthreads();
  XcdBarrier bar = xcd_barrier_post(p.bar(), stw);

  PHASE_LOOP(192 + 1024 + MISC_ITEMS + CONV_SMALL,
    if (it < 192) item_mod(p, smem, it);
    else if (it < 192 + 1024) item_rope(p, it - 192);
    else if (it < 192 + 1024 + MISC_ITEMS) item_misc(p, it - 192 - 1024);
    else item_conv(p, smem, 0, it - 192 - 1024 - MISC_ITEMS);
  )
  xcd_barrier(bar);
  PHASE_LOOP(T_ / 4, item_norm0(p, it);)
  xcd_barrier(bar);

  for (int l = 0; l < 2; ++l) {
    phase_p1(p, lds8, G, bid);
    xcd_barrier(bar);
    PHASE_LOOP(128 + 512 + 768 + 1024,
      if (it < 128) item_sgu(p, smem, l, it);
      else if (it < 640) item_pool(p, smem, l, it - 128);
      else if (it < 1408) item_qproj(p, smem, it - 640);
      else item_kvproj(p, smem, it - 1408);
    )
    xcd_barrier(bar);
    if ((bid >> 3) & 1) { conv_big_loop(p, smem, l, 2 * bid + half, 2 * G); PHASE_LOOP(1024, item_attn(p, smem, it);) }
    else { PHASE_LOOP(1024, item_attn(p, smem, it);) conv_big_loop(p, smem, l, 2 * bid + half, 2 * G); }
    xcd_barrier(bar);
    phase_p4(p, lds8, l, G, bid);
    xcd_barrier(bar);
    PHASE_LOOP(512, item_p5(p, smem, l, it);)
    xcd_barrier(bar);
    phase_p7(p, lds8, l, G, bid);
    xcd_barrier(bar);
    phase_p8(p, lds8, l, G, bid);
    xcd_barrier(bar);
    const int n9 = T_ / 4 + (l == 0 ? CONV_SMALL : 0);
    PHASE_LOOP(n9,
      if (it < T_ / 4) item_p9(p, l, it);
      else item_conv(p, smem, 1, it - T_ / 4);
    )
    if (l == 0) xcd_barrier(bar);
  }
}

extern "C" void kernel_launch(void* const* d_in, const int* in_sizes, int n_in, void* d_out, int out_size, void* d_ws, size_t ws_size,
                              hipStream_t stream) {
  P p{};
  p.x = (const float*)d_in[0]; p.c = (const float*)d_in[1]; p.pos = (const int*)d_in[2];
  p.w_ada = (const float*)d_in[3]; p.b_ada = (const float*)d_in[4]; p.w_in = (const float*)d_in[5]; p.w_pool = (const float*)d_in[6];
  p.pool_scale = (const float*)d_in[7]; p.w_spatial = (const float*)d_in[8]; p.b_spatial = (const float*)d_in[9]; p.g_q = (const float*)d_in[10];
  p.w_uq = (const float*)d_in[11]; p.g_kv = (const float*)d_in[12]; p.w_ukv = (const float*)d_in[13]; p.w_out = (const float*)d_in[14];
  p.w_router = (const float*)d_in[15]; p.router_bias = (const float*)d_in[16]; p.w_gate = (const float*)d_in[17]; p.w_up = (const float*)d_in[18];
  p.w_down = (const float*)d_in[19]; p.ws_gate = (const float*)d_in[20]; p.ws_up = (const float*)d_in[21]; p.ws_down = (const float*)d_in[22];
  p.final_gain = (const float*)d_in[23];
  p.out = (float*)d_out;
  p.ws = (unsigned char*)d_ws;
  if (WS_NEED > ws_size) { fprintf(stderr, "workspace too small: need %zu have %zu\n", WS_NEED, ws_size); return; }
  hipMemsetAsync(p.ws + O_BAR, 0, CTRL_BYTES, stream);
  static int grid_blocks = 0;
  if (!grid_blocks) {
    int dev = 0, cus = 0, per_cu = 0;
    hipGetDevice(&dev);
    hipDeviceGetAttribute(&cus, hipDeviceAttributeMultiprocessorCount, dev);
    hipOccupancyMaxActiveBlocksPerMultiprocessor(&per_cu, fwd_megakernel, BLOCK_THREADS, 0);
    if (per_cu > 1) per_cu = 1;
    if (per_cu < 1) per_cu = 1;
    grid_blocks = cus * per_cu;
  }
  void* args[] = {&p};
  hipError_t e = hipLaunchCooperativeKernel((void*)fwd_megakernel, dim3(grid_blocks), dim3(BLOCK_THREADS), args, 0, stream);
  if (e != hipSuccess) fprintf(stderr, "cooperative launch failed: %s (grid %d)\n", hipGetErrorString(e), grid_blocks);
}
```

```cpp
#include <hip/hip_runtime.h>
#include <stdint.h>
#include <cstdio>

#define DI __device__ __forceinline__
#define LAS __attribute__((address_space(3)))

typedef unsigned short bf16_t;
typedef short bf16x8 __attribute__((ext_vector_type(8)));
typedef short s16x4 __attribute__((ext_vector_type(4)));
typedef float f32x4 __attribute__((ext_vector_type(4)));
typedef float f32x2 __attribute__((ext_vector_type(2)));
typedef unsigned u32x4 __attribute__((ext_vector_type(4)));
typedef unsigned u32x2 __attribute__((ext_vector_type(2)));
typedef __bf16 bf16x2_t __attribute__((ext_vector_type(2)));

constexpr int T_ = 16384, D_ = 1024, S_ = 2048, NIN = 1184;
constexpr int NTHREADS = 256;
constexpr int BLOCK_THREADS = 512;
constexpr int SMEM_MAIN = 65536, SMEM_EXTRA = 2048;
constexpr float EPS = 1e-6f;
constexpr int CSTRIDE = 64;
constexpr int LISTCAP = 16384;
constexpr int CONV_SMALL = 592 + 24 + 16 + 128;
constexpr int CONV_BIG = 96 + 6144;
constexpr int CONV_ITEMS = CONV_SMALL + CONV_BIG;

constexpr size_t al256(size_t x) { return (x + 255) & ~(size_t)255; }
constexpr size_t CTRL_BYTES = (size_t)3456 * 4 + (size_t)2 * 64 * CSTRIDE * 4;
constexpr size_t O_BAR = 0;
constexpr size_t O_MOD = O_BAR + al256(CTRL_BYTES);
constexpr size_t O_ROPEC = O_MOD + al256((size_t)2 * 8 * 6144 * 4);
constexpr size_t O_ROPES = O_ROPEC + al256((size_t)T_ * 16 * 4);
constexpr size_t O_WIN = O_ROPES + al256((size_t)T_ * 16 * 4);
constexpr size_t O_WUQ = O_WIN + al256((size_t)1280 * 1024 * 2);
constexpr size_t O_WUKV = O_WUQ + al256((size_t)768 * 256 * 2);
constexpr size_t O_WOUT = O_WUKV + al256((size_t)1024 * 256 * 2);
constexpr size_t O_WSG = O_WOUT + al256((size_t)1024 * 1024 * 2);
constexpr size_t O_WSD = O_WSG + al256((size_t)512 * 1024 * 2);
constexpr size_t O_WSP = O_WSD + al256((size_t)1024 * 256 * 2);
constexpr size_t O_WPOOL = O_WSP + al256((size_t)2 * 4 * 128 * 128 * 2);
constexpr size_t O_WRHI = O_WPOOL + al256((size_t)2 * 4 * 64 * 64 * 2);
constexpr size_t O_WRLO = O_WRHI + al256((size_t)2 * 64 * 1024 * 2);
constexpr size_t O_WGU = O_WRLO + al256((size_t)2 * 64 * 1024 * 2);
constexpr size_t O_WD = O_WGU + al256((size_t)64 * 512 * 1024 * 2);
constexpr size_t O_H = O_WD + al256((size_t)64 * 1024 * 256 * 2);
constexpr size_t O_ACT = O_H + al256((size_t)T_ * 1024 * 2);
constexpr size_t O_YSH = O_ACT + al256((size_t)(T_ * 8 + T_) * 256 * 2);
constexpr size_t O_LIST = O_YSH + al256((size_t)T_ * 1024 * 2);
constexpr size_t O_TOPW = O_LIST + al256((size_t)64 * LISTCAP * 4);
constexpr size_t O_ROWSS = O_TOPW + al256((size_t)T_ * 8 * 4);
constexpr size_t O_RSQ = O_ROWSS + al256((size_t)T_ * 16 * 4);
constexpr size_t O_BIG = O_RSQ + al256((size_t)T_ * 8 * 4);
constexpr size_t O_YROWS = O_BIG;
constexpr size_t O_PROJ = O_BIG;
constexpr size_t O_Q = O_PROJ + al256((size_t)T_ * NIN * 2);
constexpr size_t O_KB = O_Q + al256((size_t)T_ * 8 * 96 * 2);
constexpr size_t O_V = O_KB + al256((size_t)T_ * 8 * 96 * 2);
constexpr size_t O_Y = O_V + al256((size_t)T_ * 8 * 64 * 2);
constexpr size_t WS_NEED = O_BIG + al256((size_t)T_ * 8 * 1024 * 2);

struct P {
  const float *x, *c; const int* pos;
  const float *w_ada, *b_ada, *w_in, *w_pool, *pool_scale, *w_spatial, *b_spatial, *g_q, *w_uq, *g_kv, *w_ukv, *w_out,
      *w_router, *router_bias, *w_gate, *w_up, *w_down, *ws_gate, *ws_up, *ws_down, *final_gain;
  float* out;
  unsigned char* ws;
  DI unsigned* bar() const { return (unsigned*)(ws + O_BAR); }
  DI int* cnt() const { return (int*)(ws + O_BAR) + 3456; }
  DI float* mod() const { return (float*)(ws + O_MOD); }
  DI float* ropec() const { return (float*)(ws + O_ROPEC); }
  DI float* ropes() const { return (float*)(ws + O_ROPES); }
  DI bf16_t* win_t() const { return (bf16_t*)(ws + O_WIN); }
  DI bf16_t* wuq_t() const { return (bf16_t*)(ws + O_WUQ); }
  DI bf16_t* wukv_t() const { return (bf16_t*)(ws + O_WUKV); }
  DI bf16_t* wout_t() const { return (bf16_t*)(ws + O_WOUT); }
  DI bf16_t* wsg_t() const { return (bf16_t*)(ws + O_WSG); }
  DI bf16_t* wsd_t() const { return (bf16_t*)(ws + O_WSD); }
  DI bf16_t* wsp_b() const { return (bf16_t*)(ws + O_WSP); }
  DI bf16_t* wpool_t() const { return (bf16_t*)(ws + O_WPOOL); }
  DI bf16_t* wr_hi() const { return (bf16_t*)(ws + O_WRHI); }
  DI bf16_t* wr_lo() const { return (bf16_t*)(ws + O_WRLO); }
  DI bf16_t* wgu_t() const { return (bf16_t*)(ws + O_WGU); }
  DI bf16_t* wd_t() const { return (bf16_t*)(ws + O_WD); }
  DI bf16_t* h() const { return (bf16_t*)(ws + O_H); }
  DI bf16_t* act() const { return (bf16_t*)(ws + O_ACT); }
  DI bf16_t* ysh() const { return (bf16_t*)(ws + O_YSH); }
  DI int* list() const { return (int*)(ws + O_LIST); }
  DI float* topw() const { return (float*)(ws + O_TOPW); }
  DI float* rowss() const { return (float*)(ws + O_ROWSS); }
  DI float* rsq() const { return (float*)(ws + O_RSQ); }
  DI bf16_t* yrows() const { return (bf16_t*)(ws + O_YROWS); }
  DI bf16_t* proj() const { return (bf16_t*)(ws + O_PROJ); }
  DI bf16_t* Q() const { return (bf16_t*)(ws + O_Q); }
  DI bf16_t* Kb() const { return (bf16_t*)(ws + O_KB); }
  DI bf16_t* V() const { return (bf16_t*)(ws + O_V); }
  DI bf16_t* Y() const { return (bf16_t*)(ws + O_Y); }
};

DI unsigned pack2(float lo, float hi) { f32x2 f = {lo, hi}; bf16x2_t b = __builtin_convertvector(f, bf16x2_t); return __builtin_bit_cast(unsigned, b); }
DI float bf2f(unsigned short b) { return __uint_as_float(((unsigned)b) << 16); }
DI float bflo(unsigned u) { return __uint_as_float(u << 16); }
DI float bfhi(unsigned u) { return __uint_as_float(u & 0xffff0000u); }
constexpr int WTAB_OFF = 128 * 1024 + 16384 + 16;
DI int hw_slot() { return (int)(__builtin_amdgcn_s_getreg((5 << 11) | 4) & 63u); }
DI int lane_id() { unsigned z = 0u; asm volatile("" : "+v"(z)); return (int)__builtin_amdgcn_mbcnt_hi(~0u, __builtin_amdgcn_mbcnt_lo(~0u, z)); }
DI int full_tid() {
  const int wv = __builtin_amdgcn_readfirstlane(((LAS const int*)(size_t)WTAB_OFF)[hw_slot()]);
  int t = (wv << 6) | lane_id(); asm volatile("" : "+v"(t)); return t;
}
DI int otid() { return full_tid() & 255; }

constexpr float YSCALE = 16.f;
DI unsigned pack4_fp8(f32x4 v) {
  const float a = __builtin_amdgcn_fmed3f(v[0], -448.f, 448.f), b = __builtin_amdgcn_fmed3f(v[1], -448.f, 448.f), c = __builtin_amdgcn_fmed3f(v[2], -448.f, 448.f), d = __builtin_amdgcn_fmed3f(v[3], -448.f, 448.f);
  int w = 0; w = __builtin_amdgcn_cvt_pk_fp8_f32(a, b, w, false); w = __builtin_amdgcn_cvt_pk_fp8_f32(c, d, w, true); return (unsigned)w;
}
DI float wsum(float v) { for (int o = 32; o; o >>= 1) v += __shfl_xor(v, o); return v; }
DI float silu_f(float x) { return x / (1.f + __expf(-x)); }
DI float gelu_tanh(float x) { float z = 0.7978845608028654f * (x + 0.044715f * x * x * x); float e = __expf(2.f * z); float t = 1.f - 2.f / (1.f + e); return 0.5f * x * (1.f + t); }

#define XB_TMO      128
#define XB_XCNT(j)  (256  + 64 * (j))
#define XB_XSUB(j)  (1280 + 64 * (j))
#define XB_XGEN(j)  (2304 + 64 * (j))
#define XB_TOP      3328
#define XB_TOPGEN   3392
#define XCD_BAR_WORDS 3456
#define XB_SPIN_CAP (1u << 20)
DI unsigned xb_ld(unsigned* p) { return __hip_atomic_load(p, __ATOMIC_RELAXED, __HIP_MEMORY_SCOPE_AGENT); }
DI unsigned xb_add(unsigned* p, unsigned v) { return __hip_atomic_fetch_add(p, v, __ATOMIC_RELAXED, __HIP_MEMORY_SCOPE_AGENT); }
DI unsigned xb_xcc_id() { return (unsigned)__builtin_amdgcn_s_getreg((3 << 11) | 20) & 0xFu; }
#define XB_SPIN(cond, bar) do { unsigned _sp = 0; while (cond) { __builtin_amdgcn_s_sleep(1); \
    if ((++_sp & 255u) == 0u) { if (xb_ld(&(bar)[XB_TMO])) break; if (_sp > XB_SPIN_CAP) { atomicAdd(&(bar)[XB_TMO], 1u); break; } } } } while (0)
struct XcdBarrier { unsigned* bar; unsigned x; volatile LAS unsigned* st; };
DI XcdBarrier xcd_barrier_post(unsigned* bar, volatile LAS unsigned* st) {
  XcdBarrier b; b.bar = bar; b.x = xb_xcc_id(); b.st = st;
  if (full_tid() == 0) (void)xb_add(&bar[XB_XCNT(b.x)], 1u);
  return b;
}
DI void xcd_barrier_complete(unsigned* bar, unsigned x, unsigned& nloc, unsigned& nx) {
  const unsigned G = gridDim.x * gridDim.y * gridDim.z;
  unsigned sum, cnt, mine, sp = 0u;
  for (;;) {
    sum = 0u; cnt = 0u; mine = 0u;
#pragma unroll
    for (unsigned j = 0; j < 16; ++j) { const unsigned c = xb_ld(&bar[XB_XCNT(j)]); sum += c; cnt += (c > 0u) ? 1u : 0u; mine = (j == x) ? c : mine; }
    if (sum == G) break;
    __builtin_amdgcn_s_sleep(1);
    if ((++sp & 255u) == 0u) { if (xb_ld(&bar[XB_TMO])) break; if (sp > XB_SPIN_CAP) { atomicAdd(&bar[XB_TMO], 1u); break; } }
  }
  nloc = mine > 0u ? mine : 1u; nx = cnt > 0u ? cnt : 1u;
}
DI void xcd_barrier(const XcdBarrier& b0) {
  XcdBarrier b = b0; b.x = xb_xcc_id();
  asm volatile("s_waitcnt vmcnt(0)" ::: "memory");
  __syncthreads();
  if (full_tid() == 0) {
    unsigned* bar = b.bar;
    __builtin_amdgcn_s_waitcnt(0);
    unsigned nloc = b.st[0], nx = b.st[1];
    if (nloc == 0u) { xcd_barrier_complete(bar, b.x, nloc, nx); b.st[0] = nloc; b.st[1] = nx; }
    const unsigned old = xb_add(&bar[XB_XSUB(b.x)], 1u);
    const unsigned gen = old / nloc;
    if (old + 1u == (gen + 1u) * nloc) {
      __builtin_amdgcn_fence(__ATOMIC_RELEASE, "agent");
      asm volatile("s_waitcnt vmcnt(0)" ::: "memory");
      const unsigned og = xb_add(&bar[XB_TOP], 1u);
      const unsigned tg = og / nx;
      if (og + 1u == (tg + 1u) * nx) xb_add(&bar[XB_TOPGEN], 1u);
      else XB_SPIN(xb_ld(&bar[XB_TOPGEN]) == tg, bar);
      __builtin_amdgcn_fence(__ATOMIC_ACQUIRE, "agent");
      xb_add(&bar[XB_XGEN(b.x)], 1u);
      asm volatile("s_waitcnt vmcnt(0)" ::: "memory");
    } else {
      XB_SPIN(xb_ld(&bar[XB_XGEN(b.x)]) == gen, bar);
      __builtin_amdgcn_fence(__ATOMIC_ACQUIRE, "agent");
      asm volatile("s_waitcnt vmcnt(0)" ::: "memory");
    }
  }
  __syncthreads();
}


template <int RB> DI void ot_put(unsigned char* base, int row, int unit, u32x2 v) { *(u32x2*)(base + row * RB + ((unit ^ (row & 15)) << 3)) = v; }
template <int RB> DI u32x4 ot_get(const unsigned char* base, int row, int chunk) {
  const u32x4 v = *(const u32x4*)(base + row * RB + ((chunk ^ ((row & 15) >> 1)) << 4));
  return (row & 1) ? (u32x4){v.z, v.w, v.x, v.y} : v;
}

template <class Epi>
DI void gemm128_stream(unsigned char* smem, const unsigned char* abase, const unsigned (&ao)[4], const unsigned char* bbase, const unsigned (&bo)[4], int nk, int ntile, size_t btile_stride, Epi&& epi) {
  const int tid = otid(), lane = tid & 63, w = tid >> 6;
  const int wm = w >> 1, wn = w & 1;
  const int r_s = tid >> 3, c_s = tid & 7;
  const int st_off = r_s * 128 + ((c_s ^ (r_s & 7)) << 4);
  const int fr = lane & 15, fq = lane >> 4;
  const int sw0 = ((0 + fq) ^ (fr & 7)) << 4, sw1 = ((4 + fq) ^ (fr & 7)) << 4;
  const int arow_off = (wm * 64 + fr) * 128, brow_off = 32768 + (wn * 64 + fr) * 128;
  u32x4 ra0[4], rb0[4], ra1[4], rb1[4];
  f32x4 acc[4][4];
#pragma unroll
  for (int i = 0; i < 4; ++i)
#pragma unroll
    for (int j = 0; j < 4; ++j) acc[i][j] = (f32x4){0.f, 0.f, 0.f, 0.f};
  const int total = nk * ntile;
  int lkt = 0, ltl = 0;
  auto load = [&](u32x4 (&ra)[4], u32x4 (&rb)[4]) {
    const unsigned char* ab = abase + lkt * 128;
    const unsigned char* bb = bbase + ((size_t)ltl * btile_stride + lkt * 64) * 2;
#pragma unroll
    for (int j = 0; j < 4; ++j) { ra[j] = *(const u32x4*)(ab + ao[j]); rb[j] = *(const u32x4*)(bb + bo[j]); }
    const bool last = (lkt == nk - 1) && (ltl == ntile - 1);
    const int nl = (lkt == nk - 1) ? 0 : lkt + 1;
    ltl = last ? ltl : ((lkt == nk - 1) ? ltl + 1 : ltl);
    lkt = last ? lkt : nl;
  };
  auto store = [&](const u32x4 (&ra)[4], const u32x4 (&rb)[4], int bufo) {
#pragma unroll
    for (int j = 0; j < 4; ++j) { *(u32x4*)(smem + bufo + st_off + j * 4096) = ra[j]; *(u32x4*)(smem + 32768 + bufo + st_off + j * 4096) = rb[j]; }
  };
  int kt = 0, tile = 0;
  auto body = [&](int s, int cur, u32x4 (&lra)[4], u32x4 (&lrb)[4], const u32x4 (&wra)[4], const u32x4 (&wrb)[4]) {
    load(lra, lrb);
#pragma unroll
    for (int ks = 0; ks < 2; ++ks) {
      const int sw = ks ? sw1 : sw0;
      bf16x8 af[4], bfr[4];
#pragma unroll
      for (int i = 0; i < 4; ++i) af[i] = *(const bf16x8*)(smem + cur + arow_off + i * 2048 + sw);
#pragma unroll
      for (int j = 0; j < 4; ++j) bfr[j] = *(const bf16x8*)(smem + cur + brow_off + j * 2048 + sw);
#pragma unroll
      for (int i = 0; i < 4; ++i)
#pragma unroll
        for (int j = 0; j < 4; ++j) acc[i][j] = __builtin_amdgcn_mfma_f32_16x16x32_bf16(bfr[j], af[i], acc[i][j], 0, 0, 0);
    }
    if (s + 1 < total) store(wra, wrb, 16384 - cur);
    if (kt == nk - 1) {
      int wm2 = wm, wn2 = wn, fr2 = fr, fq2 = fq;
      asm volatile("" : "+v"(wm2), "+v"(wn2), "+v"(fr2), "+v"(fq2));
      epi(acc, tile, cur, wm2, wn2, fr2, fq2);
#pragma unroll
      for (int i = 0; i < 4; ++i)
#pragma unroll
        for (int j = 0; j < 4; ++j) acc[i][j] = (f32x4){0.f, 0.f, 0.f, 0.f};
    }
    __syncthreads();
    if (++kt == nk) { kt = 0; ++tile; }
  };
  load(ra0, rb0);
  load(ra1, rb1);
  store(ra0, rb0, 0);
  __syncthreads();
  for (int s = 0; s < total; s += 2) {
    body(s, 0, ra0, rb0, ra1, rb1);
    if (s + 1 >= total) break;
    body(s + 1, 16384, ra1, rb1, ra0, rb0);
  }
}
template <class Epi>
DI void gemm128(unsigned char* smem, const unsigned char* abase, const unsigned (&ao)[4], const unsigned char* bbase, const unsigned (&bo)[4], int nk, Epi&& epi) {
  gemm128_stream(smem, abase, ao, bbase, bo, nk, 1, 0, [&](f32x4 (&acc)[4][4], int, int, int wm, int wn, int fr, int fq) { __syncthreads(); epi(acc, wm, wn, fr, fq); });
}


namespace t8 {
constexpr int BM = 256, BK = 64, HALF = 128, HTB = HALF * BK * 2, STAGE_BYTES = 8 * HTB;
DI int lds_byte(int r, int c) { const int st = (r >> 4) * 2 + (c >> 5), rr = r & 15, cc = c & 31, ob = rr * 64 + cc * 2; return st * 1024 + (ob ^ (((ob >> 9) & 1) << 5)); }
DI void stage_rc(int b, int& R, int& C) { const int st = b / 1024, sb = b % 1024, swz = sb ^ (((sb >> 9) & 1) << 5); R = (st >> 1) * 16 + swz / 64; C = (st & 1) * 32 + (swz % 64) / 2; }
DI int perm32(int rho) { const int n = rho >> 4, i = rho & 15; return 8 * (i >> 2) + 4 * n + (i & 3); }
struct Unit { int pm, pn, tab; const unsigned char* bbase; };
constexpr int TAB_OFF = STAGE_BYTES;
constexpr int START_OFF = STAGE_BYTES + 12288;

template <bool PERM, class Sched, class RowOff, class Epi>
DI void gemm_phase(LAS unsigned char* lds, const unsigned char* Abase, const int K, const Sched& S, const RowOff& RO, const Epi& E) {
  const int tid = full_tid();
  const int wid = __builtin_amdgcn_readfirstlane(tid >> 6), lane = tid & 63, wr = wid >> 2, wc = wid & 3, fr = lane & 15, fq = lane >> 4;
  const int nt = K / BK;
  unsigned voffB[2][2];
#pragma unroll
  for (int h = 0; h < 2; ++h)
#pragma unroll
    for (int i = 0; i < 2; ++i) { int R, C; stage_rc(tid * 16 + i * 8192, R, C); const int rho = h * HALF + R;
      const int Rb = PERM ? (((rho >> 5) & 3) * 64 + ((rho >> 2) & 3) * 16 + (rho >> 7) * 8 + ((rho >> 4) & 1) * 4 + (rho & 3)) : rho; voffB[h][i] = (unsigned)(Rb * K + C) * 2u; }
  auto apiece = [&](const Unit& u, int h, int i) -> unsigned { int R, C; stage_rc(tid * 16 + i * 8192, R, C); return RO(u, h * HALF + R) + (unsigned)(C * 2); };
  const size_t kstep = (size_t)(BK * 2);
  const unsigned ldsw = (unsigned)wid * 1024u;
  const int aoff = lds_byte(wr * 64 + fr, fq * 8), boff = lds_byte(wc * 32 + fr, fq * 8);
  LAS const unsigned char* ldsA = lds + aoff; LAS const unsigned char* ldsB = lds + 4 * HTB + boff;
  asm volatile("" : "+v"(ldsA), "+v"(ldsB));
#define T8_SA(b, h) (((b) * 2 + (h)) * HTB)
#define T8_SB(b, h) ((4 + (b) * 2 + (h)) * HTB)
#define T8_STAGE(bufoff, gbase, voff) do { _Pragma("unroll") for (int _i = 0; _i < 2; ++_i) \
    __builtin_amdgcn_global_load_lds((const unsigned*)((const char*)(gbase) + (voff)[_i]), (LAS unsigned*)(lds + (bufoff) + ldsw + _i * 8192), 16, 0, 0); } while (0)
#define T8_LDA(dst, b, h) do { _Pragma("unroll") for (int m = 0; m < 4; ++m) _Pragma("unroll") for (int k = 0; k < 2; ++k) dst[m][k] = *(const LAS bf16x8*)(ldsA + T8_SA(b, h) + m * 2048 + k * 1024); } while (0)
#define T8_LDB(dst, b, h) do { _Pragma("unroll") for (int n = 0; n < 2; ++n) _Pragma("unroll") for (int k = 0; k < 2; ++k) dst[n][k] = *(const LAS bf16x8*)(ldsB + (T8_SB(b, h) - 4 * HTB) + n * 2048 + k * 1024); } while (0)
#define T8_MMA(ai, bj, At, Bt) do { __builtin_amdgcn_s_setprio(1); _Pragma("unroll") for (int m = 0; m < 4; ++m) _Pragma("unroll") for (int n = 0; n < 2; ++n) _Pragma("unroll") for (int k = 0; k < 2; ++k) \
    acc[ai][bj][m][n] = __builtin_amdgcn_mfma_f32_16x16x32_bf16(Bt[n][k], At[m][k], acc[ai][bj][m][n], 0, 0, 0); __builtin_amdgcn_s_setprio(0); } while (0)
#define T8_WAIT_V(n) asm volatile("s_waitcnt vmcnt(" #n ")" ::: "memory")
#define T8_WAIT_L(n) asm volatile("s_waitcnt lgkmcnt(" #n ")" ::: "memory")
#define T8_BAR __builtin_amdgcn_s_barrier()
#define T8_SCHED __builtin_amdgcn_sched_barrier(0)
  Unit cur, nxt; int ui = 0;
  if (!S.next(0, cur)) return;
  f32x4 acc[2][2][4][2];
#pragma unroll
  for (int a = 0; a < 2; ++a)
#pragma unroll
    for (int b = 0; b < 2; ++b)
#pragma unroll
      for (int m = 0; m < 4; ++m)
#pragma unroll
        for (int n = 0; n < 2; ++n) acc[a][b][m][n] = (f32x4){0.f, 0.f, 0.f, 0.f};
  bf16x8 At[4][2], B0[2][2], B1[2][2];
  unsigned vc[2][2];
#pragma unroll
  for (int h = 0; h < 2; ++h)
#pragma unroll
    for (int i = 0; i < 2; ++i) vc[h][i] = apiece(cur, h, i);
  const char* cB = (const char*)cur.bbase;
  const char* gA = (const char*)Abase;
  T8_STAGE(T8_SB(0, 0), cB, voffB[0]); T8_STAGE(T8_SA(0, 0), gA, vc[0]); T8_STAGE(T8_SB(0, 1), cB, voffB[1]); T8_STAGE(T8_SA(0, 1), gA, vc[1]);
  if (wr == 1) T8_BAR;
  T8_WAIT_V(4); T8_BAR;
  T8_STAGE(T8_SB(1, 0), cB + kstep, voffB[0]); T8_STAGE(T8_SA(1, 0), gA + kstep, vc[0]); T8_STAGE(T8_SB(1, 1), cB + kstep, voffB[1]);
  T8_WAIT_V(6); T8_BAR;
  for (;;) {
    const bool has_next = S.next(ui + 1, nxt);
    const char* nB = has_next ? (const char*)nxt.bbase : cB;
#pragma unroll 1
    for (int t = 0; t < nt; t += 2) {
      const bool last = (t == nt - 2);
      const char* a1 = gA + (size_t)(t + 1) * kstep;
      const char* a2 = last ? gA : gA + (size_t)(t + 2) * kstep; const char* b2 = last ? nB : cB + (size_t)(t + 2) * kstep;
      const char* a3 = a2 + kstep; const char* b3 = b2 + kstep;
      if (last && has_next) { vc[0][0] = apiece(nxt, 0, 0); vc[0][1] = apiece(nxt, 0, 1); }
      T8_LDB(B0, 0, 0); T8_SCHED; T8_LDA(At, 0, 0); T8_STAGE(T8_SA(1, 1), a1, vc[1]);
      T8_WAIT_L(8); T8_BAR; T8_WAIT_L(0); T8_MMA(0, 0, At, B0); T8_BAR; T8_SCHED;
      if (last && has_next) { vc[1][0] = apiece(nxt, 1, 0); vc[1][1] = apiece(nxt, 1, 1); }
      T8_LDB(B1, 0, 1); T8_STAGE(T8_SB(0, 0), b2, voffB[0]);
      T8_BAR; T8_WAIT_L(0); T8_MMA(0, 1, At, B1); T8_BAR;
      T8_LDA(At, 0, 1); T8_STAGE(T8_SA(0, 0), a2, vc[0]);
      T8_BAR; T8_WAIT_L(0); T8_MMA(1, 0, At, B0); T8_BAR; T8_SCHED;
      T8_STAGE(T8_SB(0, 1), b2, voffB[1]);
      T8_WAIT_V(6); T8_BAR; T8_MMA(1, 1, At, B1); T8_BAR;
      T8_LDB(B0, 1, 0); T8_SCHED; T8_LDA(At, 1, 0); T8_STAGE(T8_SA(0, 1), a2, vc[1]);
      T8_WAIT_L(8); T8_BAR; T8_WAIT_L(0); T8_MMA(0, 0, At, B0); T8_BAR; T8_SCHED;
      T8_LDB(B1, 1, 1); T8_STAGE(T8_SB(1, 0), b3, voffB[0]);
      T8_BAR; T8_WAIT_L(0); T8_MMA(0, 1, At, B1); T8_BAR;
      T8_LDA(At, 1, 1); T8_STAGE(T8_SA(1, 0), a3, vc[0]);
      T8_BAR; T8_WAIT_L(0); T8_MMA(1, 0, At, B0); T8_BAR; T8_SCHED;
      T8_STAGE(T8_SB(1, 1), b3, voffB[1]);
      T8_WAIT_V(6); T8_BAR; T8_MMA(1, 1, At, B1); T8_BAR;
    }
    E(acc, cur, wr, wc, fr, fq);
    if (!has_next) break;
#pragma unroll
    for (int a = 0; a < 2; ++a)
#pragma unroll
      for (int b = 0; b < 2; ++b)
#pragma unroll
        for (int m = 0; m < 4; ++m)
#pragma unroll
          for (int n = 0; n < 2; ++n) acc[a][b][m][n] = (f32x4){0.f, 0.f, 0.f, 0.f};
    cur = nxt; cB = nB; ++ui;
  }
  T8_WAIT_V(0);
  if (wr == 0) T8_BAR;
  T8_BAR;
#undef T8_SA
#undef T8_SB
#undef T8_STAGE
#undef T8_LDA
#undef T8_LDB
#undef T8_MMA
#undef T8_WAIT_V
#undef T8_WAIT_L
#undef T8_BAR
#undef T8_SCHED
}

struct DenseSched {
  int nM, nN, nwg, G, c; const unsigned char* Bt; size_t tstep;
  DI void init(int M, int N, int K, int G_, int c_, const void* Bt_) { nM = M / BM; nN = N / BM; nwg = nM * nN; G = G_; c = c_; Bt = (const unsigned char*)Bt_; tstep = (size_t)BM * K * 2; }
  DI bool next(int i, Unit& u) const {
    const long L = (long)i * G + c; if (L >= nwg) return false;
    int wgid = (int)L; { const int q = nwg / 8, r = nwg % 8, xcd = wgid % 8, off = wgid / 8; wgid = (xcd < r ? xcd * (q + 1) : r * (q + 1) + (xcd - r) * q) + off; }
    const int nig = 8 * nN, gid = wgid / nig, fm = gid * 8, gsz = (nM - fm) < 8 ? (nM - fm) : 8;
    u.pm = fm + ((wgid % nig) % gsz); u.pn = (wgid % nig) / gsz; u.tab = 0; u.bbase = Bt + (size_t)u.pn * tstep; return true;
  }
};
struct DenseRows { unsigned rowbytes; DI unsigned operator()(const Unit& u, int row) const { return (unsigned)(u.pm * BM + row) * rowbytes; } };

struct MoeSched {
  LAS const int* start; int npn, nmt, G, c; const unsigned char* wexp; const unsigned char* wsh; size_t estride, tstep;
  DI bool locate(int i, int& mt, int& pn, int& tab) const {
    const int R = nmt / G;
    if (i < R * npn) { const int r = i / npn; pn = i - r * npn; mt = r * G + c; tab = r; return true; }
    const int j = i - R * npn, L = j * G + c, rem = (nmt - R * G) * npn;
    if (L >= rem) return false;
    const int q = L / npn; pn = L - q * npn; mt = R * G + q; tab = R + j; return true;
  }
  DI bool next(int i, Unit& u) const {
    int mt, pn, tab;
    if (!locate(i, mt, pn, tab)) return false;
    u.pm = mt; u.pn = pn; u.tab = tab;
    const int e = __builtin_amdgcn_readfirstlane(start[128 + tab]);
    u.bbase = (e == 64 ? wsh : wexp + (size_t)e * estride) + (size_t)pn * tstep; return true;
  }
};
}

DI void moe_prepare(const P& p, LAS unsigned char* lds, int l, int npn, int G, int c, int& total_units) {
  LAS int* start = (LAS int*)(lds + t8::START_OFF);
  __syncthreads();
  if (full_tid() == 0) {
    int s = 0;
    for (int e = 0; e < 64; ++e) { start[e] = s; s += (p.cnt()[(l * 64 + e) * CSTRIDE] + 255) >> 8; }
    start[64] = s; start[65] = s + 64;
  }
  __syncthreads();
  const int nmt = start[65];
  total_units = nmt;
  const int tid = full_tid();
  t8::MoeSched S{start, npn, nmt, G, c, nullptr, nullptr, 0, 0};
  int last_tab = -1;
  for (int i = 0; i < 16; ++i) {
    int mt, pn, tab;
    if (!S.locate(i, mt, pn, tab)) break;
    if (tab == last_tab) continue;
    last_tab = tab;
    int e = 64;
    if (mt < start[64]) {
      e = 0;
#pragma unroll 4
      for (int q = 1; q < 64; ++q) e = (start[q] <= mt) ? q : e;
    }
    if (tid == 0) start[128 + tab] = e;
    if (tid < 256) {
      int slot;
      if (mt >= start[64]) slot = T_ * 8 + (mt - start[64]) * 256 + tid;
      else {
        const int idx = (mt - start[e]) * 256 + tid;
        slot = idx < p.cnt()[(l * 64 + e) * CSTRIDE] ? p.list()[(size_t)e * LISTCAP + idx] : -1;
      }
      ((LAS int*)(lds + t8::TAB_OFF))[tab * 256 + tid] = slot;
    }
  }
  __syncthreads();
}

DI void item_mod(const P& p, unsigned char* smem, int item) {
  const int l = item / 96, cb = item % 96;
  const int tid = otid(), w = tid >> 6, lane = tid & 63;
  float* sc = (float*)smem;
  float* red = (float*)(smem + 32768);
  __syncthreads();
  for (int i = tid; i < 8192; i += NTHREADS) sc[i] = silu_f(p.c[i]);
  __syncthreads();
  const int col = cb * 64 + lane;
  const float* W = p.w_ada + (size_t)l * 1024 * 6144 + col;
  float acc[8];
#pragma unroll
  for (int b = 0; b < 8; ++b) acc[b] = 0.f;
  for (int k0 = w * 256; k0 < w * 256 + 256; k0 += 16) {
    float wv[16];
#pragma unroll
    for (int u = 0; u < 16; ++u) wv[u] = W[(size_t)(k0 + u) * 6144];
#pragma unroll
    for (int u = 0; u < 16; ++u)
#pragma unroll
      for (int b = 0; b < 8; ++b) acc[b] += sc[b * 1024 + k0 + u] * wv[u];
  }
#pragma unroll
  for (int b = 0; b < 8; ++b) red[(w * 8 + b) * 64 + lane] = acc[b];
  __syncthreads();
  for (int o = tid; o < 512; o += NTHREADS) {
    const int b = o >> 6, cc = o & 63;
    const float v = red[(0 * 8 + b) * 64 + cc] + red[(1 * 8 + b) * 64 + cc] + red[(2 * 8 + b) * 64 + cc] + red[(3 * 8 + b) * 64 + cc];
    p.mod()[((size_t)l * 8 + b) * 6144 + cb * 64 + cc] = v + p.b_ada[(size_t)l * 6144 + cb * 64 + cc];
  }
}

DI void conv_tile(unsigned char* smem, const float* src, int ldsrc, int k0, int n0, bf16_t* dst, int lddst, int mode, const float* kscale) {
  float* t = (float*)smem;
  const int tid = otid();
  __syncthreads();
  {
    const int kk = tid >> 3, nq = tid & 7;
#pragma unroll
    for (int hh = 0; hh < 2; ++hh) {
      const int k = kk + 32 * hh;
      const float4 v = *(const float4*)(src + (size_t)(k0 + k) * ldsrc + n0 + nq * 4);
      const float s = kscale ? kscale[k0 + k] : 1.f;
      t[k * 33 + nq * 4 + 0] = v.x * s; t[k * 33 + nq * 4 + 1] = v.y * s; t[k * 33 + nq * 4 + 2] = v.z * s; t[k * 33 + nq * 4 + 3] = v.w * s;
    }
  }
  __syncthreads();
  {
    const int n = tid >> 3, kc = tid & 7;
    u32x4 wv;
    wv.x = pack2(t[(kc * 8 + 0) * 33 + n], t[(kc * 8 + 1) * 33 + n]);
    wv.y = pack2(t[(kc * 8 + 2) * 33 + n], t[(kc * 8 + 3) * 33 + n]);
    wv.z = pack2(t[(kc * 8 + 4) * 33 + n], t[(kc * 8 + 5) * 33 + n]);
    wv.w = pack2(t[(kc * 8 + 6) * 33 + n], t[(kc * 8 + 7) * 33 + n]);
    const int nn = n0 + n;
    const int orow = (mode == 0) ? nn : (256 * (nn >> 7) + 16 * ((nn & 127) >> 3) + (mode == 2 ? 8 : 0) + (nn & 7));
    *(u32x4*)(dst + (size_t)orow * lddst + k0 + kc * 8) = wv;
  }
}

DI void conv_big(unsigned char* smem, const float* src, int ldsrc, int k0, int n0, bf16_t* dst, int lddst, int mode, const float* kscale) {
  float* t = (float*)smem;
  const int tid = otid();
  __syncthreads();
  {
    const int c4 = tid & 31, r0 = tid >> 5;
    float4 v[8];
#pragma unroll
    for (int hh = 0; hh < 8; ++hh) v[hh] = *(const float4*)(src + (size_t)(k0 + r0 + 8 * hh) * ldsrc + n0 + c4 * 4);
#pragma unroll
    for (int hh = 0; hh < 8; ++hh) {
      const int k = r0 + 8 * hh;
      const float sc = kscale ? kscale[k0 + k] : 1.f;
      *(float4*)(t + k * 132 + c4 * 4) = (float4){v[hh].x * sc, v[hh].y * sc, v[hh].z * sc, v[hh].w * sc};
    }
  }
  __syncthreads();
  {
    const int n = tid >> 1, kh = tid & 1;
    const int nn = n0 + n;
    const int orow = (mode == 0) ? nn : (256 * (nn >> 7) + 16 * ((nn & 127) >> 3) + (mode == 2 ? 8 : 0) + (nn & 7));
    bf16_t* d = dst + (size_t)orow * lddst + k0 + kh * 32;
#pragma unroll
    for (int c = 0; c < 4; ++c) {
      const float* tp = t + (kh * 32 + c * 8) * 132 + n;
      u32x4 wv;
      wv.x = pack2(tp[0 * 132], tp[1 * 132]); wv.y = pack2(tp[2 * 132], tp[3 * 132]); wv.z = pack2(tp[4 * 132], tp[5 * 132]); wv.w = pack2(tp[6 * 132], tp[7 * 132]);
      *(u32x4*)(d + c * 8) = wv;
    }
  }
}

DI void item_conv(const P& p, unsigned char* smem, int l, int idx) {
  if (idx < 592) { conv_tile(smem, p.w_in + (size_t)l * 1024 * NIN, NIN, (idx / 37) * 64, (idx % 37) * 32, p.win_t(), 1024, 0, nullptr); return; }
  idx -= 592;
  if (idx < 24) { conv_big(smem, p.w_uq + (size_t)l * 256 * 768, 768, (idx / 6) * 64, (idx % 6) * 128, p.wuq_t(), 256, 0, p.g_q + l * 256); return; }
  idx -= 24;
  if (idx < 16) { conv_big(smem, p.w_ukv + (size_t)l * 128 * 1024, 1024, (idx / 8) * 64, (idx % 8) * 128, p.wukv_t(), 256, 0, p.g_kv + l * 128); return; }
  idx -= 16;
  if (idx < 128) { conv_big(smem, p.w_out + (size_t)l * 1024 * 1024, 1024, (idx / 8) * 64, (idx % 8) * 128, p.wout_t(), 1024, 0, nullptr); return; }
  idx -= 128;
  if (idx < 32) { conv_big(smem, p.ws_gate + (size_t)l * 1024 * 256, 256, (idx / 2) * 64, (idx % 2) * 128, p.wsg_t(), 1024, 1, nullptr); return; }
  idx -= 32;
  if (idx < 32) { conv_big(smem, p.ws_up + (size_t)l * 1024 * 256, 256, (idx / 2) * 64, (idx % 2) * 128, p.wsg_t(), 1024, 2, nullptr); return; }
  idx -= 32;
  if (idx < 32) { conv_big(smem, p.ws_down + (size_t)l * 256 * 1024, 1024, (idx / 8) * 64, (idx % 8) * 128, p.wsd_t(), 256, 0, nullptr); return; }
  idx -= 32;
  const int e = idx / 96, r = idx % 96;
  if (r < 32) conv_big(smem, p.w_gate + ((size_t)l * 64 + e) * 1024 * 256, 256, (r / 2) * 64, (r % 2) * 128, p.wgu_t() + (size_t)e * 512 * 1024, 1024, 1, nullptr);
  else if (r < 64) conv_big(smem, p.w_up + ((size_t)l * 64 + e) * 1024 * 256, 256, ((r - 32) / 2) * 64, ((r - 32) % 2) * 128, p.wgu_t() + (size_t)e * 512 * 1024, 1024, 2, nullptr);
  else conv_big(smem, p.w_down + ((size_t)l * 64 + e) * 256 * 1024, 1024, ((r - 64) / 8) * 64, ((r - 64) % 8) * 128, p.wd_t() + (size_t)e * 1024 * 256, 256, 0, nullptr);
}


DI void conv_big_desc(const P& p, int l, int idx, const float*& src, int& ldsrc, int& k0, int& n0, bf16_t*& dst, int& lddst, int& mode) {
  if (idx < 32) { src = p.ws_gate + (size_t)l * 1024 * 256; ldsrc = 256; k0 = (idx / 2) * 64; n0 = (idx % 2) * 128; dst = p.wsg_t(); lddst = 1024; mode = 1; return; }
  idx -= 32;
  if (idx < 32) { src = p.ws_up + (size_t)l * 1024 * 256; ldsrc = 256; k0 = (idx / 2) * 64; n0 = (idx % 2) * 128; dst = p.wsg_t(); lddst = 1024; mode = 2; return; }
  idx -= 32;
  if (idx < 32) { src = p.ws_down + (size_t)l * 256 * 1024; ldsrc = 1024; k0 = (idx / 8) * 64; n0 = (idx % 8) * 128; dst = p.wsd_t(); lddst = 256; mode = 0; return; }
  idx -= 32;
  const int e = idx / 96, r = idx % 96;
  if (r < 32) { src = p.w_gate + ((size_t)l * 64 + e) * 1024 * 256; ldsrc = 256; k0 = (r / 2) * 64; n0 = (r % 2) * 128; dst = p.wgu_t() + (size_t)e * 512 * 1024; lddst = 1024; mode = 1; }
  else if (r < 64) { src = p.w_up + ((size_t)l * 64 + e) * 1024 * 256; ldsrc = 256; k0 = ((r - 32) / 2) * 64; n0 = ((r - 32) % 2) * 128; dst = p.wgu_t() + (size_t)e * 512 * 1024; lddst = 1024; mode = 2; }
  else { src = p.w_down + ((size_t)l * 64 + e) * 256 * 1024; ldsrc = 1024; k0 = ((r - 64) / 8) * 64; n0 = ((r - 64) % 8) * 128; dst = p.wd_t() + (size_t)e * 1024 * 256; lddst = 256; mode = 0; }
}
DI void conv_big_load(const P& p, int l, int idx, int tid, f32x4 (&v)[8]) {
  idx = idx < CONV_BIG ? idx : CONV_BIG - 1;
  const float* src; int ldsrc, k0, n0; bf16_t* dst; int lddst, mode;
  conv_big_desc(p, l, idx, src, ldsrc, k0, n0, dst, lddst, mode);
  const int c4 = tid & 31, r0 = tid >> 5;
#pragma unroll
  for (int hh = 0; hh < 8; ++hh) v[hh] = *(const f32x4*)(src + (size_t)(k0 + r0 + 8 * hh) * ldsrc + n0 + c4 * 4);
}
DI void conv_big_finish(const P& p, unsigned char* smem, int l, int idx, int tid, const f32x4 (&v)[8]) {
  const float* src; int ldsrc, k0, n0; bf16_t* dst; int lddst, mode;
  conv_big_desc(p, l, idx, src, ldsrc, k0, n0, dst, lddst, mode);
  float* t = (float*)smem;
  const int c4 = tid & 31, r0 = tid >> 5;
  __syncthreads();
#pragma unroll
  for (int hh = 0; hh < 8; ++hh) *(f32x4*)(t + (r0 + 8 * hh) * 132 + c4 * 4) = v[hh];
  __syncthreads();
  const int n = tid >> 1, kh = tid & 1;
  const int nn = n0 + n;
  const int orow = (mode == 0) ? nn : (256 * (nn >> 7) + 16 * ((nn & 127) >> 3) + (mode == 2 ? 8 : 0) + (nn & 7));
  bf16_t* d = dst + (size_t)orow * lddst + k0 + kh * 32;
#pragma unroll
  for (int c = 0; c < 4; ++c) {
    const float* tp = t + (kh * 32 + c * 8) * 132 + n;
    u32x4 wv;
    wv.x = pack2(tp[0 * 132], tp[1 * 132]); wv.y = pack2(tp[2 * 132], tp[3 * 132]); wv.z = pack2(tp[4 * 132], tp[5 * 132]); wv.w = pack2(tp[6 * 132], tp[7 * 132]);
    *(u32x4*)(d + c * 8) = wv;
  }
}
DI void conv_big_loop(const P& p, unsigned char* smem, int l, int first, int step) {
  if (first >= CONV_BIG) return;
  const int tid = otid();
  f32x4 va[8], vb[8];
  conv_big_load(p, l, first, tid, va); conv_big_load(p, l, first + step, tid, vb);
  for (int it = first; it < CONV_BIG; it += 2 * step) {
    conv_big_finish(p, smem, l, it, tid, va);
    conv_big_load(p, l, it + 2 * step, tid, va);
    if (it + step >= CONV_BIG) break;
    conv_big_finish(p, smem, l, it + step, tid, vb);
    conv_big_load(p, l, it + 3 * step, tid, vb);
  }
}

constexpr int MISC_ITEMS = 64 + 128 + 512 + 64;
DI void item_misc(const P& p, int item) {
  const int tid = otid();
  if (item < 64) {
    const int i = (item * NTHREADS + tid) * 8;
    const int k0 = i & 127, t = (i >> 7) & 127;
    const float4 a = *(const float4*)(p.w_spatial + i), c = *(const float4*)(p.w_spatial + i + 4);
    u32x4 o;
    o.x = pack2(k0 + 0 <= t ? a.x : 0.f, k0 + 1 <= t ? a.y : 0.f); o.y = pack2(k0 + 2 <= t ? a.z : 0.f, k0 + 3 <= t ? a.w : 0.f);
    o.z = pack2(k0 + 4 <= t ? c.x : 0.f, k0 + 5 <= t ? c.y : 0.f); o.w = pack2(k0 + 6 <= t ? c.z : 0.f, k0 + 7 <= t ? c.w : 0.f);
    *(u32x4*)(p.wsp_b() + i) = o;
  } else if (item < 64 + 128) {
    const int i = (item - 64) * NTHREADS + tid;
    const int c = i & 63, dd = (i >> 6) & 63, lg = i >> 12;
    const f32x2 f = {p.w_pool[((size_t)lg * 64 + c) * 64 + dd], 0.f}; const bf16x2_t bb = __builtin_convertvector(f, bf16x2_t);
    p.wpool_t()[i] = (bf16_t)(__builtin_bit_cast(unsigned, bb) & 0xffffu);
  } else if (item >= 64 + 128 + 512) {
    const int i = (item - 704) * NTHREADS + tid;
    *(u32x4*)(p.wukv_t() + (size_t)(i >> 4) * 256 + 128 + (i & 15) * 8) = (u32x4){0u, 0u, 0u, 0u};
  } else {
    const int i = (item - 192) * NTHREADS + tid;
    const int e = i & 63, k = (i >> 6) & 1023, l = i >> 16;
    const float v = p.w_router[i];
    const unsigned hi = pack2(v, 0.f) & 0xffffu;
    const unsigned lo = pack2(v - bflo(hi), 0.f) & 0xffffu;
    p.wr_hi()[(size_t)l * 65536 + e * 1024 + k] = (bf16_t)hi;
    p.wr_lo()[(size_t)l * 65536 + e * 1024 + k] = (bf16_t)lo;
  }
}

DI void item_rope(const P& p, int item) {
  const int i = item * NTHREADS + otid();
  const int t = i >> 4, f = i & 15;
  const float inv = exp2f(-(float)(2 * f) * (13.287712379549449f / 32.f));
  const float ang = (float)p.pos[t] * inv;
  const double rev = (double)ang * 0.15915494309189535;
  const float fr = (float)(rev - floor(rev));
  p.ropec()[i] = __builtin_amdgcn_cosf(fr);
  p.ropes()[i] = __builtin_amdgcn_sinf(fr);
}

DI void item_norm0(const P& p, int item) {
  const int tid = otid(), w = tid >> 6, lane = tid & 63;
  const int t = item * 4 + w, b = t >> 11;
  const float* xr = p.x + (size_t)t * 1024;
  const float* md = p.mod() + (size_t)b * 6144;
  float4 v[4]; float ss = 0.f;
#pragma unroll
  for (int j = 0; j < 4; ++j) { v[j] = *(const float4*)(xr + j * 256 + lane * 4); ss += v[j].x * v[j].x + v[j].y * v[j].y + v[j].z * v[j].z + v[j].w * v[j].w; }
  ss = wsum(ss);
  const float rstd = rsqrtf(ss * (1.f / 1024.f) + EPS);
#pragma unroll
  for (int j = 0; j < 4; ++j) {
    const int idx = j * 256 + lane * 4;
    const float4 sh = *(const float4*)(md + idx), sc = *(const float4*)(md + 1024 + idx);
    u32x2 o;
    o.x = pack2(v[j].x * rstd * (1.f + sc.x) + sh.x, v[j].y * rstd * (1.f + sc.y) + sh.y);
    o.y = pack2(v[j].z * rstd * (1.f + sc.z) + sh.z, v[j].w * rstd * (1.f + sc.w) + sh.w);
    *(u32x2*)(p.h() + (size_t)t * 1024 + idx) = o;
  }
}

DI void item_p1(const P& p, unsigned char* smem, int item) {
  const int m = item / 10, nt = item % 10;
  const int tid = otid(), r_s = tid >> 3, c_s = tid & 7;
  __syncthreads();
  unsigned ao[4], bo[4];
#pragma unroll
  for (int j = 0; j < 4; ++j) {
    const int row = r_s + 32 * j;
    ao[j] = (unsigned)(((m * 128 + row) * 1024 + c_s * 8) * 2);
    int n = nt * 128 + row; n = n < NIN ? n : NIN - 1;
    bo[j] = (unsigned)((n * 1024 + c_s * 8) * 2);
  }
  bf16_t* proj = p.proj();
  gemm128(smem, (const unsigned char*)p.h(), ao, (const unsigned char*)p.win_t(), bo, 16, [=](f32x4 (&acc)[4][4], int wm, int wn, int fr, int fq) {
    unsigned char* ob = smem + wm * 16384;
#pragma unroll
    for (int i = 0; i < 4; ++i)
#pragma unroll
      for (int j = 0; j < 4; ++j) {
        u32x2 o; o.x = pack2(acc[i][j][0], acc[i][j][1]); o.y = pack2(acc[i][j][2], acc[i][j][3]);
        ot_put<256>(ob, i * 16 + fr, wn * 16 + j * 4 + fq, o);
      }
    __syncthreads();
    {
      const int tid2 = fq * 16 + fr + 64 * (wm * 2 + wn);
      const int chunk = tid2 & 15;
      if (nt * 128 + chunk * 8 < NIN) {
#pragma unroll
        for (int i = 0; i < 8; ++i) {
          const int row = (tid2 >> 4) + 16 * i;
          const u32x4 v = ot_get<256>(smem + (row >> 6) * 16384, row & 63, chunk);
          *(u32x4*)(proj + (size_t)(m * 128 + row) * NIN + nt * 128 + chunk * 8) = v;
        }
      }
    }
  });
}

DI void item_qproj(const P& p, unsigned char* smem, int item) {
  const int m = item / 6, nt = item % 6;
  const int tid = otid(), r_s = tid >> 3, c_s = tid & 7;
  float* rowf = (float*)(smem + SMEM_MAIN + 1024);
  __syncthreads();
  {
    const int row = tid >> 1, half = tid & 1;
    const bf16_t* src = p.proj() + (size_t)(m * 128 + row) * NIN + 768 + half * 128;
    float ss = 0.f;
#pragma unroll
    for (int q = 0; q < 16; ++q) {
      const u32x4 v = *(const u32x4*)(src + q * 8);
      ss += bflo(v.x) * bflo(v.x) + bfhi(v.x) * bfhi(v.x) + bflo(v.y) * bflo(v.y) + bfhi(v.y) * bfhi(v.y) + bflo(v.z) * bflo(v.z) + bfhi(v.z) * bfhi(v.z) + bflo(v.w) * bflo(v.w) + bfhi(v.w) * bfhi(v.w);
    }
    ss += __shfl_xor(ss, 1);
    if (half == 0) rowf[row] = rsqrtf(ss * (1.f / 256.f) + EPS);
  }
  unsigned ao[4], bo[4];
#pragma unroll
  for (int j = 0; j < 4; ++j) {
    const int row = r_s + 32 * j;
    ao[j] = (unsigned)(((m * 128 + row) * NIN + 768 + c_s * 8) * 2);
    bo[j] = (unsigned)(((nt * 128 + row) * 256 + c_s * 8) * 2);
  }
  bf16_t* Q = p.Q(); const float* ropec = p.ropec(); const float* ropes = p.ropes();
  const float QS = 0.10206207261596577f * 1.4426950408889634f;
  gemm128(smem, (const unsigned char*)p.proj(), ao, (const unsigned char*)p.wuq_t(), bo, 4, [=](f32x4 (&acc)[4][4], int wm, int wn, int fr, int fq) {
#pragma unroll
    for (int i = 0; i < 4; ++i) {
      const int tl = wm * 64 + i * 16 + fr, t = m * 128 + tl;
      const int b = t >> 11, s = t & 2047;
      const float rs = rowf[tl] * QS;
#pragma unroll
      for (int j = 0; j < 4; ++j) {
        const int c0 = nt * 128 + wn * 64 + j * 16;
        const int head = c0 / 96, d0 = c0 % 96;
        bf16_t* dst = Q + ((size_t)((b * 8 + head) * 2048 + s)) * 96 + d0 + fq * 4;
        if (d0 == 64) {
          if (j < 3) {
            const float4 cs = *(const float4*)(ropec + (size_t)t * 16 + fq * 4), sn = *(const float4*)(ropes + (size_t)t * 16 + fq * 4);
            const f32x4 x1 = acc[i][j] * rs, x2 = acc[i][j + 1 < 4 ? j + 1 : 3] * rs;
            u32x2 o1, o2;
            o1.x = pack2(x1[0] * cs.x - x2[0] * sn.x, x1[1] * cs.y - x2[1] * sn.y);
            o1.y = pack2(x1[2] * cs.z - x2[2] * sn.z, x1[3] * cs.w - x2[3] * sn.w);
            o2.x = pack2(x2[0] * cs.x + x1[0] * sn.x, x2[1] * cs.y + x1[1] * sn.y);
            o2.y = pack2(x2[2] * cs.z + x1[2] * sn.z, x2[3] * cs.w + x1[3] * sn.w);
            *(u32x2*)dst = o1; *(u32x2*)(dst + 16) = o2;
          }
        } else if (d0 != 80) {
          const f32x4 x = acc[i][j] * rs;
          u32x2 o; o.x = pack2(x[0], x[1]); o.y = pack2(x[2], x[3]);
          *(u32x2*)dst = o;
        }
      }
    }
  });
}

DI void item_kvproj(const P& p, unsigned char* smem, int item) {
  const int m = item >> 3, head = item & 7;
  const int tid = otid(), r_s = tid >> 3, c_s = tid & 7;
  float* rowf = (float*)(smem + SMEM_MAIN + 1024);
  __syncthreads();
  {
    const int row = tid >> 1, half = tid & 1;
    const int t = m * 128 + row, b = t >> 11, s = t & 2047;
    const bf16_t* src = p.proj() + (size_t)t * NIN + 1024 + half * 64;
    float ss = 0.f;
#pragma unroll
    for (int q = 0; q < 8; ++q) {
      const u32x4 v = *(const u32x4*)(src + q * 8);
      ss += bflo(v.x) * bflo(v.x) + bfhi(v.x) * bfhi(v.x) + bflo(v.y) * bflo(v.y) + bfhi(v.y) * bfhi(v.y) + bflo(v.z) * bflo(v.z) + bfhi(v.z) * bfhi(v.z) + bflo(v.w) * bflo(v.w) + bfhi(v.w) * bfhi(v.w);
    }
    ss += __shfl_xor(ss, 1);
    if (half == 0) rowf[row] = rsqrtf(ss * (1.f / 128.f) + EPS);
    const bf16_t* kp = p.proj() + (size_t)t * NIN + 1152 + half * 8;
    const u32x4 a1 = *(const u32x4*)kp, a2 = *(const u32x4*)(kp + 16);
    const float* cp = p.ropec() + (size_t)t * 16 + half * 8; const float* sp = p.ropes() + (size_t)t * 16 + half * 8;
    const float4 c0 = *(const float4*)cp, c1 = *(const float4*)(cp + 4), s0 = *(const float4*)sp, s1 = *(const float4*)(sp + 4);
    const float x1[8] = {bflo(a1.x), bfhi(a1.x), bflo(a1.y), bfhi(a1.y), bflo(a1.z), bfhi(a1.z), bflo(a1.w), bfhi(a1.w)};
    const float x2[8] = {bflo(a2.x), bfhi(a2.x), bflo(a2.y), bfhi(a2.y), bflo(a2.z), bfhi(a2.z), bflo(a2.w), bfhi(a2.w)};
    const float cc[8] = {c0.x, c0.y, c0.z, c0.w, c1.x, c1.y, c1.z, c1.w};
    const float sn[8] = {s0.x, s0.y, s0.z, s0.w, s1.x, s1.y, s1.z, s1.w};
    u32x4 o1, o2;
    o1.x = pack2(x1[0] * cc[0] - x2[0] * sn[0], x1[1] * cc[1] - x2[1] * sn[1]);
    o1.y = pack2(x1[2] * cc[2] - x2[2] * sn[2], x1[3] * cc[3] - x2[3] * sn[3]);
    o1.z = pack2(x1[4] * cc[4] - x2[4] * sn[4], x1[5] * cc[5] - x2[5] * sn[5]);
    o1.w = pack2(x1[6] * cc[6] - x2[6] * sn[6], x1[7] * cc[7] - x2[7] * sn[7]);
    o2.x = pack2(x2[0] * cc[0] + x1[0] * sn[0], x2[1] * cc[1] + x1[1] * sn[1]);
    o2.y = pack2(x2[2] * cc[2] + x1[2] * sn[2], x2[3] * cc[3] + x1[3] * sn[3]);
    o2.z = pack2(x2[4] * cc[4] + x1[4] * sn[4], x2[5] * cc[5] + x1[5] * sn[5]);
    o2.w = pack2(x2[6] * cc[6] + x1[6] * sn[6], x2[7] * cc[7] + x1[7] * sn[7]);
    bf16_t* kd = p.Kb() + ((size_t)((b * 8 + head) * 2048 + s)) * 96 + 64 + half * 8;
    *(u32x4*)kd = o1; *(u32x4*)(kd + 16) = o2;
  }
  unsigned ao[4], bo[4];
#pragma unroll
  for (int j = 0; j < 4; ++j) {
    const int row = r_s + 32 * j;
    ao[j] = (unsigned)(((m * 128 + row) * NIN + 1024 + c_s * 8) * 2);
    bo[j] = (unsigned)(((head * 128 + row) * 128 + c_s * 8) * 2);
  }
  bf16_t* Kb = p.Kb(); bf16_t* V = p.V();
  gemm128(smem, (const unsigned char*)p.proj(), ao, (const unsigned char*)p.wukv_t(), bo, 2, [=](f32x4 (&acc)[4][4], int wm, int wn, int fr, int fq) {
#pragma unroll
    for (int i = 0; i < 4; ++i) {
      const int tl = wm * 64 + i * 16 + fr, t = m * 128 + tl;
      const int b = t >> 11, s = t & 2047;
      const float rs = rowf[tl];
      const size_t rowi = (size_t)((b * 8 + head) * 2048 + s);
#pragma unroll
      for (int j = 0; j < 4; ++j) {
        const int d = j * 16 + fq * 4;
        const f32x4 x = acc[i][j] * rs;
        u32x2 o; o.x = pack2(x[0], x[1]); o.y = pack2(x[2], x[3]);
        if (wn == 0) *(u32x2*)(Kb + rowi * 96 + d) = o; else *(u32x2*)(V + rowi * 64 + d) = o;
      }
    }
  });
}

DI void item_pool(const P& p, unsigned char* smem, int l, int item) {
  const int tid = otid(), w = tid >> 6, lane = tid & 63, fr = lane & 15, fq = lane >> 4;
  const int tile = item >> 2, g = item & 3;
  const int t0 = tile * 128, s0 = t0 & 2047;
  const int wdw = 2 << g;
  unsigned char* al = smem;
  unsigned char* dl = smem + 20480;
  __syncthreads();
  for (int id = tid; id < 143 * 8; id += NTHREADS) {
    const int row = id >> 3, c = id & 7;
    const int srel = s0 - 15 + row;
    u32x4 v = (u32x4){0u, 0u, 0u, 0u};
    if (srel >= 0) v = *(const u32x4*)(p.proj() + (size_t)(t0 - 15 + row) * NIN + g * 64 + c * 8);
    *(u32x4*)(al + row * 128 + c * 16) = v;
  }
  __syncthreads();
  {
    const int tl = tid >> 1, cb = (tid & 1) * 4;
    const int pos = s0 + tl;
    const int nw = (pos + 1 < wdw) ? pos + 1 : wdw;
    const float inv = 1.f / (float)nw;
#pragma unroll
    for (int q = 0; q < 4; ++q) {
      const int c = cb + q;
      float sm[8];
#pragma unroll
      for (int e = 0; e < 8; ++e) sm[e] = 0.f;
      for (int j = 0; j < nw; ++j) {
        const u32x4 v = *(const u32x4*)(al + (tl + 15 - j) * 128 + c * 16);
        sm[0] += bflo(v.x); sm[1] += bfhi(v.x); sm[2] += bflo(v.y); sm[3] += bfhi(v.y); sm[4] += bflo(v.z); sm[5] += bfhi(v.z); sm[6] += bflo(v.w); sm[7] += bfhi(v.w);
      }
      const u32x4 a = *(const u32x4*)(al + (tl + 15) * 128 + c * 16);
      u32x4 o;
      o.x = pack2(sm[0] * inv - bflo(a.x), sm[1] * inv - bfhi(a.x)); o.y = pack2(sm[2] * inv - bflo(a.y), sm[3] * inv - bfhi(a.y));
      o.z = pack2(sm[4] * inv - bflo(a.z), sm[5] * inv - bfhi(a.z)); o.w = pack2(sm[6] * inv - bflo(a.w), sm[7] * inv - bfhi(a.w));
      *(u32x4*)(dl + tl * 128 + ((c ^ (tl & 7)) << 4)) = o;
    }
  }
  __syncthreads();
  {
    const bf16_t* wp = p.wpool_t() + ((size_t)(l * 4 + g) * 64) * 64;
    f32x4 acc[2][4];
#pragma unroll
    for (int i = 0; i < 2; ++i)
#pragma unroll
      for (int j = 0; j < 4; ++j) acc[i][j] = (f32x4){0.f, 0.f, 0.f, 0.f};
#pragma unroll
    for (int ks = 0; ks < 2; ++ks) {
      bf16x8 df[2], wf[4];
#pragma unroll
      for (int i = 0; i < 2; ++i) { const int row = w * 32 + i * 16 + fr; df[i] = *(const bf16x8*)(dl + row * 128 + (((ks * 4 + fq) ^ (row & 7)) << 4)); }
#pragma unroll
      for (int j = 0; j < 4; ++j) wf[j] = *(const bf16x8*)(wp + (size_t)(j * 16 + fr) * 64 + ks * 32 + fq * 8);
#pragma unroll
      for (int i = 0; i < 2; ++i)
#pragma unroll
        for (int j = 0; j < 4; ++j) acc[i][j] = __builtin_amdgcn_mfma_f32_16x16x32_bf16(wf[j], df[i], acc[i][j], 0, 0, 0);
    }
#pragma unroll
    for (int i = 0; i < 2; ++i) {
      const int t = t0 + w * 32 + i * 16 + fr;
#pragma unroll
      for (int j = 0; j < 4; ++j) {
        const int cc = g * 64 + j * 16 + fq * 4;
        const float4 ps = *(const float4*)(p.pool_scale + l * 256 + cc);
        u32x2 o; o.x = pack2(acc[i][j][0] * ps.x, acc[i][j][1] * ps.y); o.y = pack2(acc[i][j][2] * ps.z, acc[i][j][3] * ps.w);
        *(u32x2*)(p.Y() + (size_t)t * 1024 + cc) = o;
      }
    }
  }
}

DI void item_sgu(const P& p, unsigned char* smem, int l, int chunk) {
  const int tid = otid(), w = tid >> 6, lane = tid & 63, fr = lane & 15, fq = lane >> 4;
  const int t0 = chunk * 128;
  unsigned char* vn = smem;
  __syncthreads();
#pragma unroll 1
  for (int ps = 0; ps < 4; ++ps) {
    const int tl = ps * 32 + (tid >> 3), part = tid & 7;
    const bf16_t* src = p.proj() + (size_t)(t0 + tl) * NIN + 512 + part * 32;
    float x[32];
#pragma unroll
    for (int q = 0; q < 4; ++q) {
      const u32x4 v = *(const u32x4*)(src + q * 8);
      x[q * 8 + 0] = gelu_tanh(bflo(v.x)); x[q * 8 + 1] = gelu_tanh(bfhi(v.x)); x[q * 8 + 2] = gelu_tanh(bflo(v.y)); x[q * 8 + 3] = gelu_tanh(bfhi(v.y));
      x[q * 8 + 4] = gelu_tanh(bflo(v.z)); x[q * 8 + 5] = gelu_tanh(bfhi(v.z)); x[q * 8 + 6] = gelu_tanh(bflo(v.w)); x[q * 8 + 7] = gelu_tanh(bfhi(v.w));
    }
    float sm = 0.f;
#pragma unroll
    for (int e = 0; e < 32; ++e) sm += x[e];
    sm += __shfl_xor(sm, 1); sm += __shfl_xor(sm, 2); sm += __shfl_xor(sm, 4);
    const float mu = sm * (1.f / 256.f);
    float vs = 0.f;
#pragma unroll
    for (int e = 0; e < 32; ++e) { x[e] -= mu; vs += x[e] * x[e]; }
    vs += __shfl_xor(vs, 1); vs += __shfl_xor(vs, 2); vs += __shfl_xor(vs, 4);
    const float rstd = rsqrtf(vs * (1.f / 256.f) + EPS);
#pragma unroll
    for (int q = 0; q < 4; ++q) {
      const int c = part * 4 + q;
      u32x4 o;
      o.x = pack2(x[q * 8 + 0] * rstd, x[q * 8 + 1] * rstd); o.y = pack2(x[q * 8 + 2] * rstd, x[q * 8 + 3] * rstd);
      o.z = pack2(x[q * 8 + 4] * rstd, x[q * 8 + 5] * rstd); o.w = pack2(x[q * 8 + 6] * rstd, x[q * 8 + 7] * rstd);
      *(u32x4*)(vn + tl * 512 + (((c >> 1) ^ (tl & 7)) << 5) + ((c & 1) << 4)) = o;
    }
  }
  __syncthreads();
  const int qq = fr >> 2, pp = fr & 3;
#pragma unroll 1
  for (int hh = 0; hh < 4; ++hh) {
    f32x4 acc[4][2];
#pragma unroll
    for (int df = 0; df < 4; ++df) { acc[df][0] = (f32x4){0.f, 0.f, 0.f, 0.f}; acc[df][1] = (f32x4){0.f, 0.f, 0.f, 0.f}; }
    const bf16_t* wb = p.wsp_b() + ((size_t)(l * 4 + hh) * 128) * 128;
    for (int kb = 0; kb <= w; ++kb) {
      bf16x8 wf[2];
#pragma unroll
      for (int f = 0; f < 2; ++f) {
        const bf16_t* wr = wb + (size_t)((2 * w + f) * 16 + fr) * 128 + kb * 32 + fq * 4;
        const u32x2 lo = *(const u32x2*)wr, hi = *(const u32x2*)(wr + 16);
        u32x4 u; u.x = lo.x; u.y = lo.y; u.z = hi.x; u.w = hi.y;
        wf[f] = __builtin_bit_cast(bf16x8, u);
      }
#pragma unroll
      for (int df = 0; df < 4; ++df) {
        const int keyA = kb * 32 + fq * 4 + qq, keyB = keyA + 16;
        const int slot = hh * 4 + df;
        const s16x4 lo = __builtin_amdgcn_ds_read_tr16_b64_v4i16((LAS s16x4*)(vn + keyA * 512 + ((slot ^ (keyA & 7)) << 5) + pp * 8));
        const s16x4 hi = __builtin_amdgcn_ds_read_tr16_b64_v4i16((LAS s16x4*)(vn + keyB * 512 + ((slot ^ (keyB & 7)) << 5) + pp * 8));
        bf16x8 vf; vf[0] = lo[0]; vf[1] = lo[1]; vf[2] = lo[2]; vf[3] = lo[3]; vf[4] = hi[0]; vf[5] = hi[1]; vf[6] = hi[2]; vf[7] = hi[3];
        acc[df][0] = __builtin_amdgcn_mfma_f32_16x16x32_bf16(vf, wf[0], acc[df][0], 0, 0, 0);
        acc[df][1] = __builtin_amdgcn_mfma_f32_16x16x32_bf16(vf, wf[1], acc[df][1], 0, 0, 0);
      }
    }
#pragma unroll
    for (int f = 0; f < 2; ++f) {
      const int tl = (2 * w + f) * 16 + fr, t = t0 + tl;
      const float bias = p.b_spatial[(l * 4 + hh) * 128 + tl];
#pragma unroll
      for (int df = 0; df < 4; ++df) {
        const int d = hh * 64 + df * 16 + fq * 4;
        const u32x2 uu = *(const u32x2*)(p.proj() + (size_t)t * NIN + 256 + d);
        u32x2 o;
        o.x = pack2(gelu_tanh(bflo(uu.x)) * (acc[df][f][0] + bias), gelu_tanh(bfhi(uu.x)) * (acc[df][f][1] + bias));
        o.y = pack2(gelu_tanh(bflo(uu.y)) * (acc[df][f][2] + bias), gelu_tanh(bfhi(uu.y)) * (acc[df][f][3] + bias));
        *(u32x2*)(p.Y() + (size_t)t * 1024 + 256 + d) = o;
      }
    }
  }
}

DI void item_attn(const P& p, unsigned char* smem, int item) {
  const int tid = otid(), w = tid >> 6, lane = tid & 63;
  const int fr = lane & 15, fq = lane >> 4;
  const int rnd = item >> 9, blk = item & 511;
  const int qb = rnd == 0 ? 15 - (blk >> 6) : (blk >> 6);
  const int bh = blk & 63, b = bh >> 3, h = bh & 7;
  const int q0 = qb * 128;
  const int nkt = 2 * qb + 2;
  const bf16_t* Qg = p.Q() + (size_t)bh * 2048 * 96;
  const bf16_t* Kg = p.Kb() + (size_t)bh * 2048 * 96;
  const bf16_t* Vg = p.V() + (size_t)bh * 2048 * 64;
  int kkey[3], kdst[3], kc[3];
#pragma unroll
  for (int j = 0; j < 3; ++j) { const int id = tid + 256 * j; kkey[j] = id / 12; kc[j] = id % 12; kdst[j] = kkey[j] * 256 + ((kc[j] ^ (kkey[j] & 15)) << 4); }
  int vkey[2], vdst[2], vc[2];
#pragma unroll
  for (int j = 0; j < 2; ++j) { const int id = tid + 256 * j; vkey[j] = id >> 3; vc[j] = id & 7; vdst[j] = vkey[j] * 128 + (((vc[j] >> 1) ^ ((vkey[j] >> 1) & 3)) << 5) + ((vc[j] & 1) << 4); }
  bf16x8 qf[3][2];
#pragma unroll
  for (int ks = 0; ks < 3; ++ks)
#pragma unroll
    for (int f = 0; f < 2; ++f) qf[ks][f] = *(const bf16x8*)(Qg + (size_t)(q0 + 32 * w + 16 * f + fr) * 96 + ks * 32 + fq * 8);
  f32x4 o[4][2];
#pragma unroll
  for (int f = 0; f < 4; ++f) { o[f][0] = (f32x4){0.f, 0.f, 0.f, 0.f}; o[f][1] = (f32x4){0.f, 0.f, 0.f, 0.f}; }
  float mrun[2] = {-INFINITY, -INFINITY}, lrun[2] = {0.f, 0.f};
  u32x4 rk[3], rv[2];
  __syncthreads();
#pragma unroll
  for (int j = 0; j < 3; ++j) rk[j] = *(const u32x4*)(Kg + (size_t)kkey[j] * 96 + kc[j] * 8);
#pragma unroll
  for (int j = 0; j < 2; ++j) rv[j] = *(const u32x4*)(Vg + (size_t)vkey[j] * 64 + vc[j] * 8);
#pragma unroll
  for (int j = 0; j < 3; ++j) *(u32x4*)(smem + kdst[j]) = rk[j];
#pragma unroll
  for (int j = 0; j < 2; ++j) *(u32x4*)(smem + 32768 + vdst[j]) = rv[j];
  __syncthreads();
  const int rowmin = q0 + 32 * w;
  for (int kt = 0; kt < nkt; ++kt) {
    const int cur = kt & 1;
    const bool more = kt + 1 < nkt;
    if (more) {
      const int key0n = (kt + 1) * 64;
#pragma unroll
      for (int j = 0; j < 3; ++j) rk[j] = *(const u32x4*)(Kg + (size_t)(key0n + kkey[j]) * 96 + kc[j] * 8);
#pragma unroll
      for (int j = 0; j < 2; ++j) rv[j] = *(const u32x4*)(Vg + (size_t)(key0n + vkey[j]) * 64 + vc[j] * 8);
    }
    const int key0 = kt * 64;
    if (key0 <= rowmin + 31) {
      const unsigned char* Kl = smem + cur * 16384;
      const unsigned char* Vl = smem + 32768 + cur * 8192;
      f32x4 st[4][2];
#pragma unroll
      for (int kf = 0; kf < 4; ++kf) { st[kf][0] = (f32x4){0.f, 0.f, 0.f, 0.f}; st[kf][1] = (f32x4){0.f, 0.f, 0.f, 0.f}; }
#pragma unroll
      for (int ks = 0; ks < 3; ++ks)
#pragma unroll
        for (int kf = 0; kf < 4; ++kf) {
          const int key = kf * 16 + fr;
          const bf16x8 a = *(const bf16x8*)(Kl + key * 256 + (((ks * 4 + fq) ^ (key & 15)) << 4));
          st[kf][0] = __builtin_amdgcn_mfma_f32_16x16x32_bf16(a, qf[ks][0], st[kf][0], 0, 0, 0);
          st[kf][1] = __builtin_amdgcn_mfma_f32_16x16x32_bf16(a, qf[ks][1], st[kf][1], 0, 0, 0);
        }
      const bool needmask = (key0 + 63 > rowmin);
#pragma unroll
      for (int f = 0; f < 2; ++f) {
        const int qabs = rowmin + 16 * f + fr;
        if (needmask) {
#pragma unroll
          for (int kf = 0; kf < 4; ++kf)
#pragma unroll
            for (int r = 0; r < 4; ++r) { const int kabs = key0 + kf * 16 + fq * 4 + r; if (kabs > qabs) st[kf][f][r] = -INFINITY; }
        }
        float mx = st[0][f][0];
#pragma unroll
        for (int kf = 0; kf < 4; ++kf)
#pragma unroll
          for (int r = 0; r < 4; ++r) mx = fmaxf(mx, st[kf][f][r]);
        mx = fmaxf(mx, __shfl_xor(mx, 16)); mx = fmaxf(mx, __shfl_xor(mx, 32));
        const float mnew = fmaxf(mrun[f], mx);
        const float alpha = __builtin_amdgcn_exp2f(mrun[f] - mnew);
        mrun[f] = mnew;
        float ls = 0.f;
#pragma unroll
        for (int kf = 0; kf < 4; ++kf)
#pragma unroll
          for (int r = 0; r < 4; ++r) { const float pv = __builtin_amdgcn_exp2f(st[kf][f][r] - mnew); st[kf][f][r] = pv; ls += pv; }
        lrun[f] = lrun[f] * alpha + ls;
#pragma unroll
        for (int df = 0; df < 4; ++df) o[df][f] = o[df][f] * alpha;
      }
      bf16x8 pf[2][2];
#pragma unroll
      for (int kb = 0; kb < 2; ++kb)
#pragma unroll
        for (int f = 0; f < 2; ++f) {
          u32x4 u;
          u.x = pack2(st[2 * kb][f][0], st[2 * kb][f][1]); u.y = pack2(st[2 * kb][f][2], st[2 * kb][f][3]);
          u.z = pack2(st[2 * kb + 1][f][0], st[2 * kb + 1][f][1]); u.w = pack2(st[2 * kb + 1][f][2], st[2 * kb + 1][f][3]);
          pf[kb][f] = __builtin_bit_cast(bf16x8, u);
        }
      const int qq = fr >> 2, pp = fr & 3;
#pragma unroll
      for (int kb = 0; kb < 2; ++kb)
#pragma unroll
        for (int df = 0; df < 4; ++df) {
          const int keyA = kb * 32 + fq * 4 + qq, keyB = keyA + 16;
          const int offA = keyA * 128 + ((df ^ ((keyA >> 1) & 3)) << 5) + pp * 8;
          const int offB = keyB * 128 + ((df ^ ((keyB >> 1) & 3)) << 5) + pp * 8;
          const s16x4 lo = __builtin_amdgcn_ds_read_tr16_b64_v4i16((LAS s16x4*)(Vl + offA));
          const s16x4 hi = __builtin_amdgcn_ds_read_tr16_b64_v4i16((LAS s16x4*)(Vl + offB));
          bf16x8 vf; vf[0] = lo[0]; vf[1] = lo[1]; vf[2] = lo[2]; vf[3] = lo[3]; vf[4] = hi[0]; vf[5] = hi[1]; vf[6] = hi[2]; vf[7] = hi[3];
          o[df][0] = __builtin_amdgcn_mfma_f32_16x16x32_bf16(vf, pf[kb][0], o[df][0], 0, 0, 0);
          o[df][1] = __builtin_amdgcn_mfma_f32_16x16x32_bf16(vf, pf[kb][1], o[df][1], 0, 0, 0);
        }
    }
    if (more) {
      const int nx = cur ^ 1;
#pragma unroll
      for (int j = 0; j < 3; ++j) *(u32x4*)(smem + nx * 16384 + kdst[j]) = rk[j];
#pragma unroll
      for (int j = 0; j < 2; ++j) *(u32x4*)(smem + 32768 + nx * 8192 + vdst[j]) = rv[j];
    }
    __syncthreads();
  }
#pragma unroll
  for (int f = 0; f < 2; ++f) {
    float lt = lrun[f]; lt += __shfl_xor(lt, 16); lt += __shfl_xor(lt, 32);
    const float inv = 1.f / lt;
    const int t = b * 2048 + rowmin + 16 * f + fr;
#pragma unroll
    for (int df = 0; df < 4; ++df) {
      const f32x4 x = o[df][f] * inv;
      u32x2 ov; ov.x = pack2(x[0], x[1]); ov.y = pack2(x[2], x[3]);
      *(u32x2*)(p.Y() + (size_t)t * 1024 + 512 + h * 64 + df * 16 + fq * 4) = ov;
    }
  }
}

DI void item_p4(const P& p, unsigned char* smem, int l, int item) {
  const int m = item >> 3, nt = item & 7;
  const int tid = otid(), r_s = tid >> 3, c_s = tid & 7;
  unsigned ao[4], bo[4];
#pragma unroll
  for (int j = 0; j < 4; ++j) {
    const int row = r_s + 32 * j;
    ao[j] = (unsigned)(((m * 128 + row) * 1024 + c_s * 8) * 2);
    bo[j] = (unsigned)(((nt * 128 + row) * 1024 + c_s * 8) * 2);
  }
  const float* xin = (l == 0) ? p.x : p.out;
  float* xout = p.out;
  const float* mod = p.mod() + (size_t)l * 8 * 6144 + 2048;
  float* rowss = p.rowss();
  gemm128(smem, (const unsigned char*)p.Y(), ao, (const unsigned char*)p.wout_t(), bo, 16, [=](f32x4 (&acc)[4][4], int wm, int wn, int fr, int fq) {
#pragma unroll
    for (int i = 0; i < 4; ++i) {
      const int t = m * 128 + wm * 64 + i * 16 + fr, b = t >> 11;
      float ss = 0.f;
#pragma unroll
      for (int j = 0; j < 4; ++j) {
        const int n = nt * 128 + wn * 64 + j * 16 + fq * 4;
        const float4 xv = *(const float4*)(xin + (size_t)t * 1024 + n);
        const float4 g = *(const float4*)(mod + (size_t)b * 6144 + n);
        float4 ov = {xv.x + g.x * acc[i][j][0], xv.y + g.y * acc[i][j][1], xv.z + g.z * acc[i][j][2], xv.w + g.w * acc[i][j][3]};
        ss += ov.x * ov.x + ov.y * ov.y + ov.z * ov.z + ov.w * ov.w;
        *(float4*)(xout + (size_t)t * 1024 + n) = ov;
      }
      ss += __shfl_xor(ss, 16); ss += __shfl_xor(ss, 32);
      if (fq == 0) rowss[(size_t)t * 16 + nt * 2 + wn] = ss;
    }
  });
}

DI void item_p5(const P& p, unsigned char* smem, int l, int item) {
  const int tid = otid(), w = tid >> 6, lane = tid & 63, fr = lane & 15, fq = lane >> 4;
  const int tf = w >> 1, kh = w & 1;
  const int tb = item * 32 + tf * 16;
  const int t = tb + fr, b = (item * 32) >> 11;
  const float* xr = p.out + (size_t)t * 1024 + kh * 512 + fq * 8;
  float* mds = (float*)(smem + 32768);
  __syncthreads();
  {
    const float* md = p.mod() + ((size_t)l * 8 + b) * 6144 + 3072;
    for (int i = tid; i < 512; i += NTHREADS) *(float4*)(mds + i * 4) = *(const float4*)(md + i * 4);
  }
  float rstd;
  {
    const float4* rp = (const float4*)(p.rowss() + (size_t)t * 16);
    const float4 a = rp[0], c = rp[1], d = rp[2], e = rp[3];
    const float ss = ((a.x + a.y) + (a.z + a.w)) + ((c.x + c.y) + (c.z + c.w)) + ((d.x + d.y) + (d.z + d.w)) + ((e.x + e.y) + (e.z + e.w));
    rstd = rsqrtf(ss * (1.f / 1024.f) + EPS);
  }
  const bf16_t* whi = p.wr_hi() + (size_t)l * 65536 + (size_t)fr * 1024 + kh * 512 + fq * 8;
  bf16_t* hdst = p.h() + (size_t)t * 1024 + kh * 512 + fq * 8;
  f32x4 acc[4];
#pragma unroll
  for (int nf = 0; nf < 4; ++nf) acc[nf] = (f32x4){0.f, 0.f, 0.f, 0.f};
  bf16x8 w0[4], w1[4], w2[4]; f32x4 xa0, xb0, xa1, xb1, xa2, xb2;
#pragma unroll
  for (int nf = 0; nf < 4; ++nf) { w0[nf] = *(const bf16x8*)(whi + (size_t)nf * 16384); w1[nf] = *(const bf16x8*)(whi + (size_t)nf * 16384 + 32); }
  xa0 = *(const f32x4*)(xr); xb0 = *(const f32x4*)(xr + 4); xa1 = *(const f32x4*)(xr + 32); xb1 = *(const f32x4*)(xr + 36);
  __syncthreads();
#define P5_LOAD(W, XA, XB, ks_) do { const int kn_ = (ks_) < 16 ? (ks_) : 15; _Pragma("unroll") for (int nf = 0; nf < 4; ++nf) W[nf] = *(const bf16x8*)(whi + (size_t)nf * 16384 + kn_ * 32); \
    XA = *(const f32x4*)(xr + kn_ * 32); XB = *(const f32x4*)(xr + kn_ * 32 + 4); } while (0)
#define P5_STEP(W, XA, XB, ks_) do { const int k0 = kh * 512 + (ks_) * 32 + fq * 8; \
    const f32x4 ha = *(const f32x4*)(mds + k0), hb = *(const f32x4*)(mds + k0 + 4), sa = *(const f32x4*)(mds + 1024 + k0), sb = *(const f32x4*)(mds + 1024 + k0 + 4); \
    const f32x4 va = XA * rstd * (sa + 1.f) + ha, vb = XB * rstd * (sb + 1.f) + hb; \
    u32x4 uh, ul; uh.x = pack2(va[0], va[1]); uh.y = pack2(va[2], va[3]); uh.z = pack2(vb[0], vb[1]); uh.w = pack2(vb[2], vb[3]); \
    ul.x = pack2(va[0] - bflo(uh.x), va[1] - bfhi(uh.x)); ul.y = pack2(va[2] - bflo(uh.y), va[3] - bfhi(uh.y)); \
    ul.z = pack2(vb[0] - bflo(uh.z), vb[1] - bfhi(uh.z)); ul.w = pack2(vb[2] - bflo(uh.w), vb[3] - bfhi(uh.w)); \
    *(u32x4*)(hdst + (ks_) * 32) = uh; \
    const bf16x8 bh = __builtin_bit_cast(bf16x8, uh), bl = __builtin_bit_cast(bf16x8, ul); \
    _Pragma("unroll") for (int nf = 0; nf < 4; ++nf) { acc[nf] = __builtin_amdgcn_mfma_f32_16x16x32_bf16(W[nf], bh, acc[nf], 0, 0, 0); acc[nf] = __builtin_amdgcn_mfma_f32_16x16x32_bf16(W[nf], bl, acc[nf], 0, 0, 0); } } while (0)
#pragma unroll 1
  for (int ks = 0; ks < 15; ks += 3) {
    P5_LOAD(w2, xa2, xb2, ks + 2); P5_STEP(w0, xa0, xb0, ks);
    P5_LOAD(w0, xa0, xb0, ks + 3); P5_STEP(w1, xa1, xb1, ks + 1);
    P5_LOAD(w1, xa1, xb1, ks + 4); P5_STEP(w2, xa2, xb2, ks + 2);
  }
  P5_STEP(w0, xa0, xb0, 15);
#undef P5_LOAD
#undef P5_STEP
  float* red = (float*)smem;
  int* info = (int*)(smem + 16384) + w * 512;
  int* cntw = (int*)(smem + 24576);
#pragma unroll
  for (int nf = 0; nf < 4; ++nf) *(f32x4*)(red + w * 1024 + fr * 64 + nf * 16 + fq * 4) = acc[nf];
  __syncthreads();
  const float bias = p.router_bias[l * 64 + lane];
  int cnt_local = 0;
  const int tq0 = kh * 8;
#pragma unroll 1
  for (int q = 0; q < 8; ++q) {
    const float lgt = red[(tf * 2) * 1024 + (tq0 + q) * 64 + lane] + red[(tf * 2 + 1) * 1024 + (tq0 + q) * 64 + lane];
    const float s = 1.f / (1.f + __expf(-lgt));
    const float sel = s + bias;
    float m1 = sel; m1 = fmaxf(m1, __shfl_xor(m1, 1)); m1 = fmaxf(m1, __shfl_xor(m1, 2)); m1 = fmaxf(m1, __shfl_xor(m1, 4));
    const unsigned long long eq = __ballot(sel == m1);
    const int gbase = lane & ~7;
    const unsigned gm = (unsigned)((eq >> gbase) & 0xffull);
    const int first = gbase + __ffs(gm) - 1;
    float m2 = (lane == first) ? -INFINITY : sel;
    m2 = fmaxf(m2, __shfl_xor(m2, 1)); m2 = fmaxf(m2, __shfl_xor(m2, 2)); m2 = fmaxf(m2, __shfl_xor(m2, 4));
    const float gs = m1 + m2;
    const int myg = lane >> 3; int rank = 0;
#pragma unroll
    for (int j = 0; j < 8; ++j) { const float gj = __int_as_float(__builtin_amdgcn_readlane(__float_as_int(gs), j * 8)); rank += ((gj > gs) || (gj == gs && j < myg)) ? 1 : 0; }
    const bool gsel = rank < 4;
    const unsigned sb = (unsigned)__float_as_int(sel);
    const unsigned okey = (sb & 0x80000000u) ? ~sb : (sb | 0x80000000u);
    const unsigned key = gsel ? ((okey & ~63u) | (unsigned)(63 - lane)) : 0u;
    int r = 0;
#pragma unroll
    for (int j = 0; j < 64; ++j) { const unsigned kj = (unsigned)__builtin_amdgcn_readlane((int)key, j); r += (kj > key) ? 1 : 0; }
    const bool ch = gsel && (r < 8);
    const float tot = wsum(ch ? s : 0.f);
    const unsigned long long cm = __ballot(ch);
    const int kidx = __popcll(cm & ((1ull << lane) - 1ull));
    info[q * 64 + lane] = ch ? kidx : -1;
    if (ch) p.topw()[(size_t)(tb + tq0 + q) * 8 + kidx] = s / tot * 2.5f;
    cnt_local += ch ? 1 : 0;
  }
  cntw[w * 64 + lane] = cnt_local;
  __syncthreads();
  if (w == 0) {
    const int tot = cntw[lane] + cntw[64 + lane] + cntw[128 + lane] + cntw[192 + lane];
    int bs = 0;
    if (tot > 0) bs = atomicAdd(p.cnt() + (l * 64 + lane) * CSTRIDE, tot);
    cntw[256 + lane] = bs;
  }
  __syncthreads();
  int base = cntw[256 + lane];
#pragma unroll
  for (int ww = 0; ww < 3; ++ww) base += (ww < w) ? cntw[ww * 64 + lane] : 0;
#pragma unroll 1
  for (int q = 0; q < 8; ++q) {
    const int k = info[q * 64 + lane];
    if (k >= 0) { p.list()[(size_t)lane * LISTCAP + base] = (tb + tq0 + q) * 8 + k; ++base; }
  }
}

DI void moe_table(const P& p, unsigned char* smem, int l) {
  int* start = (int*)(smem + SMEM_MAIN);
  __syncthreads();
  if (otid() == 0) {
    int s = 0;
    for (int e = 0; e < 64; ++e) { start[e] = s; s += (p.cnt()[(l * 64 + e) * CSTRIDE] + 127) >> 7; }
    start[64] = s;
  }
  __syncthreads();
}
DI void moe_rows(const P& p, unsigned char* smem, int l, int mt, int& e_out) {
  const int* start = (const int*)(smem + SMEM_MAIN);
  int* rowinfo = (int*)(smem + SMEM_MAIN + 512);
  const int tid = otid();
  int e;
  if (mt >= start[64]) { e = 64; if (tid < 128) rowinfo[tid] = T_ * 8 + (mt - start[64]) * 128 + tid; }
  else {
    e = 0;
    for (int q = 1; q < 64; ++q) e = (start[q] <= mt) ? q : e;
    const int tl = mt - start[e];
    const int cnt = p.cnt()[(l * 64 + e) * CSTRIDE];
    if (tid < 128) { const int idx = tl * 128 + tid; rowinfo[tid] = idx < cnt ? p.list()[(size_t)e * LISTCAP + idx] : -1; }
  }
  e_out = e;
}

DI void item_p7(const P& p, unsigned char* smem, int l, int item) {
  const int mt = item >> 2, nt = item & 3;
  const int tid = otid(), r_s = tid >> 3, c_s = tid & 7;
  int* rowinfo = (int*)(smem + SMEM_MAIN + 512);
  __syncthreads();
  int e; moe_rows(p, smem, l, mt, e);
  __syncthreads();
  const bf16_t* wbase = (e == 64) ? p.wsg_t() : p.wgu_t() + (size_t)e * 512 * 1024;
  unsigned ao[4], bo[4];
#pragma unroll
  for (int j = 0; j < 4; ++j) {
    const int row = r_s + 32 * j;
    const int slot = rowinfo[row];
    const int tok = slot < 0 ? 0 : (slot >= T_ * 8 ? slot - T_ * 8 : slot >> 3);
    ao[j] = (unsigned)((tok * 1024 + c_s * 8) * 2);
    bo[j] = (unsigned)(((nt * 128 + row) * 1024 + c_s * 8) * 2);
  }
  bf16_t* act = p.act();
  gemm128(smem, (const unsigned char*)p.h(), ao, (const unsigned char*)wbase, bo, 16, [=](f32x4 (&acc)[4][4], int wm, int wn, int fr, int fq) {
    unsigned char* ob = smem + wm * 8192;
#pragma unroll
    for (int i = 0; i < 4; ++i) {
#pragma unroll
      for (int jj = 0; jj < 2; ++jj) {
        const f32x4 g = acc[i][2 * jj], u = acc[i][2 * jj + 1];
        u32x2 o; o.x = pack2(silu_f(g[0]) * u[0], silu_f(g[1]) * u[1]); o.y = pack2(silu_f(g[2]) * u[2], silu_f(g[3]) * u[3]);
        ot_put<128>(ob, i * 16 + fr, wn * 8 + jj * 4 + fq, o);
      }
    }
    __syncthreads();
    {
      const int tid2 = fq * 16 + fr + 64 * (wm * 2 + wn);
      const int chunk = tid2 & 7;
#pragma unroll
      for (int i = 0; i < 4; ++i) {
        const int row = (tid2 >> 3) + 32 * i;
        const int slot = rowinfo[row];
        if (slot >= 0) {
          const u32x4 v = ot_get<128>(smem + (row >> 6) * 8192, row & 63, chunk);
          *(u32x4*)(act + (size_t)slot * 256 + nt * 64 + chunk * 8) = v;
        }
      }
    }
  });
}

DI void item_p8(const P& p, unsigned char* smem, int l, int item) {
  const int mt = item >> 1, nh = item & 1;
  const int tid = otid(), r_s = tid >> 3, c_s = tid & 7;
  int* rowinfo = (int*)(smem + SMEM_MAIN + 512);
  __syncthreads();
  int e; moe_rows(p, smem, l, mt, e);
  __syncthreads();
  const bf16_t* wbase = (e == 64) ? p.wsd_t() : p.wd_t() + (size_t)e * 1024 * 256;
  unsigned ao[4], bo[4];
#pragma unroll
  for (int j = 0; j < 4; ++j) {
    const int row = r_s + 32 * j;
    const int slot = rowinfo[row];
    ao[j] = (unsigned)(((slot < 0 ? 0 : slot) * 256 + c_s * 8) * 2);
    bo[j] = (unsigned)(((nh * 512 + row) * 256 + c_s * 8) * 2);
  }
  bf16_t* yrows = p.yrows(); bf16_t* ysh = p.ysh(); const float* topw = p.topw();
  gemm128_stream(smem, (const unsigned char*)p.act(), ao, (const unsigned char*)wbase, bo, 4, 4, (size_t)128 * 256, [=](f32x4 (&acc)[4][4], int tile, int cur, int wm, int wn, int fr, int fq) {
    const int nt = nh * 4 + tile;
    unsigned char* ob = smem + cur + (wm ? 32768 : 0);
    __syncthreads();
#pragma unroll
    for (int i = 0; i < 4; ++i) {
      const int slot = rowinfo[wm * 64 + i * 16 + fr];
      const float wv = (slot < 0 || slot >= T_ * 8) ? 1.f : topw[slot];
#pragma unroll
      for (int j = 0; j < 4; ++j) {
        const f32x4 x = acc[i][j] * wv;
        u32x2 o; o.x = pack2(x[0], x[1]); o.y = pack2(x[2], x[3]);
        ot_put<256>(ob, i * 16 + fr, wn * 16 + j * 4 + fq, o);
      }
    }
    __syncthreads();
    {
      const int tid2 = fq * 16 + fr + 64 * (wm * 2 + wn);
      const int chunk = tid2 & 15;
#pragma unroll
      for (int i = 0; i < 8; ++i) {
        const int row = (tid2 >> 4) + 16 * i;
        const int slot = rowinfo[row];
        if (slot >= 0) {
          const u32x4 v = ot_get<256>(smem + cur + ((row >> 6) ? 32768 : 0), row & 63, chunk);
          bf16_t* dst = (slot >= T_ * 8) ? ysh + (size_t)(slot - T_ * 8) * 1024 : yrows + (size_t)slot * 1024;
          *(u32x4*)(dst + nt * 128 + chunk * 8) = v;
        }
      }
    }
  });
}

DI void item_p9(const P& p, int l, int item) {
  const int tid = otid(), w = tid >> 6, lane = tid & 63;
  const int t = item * 4 + w, b = t >> 11;
  const float* md = p.mod() + ((size_t)l * 8 + b) * 6144;
  const int c0 = lane * 16;
  float a[16];
  {
    const u32x4 y0 = *(const u32x4*)(p.ysh() + (size_t)t * 1024 + c0), y1 = *(const u32x4*)(p.ysh() + (size_t)t * 1024 + c0 + 8);
    a[0] = bflo(y0.x); a[1] = bfhi(y0.x); a[2] = bflo(y0.y); a[3] = bfhi(y0.y); a[4] = bflo(y0.z); a[5] = bfhi(y0.z); a[6] = bflo(y0.w); a[7] = bfhi(y0.w);
    a[8] = bflo(y1.x); a[9] = bfhi(y1.x); a[10] = bflo(y1.y); a[11] = bfhi(y1.y); a[12] = bflo(y1.z); a[13] = bfhi(y1.z); a[14] = bflo(y1.w); a[15] = bfhi(y1.w);
  }
  float r[16];
#pragma unroll
  for (int e = 0; e < 16; ++e) r[e] = 0.f;
  const unsigned char* yr = (const unsigned char*)p.yrows() + (size_t)t * 8 * 1024 + c0;
  u32x4 yk[8];
#pragma unroll
  for (int k = 0; k < 8; ++k) yk[k] = *(const u32x4*)(yr + k * 1024);
#pragma unroll
  for (int k = 0; k < 8; ++k) {
#pragma unroll
    for (int q = 0; q < 4; ++q) {
      const f32x2 lo = __builtin_amdgcn_cvt_pk_f32_fp8((int)yk[k][q], false), hi = __builtin_amdgcn_cvt_pk_f32_fp8((int)yk[k][q], true);
      r[q * 4 + 0] += lo.x; r[q * 4 + 1] += lo.y; r[q * 4 + 2] += hi.x; r[q * 4 + 3] += hi.y;
    }
  }
  float v[16]; float ss = 0.f;
#pragma unroll
  for (int q = 0; q < 4; ++q) {
    const float4 xv = *(const float4*)(p.out + (size_t)t * 1024 + c0 + q * 4);
    const float4 g = *(const float4*)(md + 5120 + c0 + q * 4);
    v[q * 4 + 0] = xv.x + g.x * (a[q * 4 + 0] + r[q * 4 + 0] * (1.f / YSCALE));
    v[q * 4 + 1] = xv.y + g.y * (a[q * 4 + 1] + r[q * 4 + 1] * (1.f / YSCALE));
    v[q * 4 + 2] = xv.z + g.z * (a[q * 4 + 2] + r[q * 4 + 2] * (1.f / YSCALE));
    v[q * 4 + 3] = xv.w + g.w * (a[q * 4 + 3] + r[q * 4 + 3] * (1.f / YSCALE));
    ss += v[q * 4 + 0] * v[q * 4 + 0] + v[q * 4 + 1] * v[q * 4 + 1] + v[q * 4 + 2] * v[q * 4 + 2] + v[q * 4 + 3] * v[q * 4 + 3];
  }
  ss = wsum(ss);
  const float rstd = rsqrtf(ss * (1.f / 1024.f) + EPS);
  if (l == 0) {
    const float* md1 = p.mod() + ((size_t)8 + b) * 6144;
    unsigned hw[8];
#pragma unroll
    for (int q = 0; q < 4; ++q) {
      *(float4*)(p.out + (size_t)t * 1024 + c0 + q * 4) = (float4){v[q * 4 + 0], v[q * 4 + 1], v[q * 4 + 2], v[q * 4 + 3]};
      const float4 sh = *(const float4*)(md1 + c0 + q * 4), sc = *(const float4*)(md1 + 1024 + c0 + q * 4);
      hw[q * 2 + 0] = pack2(v[q * 4 + 0] * rstd * (1.f + sc.x) + sh.x, v[q * 4 + 1] * rstd * (1.f + sc.y) + sh.y);
      hw[q * 2 + 1] = pack2(v[q * 4 + 2] * rstd * (1.f + sc.z) + sh.z, v[q * 4 + 3] * rstd * (1.f + sc.w) + sh.w);
    }
    *(u32x4*)(p.h() + (size_t)t * 1024 + c0) = (u32x4){hw[0], hw[1], hw[2], hw[3]};
    *(u32x4*)(p.h() + (size_t)t * 1024 + c0 + 8) = (u32x4){hw[4], hw[5], hw[6], hw[7]};
  } else {
#pragma unroll
    for (int q = 0; q < 4; ++q) {
      const float4 fg = *(const float4*)(p.final_gain + c0 + q * 4);
      *(float4*)(p.out + (size_t)t * 1024 + c0 + q * 4) = (float4){v[q * 4 + 0] * rstd * fg.x, v[q * 4 + 1] * rstd * fg.y, v[q * 4 + 2] * rstd * fg.z, v[q * 4 + 3] * rstd * fg.w};
    }
  }
}

DI int xcd_vb(int bid, int G) { return ((G & 7) == 0) ? (bid & 7) * (G >> 3) + (bid >> 3) : bid; }

DI void phase_p1(const P& p, LAS unsigned char* lds, int G, int bid) {
  t8::DenseSched S; S.init(T_, 1280, 1024, G, bid, p.win_t());
  t8::DenseRows RO{2048u};
  bf16_t* proj = p.proj(); float* rsq = p.rsq();
  t8::gemm_phase<true>(lds, (const unsigned char*)p.h(), 1024, S, RO, [=](const f32x4 (&acc)[2][2][4][2], const t8::Unit& u, int wr, int wc, int fr, int fq) {
    const int c0 = u.pn * 256 + wc * 64 + fq * 16;
    const bool want_ss = (u.pn == 3) || (u.pn == 4 && wc < 2);
#pragma unroll
    for (int ai = 0; ai < 2; ++ai)
#pragma unroll
      for (int m = 0; m < 4; ++m) {
        const int r = u.pm * 256 + ai * 128 + wr * 64 + m * 16 + fr;
        if (want_ss) {
          float ss = 0.f;
#pragma unroll
          for (int bj = 0; bj < 2; ++bj)
#pragma unroll
            for (int n = 0; n < 2; ++n) { const f32x4 a = acc[ai][bj][m][n]; ss += a[0] * a[0] + a[1] * a[1] + a[2] * a[2] + a[3] * a[3]; }
          ss += __shfl_xor(ss, 16); ss += __shfl_xor(ss, 32);
          if (fq == 0) rsq[(size_t)r * 8 + (u.pn == 3 ? wc : 4 + wc)] = ss;
        }
        if (c0 < NIN) {
#pragma unroll
          for (int bj = 0; bj < 2; ++bj) {
            const f32x4 v0 = acc[ai][bj][m][0], v1 = acc[ai][bj][m][1];
            u32x4 o; o.x = pack2(v0[0], v0[1]); o.y = pack2(v0[2], v0[3]); o.z = pack2(v1[0], v1[1]); o.w = pack2(v1[2], v1[3]);
            *(u32x4*)(proj + (size_t)r * NIN + c0 + bj * 8) = o;
          }
        }
        asm volatile("" ::: "memory");
      }
  });
}

DI void phase_p4(const P& p, LAS unsigned char* lds, int l, int G, int bid) {
  t8::DenseSched S; S.init(T_, 1024, 1024, G, bid, p.wout_t());
  t8::DenseRows RO{2048u};
  const float* xin = (l == 0) ? p.x : p.out; float* xout = p.out;
  const float* mod = p.mod() + (size_t)l * 8 * 6144 + 2048;
  float* rowss = p.rowss();
  t8::gemm_phase<true>(lds, (const unsigned char*)p.Y(), 1024, S, RO, [=](const f32x4 (&acc)[2][2][4][2], const t8::Unit& u, int wr, int wc, int fr, int fq) {
    float4 xq[2][4];
    const int cbase = u.pn * 256 + wc * 64 + fq * 16;
    {
      const int r0 = u.pm * 256 + wr * 64 + fr;
#pragma unroll
      for (int q = 0; q < 4; ++q) xq[0][q] = *(const float4*)(xin + (size_t)r0 * 1024 + cbase + q * 4);
    }
#pragma unroll
    for (int ai = 0; ai < 2; ++ai)
#pragma unroll
      for (int m = 0; m < 4; ++m) {
        const int it = ai * 4 + m;
        const int r = u.pm * 256 + ai * 128 + wr * 64 + m * 16 + fr, b = r >> 11;
        if (it < 7) {
          const int rn = u.pm * 256 + ((it + 1) >> 2) * 128 + wr * 64 + ((it + 1) & 3) * 16 + fr;
#pragma unroll
          for (int q = 0; q < 4; ++q) xq[(it + 1) & 1][q] = *(const float4*)(xin + (size_t)rn * 1024 + cbase + q * 4);
        }
        float ss = 0.f;
#pragma unroll
        for (int bj = 0; bj < 2; ++bj)
#pragma unroll
          for (int n = 0; n < 2; ++n) {
            const int c0 = cbase + bj * 8 + n * 4;
            const float4 xv = xq[it & 1][bj * 2 + n];
            const float4 g = *(const float4*)(mod + (size_t)b * 6144 + c0);
            const f32x4 a = acc[ai][bj][m][n];
            float4 ov = {xv.x + g.x * a[0], xv.y + g.y * a[1], xv.z + g.z * a[2], xv.w + g.w * a[3]};
            ss += ov.x * ov.x + ov.y * ov.y + ov.z * ov.z + ov.w * ov.w;
            *(float4*)(xout + (size_t)r * 1024 + c0) = ov;
          }
        ss += __shfl_xor(ss, 16); ss += __shfl_xor(ss, 32);
        if (fq == 0) rowss[(size_t)r * 16 + u.pn * 4 + wc] = ss;
      }
  });
}

struct RowsP7 { LAS const int* tab; DI unsigned operator()(const t8::Unit& u, int row) const { const int slot = tab[u.tab * 256 + row]; const int tok = slot < 0 ? 0 : (slot >= T_ * 8 ? slot - T_ * 8 : slot >> 3); return (unsigned)tok * 2048u; } };
struct RowsP8 { LAS const int* tab; DI unsigned operator()(const t8::Unit& u, int row) const { const int slot = tab[u.tab * 256 + row]; return (unsigned)(slot < 0 ? 0 : slot) * 512u; } };

DI void phase_p7(const P& p, LAS unsigned char* lds, int l, int G, int bid) {
  int total; const int c = xcd_vb(bid, G);
  moe_prepare(p, lds, l, 2, G, c, total);
  t8::MoeSched S{(LAS const int*)(lds + t8::START_OFF), 2, total, G, c, (const unsigned char*)p.wgu_t(), (const unsigned char*)p.wsg_t(), (size_t)512 * 1024 * 2, (size_t)256 * 1024 * 2};
  RowsP7 RO{(LAS const int*)(lds + t8::TAB_OFF)};
  LAS const int* tab = (LAS const int*)(lds + t8::TAB_OFF);
  bf16_t* act = p.act();
  t8::gemm_phase<true>(lds, (const unsigned char*)p.h(), 1024, S, RO, [=](const f32x4 (&acc)[2][2][4][2], const t8::Unit& u, int wr, int wc, int fr, int fq) {
#pragma unroll
    for (int ai = 0; ai < 2; ++ai)
#pragma unroll
      for (int m = 0; m < 4; ++m) {
        const int slot = tab[u.tab * 256 + ai * 128 + wr * 64 + m * 16 + fr];
        if (slot >= 0) {
          const f32x4 g0 = acc[ai][0][m][0], g1 = acc[ai][0][m][1], u0 = acc[ai][1][m][0], u1 = acc[ai][1][m][1];
          u32x4 o;
          o.x = pack2(silu_f(g0[0]) * u0[0], silu_f(g0[1]) * u0[1]); o.y = pack2(silu_f(g0[2]) * u0[2], silu_f(g0[3]) * u0[3]);
          o.z = pack2(silu_f(g1[0]) * u1[0], silu_f(g1[1]) * u1[1]); o.w = pack2(silu_f(g1[2]) * u1[2], silu_f(g1[3]) * u1[3]);
          *(u32x4*)(act + (size_t)slot * 256 + u.pn * 128 + wc * 32 + fq * 8) = o;
        }
        asm volatile("" ::: "memory");
      }
  });
}

DI void phase_p8(const P& p, LAS unsigned char* lds, int l, int G, int bid) {
  int total; const int c = xcd_vb(bid, G);
  moe_prepare(p, lds, l, 4, G, c, total);
  t8::MoeSched S{(LAS const int*)(lds + t8::START_OFF), 4, total, G, c, (const unsigned char*)p.wd_t(), (const unsigned char*)p.wsd_t(), (size_t)1024 * 256 * 2, (size_t)256 * 256 * 2};
  RowsP8 RO{(LAS const int*)(lds + t8::TAB_OFF)};
  LAS const int* tab = (LAS const int*)(lds + t8::TAB_OFF);
  unsigned char* yrows = (unsigned char*)p.yrows(); bf16_t* ysh = p.ysh(); const float* topw = p.topw();
  t8::gemm_phase<true>(lds, (const unsigned char*)p.act(), 256, S, RO, [=](const f32x4 (&acc)[2][2][4][2], const t8::Unit& u, int wr, int wc, int fr, int fq) {
    int slots[2][4]; float wvs[2][4];
#pragma unroll
    for (int ai = 0; ai < 2; ++ai)
#pragma unroll
      for (int m = 0; m < 4; ++m) slots[ai][m] = tab[u.tab * 256 + ai * 128 + wr * 64 + m * 16 + fr];
#pragma unroll
    for (int ai = 0; ai < 2; ++ai)
#pragma unroll
      for (int m = 0; m < 4; ++m) wvs[ai][m] = (slots[ai][m] < 0 || slots[ai][m] >= T_ * 8) ? 1.f : topw[slots[ai][m]] * YSCALE;
    const int c0 = u.pn * 256 + wc * 64 + fq * 16;
#pragma unroll
    for (int ai = 0; ai < 2; ++ai)
#pragma unroll
      for (int m = 0; m < 4; ++m) {
        const int slot = slots[ai][m];
        if (slot >= 0) {
          const float wv = wvs[ai][m];
          if (slot >= T_ * 8) {
            bf16_t* dst = ysh + (size_t)(slot - T_ * 8) * 1024 + c0;
#pragma unroll
            for (int bj = 0; bj < 2; ++bj) {
              const f32x4 v0 = acc[ai][bj][m][0], v1 = acc[ai][bj][m][1];
              u32x4 o; o.x = pack2(v0[0], v0[1]); o.y = pack2(v0[2], v0[3]); o.z = pack2(v1[0], v1[1]); o.w = pack2(v1[2], v1[3]);
              *(u32x4*)(dst + bj * 8) = o;
            }
          } else {
            u32x4 o;
            o.x = pack4_fp8(acc[ai][0][m][0] * wv); o.y = pack4_fp8(acc[ai][0][m][1] * wv); o.z = pack4_fp8(acc[ai][1][m][0] * wv); o.w = pack4_fp8(acc[ai][1][m][1] * wv);
            *(u32x4*)(yrows + (size_t)slot * 1024 + c0) = o;
          }
        }
        asm volatile("" ::: "memory");
      }
  });
}


DI void phase_kvproj(const P& p, LAS unsigned char* lds, int G, int bid) {
  t8::DenseSched S; S.init(T_, 1024, 256, G, bid, p.wukv_t());
  t8::DenseRows RO{(unsigned)(NIN * 2)};
  bf16_t* Kb = p.Kb(); bf16_t* V = p.V(); const float* rsq = p.rsq();
  t8::gemm_phase<true>(lds, (const unsigned char*)(p.proj() + 1024), 256, S, RO, [=](const f32x4 (&acc)[2][2][4][2], const t8::Unit& u, int wr, int wc, int fr, int fq) {
    const int head = u.pn * 2 + (wc >> 1), d0 = (wc & 1) * 64 + fq * 16;
#pragma unroll
    for (int ai = 0; ai < 2; ++ai)
#pragma unroll
      for (int m = 0; m < 4; ++m) {
        const int t = u.pm * 256 + ai * 128 + wr * 64 + m * 16 + fr, b = t >> 11, sq = t & 2047;
        const float rs = rsqrtf((rsq[(size_t)t * 8 + 4] + rsq[(size_t)t * 8 + 5]) * (1.f / 128.f) + EPS);
        const size_t rowi = (size_t)((b * 8 + head) * 2048 + sq);
        bf16_t* dst = (d0 < 64) ? Kb + rowi * 96 + d0 : V + rowi * 64 + (d0 - 64);
#pragma unroll
        for (int bj = 0; bj < 2; ++bj) {
          const f32x4 v0 = acc[ai][bj][m][0] * rs, v1 = acc[ai][bj][m][1] * rs;
          u32x4 o; o.x = pack2(v0[0], v0[1]); o.y = pack2(v0[2], v0[3]); o.z = pack2(v1[0], v1[1]); o.w = pack2(v1[2], v1[3]);
          *(u32x4*)(dst + bj * 8) = o;
        }
        asm volatile("" ::: "memory");
      }
  });
}
DI void phase_qproj(const P& p, LAS unsigned char* lds, int G, int bid) {
  t8::DenseSched S; S.init(T_, 768, 256, G, bid, p.wuq_t());
  t8::DenseRows RO{(unsigned)(NIN * 2)};
  bf16_t* Q = p.Q(); const float* rsq = p.rsq(); const float* ropec = p.ropec(); const float* ropes = p.ropes();
  const float QS = 0.10206207261596577f * 1.4426950408889634f;
  t8::gemm_phase<false>(lds, (const unsigned char*)(p.proj() + 768), 256, S, RO, [=](const f32x4 (&acc)[2][2][4][2], const t8::Unit& u, int wr, int wc, int fr, int fq) {
#pragma unroll
    for (int ai = 0; ai < 2; ++ai)
#pragma unroll
      for (int m = 0; m < 4; ++m) {
        const int t = u.pm * 256 + ai * 128 + wr * 64 + m * 16 + fr, b = t >> 11, sq = t & 2047;
        const f32x4 pq = *(const f32x4*)(rsq + (size_t)t * 8);
        const float rs = rsqrtf(((pq[0] + pq[1]) + (pq[2] + pq[3])) * (1.f / 256.f) + EPS) * QS;
#pragma unroll
        for (int bj = 0; bj < 2; ++bj) {
          const int cg = u.pn * 256 + bj * 128 + wc * 32;
          const int head = cg / 96, d0 = cg - head * 96;
          bf16_t* dst = Q + ((size_t)((b * 8 + head) * 2048 + sq)) * 96 + d0 + fq * 4;
          const f32x4 x1 = acc[ai][bj][m][0] * rs, x2 = acc[ai][bj][m][1] * rs;
          u32x2 o1, o2;
          if (d0 == 64) {
            const f32x4 cs = *(const f32x4*)(ropec + (size_t)t * 16 + fq * 4), sn = *(const f32x4*)(ropes + (size_t)t * 16 + fq * 4);
            const f32x4 y1 = x1 * cs - x2 * sn, y2 = x2 * cs + x1 * sn;
            o1.x = pack2(y1[0], y1[1]); o1.y = pack2(y1[2], y1[3]); o2.x = pack2(y2[0], y2[1]); o2.y = pack2(y2[2], y2[3]);
          } else {
            o1.x = pack2(x1[0], x1[1]); o1.y = pack2(x1[2], x1[3]); o2.x = pack2(x2[0], x2[1]); o2.y = pack2(x2[2], x2[3]);
          }
          *(u32x2*)dst = o1; *(u32x2*)(dst + 16) = o2;
        }
        asm volatile("" ::: "memory");
      }
  });
}
DI void item_kpe(const P& p, int item) {
  const int tid = otid();
  const int t = item * 128 + (tid >> 1), half = tid & 1, b = t >> 11, sq = t & 2047;
  const bf16_t* kp = p.proj() + (size_t)t * NIN + 1152 + half * 8;
  const u32x4 a1 = *(const u32x4*)kp, a2 = *(const u32x4*)(kp + 16);
  const float* cp = p.ropec() + (size_t)t * 16 + half * 8; const float* sp = p.ropes() + (size_t)t * 16 + half * 8;
  const f32x4 c0 = *(const f32x4*)cp, c1 = *(const f32x4*)(cp + 4), s0 = *(const f32x4*)sp, s1 = *(const f32x4*)(sp + 4);
  const f32x4 x1a = {bflo(a1.x), bfhi(a1.x), bflo(a1.y), bfhi(a1.y)}, x1b = {bflo(a1.z), bfhi(a1.z), bflo(a1.w), bfhi(a1.w)};
  const f32x4 x2a = {bflo(a2.x), bfhi(a2.x), bflo(a2.y), bfhi(a2.y)}, x2b = {bflo(a2.z), bfhi(a2.z), bflo(a2.w), bfhi(a2.w)};
  const f32x4 y1a = x1a * c0 - x2a * s0, y1b = x1b * c1 - x2b * s1, y2a = x2a * c0 + x1a * s0, y2b = x2b * c1 + x1b * s1;
  u32x4 o1, o2;
  o1.x = pack2(y1a[0], y1a[1]); o1.y = pack2(y1a[2], y1a[3]); o1.z = pack2(y1b[0], y1b[1]); o1.w = pack2(y1b[2], y1b[3]);
  o2.x = pack2(y2a[0], y2a[1]); o2.y = pack2(y2a[2], y2a[3]); o2.z = pack2(y2b[0], y2b[1]); o2.w = pack2(y2b[2], y2b[3]);
#pragma unroll
  for (int head = 0; head < 8; ++head) {
    bf16_t* kd = p.Kb() + ((size_t)((b * 8 + head) * 2048 + sq)) * 96 + 64 + half * 8;
    *(u32x4*)kd = o1; *(u32x4*)(kd + 16) = o2;
  }
}

constexpr int HALF_LDS = SMEM_MAIN + SMEM_EXTRA;
#define PHASE_LOOP(n, ...) for (int base_ = 2 * bid; base_ < (n); base_ += 2 * G) { int it = base_ + half; it = it < (n) ? it : (n) - 1; __VA_ARGS__ }
__global__ void __launch_bounds__(BLOCK_THREADS, 2) fwd_megakernel(P p) {
  const __attribute__((address_space(4))) P* kp_ = (const __attribute__((address_space(4))) P*)__builtin_amdgcn_kernarg_segment_ptr();
  (void)p;
#define LP() ([&]() __attribute__((always_inline)) { const __attribute__((address_space(4))) P* q_ = kp_; asm volatile("" : "+s"(q_)); P r_; __builtin_memcpy(&r_, q_, sizeof(P)); return r_; }())

  __shared__ __attribute__((aligned(16))) unsigned char smem_all[t8::STAGE_BYTES + 16384 + 16 + 256];
  const int G = gridDim.x, bid = blockIdx.x;
  {
    LAS int* wtab = (LAS int*)(smem_all + WTAB_OFF);
    if ((threadIdx.x & 63) == 0) wtab[hw_slot()] = (int)(threadIdx.x >> 6);
    __syncthreads();
  }
  const int half = __builtin_amdgcn_readfirstlane(full_tid() >> 8);
  unsigned char* smem = smem_all + half * HALF_LDS;
  volatile LAS unsigned* stw = (volatile LAS unsigned*)(smem_all + t8::STAGE_BYTES + 16384);
  LAS unsigned char* lds8 = (LAS unsigned char*)smem_all;
  if (full_tid() == 0) { stw[0] = 0u; stw[1] = 0u; }
  __syncthreads();
  XcdBarrier bar = xcd_barrier_post(LP().bar(), stw);

  PHASE_LOOP(192 + 1024 + MISC_ITEMS + CONV_SMALL,
    if (it < 192) item_mod(LP(), smem, it);
    else if (it < 192 + 1024) item_rope(LP(), it - 192);
    else if (it < 192 + 1024 + MISC_ITEMS) item_misc(LP(), it - 192 - 1024);
    else item_conv(LP(), smem, 0, it - 192 - 1024 - MISC_ITEMS);
  )
  xcd_barrier(bar);
  PHASE_LOOP(T_ / 4, item_norm0(LP(), it);)
  xcd_barrier(bar);

  for (int l = 0; l < 2; ++l) {
    phase_p1(LP(), lds8, G, bid);
    xcd_barrier(bar);
    phase_kvproj(LP(), lds8, G, bid);
    phase_qproj(LP(), lds8, G, bid);
    __syncthreads();
    {
      const int rb = G - 1 - bid;
      for (int base_ = 2 * rb; base_ < 128 + 512 + 128; base_ += 2 * G) {
        const int it = base_ + half;
        if (it < 128) item_sgu(LP(), smem, l, it);
        else if (it < 640) item_pool(LP(), smem, l, it - 128);
        else item_kpe(LP(), it - 640);
      }
    }
    xcd_barrier(bar);
    if ((bid >> 3) & 1) { conv_big_loop(LP(), smem, l, 2 * bid + half, 2 * G); PHASE_LOOP(1024, item_attn(LP(), smem, it);) }
    else { PHASE_LOOP(1024, item_attn(LP(), smem, it);) conv_big_loop(LP(), smem, l, 2 * bid + half, 2 * G); }
    xcd_barrier(bar);
    phase_p4(LP(), lds8, l, G, bid);
    xcd_barrier(bar);
    PHASE_LOOP(512, item_p5(LP(), smem, l, it);)
    xcd_barrier(bar);
    phase_p7(LP(), lds8, l, G, bid);
    xcd_barrier(bar);
    phase_p8(LP(), lds8, l, G, bid);
    xcd_barrier(bar);
    const int n9 = T_ / 4 + (l == 0 ? CONV_SMALL : 0);
    PHASE_LOOP(n9,
      if (it < T_ / 4) item_p9(LP(), l, it);
      else item_conv(LP(), smem, 1, it - T_ / 4);
    )
    if (l == 0) xcd_barrier(bar);
  }
}

extern "C" void kernel_launch(void* const* d_in, const int* in_sizes, int n_in, void* d_out, int out_size, void* d_ws, size_t ws_size,
                              hipStream_t stream) {
  P p{};
  p.x = (const float*)d_in[0]; p.c = (const float*)d_in[1]; p.pos = (const int*)d_in[2];
  p.w_ada = (const float*)d_in[3]; p.b_ada = (const float*)d_in[4]; p.w_in = (const float*)d_in[5]; p.w_pool = (const float*)d_in[6];
  p.pool_scale = (const float*)d_in[7]; p.w_spatial = (const float*)d_in[8]; p.b_spatial = (const float*)d_in[9]; p.g_q = (const float*)d_in[10];
  p.w_uq = (const float*)d_in[11]; p.g_kv = (const float*)d_in[12]; p.w_ukv = (const float*)d_in[13]; p.w_out = (const float*)d_in[14];
  p.w_router = (const float*)d_in[15]; p.router_bias = (const float*)d_in[16]; p.w_gate = (const float*)d_in[17]; p.w_up = (const float*)d_in[18];
  p.w_down = (const float*)d_in[19]; p.ws_gate = (const float*)d_in[20]; p.ws_up = (const float*)d_in[21]; p.ws_down = (const float*)d_in[22];
  p.final_gain = (const float*)d_in[23];
  p.out = (float*)d_out;
  p.ws = (unsigned char*)d_ws;
  if (WS_NEED > ws_size) { fprintf(stderr, "workspace too small: need %zu have %zu\n", WS_NEED, ws_size); return; }
  hipMemsetAsync(p.ws + O_BAR, 0, CTRL_BYTES, stream);
  static int grid_blocks = 0;
  if (!grid_blocks) {
    int dev = 0, cus = 0, per_cu = 0;
    hipGetDevice(&dev);
    hipDeviceGetAttribute(&cus, hipDeviceAttributeMultiprocessorCount, dev);
    hipOccupancyMaxActiveBlocksPerMultiprocessor(&per_cu, fwd_megakernel, BLOCK_THREADS, 0);
    if (per_cu > 1) per_cu = 1;
    if (per_cu < 1) per_cu = 1;
    grid_blocks = cus * per_cu;
  }
  void* args[] = {&p};
  hipError_t e = hipLaunchCooperativeKernel((void*)fwd_megakernel, dim3(grid_blocks), dim3(BLOCK_THREADS), args, 0, stream);
  if (e != hipSuccess) fprintf(stderr, "cooperative launch failed: %s (grid %d)\n", hipGetErrorString(e), grid_blocks);
}
```

```cpp
#include <hip/hip_runtime.h>
#include <stdint.h>
#include <cstdio>

#define DI __device__ __forceinline__
#define LAS __attribute__((address_space(3)))

typedef unsigned short bf16_t;
typedef short bf16x8 __attribute__((ext_vector_type(8)));
typedef short s16x4 __attribute__((ext_vector_type(4)));
typedef float f32x4 __attribute__((ext_vector_type(4)));
typedef float f32x2 __attribute__((ext_vector_type(2)));
typedef unsigned u32x4 __attribute__((ext_vector_type(4)));
typedef unsigned u32x2 __attribute__((ext_vector_type(2)));
typedef __bf16 bf16x2_t __attribute__((ext_vector_type(2)));

constexpr int T_ = 16384, D_ = 1024, S_ = 2048, NIN = 1184;
constexpr int NTHREADS = 256;
constexpr int BLOCK_THREADS = 512;
constexpr int SMEM_MAIN = 65536, SMEM_EXTRA = 2048;
constexpr float EPS = 1e-6f;
constexpr int CSTRIDE = 64;
constexpr int LISTCAP = 16384;
constexpr int CONV_SMALL = 592 + 24 + 16 + 128;
constexpr int CONV_BIG = 96 + 6144;
constexpr int CONV_ITEMS = CONV_SMALL + CONV_BIG;

constexpr size_t al256(size_t x) { return (x + 255) & ~(size_t)255; }
constexpr size_t CTRL_BYTES = (size_t)3456 * 4 + (size_t)2 * 64 * CSTRIDE * 4;
constexpr size_t O_BAR = 0;
constexpr size_t O_MOD = O_BAR + al256(CTRL_BYTES);
constexpr size_t O_ROPEC = O_MOD + al256((size_t)2 * 8 * 6144 * 4);
constexpr size_t O_ROPES = O_ROPEC + al256((size_t)T_ * 16 * 4);
constexpr size_t O_WIN = O_ROPES + al256((size_t)T_ * 16 * 4);
constexpr size_t O_WUQ = O_WIN + al256((size_t)1280 * 1024 * 2);
constexpr size_t O_WUKV = O_WUQ + al256((size_t)768 * 256 * 2);
constexpr size_t O_WOUT = O_WUKV + al256((size_t)1024 * 256 * 2);
constexpr size_t O_WSG = O_WOUT + al256((size_t)1024 * 1024 * 2);
constexpr size_t O_WSD = O_WSG + al256((size_t)512 * 1024 * 2);
constexpr size_t O_WSP = O_WSD + al256((size_t)1024 * 256 * 2);
constexpr size_t O_WPOOL = O_WSP + al256((size_t)2 * 4 * 128 * 128 * 2);
constexpr size_t O_WRHI = O_WPOOL + al256((size_t)2 * 4 * 64 * 64 * 2);
constexpr size_t O_WRLO = O_WRHI + al256((size_t)2 * 64 * 1024 * 2);
constexpr size_t O_WGU = O_WRLO + al256((size_t)2 * 64 * 1024 * 2);
constexpr size_t O_WD = O_WGU + al256((size_t)64 * 512 * 1024 * 2);
constexpr size_t O_H = O_WD + al256((size_t)64 * 1024 * 256 * 2);
constexpr size_t O_ACT = O_H + al256((size_t)T_ * 1024 * 2);
constexpr size_t O_YSH = O_ACT + al256((size_t)(T_ * 8 + T_) * 256 * 2);
constexpr size_t O_LIST = O_YSH + al256((size_t)T_ * 1024 * 2);
constexpr size_t O_TOPW = O_LIST + al256((size_t)64 * LISTCAP * 4);
constexpr size_t O_ROWSS = O_TOPW + al256((size_t)T_ * 8 * 4);
constexpr size_t O_RSQ = O_ROWSS + al256((size_t)T_ * 16 * 4);
constexpr size_t O_BIG = O_RSQ + al256((size_t)T_ * 8 * 4);
constexpr size_t O_YROWS = O_BIG;
constexpr size_t O_PROJ = O_BIG;
constexpr size_t O_Q = O_PROJ + al256((size_t)T_ * NIN * 2);
constexpr size_t O_KB = O_Q + al256((size_t)T_ * 8 * 96 * 2);
constexpr size_t O_V = O_KB + al256((size_t)T_ * 8 * 96 * 2);
constexpr size_t O_Y = O_V + al256((size_t)T_ * 8 * 64 * 2);
constexpr size_t WS_NEED = O_BIG + al256((size_t)T_ * 8 * 1024 * 2);

struct P {
  const float *x, *c; const int* pos;
  const float *w_ada, *b_ada, *w_in, *w_pool, *pool_scale, *w_spatial, *b_spatial, *g_q, *w_uq, *g_kv, *w_ukv, *w_out,
      *w_router, *router_bias, *w_gate, *w_up, *w_down, *ws_gate, *ws_up, *ws_down, *final_gain;
  float* out;
  unsigned char* ws;
  DI unsigned* bar() const { return (unsigned*)(ws + O_BAR); }
  DI int* cnt() const { return (int*)(ws + O_BAR) + 3456; }
  DI float* mod() const { return (float*)(ws + O_MOD); }
  DI float* ropec() const { return (float*)(ws + O_ROPEC); }
  DI float* ropes() const { return (float*)(ws + O_ROPES); }
  DI bf16_t* win_t() const { return (bf16_t*)(ws + O_WIN); }
  DI bf16_t* wuq_t() const { return (bf16_t*)(ws + O_WUQ); }
  DI bf16_t* wukv_t() const { return (bf16_t*)(ws + O_WUKV); }
  DI bf16_t* wout_t() const { return (bf16_t*)(ws + O_WOUT); }
  DI bf16_t* wsg_t() const { return (bf16_t*)(ws + O_WSG); }
  DI bf16_t* wsd_t() const { return (bf16_t*)(ws + O_WSD); }
  DI bf16_t* wsp_b() const { return (bf16_t*)(ws + O_WSP); }
  DI bf16_t* wpool_t() const { return (bf16_t*)(ws + O_WPOOL); }
  DI bf16_t* wr_hi() const { return (bf16_t*)(ws + O_WRHI); }
  DI bf16_t* wr_lo() const { return (bf16_t*)(ws + O_WRLO); }
  DI bf16_t* wgu_t() const { return (bf16_t*)(ws + O_WGU); }
  DI bf16_t* wd_t() const { return (bf16_t*)(ws + O_WD); }
  DI bf16_t* h() const { return (bf16_t*)(ws + O_H); }
  DI bf16_t* act() const { return (bf16_t*)(ws + O_ACT); }
  DI bf16_t* ysh() const { return (bf16_t*)(ws + O_YSH); }
  DI int* list() const { return (int*)(ws + O_LIST); }
  DI float* topw() const { return (float*)(ws + O_TOPW); }
  DI float* rowss() const { return (float*)(ws + O_ROWSS); }
  DI float* rsq() const { return (float*)(ws + O_RSQ); }
  DI bf16_t* yrows() const { return (bf16_t*)(ws + O_YROWS); }
  DI bf16_t* proj() const { return (bf16_t*)(ws + O_PROJ); }
  DI bf16_t* Q() const { return (bf16_t*)(ws + O_Q); }
  DI bf16_t* Kb() const { return (bf16_t*)(ws + O_KB); }
  DI bf16_t* V() const { return (bf16_t*)(ws + O_V); }
  DI bf16_t* Y() const { return (bf16_t*)(ws + O_Y); }
};

DI unsigned pack2(float lo, float hi) { f32x2 f = {lo, hi}; bf16x2_t b = __builtin_convertvector(f, bf16x2_t); return __builtin_bit_cast(unsigned, b); }
DI float bf2f(unsigned short b) { return __uint_as_float(((unsigned)b) << 16); }
DI float bflo(unsigned u) { return __uint_as_float(u << 16); }
DI float bfhi(unsigned u) { return __uint_as_float(u & 0xffff0000u); }
constexpr int WTAB_OFF = 128 * 1024 + 16384 + 16;
DI int hw_slot() { return (int)(__builtin_amdgcn_s_getreg((5 << 11) | 4) & 63u); }
DI int lane_id() { unsigned z = 0u; asm volatile("" : "+v"(z)); return (int)__builtin_amdgcn_mbcnt_hi(~0u, __builtin_amdgcn_mbcnt_lo(~0u, z)); }
DI int full_tid() {
  const int wv = __builtin_amdgcn_readfirstlane(((LAS const int*)(size_t)WTAB_OFF)[hw_slot()]);
  int t = (wv << 6) | lane_id(); asm volatile("" : "+v"(t)); return t;
}
DI int otid() { return full_tid() & 255; }

constexpr float YSCALE = 16.f;
DI unsigned pack4_fp8(f32x4 v) {
  const float a = __builtin_amdgcn_fmed3f(v[0], -448.f, 448.f), b = __builtin_amdgcn_fmed3f(v[1], -448.f, 448.f), c = __builtin_amdgcn_fmed3f(v[2], -448.f, 448.f), d = __builtin_amdgcn_fmed3f(v[3], -448.f, 448.f);
  int w = 0; w = __builtin_amdgcn_cvt_pk_fp8_f32(a, b, w, false); w = __builtin_amdgcn_cvt_pk_fp8_f32(c, d, w, true); return (unsigned)w;
}
DI float wsum(float v) { for (int o = 32; o; o >>= 1) v += __shfl_xor(v, o); return v; }
DI float silu_f(float x) { return x / (1.f + __expf(-x)); }
DI float gelu_tanh(float x) { float z = 0.7978845608028654f * (x + 0.044715f * x * x * x); float e = __expf(2.f * z); float t = 1.f - 2.f / (1.f + e); return 0.5f * x * (1.f + t); }

#define XB_TMO      128
#define XB_XCNT(j)  (256  + 64 * (j))
#define XB_XSUB(j)  (1280 + 64 * (j))
#define XB_XGEN(j)  (2304 + 64 * (j))
#define XB_TOP      3328
#define XB_TOPGEN   3392
#define XCD_BAR_WORDS 3456
#define XB_SPIN_CAP (1u << 20)
DI unsigned xb_ld(unsigned* p) { return __hip_atomic_load(p, __ATOMIC_RELAXED, __HIP_MEMORY_SCOPE_AGENT); }
DI unsigned xb_add(unsigned* p, unsigned v) { return __hip_atomic_fetch_add(p, v, __ATOMIC_RELAXED, __HIP_MEMORY_SCOPE_AGENT); }
DI unsigned xb_xcc_id() { return (unsigned)__builtin_amdgcn_s_getreg((3 << 11) | 20) & 0xFu; }
#define XB_SPIN(cond, bar) do { unsigned _sp = 0; while (cond) { __builtin_amdgcn_s_sleep(1); \
    if ((++_sp & 255u) == 0u) { if (xb_ld(&(bar)[XB_TMO])) break; if (_sp > XB_SPIN_CAP) { atomicAdd(&(bar)[XB_TMO], 1u); break; } } } } while (0)
struct XcdBarrier { unsigned* bar; unsigned x; volatile LAS unsigned* st; };
DI XcdBarrier xcd_barrier_post(unsigned* bar, volatile LAS unsigned* st) {
  XcdBarrier b; b.bar = bar; b.x = xb_xcc_id(); b.st = st;
  if (full_tid() == 0) (void)xb_add(&bar[XB_XCNT(b.x)], 1u);
  return b;
}
DI void xcd_barrier_complete(unsigned* bar, unsigned x, unsigned& nloc, unsigned& nx) {
  const unsigned G = gridDim.x * gridDim.y * gridDim.z;
  unsigned sum, cnt, mine, sp = 0u;
  for (;;) {
    sum = 0u; cnt = 0u; mine = 0u;
#pragma unroll
    for (unsigned j = 0; j < 16; ++j) { const unsigned c = xb_ld(&bar[XB_XCNT(j)]); sum += c; cnt += (c > 0u) ? 1u : 0u; mine = (j == x) ? c : mine; }
    if (sum == G) break;
    __builtin_amdgcn_s_sleep(1);
    if ((++sp & 255u) == 0u) { if (xb_ld(&bar[XB_TMO])) break; if (sp > XB_SPIN_CAP) { atomicAdd(&bar[XB_TMO], 1u); break; } }
  }
  nloc = mine > 0u ? mine : 1u; nx = cnt > 0u ? cnt : 1u;
}
DI void xcd_barrier(const XcdBarrier& b0) {
  XcdBarrier b = b0; b.x = xb_xcc_id();
  asm volatile("s_waitcnt vmcnt(0)" ::: "memory");
  __syncthreads();
  if (full_tid() == 0) {
    unsigned* bar = b.bar;
    __builtin_amdgcn_s_waitcnt(0);
    unsigned nloc = b.st[0], nx = b.st[1];
    if (nloc == 0u) { xcd_barrier_complete(bar, b.x, nloc, nx); b.st[0] = nloc; b.st[1] = nx; }
    const unsigned old = xb_add(&bar[XB_XSUB(b.x)], 1u);
    const unsigned gen = old / nloc;
    if (old + 1u == (gen + 1u) * nloc) {
      __builtin_amdgcn_fence(__ATOMIC_RELEASE, "agent");
      asm volatile("s_waitcnt vmcnt(0)" ::: "memory");
      const unsigned og = xb_add(&bar[XB_TOP], 1u);
      const unsigned tg = og / nx;
      if (og + 1u == (tg + 1u) * nx) xb_add(&bar[XB_TOPGEN], 1u);
      else XB_SPIN(xb_ld(&bar[XB_TOPGEN]) == tg, bar);
      __builtin_amdgcn_fence(__ATOMIC_ACQUIRE, "agent");
      xb_add(&bar[XB_XGEN(b.x)], 1u);
      asm volatile("s_waitcnt vmcnt(0)" ::: "memory");
    } else {
      XB_SPIN(xb_ld(&bar[XB_XGEN(b.x)]) == gen, bar);
      __builtin_amdgcn_fence(__ATOMIC_ACQUIRE, "agent");
      asm volatile("s_waitcnt vmcnt(0)" ::: "memory");
    }
  }
  __syncthreads();
}


template <int RB> DI void ot_put(unsigned char* base, int row, int unit, u32x2 v) { *(u32x2*)(base + row * RB + ((unit ^ (row & 15)) << 3)) = v; }
template <int RB> DI u32x4 ot_get(const unsigned char* base, int row, int chunk) {
  const u32x4 v = *(const u32x4*)(base + row * RB + ((chunk ^ ((row & 15) >> 1)) << 4));
  return (row & 1) ? (u32x4){v.z, v.w, v.x, v.y} : v;
}

template <class Epi>
DI void gemm128_stream(unsigned char* smem, const unsigned char* abase, const unsigned (&ao)[4], const unsigned char* bbase, const unsigned (&bo)[4], int nk, int ntile, size_t btile_stride, Epi&& epi) {
  const int tid = otid(), lane = tid & 63, w = tid >> 6;
  const int wm = w >> 1, wn = w & 1;
  const int r_s = tid >> 3, c_s = tid & 7;
  const int st_off = r_s * 128 + ((c_s ^ (r_s & 7)) << 4);
  const int fr = lane & 15, fq = lane >> 4;
  const int sw0 = ((0 + fq) ^ (fr & 7)) << 4, sw1 = ((4 + fq) ^ (fr & 7)) << 4;
  const int arow_off = (wm * 64 + fr) * 128, brow_off = 32768 + (wn * 64 + fr) * 128;
  u32x4 ra0[4], rb0[4], ra1[4], rb1[4];
  f32x4 acc[4][4];
#pragma unroll
  for (int i = 0; i < 4; ++i)
#pragma unroll
    for (int j = 0; j < 4; ++j) acc[i][j] = (f32x4){0.f, 0.f, 0.f, 0.f};
  const int total = nk * ntile;
  int lkt = 0, ltl = 0;
  auto load = [&](u32x4 (&ra)[4], u32x4 (&rb)[4]) {
    const unsigned char* ab = abase + lkt * 128;
    const unsigned char* bb = bbase + ((size_t)ltl * btile_stride + lkt * 64) * 2;
#pragma unroll
    for (int j = 0; j < 4; ++j) { ra[j] = *(const u32x4*)(ab + ao[j]); rb[j] = *(const u32x4*)(bb + bo[j]); }
    const bool last = (lkt == nk - 1) && (ltl == ntile - 1);
    const int nl = (lkt == nk - 1) ? 0 : lkt + 1;
    ltl = last ? ltl : ((lkt == nk - 1) ? ltl + 1 : ltl);
    lkt = last ? lkt : nl;
  };
  auto store = [&](const u32x4 (&ra)[4], const u32x4 (&rb)[4], int bufo) {
#pragma unroll
    for (int j = 0; j < 4; ++j) { *(u32x4*)(smem + bufo + st_off + j * 4096) = ra[j]; *(u32x4*)(smem + 32768 + bufo + st_off + j * 4096) = rb[j]; }
  };
  int kt = 0, tile = 0;
  auto body = [&](int s, int cur, u32x4 (&lra)[4], u32x4 (&lrb)[4], const u32x4 (&wra)[4], const u32x4 (&wrb)[4]) {
    load(lra, lrb);
#pragma unroll
    for (int ks = 0; ks < 2; ++ks) {
      const int sw = ks ? sw1 : sw0;
      bf16x8 af[4], bfr[4];
#pragma unroll
      for (int i = 0; i < 4; ++i) af[i] = *(const bf16x8*)(smem + cur + arow_off + i * 2048 + sw);
#pragma unroll
      for (int j = 0; j < 4; ++j) bfr[j] = *(const bf16x8*)(smem + cur + brow_off + j * 2048 + sw);
#pragma unroll
      for (int i = 0; i < 4; ++i)
#pragma unroll
        for (int j = 0; j < 4; ++j) acc[i][j] = __builtin_amdgcn_mfma_f32_16x16x32_bf16(bfr[j], af[i], acc[i][j], 0, 0, 0);
    }
    if (s + 1 < total) store(wra, wrb, 16384 - cur);
    if (kt == nk - 1) {
      int wm2 = wm, wn2 = wn, fr2 = fr, fq2 = fq;
      asm volatile("" : "+v"(wm2), "+v"(wn2), "+v"(fr2), "+v"(fq2));
      epi(acc, tile, cur, wm2, wn2, fr2, fq2);
#pragma unroll
      for (int i = 0; i < 4; ++i)
#pragma unroll
        for (int j = 0; j < 4; ++j) acc[i][j] = (f32x4){0.f, 0.f, 0.f, 0.f};
    }
    __syncthreads();
    if (++kt == nk) { kt = 0; ++tile; }
  };
  load(ra0, rb0);
  load(ra1, rb1);
  store(ra0, rb0, 0);
  __syncthreads();
  for (int s = 0; s < total; s += 2) {
    body(s, 0, ra0, rb0, ra1, rb1);
    if (s + 1 >= total) break;
    body(s + 1, 16384, ra1, rb1, ra0, rb0);
  }
}
template <class Epi>
DI void gemm128(unsigned char* smem, const unsigned char* abase, const unsigned (&ao)[4], const unsigned char* bbase, const unsigned (&bo)[4], int nk, Epi&& epi) {
  gemm128_stream(smem, abase, ao, bbase, bo, nk, 1, 0, [&](f32x4 (&acc)[4][4], int, int, int wm, int wn, int fr, int fq) { __syncthreads(); epi(acc, wm, wn, fr, fq); });
}


namespace t8 {
constexpr int BM = 256, BK = 64, HALF = 128, HTB = HALF * BK * 2, STAGE_BYTES = 8 * HTB;
DI int lds_byte(int r, int c) { const int st = (r >> 4) * 2 + (c >> 5), rr = r & 15, cc = c & 31, ob = rr * 64 + cc * 2; return st * 1024 + (ob ^ (((ob >> 9) & 1) << 5)); }
DI void stage_rc(int b, int& R, int& C) { const int st = b / 1024, sb = b % 1024, swz = sb ^ (((sb >> 9) & 1) << 5); R = (st >> 1) * 16 + swz / 64; C = (st & 1) * 32 + (swz % 64) / 2; }
DI int perm32(int rho) { const int n = rho >> 4, i = rho & 15; return 8 * (i >> 2) + 4 * n + (i & 3); }
struct Unit { int pm, pn, tab; const unsigned char* bbase; };
constexpr int TAB_OFF = STAGE_BYTES;
constexpr int START_OFF = STAGE_BYTES + 12288;

template <bool PERM, class Sched, class RowOff, class Epi>
DI void gemm_phase(LAS unsigned char* lds, const unsigned char* Abase, const int K, const Sched& S, const RowOff& RO, const Epi& E) {
  const int tid = full_tid();
  const int wid = __builtin_amdgcn_readfirstlane(tid >> 6), lane = tid & 63, wr = wid >> 2, wc = wid & 3, fr = lane & 15, fq = lane >> 4;
  const int nt = K / BK;
  unsigned voffB[2][2];
#pragma unroll
  for (int h = 0; h < 2; ++h)
#pragma unroll
    for (int i = 0; i < 2; ++i) { int R, C; stage_rc(tid * 16 + i * 8192, R, C); const int rho = h * HALF + R;
      const int Rb = PERM ? (((rho >> 5) & 3) * 64 + ((rho >> 2) & 3) * 16 + (rho >> 7) * 8 + ((rho >> 4) & 1) * 4 + (rho & 3)) : rho; voffB[h][i] = (unsigned)(Rb * K + C) * 2u; }
  auto apiece = [&](const Unit& u, int h, int i) -> unsigned { int R, C; stage_rc(tid * 16 + i * 8192, R, C); return RO(u, h * HALF + R) + (unsigned)(C * 2); };
  const size_t kstep = (size_t)(BK * 2);
  const unsigned ldsw = (unsigned)wid * 1024u;
  const int aoff = lds_byte(wr * 64 + fr, fq * 8), boff = lds_byte(wc * 32 + fr, fq * 8);
  LAS const unsigned char* ldsA = lds + aoff; LAS const unsigned char* ldsB = lds + 4 * HTB + boff;
  asm volatile("" : "+v"(ldsA), "+v"(ldsB));
#define T8_SA(b, h) (((b) * 2 + (h)) * HTB)
#define T8_SB(b, h) ((4 + (b) * 2 + (h)) * HTB)
#define T8_STAGE(bufoff, gbase, voff) do { _Pragma("unroll") for (int _i = 0; _i < 2; ++_i) \
    __builtin_amdgcn_global_load_lds((const unsigned*)((const char*)(gbase) + (voff)[_i]), (LAS unsigned*)(lds + (bufoff) + ldsw + _i * 8192), 16, 0, 0); } while (0)
#define T8_LDA(dst, b, h) do { _Pragma("unroll") for (int m = 0; m < 4; ++m) _Pragma("unroll") for (int k = 0; k < 2; ++k) dst[m][k] = *(const LAS bf16x8*)(ldsA + T8_SA(b, h) + m * 2048 + k * 1024); } while (0)
#define T8_LDB(dst, b, h) do { _Pragma("unroll") for (int n = 0; n < 2; ++n) _Pragma("unroll") for (int k = 0; k < 2; ++k) dst[n][k] = *(const LAS bf16x8*)(ldsB + (T8_SB(b, h) - 4 * HTB) + n * 2048 + k * 1024); } while (0)
#define T8_MMA(ai, bj, At, Bt) do { __builtin_amdgcn_s_setprio(1); _Pragma("unroll") for (int m = 0; m < 4; ++m) _Pragma("unroll") for (int n = 0; n < 2; ++n) _Pragma("unroll") for (int k = 0; k < 2; ++k) \
    acc[ai][bj][m][n] = __builtin_amdgcn_mfma_f32_16x16x32_bf16(Bt[n][k], At[m][k], acc[ai][bj][m][n], 0, 0, 0); __builtin_amdgcn_s_setprio(0); } while (0)
#define T8_WAIT_V(n) asm volatile("s_waitcnt vmcnt(" #n ")" ::: "memory")
#define T8_WAIT_L(n) asm volatile("s_waitcnt lgkmcnt(" #n ")" ::: "memory")
#define T8_BAR __builtin_amdgcn_s_barrier()
#define T8_SCHED __builtin_amdgcn_sched_barrier(0)
  Unit cur, nxt; int ui = 0;
  if (!S.next(0, cur)) return;
  f32x4 acc[2][2][4][2];
#pragma unroll
  for (int a = 0; a < 2; ++a)
#pragma unroll
    for (int b = 0; b < 2; ++b)
#pragma unroll
      for (int m = 0; m < 4; ++m)
#pragma unroll
        for (int n = 0; n < 2; ++n) acc[a][b][m][n] = (f32x4){0.f, 0.f, 0.f, 0.f};
  bf16x8 At[4][2], B0[2][2], B1[2][2];
  unsigned vc[2][2];
#pragma unroll
  for (int h = 0; h < 2; ++h)
#pragma unroll
    for (int i = 0; i < 2; ++i) vc[h][i] = apiece(cur, h, i);
  const char* cB = (const char*)cur.bbase;
  const char* gA = (const char*)Abase;
  T8_STAGE(T8_SB(0, 0), cB, voffB[0]); T8_STAGE(T8_SA(0, 0), gA, vc[0]); T8_STAGE(T8_SB(0, 1), cB, voffB[1]); T8_STAGE(T8_SA(0, 1), gA, vc[1]);
  if (wr == 1) T8_BAR;
  T8_WAIT_V(4); T8_BAR;
  T8_STAGE(T8_SB(1, 0), cB + kstep, voffB[0]); T8_STAGE(T8_SA(1, 0), gA + kstep, vc[0]); T8_STAGE(T8_SB(1, 1), cB + kstep, voffB[1]);
  T8_WAIT_V(6); T8_BAR;
  for (;;) {
    const bool has_next = S.next(ui + 1, nxt);
    const char* nB = has_next ? (const char*)nxt.bbase : cB;
#pragma unroll 1
    for (int t = 0; t < nt; t += 2) {
      const bool last = (t == nt - 2);
      const char* a1 = gA + (size_t)(t + 1) * kstep;
      const char* a2 = last ? gA : gA + (size_t)(t + 2) * kstep; const char* b2 = last ? nB : cB + (size_t)(t + 2) * kstep;
      const char* a3 = a2 + kstep; const char* b3 = b2 + kstep;
      if (last && has_next) { vc[0][0] = apiece(nxt, 0, 0); vc[0][1] = apiece(nxt, 0, 1); }
      T8_LDB(B0, 0, 0); T8_SCHED; T8_LDA(At, 0, 0); T8_STAGE(T8_SA(1, 1), a1, vc[1]);
      T8_WAIT_L(8); T8_BAR; T8_WAIT_L(0); T8_MMA(0, 0, At, B0); T8_BAR; T8_SCHED;
      if (last && has_next) { vc[1][0] = apiece(nxt, 1, 0); vc[1][1] = apiece(nxt, 1, 1); }
      T8_LDB(B1, 0, 1); T8_STAGE(T8_SB(0, 0), b2, voffB[0]);
      T8_BAR; T8_WAIT_L(0); T8_MMA(0, 1, At, B1); T8_BAR;
      T8_LDA(At, 0, 1); T8_STAGE(T8_SA(0, 0), a2, vc[0]);
      T8_BAR; T8_WAIT_L(0); T8_MMA(1, 0, At, B0); T8_BAR; T8_SCHED;
      T8_STAGE(T8_SB(0, 1), b2, voffB[1]);
      T8_WAIT_V(6); T8_BAR; T8_MMA(1, 1, At, B1); T8_BAR;
      T8_LDB(B0, 1, 0); T8_SCHED; T8_LDA(At, 1, 0); T8_STAGE(T8_SA(0, 1), a2, vc[1]);
      T8_WAIT_L(8); T8_BAR; T8_WAIT_L(0); T8_MMA(0, 0, At, B0); T8_BAR; T8_SCHED;
      T8_LDB(B1, 1, 1); T8_STAGE(T8_SB(1, 0), b3, voffB[0]);
      T8_BAR; T8_WAIT_L(0); T8_MMA(0, 1, At, B1); T8_BAR;
      T8_LDA(At, 1, 1); T8_STAGE(T8_SA(1, 0), a3, vc[0]);
      T8_BAR; T8_WAIT_L(0); T8_MMA(1, 0, At, B0); T8_BAR; T8_SCHED;
      T8_STAGE(T8_SB(1, 1), b3, voffB[1]);
      T8_WAIT_V(6); T8_BAR; T8_MMA(1, 1, At, B1); T8_BAR;
    }
    E(acc, cur, wr, wc, fr, fq);
    if (!has_next) break;
#pragma unroll
    for (int a = 0; a < 2; ++a)
#pragma unroll
      for (int b = 0; b < 2; ++b)
#pragma unroll
        for (int m = 0; m < 4; ++m)
#pragma unroll
          for (int n = 0; n < 2; ++n) acc[a][b][m][n] = (f32x4){0.f, 0.f, 0.f, 0.f};
    cur = nxt; cB = nB; ++ui;
  }
  T8_WAIT_V(0);
  if (wr == 0) T8_BAR;
  T8_BAR;
#undef T8_SA
#undef T8_SB
#undef T8_STAGE
#undef T8_LDA
#undef T8_LDB
#undef T8_MMA
#undef T8_WAIT_V
#undef T8_WAIT_L
#undef T8_BAR
#undef T8_SCHED
}

struct DenseSched {
  int nM, nN, nwg, G, c; const unsigned char* Bt; size_t tstep;
  DI void init(int M, int N, int K, int G_, int c_, const void* Bt_) { nM = M / BM; nN = N / BM; nwg = nM * nN; G = G_; c = c_; Bt = (const unsigned char*)Bt_; tstep = (size_t)BM * K * 2; }
  DI bool next(int i, Unit& u) const {
    const long L = (long)i * G + c; if (L >= nwg) return false;
    int wgid = (int)L; { const int q = nwg / 8, r = nwg % 8, xcd = wgid % 8, off = wgid / 8; wgid = (xcd < r ? xcd * (q + 1) : r * (q + 1) + (xcd - r) * q) + off; }
    const int nig = 8 * nN, gid = wgid / nig, fm = gid * 8, gsz = (nM - fm) < 8 ? (nM - fm) : 8;
    u.pm = fm + ((wgid % nig) % gsz); u.pn = (wgid % nig) / gsz; u.tab = 0; u.bbase = Bt + (size_t)u.pn * tstep; return true;
  }
};
struct DenseRows { unsigned rowbytes; DI unsigned operator()(const Unit& u, int row) const { return (unsigned)(u.pm * BM + row) * rowbytes; } };

struct MoeSched {
  LAS const int* start; int npn, nmt, G, c; const unsigned char* wexp; const unsigned char* wsh; size_t estride, tstep;
  DI bool locate(int i, int& mt, int& pn, int& tab) const {
    const int R = nmt / G;
    if (i < R * npn) { const int r = i / npn; pn = i - r * npn; mt = r * G + c; tab = r; return true; }
    const int j = i - R * npn, L = j * G + c, rem = (nmt - R * G) * npn;
    if (L >= rem) return false;
    const int q = L / npn; pn = L - q * npn; mt = R * G + q; tab = R + j; return true;
  }
  DI bool next(int i, Unit& u) const {
    int mt, pn, tab;
    if (!locate(i, mt, pn, tab)) return false;
    u.pm = mt; u.pn = pn; u.tab = tab;
    const int e = __builtin_amdgcn_readfirstlane(start[128 + tab]);
    u.bbase = (e == 64 ? wsh : wexp + (size_t)e * estride) + (size_t)pn * tstep; return true;
  }
};
}

DI void moe_prepare(const P& p, LAS unsigned char* lds, int l, int npn, int G, int c, int& total_units, bool with_w = false) {
  LAS int* start = (LAS int*)(lds + t8::START_OFF);
  __syncthreads();
  if (full_tid() == 0) {
    int s = 0;
    for (int e = 0; e < 64; ++e) { start[e] = s; s += (p.cnt()[(l * 64 + e) * CSTRIDE] + 255) >> 8; }
    start[64] = s; start[65] = s + 64;
  }
  __syncthreads();
  const int nmt = start[65];
  total_units = nmt;
  const int tid = full_tid();
  t8::MoeSched S{start, npn, nmt, G, c, nullptr, nullptr, 0, 0};
  int last_tab = -1;
  for (int i = 0; i < 16; ++i) {
    int mt, pn, tab;
    if (!S.locate(i, mt, pn, tab)) break;
    if (tab == last_tab) continue;
    last_tab = tab;
    int e = 64;
    if (mt < start[64]) {
      e = 0;
#pragma unroll 4
      for (int q = 1; q < 64; ++q) e = (start[q] <= mt) ? q : e;
    }
    if (tid == 0) start[128 + tab] = e;
    if (tid < 256) {
      int slot;
      if (mt >= start[64]) slot = T_ * 8 + (mt - start[64]) * 256 + tid;
      else {
        const int idx = (mt - start[e]) * 256 + tid;
        slot = idx < p.cnt()[(l * 64 + e) * CSTRIDE] ? p.list()[(size_t)e * LISTCAP + idx] : -1;
      }
      ((LAS int*)(lds + t8::TAB_OFF))[tab * 256 + tid] = slot;
      if (with_w) ((LAS float*)(lds + t8::TAB_OFF))[(6 + tab) * 256 + tid] = (slot < 0 || slot >= T_ * 8) ? 1.f : p.topw()[slot] * YSCALE;
    }
  }
  __syncthreads();
}

DI void item_mod(const P& p, unsigned char* smem, int item) {
  const int l = item / 192, cb = item % 192;
  const int tid = otid(), col = tid & 31, kg = tid >> 5;
  float* sc = (float*)smem;
  float* red = (float*)(smem + 32768);
  __syncthreads();
  for (int i = tid; i < 8192; i += NTHREADS) sc[i] = silu_f(p.c[i]);
  __syncthreads();
  const float* W = p.w_ada + (size_t)l * 1024 * 6144 + (size_t)(kg * 128) * 6144 + cb * 32 + col;
  float acc[8];
#pragma unroll
  for (int b = 0; b < 8; ++b) acc[b] = 0.f;
#pragma unroll 1
  for (int k0 = 0; k0 < 128; k0 += 32) {
    float wv[32];
#pragma unroll
    for (int u = 0; u < 32; ++u) wv[u] = W[(size_t)(k0 + u) * 6144];
#pragma unroll
    for (int u = 0; u < 32; ++u)
#pragma unroll
      for (int b = 0; b < 8; ++b) acc[b] += sc[b * 1024 + kg * 128 + k0 + u] * wv[u];
  }
#pragma unroll
  for (int b = 0; b < 8; ++b) red[(kg * 8 + b) * 32 + col] = acc[b];
  __syncthreads();
  {
    const int b = tid >> 5, cc = tid & 31;
    float v = 0.f;
#pragma unroll
    for (int g = 0; g < 8; ++g) v += red[(g * 8 + b) * 32 + cc];
    p.mod()[((size_t)l * 8 + b) * 6144 + cb * 32 + cc] = v + p.b_ada[(size_t)l * 6144 + cb * 32 + cc];
  }
}

DI void conv_tile(unsigned char* smem, const float* src, int ldsrc, int k0, int n0, bf16_t* dst, int lddst, int mode, const float* kscale) {
  float* t = (float*)smem;
  const int tid = otid();
  __syncthreads();
  {
    const int kk = tid >> 3, nq = tid & 7;
#pragma unroll
    for (int hh = 0; hh < 2; ++hh) {
      const int k = kk + 32 * hh;
      const float4 v = *(const float4*)(src + (size_t)(k0 + k) * ldsrc + n0 + nq * 4);
      const float s = kscale ? kscale[k0 + k] : 1.f;
      t[k * 33 + nq * 4 + 0] = v.x * s; t[k * 33 + nq * 4 + 1] = v.y * s; t[k * 33 + nq * 4 + 2] = v.z * s; t[k * 33 + nq * 4 + 3] = v.w * s;
    }
  }
  __syncthreads();
  {
    const int n = tid >> 3, kc = tid & 7;
    u32x4 wv;
    wv.x = pack2(t[(kc * 8 + 0) * 33 + n], t[(kc * 8 + 1) * 33 + n]);
    wv.y = pack2(t[(kc * 8 + 2) * 33 + n], t[(kc * 8 + 3) * 33 + n]);
    wv.z = pack2(t[(kc * 8 + 4) * 33 + n], t[(kc * 8 + 5) * 33 + n]);
    wv.w = pack2(t[(kc * 8 + 6) * 33 + n], t[(kc * 8 + 7) * 33 + n]);
    const int nn = n0 + n;
    const int orow = (mode == 0) ? nn : (256 * (nn >> 7) + 16 * ((nn & 127) >> 3) + (mode == 2 ? 8 : 0) + (nn & 7));
    *(u32x4*)(dst + (size_t)orow * lddst + k0 + kc * 8) = wv;
  }
}

DI void conv_big(unsigned char* smem, const float* src, int ldsrc, int k0, int n0, bf16_t* dst, int lddst, int mode, const float* kscale) {
  float* t = (float*)smem;
  const int tid = otid();
  __syncthreads();
  {
    const int c4 = tid & 31, r0 = tid >> 5;
    float4 v[8];
#pragma unroll
    for (int hh = 0; hh < 8; ++hh) v[hh] = *(const float4*)(src + (size_t)(k0 + r0 + 8 * hh) * ldsrc + n0 + c4 * 4);
#pragma unroll
    for (int hh = 0; hh < 8; ++hh) {
      const int k = r0 + 8 * hh;
      const float sc = kscale ? kscale[k0 + k] : 1.f;
      *(float4*)(t + k * 132 + c4 * 4) = (float4){v[hh].x * sc, v[hh].y * sc, v[hh].z * sc, v[hh].w * sc};
    }
  }
  __syncthreads();
  {
    const int n = tid >> 1, kh = tid & 1;
    const int nn = n0 + n;
    const int orow = (mode == 0) ? nn : (256 * (nn >> 7) + 16 * ((nn & 127) >> 3) + (mode == 2 ? 8 : 0) + (nn & 7));
    bf16_t* d = dst + (size_t)orow * lddst + k0 + kh * 32;
#pragma unroll
    for (int c = 0; c < 4; ++c) {
      const float* tp = t + (kh * 32 + c * 8) * 132 + n;
      u32x4 wv;
      wv.x = pack2(tp[0 * 132], tp[1 * 132]); wv.y = pack2(tp[2 * 132], tp[3 * 132]); wv.z = pack2(tp[4 * 132], tp[5 * 132]); wv.w = pack2(tp[6 * 132], tp[7 * 132]);
      *(u32x4*)(d + c * 8) = wv;
    }
  }
}

DI void item_conv(const P& p, unsigned char* smem, int l, int idx) {
  if (idx < 592) { conv_tile(smem, p.w_in + (size_t)l * 1024 * NIN, NIN, (idx / 37) * 64, (idx % 37) * 32, p.win_t(), 1024, 0, nullptr); return; }
  idx -= 592;
  if (idx < 24) { conv_big(smem, p.w_uq + (size_t)l * 256 * 768, 768, (idx / 6) * 64, (idx % 6) * 128, p.wuq_t(), 256, 0, p.g_q + l * 256); return; }
  idx -= 24;
  if (idx < 16) { conv_big(smem, p.w_ukv + (size_t)l * 128 * 1024, 1024, (idx / 8) * 64, (idx % 8) * 128, p.wukv_t(), 256, 0, p.g_kv + l * 128); return; }
  idx -= 16;
  if (idx < 128) { conv_big(smem, p.w_out + (size_t)l * 1024 * 1024, 1024, (idx / 8) * 64, (idx % 8) * 128, p.wout_t(), 1024, 0, nullptr); return; }
  idx -= 128;
  if (idx < 32) { conv_big(smem, p.ws_gate + (size_t)l * 1024 * 256, 256, (idx / 2) * 64, (idx % 2) * 128, p.wsg_t(), 1024, 1, nullptr); return; }
  idx -= 32;
  if (idx < 32) { conv_big(smem, p.ws_up + (size_t)l * 1024 * 256, 256, (idx / 2) * 64, (idx % 2) * 128, p.wsg_t(), 1024, 2, nullptr); return; }
  idx -= 32;
  if (idx < 32) { conv_big(smem, p.ws_down + (size_t)l * 256 * 1024, 1024, (idx / 8) * 64, (idx % 8) * 128, p.wsd_t(), 256, 0, nullptr); return; }
  idx -= 32;
  const int e = idx / 96, r = idx % 96;
  if (r < 32) conv_big(smem, p.w_gate + ((size_t)l * 64 + e) * 1024 * 256, 256, (r / 2) * 64, (r % 2) * 128, p.wgu_t() + (size_t)e * 512 * 1024, 1024, 1, nullptr);
  else if (r < 64) conv_big(smem, p.w_up + ((size_t)l * 64 + e) * 1024 * 256, 256, ((r - 32) / 2) * 64, ((r - 32) % 2) * 128, p.wgu_t() + (size_t)e * 512 * 1024, 1024, 2, nullptr);
  else conv_big(smem, p.w_down + ((size_t)l * 64 + e) * 256 * 1024, 1024, ((r - 64) / 8) * 64, ((r - 64) % 8) * 128, p.wd_t() + (size_t)e * 1024 * 256, 256, 0, nullptr);
}


DI void conv_big_desc(const P& p, int l, int idx, const float*& src, int& ldsrc, int& k0, int& n0, bf16_t*& dst, int& lddst, int& mode) {
  if (idx < 32) { src = p.ws_gate + (size_t)l * 1024 * 256; ldsrc = 256; k0 = (idx / 2) * 64; n0 = (idx % 2) * 128; dst = p.wsg_t(); lddst = 1024; mode = 1; return; }
  idx -= 32;
  if (idx < 32) { src = p.ws_up + (size_t)l * 1024 * 256; ldsrc = 256; k0 = (idx / 2) * 64; n0 = (idx % 2) * 128; dst = p.wsg_t(); lddst = 1024; mode = 2; return; }
  idx -= 32;
  if (idx < 32) { src = p.ws_down + (size_t)l * 256 * 1024; ldsrc = 1024; k0 = (idx / 8) * 64; n0 = (idx % 8) * 128; dst = p.wsd_t(); lddst = 256; mode = 0; return; }
  idx -= 32;
  const int e = idx / 96, r = idx % 96;
  if (r < 32) { src = p.w_gate + ((size_t)l * 64 + e) * 1024 * 256; ldsrc = 256; k0 = (r / 2) * 64; n0 = (r % 2) * 128; dst = p.wgu_t() + (size_t)e * 512 * 1024; lddst = 1024; mode = 1; }
  else if (r < 64) { src = p.w_up + ((size_t)l * 64 + e) * 1024 * 256; ldsrc = 256; k0 = ((r - 32) / 2) * 64; n0 = ((r - 32) % 2) * 128; dst = p.wgu_t() + (size_t)e * 512 * 1024; lddst = 1024; mode = 2; }
  else { src = p.w_down + ((size_t)l * 64 + e) * 256 * 1024; ldsrc = 1024; k0 = ((r - 64) / 8) * 64; n0 = ((r - 64) % 8) * 128; dst = p.wd_t() + (size_t)e * 1024 * 256; lddst = 256; mode = 0; }
}
DI void conv_big_load(const P& p, int l, int idx, int tid, f32x4 (&v)[8]) {
  idx = idx < CONV_BIG ? idx : CONV_BIG - 1;
  const float* src; int ldsrc, k0, n0; bf16_t* dst; int lddst, mode;
  conv_big_desc(p, l, idx, src, ldsrc, k0, n0, dst, lddst, mode);
  const int c4 = tid & 31, r0 = tid >> 5;
#pragma unroll
  for (int hh = 0; hh < 8; ++hh) v[hh] = *(const f32x4*)(src + (size_t)(k0 + r0 + 8 * hh) * ldsrc + n0 + c4 * 4);
}
DI void conv_big_finish(const P& p, unsigned char* smem, int l, int idx, int tid, const f32x4 (&v)[8]) {
  const float* src; int ldsrc, k0, n0; bf16_t* dst; int lddst, mode;
  conv_big_desc(p, l, idx, src, ldsrc, k0, n0, dst, lddst, mode);
  float* t = (float*)smem;
  const int c4 = tid & 31, r0 = tid >> 5;
  __syncthreads();
#pragma unroll
  for (int hh = 0; hh < 8; ++hh) *(f32x4*)(t + (r0 + 8 * hh) * 132 + c4 * 4) = v[hh];
  __syncthreads();
  const int n = tid >> 1, kh = tid & 1;
  const int nn = n0 + n;
  const int orow = (mode == 0) ? nn : (256 * (nn >> 7) + 16 * ((nn & 127) >> 3) + (mode == 2 ? 8 : 0) + (nn & 7));
  bf16_t* d = dst + (size_t)orow * lddst + k0 + kh * 32;
#pragma unroll
  for (int c = 0; c < 4; ++c) {
    const float* tp = t + (kh * 32 + c * 8) * 132 + n;
    u32x4 wv;
    wv.x = pack2(tp[0 * 132], tp[1 * 132]); wv.y = pack2(tp[2 * 132], tp[3 * 132]); wv.z = pack2(tp[4 * 132], tp[5 * 132]); wv.w = pack2(tp[6 * 132], tp[7 * 132]);
    *(u32x4*)(d + c * 8) = wv;
  }
}
DI void conv_big_loop(const P& p, unsigned char* smem, int l, int first, int step) {
  if (first >= CONV_BIG) return;
  const int tid = otid();
  f32x4 va[8], vb[8];
  conv_big_load(p, l, first, tid, va); conv_big_load(p, l, first + step, tid, vb);
  for (int it = first; it < CONV_BIG; it += 2 * step) {
    conv_big_finish(p, smem, l, it, tid, va);
    conv_big_load(p, l, it + 2 * step, tid, va);
    if (it + step >= CONV_BIG) break;
    conv_big_finish(p, smem, l, it + step, tid, vb);
    conv_big_load(p, l, it + 3 * step, tid, vb);
  }
}

constexpr int MISC_ITEMS = 64 + 128 + 512 + 64;
DI void item_misc(const P& p, int item) {
  const int tid = otid();
  if (item < 64) {
    const int i = (item * NTHREADS + tid) * 8;
    const int k0 = i & 127, t = (i >> 7) & 127;
    const float4 a = *(const float4*)(p.w_spatial + i), c = *(const float4*)(p.w_spatial + i + 4);
    u32x4 o;
    o.x = pack2(k0 + 0 <= t ? a.x : 0.f, k0 + 1 <= t ? a.y : 0.f); o.y = pack2(k0 + 2 <= t ? a.z : 0.f, k0 + 3 <= t ? a.w : 0.f);
    o.z = pack2(k0 + 4 <= t ? c.x : 0.f, k0 + 5 <= t ? c.y : 0.f); o.w = pack2(k0 + 6 <= t ? c.z : 0.f, k0 + 7 <= t ? c.w : 0.f);
    *(u32x4*)(p.wsp_b() + i) = o;
  } else if (item < 64 + 128) {
    const int i = (item - 64) * NTHREADS + tid;
    const int c = i & 63, dd = (i >> 6) & 63, lg = i >> 12;
    const f32x2 f = {p.w_pool[((size_t)lg * 64 + c) * 64 + dd], 0.f}; const bf16x2_t bb = __builtin_convertvector(f, bf16x2_t);
    p.wpool_t()[i] = (bf16_t)(__builtin_bit_cast(unsigned, bb) & 0xffffu);
  } else if (item >= 64 + 128 + 512) {
    const int i = (item - 704) * NTHREADS + tid;
    *(u32x4*)(p.wukv_t() + (size_t)(i >> 4) * 256 + 128 + (i & 15) * 8) = (u32x4){0u, 0u, 0u, 0u};
  } else {
    const int i = (item - 192) * NTHREADS + tid;
    const int e = i & 63, k = (i >> 6) & 1023, l = i >> 16;
    const float v = p.w_router[i];
    const unsigned hi = pack2(v, 0.f) & 0xffffu;
    const unsigned lo = pack2(v - bflo(hi), 0.f) & 0xffffu;
    p.wr_hi()[(size_t)l * 65536 + e * 1024 + k] = (bf16_t)hi;
    p.wr_lo()[(size_t)l * 65536 + e * 1024 + k] = (bf16_t)lo;
  }
}

DI void item_rope(const P& p, int item) {
  const int i = item * NTHREADS + otid();
  const int t = i >> 4, f = i & 15;
  const float inv = exp2f(-(float)(2 * f) * (13.287712379549449f / 32.f));
  const float ang = (float)p.pos[t] * inv;
  const double rev = (double)ang * 0.15915494309189535;
  const float fr = (float)(rev - floor(rev));
  p.ropec()[i] = __builtin_amdgcn_cosf(fr);
  p.ropes()[i] = __builtin_amdgcn_sinf(fr);
}

DI void item_norm0(const P& p, int item) {
  const int tid = otid(), w = tid >> 6, lane = tid & 63;
  const int t0 = item * 8 + w * 2, b = t0 >> 11;
  const float* md = p.mod() + (size_t)b * 6144;
  f32x4 v[2][4];
#pragma unroll
  for (int q = 0; q < 2; ++q)
#pragma unroll
    for (int j = 0; j < 4; ++j) v[q][j] = *(const f32x4*)(p.x + (size_t)(t0 + q) * 1024 + j * 256 + lane * 4);
  float ss[2] = {0.f, 0.f};
#pragma unroll
  for (int q = 0; q < 2; ++q)
#pragma unroll
    for (int j = 0; j < 4; ++j) ss[q] += v[q][j][0] * v[q][j][0] + v[q][j][1] * v[q][j][1] + v[q][j][2] * v[q][j][2] + v[q][j][3] * v[q][j][3];
  ss[0] = wsum(ss[0]); ss[1] = wsum(ss[1]);
#pragma unroll
  for (int q = 0; q < 2; ++q) {
    const float rstd = rsqrtf(ss[q] * (1.f / 1024.f) + EPS);
#pragma unroll
    for (int j = 0; j < 4; ++j) {
      const int idx = j * 256 + lane * 4;
      const f32x4 sh = *(const f32x4*)(md + idx), sc = *(const f32x4*)(md + 1024 + idx);
      const f32x4 hv = v[q][j] * rstd * (sc + 1.f) + sh;
      u32x2 o; o.x = pack2(hv[0], hv[1]); o.y = pack2(hv[2], hv[3]);
      *(u32x2*)(p.h() + (size_t)(t0 + q) * 1024 + idx) = o;
    }
  }
}

DI void item_p1(const P& p, unsigned char* smem, int item) {
  const int m = item / 10, nt = item % 10;
  const int tid = otid(), r_s = tid >> 3, c_s = tid & 7;
  __syncthreads();
  unsigned ao[4], bo[4];
#pragma unroll
  for (int j = 0; j < 4; ++j) {
    const int row = r_s + 32 * j;
    ao[j] = (unsigned)(((m * 128 + row) * 1024 + c_s * 8) * 2);
    int n = nt * 128 + row; n = n < NIN ? n : NIN - 1;
    bo[j] = (unsigned)((n * 1024 + c_s * 8) * 2);
  }
  bf16_t* proj = p.proj();
  gemm128(smem, (const unsigned char*)p.h(), ao, (const unsigned char*)p.win_t(), bo, 16, [=](f32x4 (&acc)[4][4], int wm, int wn, int fr, int fq) {
    unsigned char* ob = smem + wm * 16384;
#pragma unroll
    for (int i = 0; i < 4; ++i)
#pragma unroll
      for (int j = 0; j < 4; ++j) {
        u32x2 o; o.x = pack2(acc[i][j][0], acc[i][j][1]); o.y = pack2(acc[i][j][2], acc[i][j][3]);
        ot_put<256>(ob, i * 16 + fr, wn * 16 + j * 4 + fq, o);
      }
    __syncthreads();
    {
      const int tid2 = fq * 16 + fr + 64 * (wm * 2 + wn);
      const int chunk = tid2 & 15;
      if (nt * 128 + chunk * 8 < NIN) {
#pragma unroll
        for (int i = 0; i < 8; ++i) {
          const int row = (tid2 >> 4) + 16 * i;
          const u32x4 v = ot_get<256>(smem + (row >> 6) * 16384, row & 63, chunk);
          *(u32x4*)(proj + (size_t)(m * 128 + row) * NIN + nt * 128 + chunk * 8) = v;
        }
      }
    }
  });
}

DI void item_qproj(const P& p, unsigned char* smem, int item) {
  const int m = item / 6, nt = item % 6;
  const int tid = otid(), r_s = tid >> 3, c_s = tid & 7;
  float* rowf = (float*)(smem + SMEM_MAIN + 1024);
  __syncthreads();
  {
    const int row = tid >> 1, half = tid & 1;
    const bf16_t* src = p.proj() + (size_t)(m * 128 + row) * NIN + 768 + half * 128;
    float ss = 0.f;
#pragma unroll
    for (int q = 0; q < 16; ++q) {
      const u32x4 v = *(const u32x4*)(src + q * 8);
      ss += bflo(v.x) * bflo(v.x) + bfhi(v.x) * bfhi(v.x) + bflo(v.y) * bflo(v.y) + bfhi(v.y) * bfhi(v.y) + bflo(v.z) * bflo(v.z) + bfhi(v.z) * bfhi(v.z) + bflo(v.w) * bflo(v.w) + bfhi(v.w) * bfhi(v.w);
    }
    ss += __shfl_xor(ss, 1);
    if (half == 0) rowf[row] = rsqrtf(ss * (1.f / 256.f) + EPS);
  }
  unsigned ao[4], bo[4];
#pragma unroll
  for (int j = 0; j < 4; ++j) {
    const int row = r_s + 32 * j;
    ao[j] = (unsigned)(((m * 128 + row) * NIN + 768 + c_s * 8) * 2);
    bo[j] = (unsigned)(((nt * 128 + row) * 256 + c_s * 8) * 2);
  }
  bf16_t* Q = p.Q(); const float* ropec = p.ropec(); const float* ropes = p.ropes();
  const float QS = 0.10206207261596577f * 1.4426950408889634f;
  gemm128(smem, (const unsigned char*)p.proj(), ao, (const unsigned char*)p.wuq_t(), bo, 4, [=](f32x4 (&acc)[4][4], int wm, int wn, int fr, int fq) {
#pragma unroll
    for (int i = 0; i < 4; ++i) {
      const int tl = wm * 64 + i * 16 + fr, t = m * 128 + tl;
      const int b = t >> 11, s = t & 2047;
      const float rs = rowf[tl] * QS;
#pragma unroll
      for (int j = 0; j < 4; ++j) {
        const int c0 = nt * 128 + wn * 64 + j * 16;
        const int head = c0 / 96, d0 = c0 % 96;
        bf16_t* dst = Q + ((size_t)((b * 8 + head) * 2048 + s)) * 96 + d0 + fq * 4;
        if (d0 == 64) {
          if (j < 3) {
            const float4 cs = *(const float4*)(ropec + (size_t)t * 16 + fq * 4), sn = *(const float4*)(ropes + (size_t)t * 16 + fq * 4);
            const f32x4 x1 = acc[i][j] * rs, x2 = acc[i][j + 1 < 4 ? j + 1 : 3] * rs;
            u32x2 o1, o2;
            o1.x = pack2(x1[0] * cs.x - x2[0] * sn.x, x1[1] * cs.y - x2[1] * sn.y);
            o1.y = pack2(x1[2] * cs.z - x2[2] * sn.z, x1[3] * cs.w - x2[3] * sn.w);
            o2.x = pack2(x2[0] * cs.x + x1[0] * sn.x, x2[1] * cs.y + x1[1] * sn.y);
            o2.y = pack2(x2[2] * cs.z + x1[2] * sn.z, x2[3] * cs.w + x1[3] * sn.w);
            *(u32x2*)dst = o1; *(u32x2*)(dst + 16) = o2;
          }
        } else if (d0 != 80) {
          const f32x4 x = acc[i][j] * rs;
          u32x2 o; o.x = pack2(x[0], x[1]); o.y = pack2(x[2], x[3]);
          *(u32x2*)dst = o;
        }
      }
    }
  });
}

DI void item_kvproj(const P& p, unsigned char* smem, int item) {
  const int m = item >> 3, head = item & 7;
  const int tid = otid(), r_s = tid >> 3, c_s = tid & 7;
  float* rowf = (float*)(smem + SMEM_MAIN + 1024);
  __syncthreads();
  {
    const int row = tid >> 1, half = tid & 1;
    const int t = m * 128 + row, b = t >> 11, s = t & 2047;
    const bf16_t* src = p.proj() + (size_t)t * NIN + 1024 + half * 64;
    float ss = 0.f;
#pragma unroll
    for (int q = 0; q < 8; ++q) {
      const u32x4 v = *(const u32x4*)(src + q * 8);
      ss += bflo(v.x) * bflo(v.x) + bfhi(v.x) * bfhi(v.x) + bflo(v.y) * bflo(v.y) + bfhi(v.y) * bfhi(v.y) + bflo(v.z) * bflo(v.z) + bfhi(v.z) * bfhi(v.z) + bflo(v.w) * bflo(v.w) + bfhi(v.w) * bfhi(v.w);
    }
    ss += __shfl_xor(ss, 1);
    if (half == 0) rowf[row] = rsqrtf(ss * (1.f / 128.f) + EPS);
    const bf16_t* kp = p.proj() + (size_t)t * NIN + 1152 + half * 8;
    const u32x4 a1 = *(const u32x4*)kp, a2 = *(const u32x4*)(kp + 16);
    const float* cp = p.ropec() + (size_t)t * 16 + half * 8; const float* sp = p.ropes() + (size_t)t * 16 + half * 8;
    const float4 c0 = *(const float4*)cp, c1 = *(const float4*)(cp + 4), s0 = *(const float4*)sp, s1 = *(const float4*)(sp + 4);
    const float x1[8] = {bflo(a1.x), bfhi(a1.x), bflo(a1.y), bfhi(a1.y), bflo(a1.z), bfhi(a1.z), bflo(a1.w), bfhi(a1.w)};
    const float x2[8] = {bflo(a2.x), bfhi(a2.x), bflo(a2.y), bfhi(a2.y), bflo(a2.z), bfhi(a2.z), bflo(a2.w), bfhi(a2.w)};
    const float cc[8] = {c0.x, c0.y, c0.z, c0.w, c1.x, c1.y, c1.z, c1.w};
    const float sn[8] = {s0.x, s0.y, s0.z, s0.w, s1.x, s1.y, s1.z, s1.w};
    u32x4 o1, o2;
    o1.x = pack2(x1[0] * cc[0] - x2[0] * sn[0], x1[1] * cc[1] - x2[1] * sn[1]);
    o1.y = pack2(x1[2] * cc[2] - x2[2] * sn[2], x1[3] * cc[3] - x2[3] * sn[3]);
    o1.z = pack2(x1[4] * cc[4] - x2[4] * sn[4], x1[5] * cc[5] - x2[5] * sn[5]);
    o1.w = pack2(x1[6] * cc[6] - x2[6] * sn[6], x1[7] * cc[7] - x2[7] * sn[7]);
    o2.x = pack2(x2[0] * cc[0] + x1[0] * sn[0], x2[1] * cc[1] + x1[1] * sn[1]);
    o2.y = pack2(x2[2] * cc[2] + x1[2] * sn[2], x2[3] * cc[3] + x1[3] * sn[3]);
    o2.z = pack2(x2[4] * cc[4] + x1[4] * sn[4], x2[5] * cc[5] + x1[5] * sn[5]);
    o2.w = pack2(x2[6] * cc[6] + x1[6] * sn[6], x2[7] * cc[7] + x1[7] * sn[7]);
    bf16_t* kd = p.Kb() + ((size_t)((b * 8 + head) * 2048 + s)) * 96 + 64 + half * 8;
    *(u32x4*)kd = o1; *(u32x4*)(kd + 16) = o2;
  }
  unsigned ao[4], bo[4];
#pragma unroll
  for (int j = 0; j < 4; ++j) {
    const int row = r_s + 32 * j;
    ao[j] = (unsigned)(((m * 128 + row) * NIN + 1024 + c_s * 8) * 2);
    bo[j] = (unsigned)(((head * 128 + row) * 128 + c_s * 8) * 2);
  }
  bf16_t* Kb = p.Kb(); bf16_t* V = p.V();
  gemm128(smem, (const unsigned char*)p.proj(), ao, (const unsigned char*)p.wukv_t(), bo, 2, [=](f32x4 (&acc)[4][4], int wm, int wn, int fr, int fq) {
#pragma unroll
    for (int i = 0; i < 4; ++i) {
      const int tl = wm * 64 + i * 16 + fr, t = m * 128 + tl;
      const int b = t >> 11, s = t & 2047;
      const float rs = rowf[tl];
      const size_t rowi = (size_t)((b * 8 + head) * 2048 + s);
#pragma unroll
      for (int j = 0; j < 4; ++j) {
        const int d = j * 16 + fq * 4;
        const f32x4 x = acc[i][j] * rs;
        u32x2 o; o.x = pack2(x[0], x[1]); o.y = pack2(x[2], x[3]);
        if (wn == 0) *(u32x2*)(Kb + rowi * 96 + d) = o; else *(u32x2*)(V + rowi * 64 + d) = o;
      }
    }
  });
}

DI void item_pool(const P& p, unsigned char* smem, int l, int item) {
  const int tid = otid(), w = tid >> 6, lane = tid & 63, fr = lane & 15, fq = lane >> 4;
  const int tile = item >> 2, g = item & 3;
  const int t0 = tile * 128, s0 = t0 & 2047;
  const int wdw = 2 << g;
  unsigned char* al = smem;
  unsigned char* dl = smem + 20480;
  __syncthreads();
  for (int id = tid; id < 143 * 8; id += NTHREADS) {
    const int row = id >> 3, c = id & 7;
    const int srel = s0 - 15 + row;
    u32x4 v = (u32x4){0u, 0u, 0u, 0u};
    if (srel >= 0) v = *(const u32x4*)(p.proj() + (size_t)(t0 - 15 + row) * NIN + g * 64 + c * 8);
    *(u32x4*)(al + row * 128 + c * 16) = v;
  }
  __syncthreads();
  {
    const int tl = tid >> 1, cb = (tid & 1) * 4;
    const int pos = s0 + tl;
    const int nw = (pos + 1 < wdw) ? pos + 1 : wdw;
    const float inv = 1.f / (float)nw;
#pragma unroll
    for (int q = 0; q < 4; ++q) {
      const int c = cb + q;
      float sm[8];
#pragma unroll
      for (int e = 0; e < 8; ++e) sm[e] = 0.f;
      for (int j = 0; j < nw; ++j) {
        const u32x4 v = *(const u32x4*)(al + (tl + 15 - j) * 128 + c * 16);
        sm[0] += bflo(v.x); sm[1] += bfhi(v.x); sm[2] += bflo(v.y); sm[3] += bfhi(v.y); sm[4] += bflo(v.z); sm[5] += bfhi(v.z); sm[6] += bflo(v.w); sm[7] += bfhi(v.w);
      }
      const u32x4 a = *(const u32x4*)(al + (tl + 15) * 128 + c * 16);
      u32x4 o;
      o.x = pack2(sm[0] * inv - bflo(a.x), sm[1] * inv - bfhi(a.x)); o.y = pack2(sm[2] * inv - bflo(a.y), sm[3] * inv - bfhi(a.y));
      o.z = pack2(sm[4] * inv - bflo(a.z), sm[5] * inv - bfhi(a.z)); o.w = pack2(sm[6] * inv - bflo(a.w), sm[7] * inv - bfhi(a.w));
      *(u32x4*)(dl + tl * 128 + ((c ^ (tl & 7)) << 4)) = o;
    }
  }
  __syncthreads();
  {
    const bf16_t* wp = p.wpool_t() + ((size_t)(l * 4 + g) * 64) * 64;
    f32x4 acc[2][4];
#pragma unroll
    for (int i = 0; i < 2; ++i)
#pragma unroll
      for (int j = 0; j < 4; ++j) acc[i][j] = (f32x4){0.f, 0.f, 0.f, 0.f};
#pragma unroll
    for (int ks = 0; ks < 2; ++ks) {
      bf16x8 df[2], wf[4];
#pragma unroll
      for (int i = 0; i < 2; ++i) { const int row = w * 32 + i * 16 + fr; df[i] = *(const bf16x8*)(dl + row * 128 + (((ks * 4 + fq) ^ (row & 7)) << 4)); }
#pragma unroll
      for (int j = 0; j < 4; ++j) wf[j] = *(const bf16x8*)(wp + (size_t)(j * 16 + fr) * 64 + ks * 32 + fq * 8);
#pragma unroll
      for (int i = 0; i < 2; ++i)
#pragma unroll
        for (int j = 0; j < 4; ++j) acc[i][j] = __builtin_amdgcn_mfma_f32_16x16x32_bf16(wf[j], df[i], acc[i][j], 0, 0, 0);
    }
#pragma unroll
    for (int i = 0; i < 2; ++i) {
      const int t = t0 + w * 32 + i * 16 + fr;
#pragma unroll
      for (int j = 0; j < 4; ++j) {
        const int cc = g * 64 + j * 16 + fq * 4;
        const float4 ps = *(const float4*)(p.pool_scale + l * 256 + cc);
        u32x2 o; o.x = pack2(acc[i][j][0] * ps.x, acc[i][j][1] * ps.y); o.y = pack2(acc[i][j][2] * ps.z, acc[i][j][3] * ps.w);
        *(u32x2*)(p.Y() + (size_t)t * 1024 + cc) = o;
      }
    }
  }
}

DI void item_sgu(const P& p, unsigned char* smem, int l, int chunk) {
  const int tid = otid(), w = tid >> 6, lane = tid & 63, fr = lane & 15, fq = lane >> 4;
  const int t0 = chunk * 128;
  unsigned char* vn = smem;
  __syncthreads();
#pragma unroll 1
  for (int ps = 0; ps < 4; ++ps) {
    const int tl = ps * 32 + (tid >> 3), part = tid & 7;
    const bf16_t* src = p.proj() + (size_t)(t0 + tl) * NIN + 512 + part * 32;
    float x[32];
#pragma unroll
    for (int q = 0; q < 4; ++q) {
      const u32x4 v = *(const u32x4*)(src + q * 8);
      x[q * 8 + 0] = gelu_tanh(bflo(v.x)); x[q * 8 + 1] = gelu_tanh(bfhi(v.x)); x[q * 8 + 2] = gelu_tanh(bflo(v.y)); x[q * 8 + 3] = gelu_tanh(bfhi(v.y));
      x[q * 8 + 4] = gelu_tanh(bflo(v.z)); x[q * 8 + 5] = gelu_tanh(bfhi(v.z)); x[q * 8 + 6] = gelu_tanh(bflo(v.w)); x[q * 8 + 7] = gelu_tanh(bfhi(v.w));
    }
    float sm = 0.f;
#pragma unroll
    for (int e = 0; e < 32; ++e) sm += x[e];
    sm += __shfl_xor(sm, 1); sm += __shfl_xor(sm, 2); sm += __shfl_xor(sm, 4);
    const float mu = sm * (1.f / 256.f);
    float vs = 0.f;
#pragma unroll
    for (int e = 0; e < 32; ++e) { x[e] -= mu; vs += x[e] * x[e]; }
    vs += __shfl_xor(vs, 1); vs += __shfl_xor(vs, 2); vs += __shfl_xor(vs, 4);
    const float rstd = rsqrtf(vs * (1.f / 256.f) + EPS);
#pragma unroll
    for (int q = 0; q < 4; ++q) {
      const int c = part * 4 + q;
      u32x4 o;
      o.x = pack2(x[q * 8 + 0] * rstd, x[q * 8 + 1] * rstd); o.y = pack2(x[q * 8 + 2] * rstd, x[q * 8 + 3] * rstd);
      o.z = pack2(x[q * 8 + 4] * rstd, x[q * 8 + 5] * rstd); o.w = pack2(x[q * 8 + 6] * rstd, x[q * 8 + 7] * rstd);
      *(u32x4*)(vn + tl * 512 + (((c >> 1) ^ (tl & 7)) << 5) + ((c & 1) << 4)) = o;
    }
  }
  __syncthreads();
  const int qq = fr >> 2, pp = fr & 3;
#pragma unroll 1
  for (int hh = 0; hh < 4; ++hh) {
    f32x4 acc[4][2];
#pragma unroll
    for (int df = 0; df < 4; ++df) { acc[df][0] = (f32x4){0.f, 0.f, 0.f, 0.f}; acc[df][1] = (f32x4){0.f, 0.f, 0.f, 0.f}; }
    const bf16_t* wb = p.wsp_b() + ((size_t)(l * 4 + hh) * 128) * 128;
    for (int kb = 0; kb <= w; ++kb) {
      bf16x8 wf[2];
#pragma unroll
      for (int f = 0; f < 2; ++f) {
        const bf16_t* wr = wb + (size_t)((2 * w + f) * 16 + fr) * 128 + kb * 32 + fq * 4;
        const u32x2 lo = *(const u32x2*)wr, hi = *(const u32x2*)(wr + 16);
        u32x4 u; u.x = lo.x; u.y = lo.y; u.z = hi.x; u.w = hi.y;
        wf[f] = __builtin_bit_cast(bf16x8, u);
      }
#pragma unroll
      for (int df = 0; df < 4; ++df) {
        const int keyA = kb * 32 + fq * 4 + qq, keyB = keyA + 16;
        const int slot = hh * 4 + df;
        const s16x4 lo = __builtin_amdgcn_ds_read_tr16_b64_v4i16((LAS s16x4*)(vn + keyA * 512 + ((slot ^ (keyA & 7)) << 5) + pp * 8));
        const s16x4 hi = __builtin_amdgcn_ds_read_tr16_b64_v4i16((LAS s16x4*)(vn + keyB * 512 + ((slot ^ (keyB & 7)) << 5) + pp * 8));
        bf16x8 vf; vf[0] = lo[0]; vf[1] = lo[1]; vf[2] = lo[2]; vf[3] = lo[3]; vf[4] = hi[0]; vf[5] = hi[1]; vf[6] = hi[2]; vf[7] = hi[3];
        acc[df][0] = __builtin_amdgcn_mfma_f32_16x16x32_bf16(vf, wf[0], acc[df][0], 0, 0, 0);
        acc[df][1] = __builtin_amdgcn_mfma_f32_16x16x32_bf16(vf, wf[1], acc[df][1], 0, 0, 0);
      }
    }
#pragma unroll
    for (int f = 0; f < 2; ++f) {
      const int tl = (2 * w + f) * 16 + fr, t = t0 + tl;
      const float bias = p.b_spatial[(l * 4 + hh) * 128 + tl];
#pragma unroll
      for (int df = 0; df < 4; ++df) {
        const int d = hh * 64 + df * 16 + fq * 4;
        const u32x2 uu = *(const u32x2*)(p.proj() + (size_t)t * NIN + 256 + d);
        u32x2 o;
        o.x = pack2(gelu_tanh(bflo(uu.x)) * (acc[df][f][0] + bias), gelu_tanh(bfhi(uu.x)) * (acc[df][f][1] + bias));
        o.y = pack2(gelu_tanh(bflo(uu.y)) * (acc[df][f][2] + bias), gelu_tanh(bfhi(uu.y)) * (acc[df][f][3] + bias));
        *(u32x2*)(p.Y() + (size_t)t * 1024 + 256 + d) = o;
      }
    }
  }
}

DI void item_attn(const P& p, unsigned char* smem, int item) {
  const int tid = otid(), w = tid >> 6, lane = tid & 63;
  const int fr = lane & 15, fq = lane >> 4;
  const int rnd = item >> 9, blk = item & 511;
  const int qb = rnd == 0 ? 15 - (blk >> 6) : (blk >> 6);
  const int bh = blk & 63, b = bh >> 3, h = bh & 7;
  const int q0 = qb * 128;
  const int nkt = 2 * qb + 2;
  const bf16_t* Qg = p.Q() + (size_t)bh * 2048 * 96;
  const bf16_t* Kg = p.Kb() + (size_t)bh * 2048 * 96;
  const bf16_t* Vg = p.V() + (size_t)bh * 2048 * 64;
  int kkey[3], kdst[3], kc[3];
#pragma unroll
  for (int j = 0; j < 3; ++j) { const int id = tid + 256 * j; kkey[j] = id / 12; kc[j] = id % 12; kdst[j] = kkey[j] * 256 + ((kc[j] ^ (kkey[j] & 15)) << 4); }
  int vkey[2], vdst[2], vc[2];
#pragma unroll
  for (int j = 0; j < 2; ++j) { const int id = tid + 256 * j; vkey[j] = id >> 3; vc[j] = id & 7; vdst[j] = vkey[j] * 128 + (((vc[j] >> 1) ^ ((vkey[j] >> 1) & 3)) << 5) + ((vc[j] & 1) << 4); }
  bf16x8 qf[3][2];
#pragma unroll
  for (int ks = 0; ks < 3; ++ks)
#pragma unroll
    for (int f = 0; f < 2; ++f) qf[ks][f] = *(const bf16x8*)(Qg + (size_t)(q0 + 32 * w + 16 * f + fr) * 96 + ks * 32 + fq * 8);
  f32x4 o[4][2];
#pragma unroll
  for (int f = 0; f < 4; ++f) { o[f][0] = (f32x4){0.f, 0.f, 0.f, 0.f}; o[f][1] = (f32x4){0.f, 0.f, 0.f, 0.f}; }
  float mrun[2] = {-INFINITY, -INFINITY}, lrun[2] = {0.f, 0.f};
  u32x4 rk[3], rv[2];
  __syncthreads();
#pragma unroll
  for (int j = 0; j < 3; ++j) rk[j] = *(const u32x4*)(Kg + (size_t)kkey[j] * 96 + kc[j] * 8);
#pragma unroll
  for (int j = 0; j < 2; ++j) rv[j] = *(const u32x4*)(Vg + (size_t)vkey[j] * 64 + vc[j] * 8);
#pragma unroll
  for (int j = 0; j < 3; ++j) *(u32x4*)(smem + kdst[j]) = rk[j];
#pragma unroll
  for (int j = 0; j < 2; ++j) *(u32x4*)(smem + 32768 + vdst[j]) = rv[j];
  __syncthreads();
  const int rowmin = q0 + 32 * w;
  for (int kt = 0; kt < nkt; ++kt) {
    const int cur = kt & 1;
    const bool more = kt + 1 < nkt;
    if (more) {
      const int key0n = (kt + 1) * 64;
#pragma unroll
      for (int j = 0; j < 3; ++j) rk[j] = *(const u32x4*)(Kg + (size_t)(key0n + kkey[j]) * 96 + kc[j] * 8);
#pragma unroll
      for (int j = 0; j < 2; ++j) rv[j] = *(const u32x4*)(Vg + (size_t)(key0n + vkey[j]) * 64 + vc[j] * 8);
    }
    const int key0 = kt * 64;
    if (key0 <= rowmin + 31) {
      const unsigned char* Kl = smem + cur * 16384;
      const unsigned char* Vl = smem + 32768 + cur * 8192;
      f32x4 st[4][2];
#pragma unroll
      for (int kf = 0; kf < 4; ++kf) { st[kf][0] = (f32x4){0.f, 0.f, 0.f, 0.f}; st[kf][1] = (f32x4){0.f, 0.f, 0.f, 0.f}; }
#pragma unroll
      for (int ks = 0; ks < 3; ++ks)
#pragma unroll
        for (int kf = 0; kf < 4; ++kf) {
          const int key = kf * 16 + fr;
          const bf16x8 a = *(const bf16x8*)(Kl + key * 256 + (((ks * 4 + fq) ^ (key & 15)) << 4));
          st[kf][0] = __builtin_amdgcn_mfma_f32_16x16x32_bf16(a, qf[ks][0], st[kf][0], 0, 0, 0);
          st[kf][1] = __builtin_amdgcn_mfma_f32_16x16x32_bf16(a, qf[ks][1], st[kf][1], 0, 0, 0);
        }
      const bool needmask = (key0 + 63 > rowmin);
#pragma unroll
      for (int f = 0; f < 2; ++f) {
        const int qabs = rowmin + 16 * f + fr;
        if (needmask) {
#pragma unroll
          for (int kf = 0; kf < 4; ++kf)
#pragma unroll
            for (int r = 0; r < 4; ++r) { const int kabs = key0 + kf * 16 + fq * 4 + r; if (kabs > qabs) st[kf][f][r] = -INFINITY; }
        }
        float mx = st[0][f][0];
#pragma unroll
        for (int kf = 0; kf < 4; ++kf)
#pragma unroll
          for (int r = 0; r < 4; ++r) mx = fmaxf(mx, st[kf][f][r]);
        mx = fmaxf(mx, __shfl_xor(mx, 16)); mx = fmaxf(mx, __shfl_xor(mx, 32));
        const float mnew = fmaxf(mrun[f], mx);
        const float alpha = __builtin_amdgcn_exp2f(mrun[f] - mnew);
        mrun[f] = mnew;
        float ls = 0.f;
#pragma unroll
        for (int kf = 0; kf < 4; ++kf)
#pragma unroll
          for (int r = 0; r < 4; ++r) { const float pv = __builtin_amdgcn_exp2f(st[kf][f][r] - mnew); st[kf][f][r] = pv; ls += pv; }
        lrun[f] = lrun[f] * alpha + ls;
#pragma unroll
        for (int df = 0; df < 4; ++df) o[df][f] = o[df][f] * alpha;
      }
      bf16x8 pf[2][2];
#pragma unroll
      for (int kb = 0; kb < 2; ++kb)
#pragma unroll
        for (int f = 0; f < 2; ++f) {
          u32x4 u;
          u.x = pack2(st[2 * kb][f][0], st[2 * kb][f][1]); u.y = pack2(st[2 * kb][f][2], st[2 * kb][f][3]);
          u.z = pack2(st[2 * kb + 1][f][0], st[2 * kb + 1][f][1]); u.w = pack2(st[2 * kb + 1][f][2], st[2 * kb + 1][f][3]);
          pf[kb][f] = __builtin_bit_cast(bf16x8, u);
        }
      const int qq = fr >> 2, pp = fr & 3;
#pragma unroll
      for (int kb = 0; kb < 2; ++kb)
#pragma unroll
        for (int df = 0; df < 4; ++df) {
          const int keyA = kb * 32 + fq * 4 + qq, keyB = keyA + 16;
          const int offA = keyA * 128 + ((df ^ ((keyA >> 1) & 3)) << 5) + pp * 8;
          const int offB = keyB * 128 + ((df ^ ((keyB >> 1) & 3)) << 5) + pp * 8;
          const s16x4 lo = __builtin_amdgcn_ds_read_tr16_b64_v4i16((LAS s16x4*)(Vl + offA));
          const s16x4 hi = __builtin_amdgcn_ds_read_tr16_b64_v4i16((LAS s16x4*)(Vl + offB));
          bf16x8 vf; vf[0] = lo[0]; vf[1] = lo[1]; vf[2] = lo[2]; vf[3] = lo[3]; vf[4] = hi[0]; vf[5] = hi[1]; vf[6] = hi[2]; vf[7] = hi[3];
          o[df][0] = __builtin_amdgcn_mfma_f32_16x16x32_bf16(vf, pf[kb][0], o[df][0], 0, 0, 0);
          o[df][1] = __builtin_amdgcn_mfma_f32_16x16x32_bf16(vf, pf[kb][1], o[df][1], 0, 0, 0);
        }
    }
    if (more) {
      const int nx = cur ^ 1;
#pragma unroll
      for (int j = 0; j < 3; ++j) *(u32x4*)(smem + nx * 16384 + kdst[j]) = rk[j];
#pragma unroll
      for (int j = 0; j < 2; ++j) *(u32x4*)(smem + 32768 + nx * 8192 + vdst[j]) = rv[j];
    }
    __syncthreads();
  }
#pragma unroll
  for (int f = 0; f < 2; ++f) {
    float lt = lrun[f]; lt += __shfl_xor(lt, 16); lt += __shfl_xor(lt, 32);
    const float inv = 1.f / lt;
    const int t = b * 2048 + rowmin + 16 * f + fr;
#pragma unroll
    for (int df = 0; df < 4; ++df) {
      const f32x4 x = o[df][f] * inv;
      u32x2 ov; ov.x = pack2(x[0], x[1]); ov.y = pack2(x[2], x[3]);
      *(u32x2*)(p.Y() + (size_t)t * 1024 + 512 + h * 64 + df * 16 + fq * 4) = ov;
    }
  }
}

DI void item_p4(const P& p, unsigned char* smem, int l, int item) {
  const int m = item >> 3, nt = item & 7;
  const int tid = otid(), r_s = tid >> 3, c_s = tid & 7;
  unsigned ao[4], bo[4];
#pragma unroll
  for (int j = 0; j < 4; ++j) {
    const int row = r_s + 32 * j;
    ao[j] = (unsigned)(((m * 128 + row) * 1024 + c_s * 8) * 2);
    bo[j] = (unsigned)(((nt * 128 + row) * 1024 + c_s * 8) * 2);
  }
  const float* xin = (l == 0) ? p.x : p.out;
  float* xout = p.out;
  const float* mod = p.mod() + (size_t)l * 8 * 6144 + 2048;
  float* rowss = p.rowss();
  gemm128(smem, (const unsigned char*)p.Y(), ao, (const unsigned char*)p.wout_t(), bo, 16, [=](f32x4 (&acc)[4][4], int wm, int wn, int fr, int fq) {
#pragma unroll
    for (int i = 0; i < 4; ++i) {
      const int t = m * 128 + wm * 64 + i * 16 + fr, b = t >> 11;
      float ss = 0.f;
#pragma unroll
      for (int j = 0; j < 4; ++j) {
        const int n = nt * 128 + wn * 64 + j * 16 + fq * 4;
        const float4 xv = *(const float4*)(xin + (size_t)t * 1024 + n);
        const float4 g = *(const float4*)(mod + (size_t)b * 6144 + n);
        float4 ov = {xv.x + g.x * acc[i][j][0], xv.y + g.y * acc[i][j][1], xv.z + g.z * acc[i][j][2], xv.w + g.w * acc[i][j][3]};
        ss += ov.x * ov.x + ov.y * ov.y + ov.z * ov.z + ov.w * ov.w;
        *(float4*)(xout + (size_t)t * 1024 + n) = ov;
      }
      ss += __shfl_xor(ss, 16); ss += __shfl_xor(ss, 32);
      if (fq == 0) rowss[(size_t)t * 16 + nt * 2 + wn] = ss;
    }
  });
}

DI void item_p5(const P& p, unsigned char* smem, int l, int item) {
  const int tid = otid(), w = tid >> 6, lane = tid & 63, fr = lane & 15, fq = lane >> 4;
  const int tf = w >> 1, kh = w & 1;
  const int tb = item * 32 + tf * 16;
  const int t = tb + fr, b = (item * 32) >> 11;
  const float* xr = p.out + (size_t)t * 1024 + kh * 512 + fq * 8;
  float* mds = (float*)(smem + 32768);
  __syncthreads();
  {
    const float* md = p.mod() + ((size_t)l * 8 + b) * 6144 + 3072;
    for (int i = tid; i < 512; i += NTHREADS) *(float4*)(mds + i * 4) = *(const float4*)(md + i * 4);
  }
  float rstd;
  {
    const float4* rp = (const float4*)(p.rowss() + (size_t)t * 16);
    const float4 a = rp[0], c = rp[1], d = rp[2], e = rp[3];
    const float ss = ((a.x + a.y) + (a.z + a.w)) + ((c.x + c.y) + (c.z + c.w)) + ((d.x + d.y) + (d.z + d.w)) + ((e.x + e.y) + (e.z + e.w));
    rstd = rsqrtf(ss * (1.f / 1024.f) + EPS);
  }
  const bf16_t* whi = p.wr_hi() + (size_t)l * 65536 + (size_t)fr * 1024 + kh * 512 + fq * 8;
  bf16_t* hdst = p.h() + (size_t)t * 1024 + kh * 512 + fq * 8;
  f32x4 acc[4];
#pragma unroll
  for (int nf = 0; nf < 4; ++nf) acc[nf] = (f32x4){0.f, 0.f, 0.f, 0.f};
  bf16x8 w0[4], w1[4], w2[4]; f32x4 xa0, xb0, xa1, xb1, xa2, xb2;
#pragma unroll
  for (int nf = 0; nf < 4; ++nf) { w0[nf] = *(const bf16x8*)(whi + (size_t)nf * 16384); w1[nf] = *(const bf16x8*)(whi + (size_t)nf * 16384 + 32); }
  xa0 = *(const f32x4*)(xr); xb0 = *(const f32x4*)(xr + 4); xa1 = *(const f32x4*)(xr + 32); xb1 = *(const f32x4*)(xr + 36);
  __syncthreads();
#define P5_LOAD(W, XA, XB, ks_) do { const int kn_ = (ks_) < 16 ? (ks_) : 15; _Pragma("unroll") for (int nf = 0; nf < 4; ++nf) W[nf] = *(const bf16x8*)(whi + (size_t)nf * 16384 + kn_ * 32); \
    XA = *(const f32x4*)(xr + kn_ * 32); XB = *(const f32x4*)(xr + kn_ * 32 + 4); } while (0)
#define P5_STEP(W, XA, XB, ks_) do { const int k0 = kh * 512 + (ks_) * 32 + fq * 8; \
    const f32x4 ha = *(const f32x4*)(mds + k0), hb = *(const f32x4*)(mds + k0 + 4), sa = *(const f32x4*)(mds + 1024 + k0), sb = *(const f32x4*)(mds + 1024 + k0 + 4); \
    const f32x4 va = XA * rstd * (sa + 1.f) + ha, vb = XB * rstd * (sb + 1.f) + hb; \
    u32x4 uh, ul; uh.x = pack2(va[0], va[1]); uh.y = pack2(va[2], va[3]); uh.z = pack2(vb[0], vb[1]); uh.w = pack2(vb[2], vb[3]); \
    ul.x = pack2(va[0] - bflo(uh.x), va[1] - bfhi(uh.x)); ul.y = pack2(va[2] - bflo(uh.y), va[3] - bfhi(uh.y)); \
    ul.z = pack2(vb[0] - bflo(uh.z), vb[1] - bfhi(uh.z)); ul.w = pack2(vb[2] - bflo(uh.w), vb[3] - bfhi(uh.w)); \
    *(u32x4*)(hdst + (ks_) * 32) = uh; \
    const bf16x8 bh = __builtin_bit_cast(bf16x8, uh), bl = __builtin_bit_cast(bf16x8, ul); \
    _Pragma("unroll") for (int nf = 0; nf < 4; ++nf) { acc[nf] = __builtin_amdgcn_mfma_f32_16x16x32_bf16(W[nf], bh, acc[nf], 0, 0, 0); acc[nf] = __builtin_amdgcn_mfma_f32_16x16x32_bf16(W[nf], bl, acc[nf], 0, 0, 0); } } while (0)
#pragma unroll 1
  for (int ks = 0; ks < 15; ks += 3) {
    P5_LOAD(w2, xa2, xb2, ks + 2); P5_STEP(w0, xa0, xb0, ks);
    P5_LOAD(w0, xa0, xb0, ks + 3); P5_STEP(w1, xa1, xb1, ks + 1);
    P5_LOAD(w1, xa1, xb1, ks + 4); P5_STEP(w2, xa2, xb2, ks + 2);
  }
  P5_STEP(w0, xa0, xb0, 15);
#undef P5_LOAD
#undef P5_STEP
  float* red = (float*)smem;
  int* info = (int*)(smem + 16384) + w * 512;
  int* cntw = (int*)(smem + 24576);
#pragma unroll
  for (int nf = 0; nf < 4; ++nf) *(f32x4*)(red + w * 1024 + fr * 64 + nf * 16 + fq * 4) = acc[nf];
  __syncthreads();
  const float bias = p.router_bias[l * 64 + lane];
  int cnt_local = 0;
  const int tq0 = kh * 8;
#pragma unroll 1
  for (int q = 0; q < 8; ++q) {
    const float lgt = red[(tf * 2) * 1024 + (tq0 + q) * 64 + lane] + red[(tf * 2 + 1) * 1024 + (tq0 + q) * 64 + lane];
    const float s = 1.f / (1.f + __expf(-lgt));
    const float sel = s + bias;
    float m1 = sel; m1 = fmaxf(m1, __shfl_xor(m1, 1)); m1 = fmaxf(m1, __shfl_xor(m1, 2)); m1 = fmaxf(m1, __shfl_xor(m1, 4));
    const unsigned long long eq = __ballot(sel == m1);
    const int gbase = lane & ~7;
    const unsigned gm = (unsigned)((eq >> gbase) & 0xffull);
    const int first = gbase + __ffs(gm) - 1;
    float m2 = (lane == first) ? -INFINITY : sel;
    m2 = fmaxf(m2, __shfl_xor(m2, 1)); m2 = fmaxf(m2, __shfl_xor(m2, 2)); m2 = fmaxf(m2, __shfl_xor(m2, 4));
    const float gs = m1 + m2;
    const int myg = lane >> 3; int rank = 0;
#pragma unroll
    for (int j = 0; j < 8; ++j) { const float gj = __int_as_float(__builtin_amdgcn_readlane(__float_as_int(gs), j * 8)); rank += ((gj > gs) || (gj == gs && j < myg)) ? 1 : 0; }
    const bool gsel = rank < 4;
    const unsigned sb = (unsigned)__float_as_int(sel);
    const unsigned okey = (sb & 0x80000000u) ? ~sb : (sb | 0x80000000u);
    const unsigned key = gsel ? ((okey & ~63u) | (unsigned)(63 - lane)) : 0u;
    int r = 0;
#pragma unroll
    for (int j = 0; j < 64; ++j) { const unsigned kj = (unsigned)__builtin_amdgcn_readlane((int)key, j); r += (kj > key) ? 1 : 0; }
    const bool ch = gsel && (r < 8);
    const float tot = wsum(ch ? s : 0.f);
    const unsigned long long cm = __ballot(ch);
    const int kidx = __popcll(cm & ((1ull << lane) - 1ull));
    info[q * 64 + lane] = ch ? kidx : -1;
    if (ch) p.topw()[(size_t)(tb + tq0 + q) * 8 + kidx] = s / tot * 2.5f;
    cnt_local += ch ? 1 : 0;
  }
  cntw[w * 64 + lane] = cnt_local;
  __syncthreads();
  if (w == 0) {
    const int tot = cntw[lane] + cntw[64 + lane] + cntw[128 + lane] + cntw[192 + lane];
    int bs = 0;
    if (tot > 0) bs = atomicAdd(p.cnt() + (l * 64 + lane) * CSTRIDE, tot);
    cntw[256 + lane] = bs;
  }
  __syncthreads();
  int base = cntw[256 + lane];
#pragma unroll
  for (int ww = 0; ww < 3; ++ww) base += (ww < w) ? cntw[ww * 64 + lane] : 0;
#pragma unroll 1
  for (int q = 0; q < 8; ++q) {
    const int k = info[q * 64 + lane];
    if (k >= 0) { p.list()[(size_t)lane * LISTCAP + base] = (tb + tq0 + q) * 8 + k; ++base; }
  }
}

DI void moe_table(const P& p, unsigned char* smem, int l) {
  int* start = (int*)(smem + SMEM_MAIN);
  __syncthreads();
  if (otid() == 0) {
    int s = 0;
    for (int e = 0; e < 64; ++e) { start[e] = s; s += (p.cnt()[(l * 64 + e) * CSTRIDE] + 127) >> 7; }
    start[64] = s;
  }
  __syncthreads();
}
DI void moe_rows(const P& p, unsigned char* smem, int l, int mt, int& e_out) {
  const int* start = (const int*)(smem + SMEM_MAIN);
  int* rowinfo = (int*)(smem + SMEM_MAIN + 512);
  const int tid = otid();
  int e;
  if (mt >= start[64]) { e = 64; if (tid < 128) rowinfo[tid] = T_ * 8 + (mt - start[64]) * 128 + tid; }
  else {
    e = 0;
    for (int q = 1; q < 64; ++q) e = (start[q] <= mt) ? q : e;
    const int tl = mt - start[e];
    const int cnt = p.cnt()[(l * 64 + e) * CSTRIDE];
    if (tid < 128) { const int idx = tl * 128 + tid; rowinfo[tid] = idx < cnt ? p.list()[(size_t)e * LISTCAP + idx] : -1; }
  }
  e_out = e;
}

DI void item_p7(const P& p, unsigned char* smem, int l, int item) {
  const int mt = item >> 2, nt = item & 3;
  const int tid = otid(), r_s = tid >> 3, c_s = tid & 7;
  int* rowinfo = (int*)(smem + SMEM_MAIN + 512);
  __syncthreads();
  int e; moe_rows(p, smem, l, mt, e);
  __syncthreads();
  const bf16_t* wbase = (e == 64) ? p.wsg_t() : p.wgu_t() + (size_t)e * 512 * 1024;
  unsigned ao[4], bo[4];
#pragma unroll
  for (int j = 0; j < 4; ++j) {
    const int row = r_s + 32 * j;
    const int slot = rowinfo[row];
    const int tok = slot < 0 ? 0 : (slot >= T_ * 8 ? slot - T_ * 8 : slot >> 3);
    ao[j] = (unsigned)((tok * 1024 + c_s * 8) * 2);
    bo[j] = (unsigned)(((nt * 128 + row) * 1024 + c_s * 8) * 2);
  }
  bf16_t* act = p.act();
  gemm128(smem, (const unsigned char*)p.h(), ao, (const unsigned char*)wbase, bo, 16, [=](f32x4 (&acc)[4][4], int wm, int wn, int fr, int fq) {
    unsigned char* ob = smem + wm * 8192;
#pragma unroll
    for (int i = 0; i < 4; ++i) {
#pragma unroll
      for (int jj = 0; jj < 2; ++jj) {
        const f32x4 g = acc[i][2 * jj], u = acc[i][2 * jj + 1];
        u32x2 o; o.x = pack2(silu_f(g[0]) * u[0], silu_f(g[1]) * u[1]); o.y = pack2(silu_f(g[2]) * u[2], silu_f(g[3]) * u[3]);
        ot_put<128>(ob, i * 16 + fr, wn * 8 + jj * 4 + fq, o);
      }
    }
    __syncthreads();
    {
      const int tid2 = fq * 16 + fr + 64 * (wm * 2 + wn);
      const int chunk = tid2 & 7;
#pragma unroll
      for (int i = 0; i < 4; ++i) {
        const int row = (tid2 >> 3) + 32 * i;
        const int slot = rowinfo[row];
        if (slot >= 0) {
          const u32x4 v = ot_get<128>(smem + (row >> 6) * 8192, row & 63, chunk);
          *(u32x4*)(act + (size_t)slot * 256 + nt * 64 + chunk * 8) = v;
        }
      }
    }
  });
}

DI void item_p8(const P& p, unsigned char* smem, int l, int item) {
  const int mt = item >> 1, nh = item & 1;
  const int tid = otid(), r_s = tid >> 3, c_s = tid & 7;
  int* rowinfo = (int*)(smem + SMEM_MAIN + 512);
  __syncthreads();
  int e; moe_rows(p, smem, l, mt, e);
  __syncthreads();
  const bf16_t* wbase = (e == 64) ? p.wsd_t() : p.wd_t() + (size_t)e * 1024 * 256;
  unsigned ao[4], bo[4];
#pragma unroll
  for (int j = 0; j < 4; ++j) {
    const int row = r_s + 32 * j;
    const int slot = rowinfo[row];
    ao[j] = (unsigned)(((slot < 0 ? 0 : slot) * 256 + c_s * 8) * 2);
    bo[j] = (unsigned)(((nh * 512 + row) * 256 + c_s * 8) * 2);
  }
  bf16_t* yrows = p.yrows(); bf16_t* ysh = p.ysh(); const float* topw = p.topw();
  gemm128_stream(smem, (const unsigned char*)p.act(), ao, (const unsigned char*)wbase, bo, 4, 4, (size_t)128 * 256, [=](f32x4 (&acc)[4][4], int tile, int cur, int wm, int wn, int fr, int fq) {
    const int nt = nh * 4 + tile;
    unsigned char* ob = smem + cur + (wm ? 32768 : 0);
    __syncthreads();
#pragma unroll
    for (int i = 0; i < 4; ++i) {
      const int slot = rowinfo[wm * 64 + i * 16 + fr];
      const float wv = (slot < 0 || slot >= T_ * 8) ? 1.f : topw[slot];
#pragma unroll
      for (int j = 0; j < 4; ++j) {
        const f32x4 x = acc[i][j] * wv;
        u32x2 o; o.x = pack2(x[0], x[1]); o.y = pack2(x[2], x[3]);
        ot_put<256>(ob, i * 16 + fr, wn * 16 + j * 4 + fq, o);
      }
    }
    __syncthreads();
    {
      const int tid2 = fq * 16 + fr + 64 * (wm * 2 + wn);
      const int chunk = tid2 & 15;
#pragma unroll
      for (int i = 0; i < 8; ++i) {
        const int row = (tid2 >> 4) + 16 * i;
        const int slot = rowinfo[row];
        if (slot >= 0) {
          const u32x4 v = ot_get<256>(smem + cur + ((row >> 6) ? 32768 : 0), row & 63, chunk);
          bf16_t* dst = (slot >= T_ * 8) ? ysh + (size_t)(slot - T_ * 8) * 1024 : yrows + (size_t)slot * 1024;
          *(u32x4*)(dst + nt * 128 + chunk * 8) = v;
        }
      }
    }
  });
}

struct P9Regs { u32x4 yk[8]; u32x4 ysh0, ysh1; };
DI void p9_load(const P& p, int t, int c0, P9Regs& R) {
  const unsigned char* yr = (const unsigned char*)p.yrows() + (size_t)t * 8 * 1024 + c0;
#pragma unroll
  for (int k = 0; k < 8; ++k) R.yk[k] = *(const u32x4*)(yr + k * 1024);
  R.ysh0 = *(const u32x4*)(p.ysh() + (size_t)t * 1024 + c0); R.ysh1 = *(const u32x4*)(p.ysh() + (size_t)t * 1024 + c0 + 8);
}
DI void p9_finish(const P& p, int l, int t, int c0, const P9Regs& R) {
  const int b = t >> 11;
  const float* md = p.mod() + ((size_t)l * 8 + b) * 6144;
  f32x4 xv[4];
#pragma unroll
  for (int q = 0; q < 4; ++q) xv[q] = *(const f32x4*)(p.out + (size_t)t * 1024 + c0 + q * 4);
  float a[16];
  a[0] = bflo(R.ysh0.x); a[1] = bfhi(R.ysh0.x); a[2] = bflo(R.ysh0.y); a[3] = bfhi(R.ysh0.y); a[4] = bflo(R.ysh0.z); a[5] = bfhi(R.ysh0.z); a[6] = bflo(R.ysh0.w); a[7] = bfhi(R.ysh0.w);
  a[8] = bflo(R.ysh1.x); a[9] = bfhi(R.ysh1.x); a[10] = bflo(R.ysh1.y); a[11] = bfhi(R.ysh1.y); a[12] = bflo(R.ysh1.z); a[13] = bfhi(R.ysh1.z); a[14] = bflo(R.ysh1.w); a[15] = bfhi(R.ysh1.w);
  float r[16];
#pragma unroll
  for (int e = 0; e < 16; ++e) r[e] = 0.f;
#pragma unroll
  for (int k = 0; k < 8; ++k) {
#pragma unroll
    for (int q = 0; q < 4; ++q) {
      const f32x2 lo = __builtin_amdgcn_cvt_pk_f32_fp8((int)R.yk[k][q], false), hi = __builtin_amdgcn_cvt_pk_f32_fp8((int)R.yk[k][q], true);
      r[q * 4 + 0] += lo.x; r[q * 4 + 1] += lo.y; r[q * 4 + 2] += hi.x; r[q * 4 + 3] += hi.y;
    }
  }
  float v[16]; float ss = 0.f;
#pragma unroll
  for (int q = 0; q < 4; ++q) {
    const f32x4 g = *(const f32x4*)(md + 5120 + c0 + q * 4);
#pragma unroll
    for (int e = 0; e < 4; ++e) { v[q * 4 + e] = xv[q][e] + g[e] * (a[q * 4 + e] + r[q * 4 + e] * (1.f / YSCALE)); ss += v[q * 4 + e] * v[q * 4 + e]; }
  }
  ss = wsum(ss);
  const float rstd = rsqrtf(ss * (1.f / 1024.f) + EPS);
  if (l == 0) {
    const float* md1 = p.mod() + ((size_t)8 + b) * 6144;
    unsigned hw[8];
#pragma unroll
    for (int q = 0; q < 4; ++q) {
      *(f32x4*)(p.out + (size_t)t * 1024 + c0 + q * 4) = (f32x4){v[q * 4 + 0], v[q * 4 + 1], v[q * 4 + 2], v[q * 4 + 3]};
      const f32x4 sh = *(const f32x4*)(md1 + c0 + q * 4), sc = *(const f32x4*)(md1 + 1024 + c0 + q * 4);
      hw[q * 2 + 0] = pack2(v[q * 4 + 0] * rstd * (1.f + sc[0]) + sh[0], v[q * 4 + 1] * rstd * (1.f + sc[1]) + sh[1]);
      hw[q * 2 + 1] = pack2(v[q * 4 + 2] * rstd * (1.f + sc[2]) + sh[2], v[q * 4 + 3] * rstd * (1.f + sc[3]) + sh[3]);
    }
    *(u32x4*)(p.h() + (size_t)t * 1024 + c0) = (u32x4){hw[0], hw[1], hw[2], hw[3]};
    *(u32x4*)(p.h() + (size_t)t * 1024 + c0 + 8) = (u32x4){hw[4], hw[5], hw[6], hw[7]};
  } else {
#pragma unroll
    for (int q = 0; q < 4; ++q) {
      const f32x4 fg = *(const f32x4*)(p.final_gain + c0 + q * 4);
      *(f32x4*)(p.out + (size_t)t * 1024 + c0 + q * 4) = (f32x4){v[q * 4 + 0] * rstd * fg[0], v[q * 4 + 1] * rstd * fg[1], v[q * 4 + 2] * rstd * fg[2], v[q * 4 + 3] * rstd * fg[3]};
    }
  }
}
DI void p9_loop(const P& p, int l, int gw, int nw) {
  const int lane = otid() & 63, c0 = lane * 16;
  P9Regs A, B;
  int t = gw;
  if (t >= T_) return;
  p9_load(p, t, c0, A);
  for (; t < T_; t += 2 * nw) {
    const int t1 = t + nw;
    p9_load(p, t1 < T_ ? t1 : t, c0, B);
    p9_finish(p, l, t, c0, A);
    if (t1 >= T_) break;
    const int t2 = t1 + nw;
    p9_load(p, t2 < T_ ? t2 : t1, c0, A);
    p9_finish(p, l, t1, c0, B);
  }
}

DI int xcd_vb(int bid, int G) { return ((G & 7) == 0) ? (bid & 7) * (G >> 3) + (bid >> 3) : bid; }

DI void phase_p1(const P& p, LAS unsigned char* lds, int G, int bid) {
  t8::DenseSched S; S.init(T_, 1280, 1024, G, bid, p.win_t());
  t8::DenseRows RO{2048u};
  bf16_t* proj = p.proj(); float* rsq = p.rsq();
  t8::gemm_phase<true>(lds, (const unsigned char*)p.h(), 1024, S, RO, [=](const f32x4 (&acc)[2][2][4][2], const t8::Unit& u, int wr, int wc, int fr, int fq) {
    const int c0 = u.pn * 256 + wc * 64 + fq * 16;
    const bool want_ss = (u.pn == 3) || (u.pn == 4 && wc < 2);
#pragma unroll
    for (int ai = 0; ai < 2; ++ai)
#pragma unroll
      for (int m = 0; m < 4; ++m) {
        const int r = u.pm * 256 + ai * 128 + wr * 64 + m * 16 + fr;
        if (want_ss) {
          float ss = 0.f;
#pragma unroll
          for (int bj = 0; bj < 2; ++bj)
#pragma unroll
            for (int n = 0; n < 2; ++n) { const f32x4 a = acc[ai][bj][m][n]; ss += a[0] * a[0] + a[1] * a[1] + a[2] * a[2] + a[3] * a[3]; }
          ss += __shfl_xor(ss, 16); ss += __shfl_xor(ss, 32);
          if (fq == 0) rsq[(size_t)r * 8 + (u.pn == 3 ? wc : 4 + wc)] = ss;
        }
        if (c0 < NIN) {
#pragma unroll
          for (int bj = 0; bj < 2; ++bj) {
            const f32x4 v0 = acc[ai][bj][m][0], v1 = acc[ai][bj][m][1];
            u32x4 o; o.x = pack2(v0[0], v0[1]); o.y = pack2(v0[2], v0[3]); o.z = pack2(v1[0], v1[1]); o.w = pack2(v1[2], v1[3]);
            *(u32x4*)(proj + (size_t)r * NIN + c0 + bj * 8) = o;
          }
        }
        asm volatile("" ::: "memory");
      }
  });
}

DI void phase_p4(const P& p, LAS unsigned char* lds, int l, int G, int bid) {
  t8::DenseSched S; S.init(T_, 1024, 1024, G, bid, p.wout_t());
  t8::DenseRows RO{2048u};
  const float* xin = (l == 0) ? p.x : p.out; float* xout = p.out;
  const float* mod = p.mod() + (size_t)l * 8 * 6144 + 2048;
  float* rowss = p.rowss();
  t8::gemm_phase<true>(lds, (const unsigned char*)p.Y(), 1024, S, RO, [=](const f32x4 (&acc)[2][2][4][2], const t8::Unit& u, int wr, int wc, int fr, int fq) {
    float4 xq[2][4];
    const int cbase = u.pn * 256 + wc * 64 + fq * 16;
    float4 gq[4];
#pragma unroll
    for (int q = 0; q < 4; ++q) gq[q] = *(const float4*)(mod + (size_t)((u.pm * 256) >> 11) * 6144 + cbase + q * 4);
    {
      const int r0 = u.pm * 256 + wr * 64 + fr;
#pragma unroll
      for (int q = 0; q < 4; ++q) xq[0][q] = *(const float4*)(xin + (size_t)r0 * 1024 + cbase + q * 4);
    }
#pragma unroll
    for (int ai = 0; ai < 2; ++ai)
#pragma unroll
      for (int m = 0; m < 4; ++m) {
        const int it = ai * 4 + m;
        const int r = u.pm * 256 + ai * 128 + wr * 64 + m * 16 + fr, b = r >> 11;
        if (it < 7) {
          const int rn = u.pm * 256 + ((it + 1) >> 2) * 128 + wr * 64 + ((it + 1) & 3) * 16 + fr;
#pragma unroll
          for (int q = 0; q < 4; ++q) xq[(it + 1) & 1][q] = *(const float4*)(xin + (size_t)rn * 1024 + cbase + q * 4);
        }
        float ss = 0.f;
#pragma unroll
        for (int bj = 0; bj < 2; ++bj)
#pragma unroll
          for (int n = 0; n < 2; ++n) {
            const int c0 = cbase + bj * 8 + n * 4;
            const float4 xv = xq[it & 1][bj * 2 + n];
            const float4 g = gq[bj * 2 + n];
            const f32x4 a = acc[ai][bj][m][n];
            float4 ov = {xv.x + g.x * a[0], xv.y + g.y * a[1], xv.z + g.z * a[2], xv.w + g.w * a[3]};
            ss += ov.x * ov.x + ov.y * ov.y + ov.z * ov.z + ov.w * ov.w;
            *(float4*)(xout + (size_t)r * 1024 + c0) = ov;
          }
        ss += __shfl_xor(ss, 16); ss += __shfl_xor(ss, 32);
        if (fq == 0) rowss[(size_t)r * 16 + u.pn * 4 + wc] = ss;
      }
  });
}

struct RowsP7 { LAS const int* tab; DI unsigned operator()(const t8::Unit& u, int row) const { const int slot = tab[u.tab * 256 + row]; const int tok = slot < 0 ? 0 : (slot >= T_ * 8 ? slot - T_ * 8 : slot >> 3); return (unsigned)tok * 2048u; } };
struct RowsP8 { LAS const int* tab; DI unsigned operator()(const t8::Unit& u, int row) const { const int slot = tab[u.tab * 256 + row]; return (unsigned)(slot < 0 ? 0 : slot) * 512u; } };

DI void phase_p7(const P& p, LAS unsigned char* lds, int l, int G, int bid) {
  int total; const int c = xcd_vb(bid, G);
  moe_prepare(p, lds, l, 2, G, c, total);
  t8::MoeSched S{(LAS const int*)(lds + t8::START_OFF), 2, total, G, c, (const unsigned char*)p.wgu_t(), (const unsigned char*)p.wsg_t(), (size_t)512 * 1024 * 2, (size_t)256 * 1024 * 2};
  RowsP7 RO{(LAS const int*)(lds + t8::TAB_OFF)};
  LAS const int* tab = (LAS const int*)(lds + t8::TAB_OFF);
  bf16_t* act = p.act();
  t8::gemm_phase<true>(lds, (const unsigned char*)p.h(), 1024, S, RO, [=](const f32x4 (&acc)[2][2][4][2], const t8::Unit& u, int wr, int wc, int fr, int fq) {
#pragma unroll
    for (int ai = 0; ai < 2; ++ai)
#pragma unroll
      for (int m = 0; m < 4; ++m) {
        const int slot = tab[u.tab * 256 + ai * 128 + wr * 64 + m * 16 + fr];
        if (slot >= 0) {
          const f32x4 g0 = acc[ai][0][m][0], g1 = acc[ai][0][m][1], u0 = acc[ai][1][m][0], u1 = acc[ai][1][m][1];
          u32x4 o;
          o.x = pack2(silu_f(g0[0]) * u0[0], silu_f(g0[1]) * u0[1]); o.y = pack2(silu_f(g0[2]) * u0[2], silu_f(g0[3]) * u0[3]);
          o.z = pack2(silu_f(g1[0]) * u1[0], silu_f(g1[1]) * u1[1]); o.w = pack2(silu_f(g1[2]) * u1[2], silu_f(g1[3]) * u1[3]);
          *(u32x4*)(act + (size_t)slot * 256 + u.pn * 128 + wc * 32 + fq * 8) = o;
        }
        asm volatile("" ::: "memory");
      }
  });
}

DI void phase_p8(const P& p, LAS unsigned char* lds, int l, int G, int bid) {
  int total; const int c = xcd_vb(bid, G);
  moe_prepare(p, lds, l, 4, G, c, total, true);
  t8::MoeSched S{(LAS const int*)(lds + t8::START_OFF), 4, total, G, c, (const unsigned char*)p.wd_t(), (const unsigned char*)p.wsd_t(), (size_t)1024 * 256 * 2, (size_t)256 * 256 * 2};
  RowsP8 RO{(LAS const int*)(lds + t8::TAB_OFF)};
  LAS const int* tab = (LAS const int*)(lds + t8::TAB_OFF);
  unsigned char* yrows = (unsigned char*)p.yrows(); bf16_t* ysh = p.ysh(); const float* topw = p.topw();
  t8::gemm_phase<true>(lds, (const unsigned char*)p.act(), 256, S, RO, [=](const f32x4 (&acc)[2][2][4][2], const t8::Unit& u, int wr, int wc, int fr, int fq) {
    int slots[2][4]; float wvs[2][4];
#pragma unroll
    for (int ai = 0; ai < 2; ++ai)
#pragma unroll
      for (int m = 0; m < 4; ++m) slots[ai][m] = tab[u.tab * 256 + ai * 128 + wr * 64 + m * 16 + fr];
#pragma unroll
    for (int ai = 0; ai < 2; ++ai)
#pragma unroll
      for (int m = 0; m < 4; ++m) wvs[ai][m] = ((LAS const float*)tab)[(6 + u.tab) * 256 + ai * 128 + wr * 64 + m * 16 + fr];
    const int c0 = u.pn * 256 + wc * 64 + fq * 16;
#pragma unroll
    for (int ai = 0; ai < 2; ++ai)
#pragma unroll
      for (int m = 0; m < 4; ++m) {
        const int slot = slots[ai][m];
        if (slot >= 0) {
          const float wv = wvs[ai][m];
          if (slot >= T_ * 8) {
            bf16_t* dst = ysh + (size_t)(slot - T_ * 8) * 1024 + c0;
#pragma unroll
            for (int bj = 0; bj < 2; ++bj) {
              const f32x4 v0 = acc[ai][bj][m][0], v1 = acc[ai][bj][m][1];
              u32x4 o; o.x = pack2(v0[0], v0[1]); o.y = pack2(v0[2], v0[3]); o.z = pack2(v1[0], v1[1]); o.w = pack2(v1[2], v1[3]);
              *(u32x4*)(dst + bj * 8) = o;
            }
          } else {
            u32x4 o;
            o.x = pack4_fp8(acc[ai][0][m][0] * wv); o.y = pack4_fp8(acc[ai][0][m][1] * wv); o.z = pack4_fp8(acc[ai][1][m][0] * wv); o.w = pack4_fp8(acc[ai][1][m][1] * wv);
            *(u32x4*)(yrows + (size_t)slot * 1024 + c0) = o;
          }
        }
        asm volatile("" ::: "memory");
      }
  });
}


DI void phase_kvproj(const P& p, LAS unsigned char* lds, int G, int bid) {
  t8::DenseSched S; S.init(T_, 1024, 256, G, bid, p.wukv_t());
  t8::DenseRows RO{(unsigned)(NIN * 2)};
  bf16_t* Kb = p.Kb(); bf16_t* V = p.V(); const float* rsq = p.rsq();
  t8::gemm_phase<true>(lds, (const unsigned char*)(p.proj() + 1024), 256, S, RO, [=](const f32x4 (&acc)[2][2][4][2], const t8::Unit& u, int wr, int wc, int fr, int fq) {
    const int head = u.pn * 2 + (wc >> 1), d0 = (wc & 1) * 64 + fq * 16;
    f32x2 rq[2][4];
#pragma unroll
    for (int ai = 0; ai < 2; ++ai)
#pragma unroll
      for (int m = 0; m < 4; ++m) rq[ai][m] = *(const f32x2*)(rsq + (size_t)(u.pm * 256 + ai * 128 + wr * 64 + m * 16 + fr) * 8 + 4);
#pragma unroll
    for (int ai = 0; ai < 2; ++ai)
#pragma unroll
      for (int m = 0; m < 4; ++m) {
        const int t = u.pm * 256 + ai * 128 + wr * 64 + m * 16 + fr, b = t >> 11, sq = t & 2047;
        const float rs = rsqrtf((rq[ai][m][0] + rq[ai][m][1]) * (1.f / 128.f) + EPS);
        const size_t rowi = (size_t)((b * 8 + head) * 2048 + sq);
        bf16_t* dst = (d0 < 64) ? Kb + rowi * 96 + d0 : V + rowi * 64 + (d0 - 64);
#pragma unroll
        for (int bj = 0; bj < 2; ++bj) {
          const f32x4 v0 = acc[ai][bj][m][0] * rs, v1 = acc[ai][bj][m][1] * rs;
          u32x4 o; o.x = pack2(v0[0], v0[1]); o.y = pack2(v0[2], v0[3]); o.z = pack2(v1[0], v1[1]); o.w = pack2(v1[2], v1[3]);
          *(u32x4*)(dst + bj * 8) = o;
        }
        asm volatile("" ::: "memory");
      }
  });
}
DI void phase_qproj(const P& p, LAS unsigned char* lds, int G, int bid) {
  t8::DenseSched S; S.init(T_, 768, 256, G, bid, p.wuq_t());
  t8::DenseRows RO{(unsigned)(NIN * 2)};
  bf16_t* Q = p.Q(); const float* rsq = p.rsq(); const float* ropec = p.ropec(); const float* ropes = p.ropes();
  const float QS = 0.10206207261596577f * 1.4426950408889634f;
  t8::gemm_phase<false>(lds, (const unsigned char*)(p.proj() + 768), 256, S, RO, [=](const f32x4 (&acc)[2][2][4][2], const t8::Unit& u, int wr, int wc, int fr, int fq) {
    f32x4 pqs[2][4];
#pragma unroll
    for (int ai = 0; ai < 2; ++ai)
#pragma unroll
      for (int m = 0; m < 4; ++m) pqs[ai][m] = *(const f32x4*)(rsq + (size_t)(u.pm * 256 + ai * 128 + wr * 64 + m * 16 + fr) * 8);
    f32x4 csq[2], snq[2];
    { const int t0 = u.pm * 256 + wr * 64 + fr; csq[0] = *(const f32x4*)(ropec + (size_t)t0 * 16 + fq * 4); snq[0] = *(const f32x4*)(ropes + (size_t)t0 * 16 + fq * 4); }
#pragma unroll
    for (int ai = 0; ai < 2; ++ai)
#pragma unroll
      for (int m = 0; m < 4; ++m) {
        const int it = ai * 4 + m;
        const int t = u.pm * 256 + ai * 128 + wr * 64 + m * 16 + fr, b = t >> 11, sq = t & 2047;
        if (it < 7) { const int tn = u.pm * 256 + ((it + 1) >> 2) * 128 + wr * 64 + ((it + 1) & 3) * 16 + fr;
          csq[(it + 1) & 1] = *(const f32x4*)(ropec + (size_t)tn * 16 + fq * 4); snq[(it + 1) & 1] = *(const f32x4*)(ropes + (size_t)tn * 16 + fq * 4); }
        const f32x4 pq = pqs[ai][m];
        const float rs = rsqrtf(((pq[0] + pq[1]) + (pq[2] + pq[3])) * (1.f / 256.f) + EPS) * QS;
#pragma unroll
        for (int bj = 0; bj < 2; ++bj) {
          const int cg = u.pn * 256 + bj * 128 + wc * 32;
          const int head = cg / 96, d0 = cg - head * 96;
          bf16_t* dst = Q + ((size_t)((b * 8 + head) * 2048 + sq)) * 96 + d0 + fq * 4;
          const f32x4 x1 = acc[ai][bj][m][0] * rs, x2 = acc[ai][bj][m][1] * rs;
          u32x2 o1, o2;
          if (d0 == 64) {
            const f32x4 cs = csq[it & 1], sn = snq[it & 1];
            const f32x4 y1 = x1 * cs - x2 * sn, y2 = x2 * cs + x1 * sn;
            o1.x = pack2(y1[0], y1[1]); o1.y = pack2(y1[2], y1[3]); o2.x = pack2(y2[0], y2[1]); o2.y = pack2(y2[2], y2[3]);
          } else {
            o1.x = pack2(x1[0], x1[1]); o1.y = pack2(x1[2], x1[3]); o2.x = pack2(x2[0], x2[1]); o2.y = pack2(x2[2], x2[3]);
          }
          *(u32x2*)dst = o1; *(u32x2*)(dst + 16) = o2;
        }
        asm volatile("" ::: "memory");
      }
  });
}
DI void item_kpe(const P& p, int item) {
  const int tid = otid();
  const int t = item * 128 + (tid >> 1), half = tid & 1, b = t >> 11, sq = t & 2047;
  const bf16_t* kp = p.proj() + (size_t)t * NIN + 1152 + half * 8;
  const u32x4 a1 = *(const u32x4*)kp, a2 = *(const u32x4*)(kp + 16);
  const float* cp = p.ropec() + (size_t)t * 16 + half * 8; const float* sp = p.ropes() + (size_t)t * 16 + half * 8;
  const f32x4 c0 = *(const f32x4*)cp, c1 = *(const f32x4*)(cp + 4), s0 = *(const f32x4*)sp, s1 = *(const f32x4*)(sp + 4);
  const f32x4 x1a = {bflo(a1.x), bfhi(a1.x), bflo(a1.y), bfhi(a1.y)}, x1b = {bflo(a1.z), bfhi(a1.z), bflo(a1.w), bfhi(a1.w)};
  const f32x4 x2a = {bflo(a2.x), bfhi(a2.x), bflo(a2.y), bfhi(a2.y)}, x2b = {bflo(a2.z), bfhi(a2.z), bflo(a2.w), bfhi(a2.w)};
  const f32x4 y1a = x1a * c0 - x2a * s0, y1b = x1b * c1 - x2b * s1, y2a = x2a * c0 + x1a * s0, y2b = x2b * c1 + x1b * s1;
  u32x4 o1, o2;
  o1.x = pack2(y1a[0], y1a[1]); o1.y = pack2(y1a[2], y1a[3]); o1.z = pack2(y1b[0], y1b[1]); o1.w = pack2(y1b[2], y1b[3]);
  o2.x = pack2(y2a[0], y2a[1]); o2.y = pack2(y2a[2], y2a[3]); o2.z = pack2(y2b[0], y2b[1]); o2.w = pack2(y2b[2], y2b[3]);
#pragma unroll
  for (int head = 0; head < 8; ++head) {
    bf16_t* kd = p.Kb() + ((size_t)((b * 8 + head) * 2048 + sq)) * 96 + 64 + half * 8;
    *(u32x4*)kd = o1; *(u32x4*)(kd + 16) = o2;
  }
}

constexpr int HALF_LDS = SMEM_MAIN + SMEM_EXTRA;
#define PHASE_LOOP(n, ...) for (int base_ = 2 * bid; base_ < (n); base_ += 2 * G) { int it = base_ + half; it = it < (n) ? it : (n) - 1; __VA_ARGS__ }
__global__ void __launch_bounds__(BLOCK_THREADS, 2) fwd_megakernel(P p) {
  const __attribute__((address_space(4))) P* kp_ = (const __attribute__((address_space(4))) P*)__builtin_amdgcn_kernarg_segment_ptr();
  (void)p;
#define LP() ([&]() __attribute__((always_inline)) { const __attribute__((address_space(4))) P* q_ = kp_; asm volatile("" : "+s"(q_)); P r_; __builtin_memcpy(&r_, q_, sizeof(P)); return r_; }())

  __shared__ __attribute__((aligned(16))) unsigned char smem_all[t8::STAGE_BYTES + 16384 + 16 + 256];
  const int G = gridDim.x, bid = blockIdx.x;
  {
    LAS int* wtab = (LAS int*)(smem_all + WTAB_OFF);
    if ((threadIdx.x & 63) == 0) wtab[hw_slot()] = (int)(threadIdx.x >> 6);
    __syncthreads();
  }
  const int half = __builtin_amdgcn_readfirstlane(full_tid() >> 8);
  unsigned char* smem = smem_all + half * HALF_LDS;
  volatile LAS unsigned* stw = (volatile LAS unsigned*)(smem_all + t8::STAGE_BYTES + 16384);
  LAS unsigned char* lds8 = (LAS unsigned char*)smem_all;
  if (full_tid() == 0) { stw[0] = 0u; stw[1] = 0u; }
  __syncthreads();
  XcdBarrier bar = xcd_barrier_post(LP().bar(), stw);

  PHASE_LOOP(384 + 1024 + MISC_ITEMS + CONV_SMALL,
    if (it < 384) item_mod(LP(), smem, it);
    else if (it < 384 + 1024) item_rope(LP(), it - 384);
    else if (it < 384 + 1024 + MISC_ITEMS) item_misc(LP(), it - 384 - 1024);
    else item_conv(LP(), smem, 0, it - 384 - 1024 - MISC_ITEMS);
  )
  xcd_barrier(bar);
  PHASE_LOOP(T_ / 8, item_norm0(LP(), it);)
  xcd_barrier(bar);

  for (int l = 0; l < 2; ++l) {
    phase_p1(LP(), lds8, G, bid);
    xcd_barrier(bar);
    phase_kvproj(LP(), lds8, G, bid);
    phase_qproj(LP(), lds8, G, bid);
    __syncthreads();
    {
      const int rb = G - 1 - bid;
      for (int base_ = 2 * rb; base_ < 128 + 512 + 128; base_ += 2 * G) {
        const int it = base_ + half;
        if (it < 128) item_sgu(LP(), smem, l, it);
        else if (it < 640) item_pool(LP(), smem, l, it - 128);
        else item_kpe(LP(), it - 640);
      }
    }
    xcd_barrier(bar);
    if ((bid >> 3) & 1) { conv_big_loop(LP(), smem, l, 2 * bid + half, 2 * G); PHASE_LOOP(1024, item_attn(LP(), smem, it);) }
    else { PHASE_LOOP(1024, item_attn(LP(), smem, it);) conv_big_loop(LP(), smem, l, 2 * bid + half, 2 * G); }
    xcd_barrier(bar);
    phase_p4(LP(), lds8, l, G, bid);
    xcd_barrier(bar);
    PHASE_LOOP(512 + (l == 0 ? CONV_SMALL : 0), if (it < 512) item_p5(LP(), smem, l, it); else item_conv(LP(), smem, 1, it - 512);)
    xcd_barrier(bar);
    phase_p7(LP(), lds8, l, G, bid);
    xcd_barrier(bar);
    phase_p8(LP(), lds8, l, G, bid);
    xcd_barrier(bar);
    p9_loop(LP(), l, bid * 8 + (full_tid() >> 6), G * 8);
    if (l == 0) xcd_barrier(bar);
  }
}

extern "C" void kernel_launch(void* const* d_in, const int* in_sizes, int n_in, void* d_out, int out_size, void* d_ws, size_t ws_size,
                              hipStream_t stream) {
  P p{};
  p.x = (const float*)d_in[0]; p.c = (const float*)d_in[1]; p.pos = (const int*)d_in[2];
  p.w_ada = (const float*)d_in[3]; p.b_ada = (const float*)d_in[4]; p.w_in = (const float*)d_in[5]; p.w_pool = (const float*)d_in[6];
  p.pool_scale = (const float*)d_in[7]; p.w_spatial = (const float*)d_in[8]; p.b_spatial = (const float*)d_in[9]; p.g_q = (const float*)d_in[10];
  p.w_uq = (const float*)d_in[11]; p.g_kv = (const float*)d_in[12]; p.w_ukv = (const float*)d_in[13]; p.w_out = (const float*)d_in[14];
  p.w_router = (const float*)d_in[15]; p.router_bias = (const float*)d_in[16]; p.w_gate = (const float*)d_in[17]; p.w_up = (const float*)d_in[18];
  p.w_down = (const float*)d_in[19]; p.ws_gate = (const float*)d_in[20]; p.ws_up = (const float*)d_in[21]; p.ws_down = (const float*)d_in[22];
  p.final_gain = (const float*)d_in[23];
  p.out = (float*)d_out;
  p.ws = (unsigned char*)d_ws;
  if (WS_NEED > ws_size) { fprintf(stderr, "workspace too small: need %zu have %zu\n", WS_NEED, ws_size); return; }
  hipMemsetAsync(p.ws + O_BAR, 0, CTRL_BYTES, stream);
  static int grid_blocks = 0;
  if (!grid_blocks) {
    int dev = 0, cus = 0, per_cu = 0;
    hipGetDevice(&dev);
    hipDeviceGetAttribute(&cus, hipDeviceAttributeMultiprocessorCount, dev);
    hipOccupancyMaxActiveBlocksPerMultiprocessor(&per_cu, fwd_megakernel, BLOCK_THREADS, 0);
    if (per_cu > 1) per_cu = 1;
    if (per_cu < 1) per_cu = 1;
    grid_blocks = cus * per_cu;
  }
  void* args[] = {&p};
  hipError_t e = hipLaunchCooperativeKernel((void*)fwd_megakernel, dim3(grid_blocks), dim3(BLOCK_THREADS), args, 0, stream);
  if (e != hipSuccess) fprintf(stderr, "cooperative launch failed: %s (grid %d)\n", hipGetErrorString(e), grid_blocks);
}
```

```cpp
#include <hip/hip_runtime.h>
#include <stdint.h>
#include <cstdio>

#define DI __device__ __forceinline__
#define LAS __attribute__((address_space(3)))

typedef unsigned short bf16_t;
typedef short bf16x8 __attribute__((ext_vector_type(8)));
typedef short s16x4 __attribute__((ext_vector_type(4)));
typedef float f32x4 __attribute__((ext_vector_type(4)));
typedef float f32x2 __attribute__((ext_vector_type(2)));
typedef unsigned u32x4 __attribute__((ext_vector_type(4)));
typedef unsigned u32x2 __attribute__((ext_vector_type(2)));
typedef __bf16 bf16x2_t __attribute__((ext_vector_type(2)));

constexpr int T_ = 16384, D_ = 1024, S_ = 2048, NIN = 1184;
constexpr int NTHREADS = 256;
constexpr int BLOCK_THREADS = 512;
constexpr int SMEM_MAIN = 65536, SMEM_EXTRA = 2048;
constexpr float EPS = 1e-6f;
constexpr int CSTRIDE = 64;
constexpr int LISTCAP = 16384;
constexpr int CONV_SMALL = 592 + 24 + 16 + 128;
constexpr int CONV_BIG = 96 + 6144;
constexpr int CONV_ITEMS = CONV_SMALL + CONV_BIG;

constexpr size_t al256(size_t x) { return (x + 255) & ~(size_t)255; }
constexpr size_t CTRL_BYTES = (size_t)3456 * 4 + (size_t)2 * 64 * CSTRIDE * 4;
constexpr size_t O_BAR = 0;
constexpr size_t O_MOD = O_BAR + al256(CTRL_BYTES);
constexpr size_t O_ROPEC = O_MOD + al256((size_t)2 * 8 * 6144 * 4);
constexpr size_t O_ROPES = O_ROPEC + al256((size_t)T_ * 16 * 4);
constexpr size_t O_WIN = O_ROPES + al256((size_t)T_ * 16 * 4);
constexpr size_t O_WUQ = O_WIN + al256((size_t)1280 * 1024 * 2);
constexpr size_t O_WUKV = O_WUQ + al256((size_t)768 * 256 * 2);
constexpr size_t O_WOUT = O_WUKV + al256((size_t)1024 * 256 * 2);
constexpr size_t O_WSG = O_WOUT + al256((size_t)1024 * 1024 * 2);
constexpr size_t O_WSD = O_WSG + al256((size_t)512 * 1024 * 2);
constexpr size_t O_WSP = O_WSD + al256((size_t)1024 * 256 * 2);
constexpr size_t O_WPOOL = O_WSP + al256((size_t)2 * 4 * 128 * 128 * 2);
constexpr size_t O_WRHI = O_WPOOL + al256((size_t)2 * 4 * 64 * 64 * 2);
constexpr size_t O_WRLO = O_WRHI + al256((size_t)2 * 64 * 1024 * 2);
constexpr size_t O_WGU = O_WRLO + al256((size_t)2 * 64 * 1024 * 2);
constexpr size_t O_WD = O_WGU + al256((size_t)64 * 512 * 1024 * 2);
constexpr size_t O_H = O_WD + al256((size_t)64 * 1024 * 256 * 2);
constexpr size_t O_ACT = O_H + al256((size_t)T_ * 1024 * 2);
constexpr size_t O_YSH = O_ACT + al256((size_t)(T_ * 8 + T_) * 256 * 2);
constexpr size_t O_LIST = O_YSH + al256((size_t)T_ * 1024 * 2);
constexpr size_t O_TOPW = O_LIST + al256((size_t)64 * LISTCAP * 4);
constexpr size_t O_ROWSS = O_TOPW + al256((size_t)T_ * 8 * 4);
constexpr size_t O_RSQ = O_ROWSS + al256((size_t)T_ * 16 * 4);
constexpr size_t O_BIG = O_RSQ + al256((size_t)T_ * 8 * 4);
constexpr size_t O_YROWS = O_BIG;
constexpr size_t O_PROJ = O_BIG;
constexpr size_t O_Q = O_PROJ + al256((size_t)T_ * NIN * 2);
constexpr size_t O_KB = O_Q + al256((size_t)T_ * 8 * 96 * 2);
constexpr size_t O_V = O_KB + al256((size_t)T_ * 8 * 96 * 2);
constexpr size_t O_Y = O_V + al256((size_t)T_ * 8 * 64 * 2);
constexpr size_t WS_NEED = O_BIG + al256((size_t)T_ * 8 * 1024 * 2);

struct P {
  const float *x, *c; const int* pos;
  const float *w_ada, *b_ada, *w_in, *w_pool, *pool_scale, *w_spatial, *b_spatial, *g_q, *w_uq, *g_kv, *w_ukv, *w_out,
      *w_router, *router_bias, *w_gate, *w_up, *w_down, *ws_gate, *ws_up, *ws_down, *final_gain;
  float* out;
  unsigned char* ws;
  DI unsigned* bar() const { return (unsigned*)(ws + O_BAR); }
  DI int* cnt() const { return (int*)(ws + O_BAR) + 3456; }
  DI float* mod() const { return (float*)(ws + O_MOD); }
  DI float* ropec() const { return (float*)(ws + O_ROPEC); }
  DI float* ropes() const { return (float*)(ws + O_ROPES); }
  DI bf16_t* win_t() const { return (bf16_t*)(ws + O_WIN); }
  DI bf16_t* wuq_t() const { return (bf16_t*)(ws + O_WUQ); }
  DI bf16_t* wukv_t() const { return (bf16_t*)(ws + O_WUKV); }
  DI bf16_t* wout_t() const { return (bf16_t*)(ws + O_WOUT); }
  DI bf16_t* wsg_t() const { return (bf16_t*)(ws + O_WSG); }
  DI bf16_t* wsd_t() const { return (bf16_t*)(ws + O_WSD); }
  DI bf16_t* wsp_b() const { return (bf16_t*)(ws + O_WSP); }
  DI bf16_t* wpool_t() const { return (bf16_t*)(ws + O_WPOOL); }
  DI bf16_t* wr_hi() const { return (bf16_t*)(ws + O_WRHI); }
  DI bf16_t* wr_lo() const { return (bf16_t*)(ws + O_WRLO); }
  DI bf16_t* wgu_t() const { return (bf16_t*)(ws + O_WGU); }
  DI bf16_t* wd_t() const { return (bf16_t*)(ws + O_WD); }
  DI bf16_t* h() const { return (bf16_t*)(ws + O_H); }
  DI bf16_t* act() const { return (bf16_t*)(ws + O_ACT); }
  DI bf16_t* ysh() const { return (bf16_t*)(ws + O_YSH); }
  DI int* list() const { return (int*)(ws + O_LIST); }
  DI float* topw() const { return (float*)(ws + O_TOPW); }
  DI float* rowss() const { return (float*)(ws + O_ROWSS); }
  DI float* rsq() const { return (float*)(ws + O_RSQ); }
  DI bf16_t* yrows() const { return (bf16_t*)(ws + O_YROWS); }
  DI bf16_t* proj() const { return (bf16_t*)(ws + O_PROJ); }
  DI bf16_t* Q() const { return (bf16_t*)(ws + O_Q); }
  DI bf16_t* Kb() const { return (bf16_t*)(ws + O_KB); }
  DI bf16_t* V() const { return (bf16_t*)(ws + O_V); }
  DI bf16_t* Y() const { return (bf16_t*)(ws + O_Y); }
};

DI unsigned pack2(float lo, float hi) { f32x2 f = {lo, hi}; bf16x2_t b = __builtin_convertvector(f, bf16x2_t); return __builtin_bit_cast(unsigned, b); }
DI float bf2f(unsigned short b) { return __uint_as_float(((unsigned)b) << 16); }
DI float bflo(unsigned u) { return __uint_as_float(u << 16); }
DI float bfhi(unsigned u) { return __uint_as_float(u & 0xffff0000u); }
constexpr int WTAB_OFF = 128 * 1024 + 16384 + 16;
DI int hw_slot() { return (int)(__builtin_amdgcn_s_getreg((5 << 11) | 4) & 63u); }
DI int lane_id() { unsigned z = 0u; asm volatile("" : "+v"(z)); return (int)__builtin_amdgcn_mbcnt_hi(~0u, __builtin_amdgcn_mbcnt_lo(~0u, z)); }
DI int full_tid() {
  const int wv = __builtin_amdgcn_readfirstlane(((LAS const int*)(size_t)WTAB_OFF)[hw_slot()]);
  int t = (wv << 6) | lane_id(); asm volatile("" : "+v"(t)); return t;
}
DI int otid() { return full_tid() & 255; }

constexpr float YSCALE = 16.f;
DI unsigned pack4_fp8(f32x4 v) {
  const float a = __builtin_amdgcn_fmed3f(v[0], -448.f, 448.f), b = __builtin_amdgcn_fmed3f(v[1], -448.f, 448.f), c = __builtin_amdgcn_fmed3f(v[2], -448.f, 448.f), d = __builtin_amdgcn_fmed3f(v[3], -448.f, 448.f);
  int w = 0; w = __builtin_amdgcn_cvt_pk_fp8_f32(a, b, w, false); w = __builtin_amdgcn_cvt_pk_fp8_f32(c, d, w, true); return (unsigned)w;
}
DI float dpp_xor1(float x) { return __int_as_float(__builtin_amdgcn_update_dpp(0, __float_as_int(x), 0xB1, 0xF, 0xF, false)); }
DI float dpp_xor2(float x) { return __int_as_float(__builtin_amdgcn_update_dpp(0, __float_as_int(x), 0x4E, 0xF, 0xF, false)); }
DI float dpp_hmir(float x) { return __int_as_float(__builtin_amdgcn_update_dpp(0, __float_as_int(x), 0x141, 0xF, 0xF, false)); }
DI float dpp_mir(float x)  { return __int_as_float(__builtin_amdgcn_update_dpp(0, __float_as_int(x), 0x140, 0xF, 0xF, false)); }
DI float max8(float x) { x = fmaxf(x, dpp_xor1(x)); x = fmaxf(x, dpp_xor2(x)); return fmaxf(x, dpp_hmir(x)); }
DI float wsum(float v) {
  v += dpp_xor1(v); v += dpp_xor2(v); v += dpp_hmir(v); v += dpp_mir(v);
  auto a = __builtin_amdgcn_permlane16_swap(__float_as_uint(v), __float_as_uint(v), false, false);
  v = __uint_as_float(a[0]) + __uint_as_float(a[1]);
  auto c = __builtin_amdgcn_permlane32_swap(__float_as_uint(v), __float_as_uint(v), false, false);
  return __uint_as_float(c[0]) + __uint_as_float(c[1]);
}

DI float silu_f(float x) { return x / (1.f + __expf(-x)); }
DI float gelu_tanh(float x) { float z = 0.7978845608028654f * (x + 0.044715f * x * x * x); float e = __expf(2.f * z); float t = 1.f - 2.f / (1.f + e); return 0.5f * x * (1.f + t); }

#define XB_TMO      128
#define XB_XCNT(j)  (256  + 64 * (j))
#define XB_XSUB(j)  (1280 + 64 * (j))
#define XB_XGEN(j)  (2304 + 64 * (j))
#define XB_TOP      3328
#define XB_TOPGEN   3392
#define XCD_BAR_WORDS 3456
#define XB_SPIN_CAP (1u << 20)
DI unsigned xb_ld(unsigned* p) { return __hip_atomic_load(p, __ATOMIC_RELAXED, __HIP_MEMORY_SCOPE_AGENT); }
DI unsigned xb_add(unsigned* p, unsigned v) { return __hip_atomic_fetch_add(p, v, __ATOMIC_RELAXED, __HIP_MEMORY_SCOPE_AGENT); }
DI unsigned xb_xcc_id() { return (unsigned)__builtin_amdgcn_s_getreg((3 << 11) | 20) & 0xFu; }
#define XB_SPIN(cond, bar) do { unsigned _sp = 0; while (cond) { __builtin_amdgcn_s_sleep(1); \
    if ((++_sp & 255u) == 0u) { if (xb_ld(&(bar)[XB_TMO])) break; if (_sp > XB_SPIN_CAP) { atomicAdd(&(bar)[XB_TMO], 1u); break; } } } } while (0)
struct XcdBarrier { unsigned* bar; unsigned x; volatile LAS unsigned* st; };
DI XcdBarrier xcd_barrier_post(unsigned* bar, volatile LAS unsigned* st) {
  XcdBarrier b; b.bar = bar; b.x = xb_xcc_id(); b.st = st;
  if (full_tid() == 0) (void)xb_add(&bar[XB_XCNT(b.x)], 1u);
  return b;
}
DI void xcd_barrier_complete(unsigned* bar, unsigned x, unsigned& nloc, unsigned& nx) {
  const unsigned G = gridDim.x * gridDim.y * gridDim.z;
  unsigned sum, cnt, mine, sp = 0u;
  for (;;) {
    sum = 0u; cnt = 0u; mine = 0u;
#pragma unroll
    for (unsigned j = 0; j < 16; ++j) { const unsigned c = xb_ld(&bar[XB_XCNT(j)]); sum += c; cnt += (c > 0u) ? 1u : 0u; mine = (j == x) ? c : mine; }
    if (sum == G) break;
    __builtin_amdgcn_s_sleep(1);
    if ((++sp & 255u) == 0u) { if (xb_ld(&bar[XB_TMO])) break; if (sp > XB_SPIN_CAP) { atomicAdd(&bar[XB_TMO], 1u); break; } }
  }
  nloc = mine > 0u ? mine : 1u; nx = cnt > 0u ? cnt : 1u;
}
DI void xcd_barrier(const XcdBarrier& b0) {
  XcdBarrier b = b0; b.x = xb_xcc_id();
  asm volatile("s_waitcnt vmcnt(0)" ::: "memory");
  __syncthreads();
  if (full_tid() == 0) {
    unsigned* bar = b.bar;
    __builtin_amdgcn_s_waitcnt(0);
    unsigned nloc = b.st[0], nx = b.st[1];
    if (nloc == 0u) { xcd_barrier_complete(bar, b.x, nloc, nx); b.st[0] = nloc; b.st[1] = nx; }
    const unsigned old = xb_add(&bar[XB_XSUB(b.x)], 1u);
    const unsigned gen = old / nloc;
    if (old + 1u == (gen + 1u) * nloc) {
      __builtin_amdgcn_fence(__ATOMIC_RELEASE, "agent");
      asm volatile("s_waitcnt vmcnt(0)" ::: "memory");
      const unsigned og = xb_add(&bar[XB_TOP], 1u);
      const unsigned tg = og / nx;
      if (og + 1u == (tg + 1u) * nx) xb_add(&bar[XB_TOPGEN], 1u);
      else XB_SPIN(xb_ld(&bar[XB_TOPGEN]) == tg, bar);
      __builtin_amdgcn_fence(__ATOMIC_ACQUIRE, "agent");
      xb_add(&bar[XB_XGEN(b.x)], 1u);
      asm volatile("s_waitcnt vmcnt(0)" ::: "memory");
    } else {
      XB_SPIN(xb_ld(&bar[XB_XGEN(b.x)]) == gen, bar);
      __builtin_amdgcn_fence(__ATOMIC_ACQUIRE, "agent");
      asm volatile("s_waitcnt vmcnt(0)" ::: "memory");
    }
  }
  __syncthreads();
}


template <int RB> DI void ot_put(unsigned char* base, int row, int unit, u32x2 v) { *(u32x2*)(base + row * RB + ((unit ^ (row & 15)) << 3)) = v; }
template <int RB> DI u32x4 ot_get(const unsigned char* base, int row, int chunk) {
  const u32x4 v = *(const u32x4*)(base + row * RB + ((chunk ^ ((row & 15) >> 1)) << 4));
  return (row & 1) ? (u32x4){v.z, v.w, v.x, v.y} : v;
}

template <class Epi>
DI void gemm128_stream(unsigned char* smem, const unsigned char* abase, const unsigned (&ao)[4], const unsigned char* bbase, const unsigned (&bo)[4], int nk, int ntile, size_t btile_stride, Epi&& epi) {
  const int tid = otid(), lane = tid & 63, w = tid >> 6;
  const int wm = w >> 1, wn = w & 1;
  const int r_s = tid >> 3, c_s = tid & 7;
  const int st_off = r_s * 128 + ((c_s ^ (r_s & 7)) << 4);
  const int fr = lane & 15, fq = lane >> 4;
  const int sw0 = ((0 + fq) ^ (fr & 7)) << 4, sw1 = ((4 + fq) ^ (fr & 7)) << 4;
  const int arow_off = (wm * 64 + fr) * 128, brow_off = 32768 + (wn * 64 + fr) * 128;
  u32x4 ra0[4], rb0[4], ra1[4], rb1[4];
  f32x4 acc[4][4];
#pragma unroll
  for (int i = 0; i < 4; ++i)
#pragma unroll
    for (int j = 0; j < 4; ++j) acc[i][j] = (f32x4){0.f, 0.f, 0.f, 0.f};
  const int total = nk * ntile;
  int lkt = 0, ltl = 0;
  auto load = [&](u32x4 (&ra)[4], u32x4 (&rb)[4]) {
    const unsigned char* ab = abase + lkt * 128;
    const unsigned char* bb = bbase + ((size_t)ltl * btile_stride + lkt * 64) * 2;
#pragma unroll
    for (int j = 0; j < 4; ++j) { ra[j] = *(const u32x4*)(ab + ao[j]); rb[j] = *(const u32x4*)(bb + bo[j]); }
    const bool last = (lkt == nk - 1) && (ltl == ntile - 1);
    const int nl = (lkt == nk - 1) ? 0 : lkt + 1;
    ltl = last ? ltl : ((lkt == nk - 1) ? ltl + 1 : ltl);
    lkt = last ? lkt : nl;
  };
  auto store = [&](const u32x4 (&ra)[4], const u32x4 (&rb)[4], int bufo) {
#pragma unroll
    for (int j = 0; j < 4; ++j) { *(u32x4*)(smem + bufo + st_off + j * 4096) = ra[j]; *(u32x4*)(smem + 32768 + bufo + st_off + j * 4096) = rb[j]; }
  };
  int kt = 0, tile = 0;
  auto body = [&](int s, int cur, u32x4 (&lra)[4], u32x4 (&lrb)[4], const u32x4 (&wra)[4], const u32x4 (&wrb)[4]) {
    load(lra, lrb);
#pragma unroll
    for (int ks = 0; ks < 2; ++ks) {
      const int sw = ks ? sw1 : sw0;
      bf16x8 af[4], bfr[4];
#pragma unroll
      for (int i = 0; i < 4; ++i) af[i] = *(const bf16x8*)(smem + cur + arow_off + i * 2048 + sw);
#pragma unroll
      for (int j = 0; j < 4; ++j) bfr[j] = *(const bf16x8*)(smem + cur + brow_off + j * 2048 + sw);
#pragma unroll
      for (int i = 0; i < 4; ++i)
#pragma unroll
        for (int j = 0; j < 4; ++j) acc[i][j] = __builtin_amdgcn_mfma_f32_16x16x32_bf16(bfr[j], af[i], acc[i][j], 0, 0, 0);
    }
    if (s + 1 < total) store(wra, wrb, 16384 - cur);
    if (kt == nk - 1) {
      int wm2 = wm, wn2 = wn, fr2 = fr, fq2 = fq;
      asm volatile("" : "+v"(wm2), "+v"(wn2), "+v"(fr2), "+v"(fq2));
      epi(acc, tile, cur, wm2, wn2, fr2, fq2);
#pragma unroll
      for (int i = 0; i < 4; ++i)
#pragma unroll
        for (int j = 0; j < 4; ++j) acc[i][j] = (f32x4){0.f, 0.f, 0.f, 0.f};
    }
    __syncthreads();
    if (++kt == nk) { kt = 0; ++tile; }
  };
  load(ra0, rb0);
  load(ra1, rb1);
  store(ra0, rb0, 0);
  __syncthreads();
  for (int s = 0; s < total; s += 2) {
    body(s, 0, ra0, rb0, ra1, rb1);
    if (s + 1 >= total) break;
    body(s + 1, 16384, ra1, rb1, ra0, rb0);
  }
}
template <class Epi>
DI void gemm128(unsigned char* smem, const unsigned char* abase, const unsigned (&ao)[4], const unsigned char* bbase, const unsigned (&bo)[4], int nk, Epi&& epi) {
  gemm128_stream(smem, abase, ao, bbase, bo, nk, 1, 0, [&](f32x4 (&acc)[4][4], int, int, int wm, int wn, int fr, int fq) { __syncthreads(); epi(acc, wm, wn, fr, fq); });
}


namespace t8 {
constexpr int BM = 256, BK = 64, HALF = 128, HTB = HALF * BK * 2, STAGE_BYTES = 8 * HTB;
DI int lds_byte(int r, int c) { const int st = (r >> 4) * 2 + (c >> 5), rr = r & 15, cc = c & 31, ob = rr * 64 + cc * 2; return st * 1024 + (ob ^ (((ob >> 9) & 1) << 5)); }
DI void stage_rc(int b, int& R, int& C) { const int st = b / 1024, sb = b % 1024, swz = sb ^ (((sb >> 9) & 1) << 5); R = (st >> 1) * 16 + swz / 64; C = (st & 1) * 32 + (swz % 64) / 2; }
DI int perm32(int rho) { const int n = rho >> 4, i = rho & 15; return 8 * (i >> 2) + 4 * n + (i & 3); }
struct Unit { int pm, pn, tab; const unsigned char* bbase; };
constexpr int TAB_OFF = STAGE_BYTES;
constexpr int START_OFF = STAGE_BYTES + 12288;

template <bool PERM, class Sched, class RowOff, class Epi>
DI void gemm_phase(LAS unsigned char* lds, const unsigned char* Abase, const int K, const Sched& S, const RowOff& RO, const Epi& E) {
  const int tid = full_tid();
  const int wid = __builtin_amdgcn_readfirstlane(tid >> 6), lane = tid & 63, wr = wid >> 2, wc = wid & 3, fr = lane & 15, fq = lane >> 4;
  const int nt = K / BK;
  unsigned voffB[2][2];
#pragma unroll
  for (int h = 0; h < 2; ++h)
#pragma unroll
    for (int i = 0; i < 2; ++i) { int R, C; stage_rc(tid * 16 + i * 8192, R, C); const int rho = h * HALF + R;
      const int Rb = PERM ? (((rho >> 5) & 3) * 64 + ((rho >> 2) & 3) * 16 + (rho >> 7) * 8 + ((rho >> 4) & 1) * 4 + (rho & 3)) : rho; voffB[h][i] = (unsigned)(Rb * K + C) * 2u; }
  auto apiece = [&](const Unit& u, int h, int i) -> unsigned { int R, C; stage_rc(tid * 16 + i * 8192, R, C); return RO(u, h * HALF + R) + (unsigned)(C * 2); };
  const size_t kstep = (size_t)(BK * 2);
  const unsigned ldsw = (unsigned)wid * 1024u;
  const int aoff = lds_byte(wr * 64 + fr, fq * 8), boff = lds_byte(wc * 32 + fr, fq * 8);
  LAS const unsigned char* ldsA = lds + aoff; LAS const unsigned char* ldsB = lds + 4 * HTB + boff;
  asm volatile("" : "+v"(ldsA), "+v"(ldsB));
#define T8_SA(b, h) (((b) * 2 + (h)) * HTB)
#define T8_SB(b, h) ((4 + (b) * 2 + (h)) * HTB)
#define T8_STAGE(bufoff, gbase, voff) do { _Pragma("unroll") for (int _i = 0; _i < 2; ++_i) \
    __builtin_amdgcn_global_load_lds((const unsigned*)((const char*)(gbase) + (voff)[_i]), (LAS unsigned*)(lds + (bufoff) + ldsw + _i * 8192), 16, 0, 0); } while (0)
#define T8_LDA(dst, b, h) do { _Pragma("unroll") for (int m = 0; m < 4; ++m) _Pragma("unroll") for (int k = 0; k < 2; ++k) dst[m][k] = *(const LAS bf16x8*)(ldsA + T8_SA(b, h) + m * 2048 + k * 1024); } while (0)
#define T8_LDB(dst, b, h) do { _Pragma("unroll") for (int n = 0; n < 2; ++n) _Pragma("unroll") for (int k = 0; k < 2; ++k) dst[n][k] = *(const LAS bf16x8*)(ldsB + (T8_SB(b, h) - 4 * HTB) + n * 2048 + k * 1024); } while (0)
#define T8_MMA(ai, bj, At, Bt) do { __builtin_amdgcn_s_setprio(1); _Pragma("unroll") for (int m = 0; m < 4; ++m) _Pragma("unroll") for (int n = 0; n < 2; ++n) _Pragma("unroll") for (int k = 0; k < 2; ++k) \
    acc[ai][bj][m][n] = __builtin_amdgcn_mfma_f32_16x16x32_bf16(Bt[n][k], At[m][k], acc[ai][bj][m][n], 0, 0, 0); __builtin_amdgcn_s_setprio(0); } while (0)
#define T8_WAIT_V(n) asm volatile("s_waitcnt vmcnt(" #n ")" ::: "memory")
#define T8_WAIT_L(n) asm volatile("s_waitcnt lgkmcnt(" #n ")" ::: "memory")
#define T8_BAR __builtin_amdgcn_s_barrier()
#define T8_SCHED __builtin_amdgcn_sched_barrier(0)
  Unit cur, nxt; int ui = 0;
  if (!S.next(0, cur)) return;
  f32x4 acc[2][2][4][2];
#pragma unroll
  for (int a = 0; a < 2; ++a)
#pragma unroll
    for (int b = 0; b < 2; ++b)
#pragma unroll
      for (int m = 0; m < 4; ++m)
#pragma unroll
        for (int n = 0; n < 2; ++n) acc[a][b][m][n] = (f32x4){0.f, 0.f, 0.f, 0.f};
  bf16x8 At[4][2], B0[2][2], B1[2][2];
  unsigned vc[2][2];
#pragma unroll
  for (int h = 0; h < 2; ++h)
#pragma unroll
    for (int i = 0; i < 2; ++i) vc[h][i] = apiece(cur, h, i);
  const char* cB = (const char*)cur.bbase;
  const char* gA = (const char*)Abase;
  T8_STAGE(T8_SB(0, 0), cB, voffB[0]); T8_STAGE(T8_SA(0, 0), gA, vc[0]); T8_STAGE(T8_SB(0, 1), cB, voffB[1]); T8_STAGE(T8_SA(0, 1), gA, vc[1]);
  if (wr == 1) T8_BAR;
  T8_WAIT_V(4); T8_BAR;
  T8_STAGE(T8_SB(1, 0), cB + kstep, voffB[0]); T8_STAGE(T8_SA(1, 0), gA + kstep, vc[0]); T8_STAGE(T8_SB(1, 1), cB + kstep, voffB[1]);
  T8_WAIT_V(6); T8_BAR;
  for (;;) {
    const bool has_next = S.next(ui + 1, nxt);
    const char* nB = has_next ? (const char*)nxt.bbase : cB;
#pragma unroll 1
    for (int t = 0; t < nt; t += 2) {
      const bool last = (t == nt - 2);
      const char* a1 = gA + (size_t)(t + 1) * kstep;
      const char* a2 = last ? gA : gA + (size_t)(t + 2) * kstep; const char* b2 = last ? nB : cB + (size_t)(t + 2) * kstep;
      const char* a3 = a2 + kstep; const char* b3 = b2 + kstep;
      if (last && has_next) { vc[0][0] = apiece(nxt, 0, 0); vc[0][1] = apiece(nxt, 0, 1); }
      T8_LDB(B0, 0, 0); T8_SCHED; T8_LDA(At, 0, 0); T8_STAGE(T8_SA(1, 1), a1, vc[1]);
      T8_WAIT_L(8); T8_BAR; T8_WAIT_L(0); T8_MMA(0, 0, At, B0); T8_BAR; T8_SCHED;
      if (last && has_next) { vc[1][0] = apiece(nxt, 1, 0); vc[1][1] = apiece(nxt, 1, 1); }
      T8_LDB(B1, 0, 1); T8_STAGE(T8_SB(0, 0), b2, voffB[0]);
      T8_BAR; T8_WAIT_L(0); T8_MMA(0, 1, At, B1); T8_BAR;
      T8_LDA(At, 0, 1); T8_STAGE(T8_SA(0, 0), a2, vc[0]);
      T8_BAR; T8_WAIT_L(0); T8_MMA(1, 0, At, B0); T8_BAR; T8_SCHED;
      T8_STAGE(T8_SB(0, 1), b2, voffB[1]);
      T8_WAIT_V(6); T8_BAR; T8_MMA(1, 1, At, B1); T8_BAR;
      T8_LDB(B0, 1, 0); T8_SCHED; T8_LDA(At, 1, 0); T8_STAGE(T8_SA(0, 1), a2, vc[1]);
      T8_WAIT_L(8); T8_BAR; T8_WAIT_L(0); T8_MMA(0, 0, At, B0); T8_BAR; T8_SCHED;
      T8_LDB(B1, 1, 1); T8_STAGE(T8_SB(1, 0), b3, voffB[0]);
      T8_BAR; T8_WAIT_L(0); T8_MMA(0, 1, At, B1); T8_BAR;
      T8_LDA(At, 1, 1); T8_STAGE(T8_SA(1, 0), a3, vc[0]);
      T8_BAR; T8_WAIT_L(0); T8_MMA(1, 0, At, B0); T8_BAR; T8_SCHED;
      T8_STAGE(T8_SB(1, 1), b3, voffB[1]);
      T8_WAIT_V(6); T8_BAR; T8_MMA(1, 1, At, B1); T8_BAR;
    }
    E(acc, cur, wr, wc, fr, fq);
    if (!has_next) break;
#pragma unroll
    for (int a = 0; a < 2; ++a)
#pragma unroll
      for (int b = 0; b < 2; ++b)
#pragma unroll
        for (int m = 0; m < 4; ++m)
#pragma unroll
          for (int n = 0; n < 2; ++n) acc[a][b][m][n] = (f32x4){0.f, 0.f, 0.f, 0.f};
    cur = nxt; cB = nB; ++ui;
  }
  T8_WAIT_V(0);
  if (wr == 0) T8_BAR;
  T8_BAR;
#undef T8_SA
#undef T8_SB
#undef T8_STAGE
#undef T8_LDA
#undef T8_LDB
#undef T8_MMA
#undef T8_WAIT_V
#undef T8_WAIT_L
#undef T8_BAR
#undef T8_SCHED
}

struct DenseSched {
  int nM, nN, nwg, G, c; const unsigned char* Bt; size_t tstep;
  DI void init(int M, int N, int K, int G_, int c_, const void* Bt_) { nM = M / BM; nN = N / BM; nwg = nM * nN; G = G_; c = c_; Bt = (const unsigned char*)Bt_; tstep = (size_t)BM * K * 2; }
  DI bool next(int i, Unit& u) const {
    const long L = (long)i * G + c; if (L >= nwg) return false;
    int wgid = (int)L; { const int q = nwg / 8, r = nwg % 8, xcd = wgid % 8, off = wgid / 8; wgid = (xcd < r ? xcd * (q + 1) : r * (q + 1) + (xcd - r) * q) + off; }
    const int nig = 8 * nN, gid = wgid / nig, fm = gid * 8, gsz = (nM - fm) < 8 ? (nM - fm) : 8;
    u.pm = fm + ((wgid % nig) % gsz); u.pn = (wgid % nig) / gsz; u.tab = 0; u.bbase = Bt + (size_t)u.pn * tstep; return true;
  }
};
struct DenseRows { unsigned rowbytes; DI unsigned operator()(const Unit& u, int row) const { return (unsigned)(u.pm * BM + row) * rowbytes; } };

struct MoeSched {
  LAS const int* start; int npn, nmt, G, c; const unsigned char* wexp; const unsigned char* wsh; size_t estride, tstep;
  DI bool locate(int i, int& mt, int& pn, int& tab) const {
    const int R = nmt / G;
    if (i < R * npn) { const int r = i / npn; pn = i - r * npn; mt = r * G + c; tab = r; return true; }
    const int j = i - R * npn, L = j * G + c, rem = (nmt - R * G) * npn;
    if (L >= rem) return false;
    const int q = L / npn; pn = L - q * npn; mt = R * G + q; tab = R + j; return true;
  }
  DI bool next(int i, Unit& u) const {
    int mt, pn, tab;
    if (!locate(i, mt, pn, tab)) return false;
    u.pm = mt; u.pn = pn; u.tab = tab;
    const int e = __builtin_amdgcn_readfirstlane(start[128 + tab]);
    u.bbase = (e == 64 ? wsh : wexp + (size_t)e * estride) + (size_t)pn * tstep; return true;
  }
};
}

DI void moe_prepare(const P& p, LAS unsigned char* lds, int l, int npn, int G, int c, int& total_units, bool with_w = false) {
  LAS int* start = (LAS int*)(lds + t8::START_OFF);
  __syncthreads();
  if (full_tid() == 0) {
    int s = 0;
    for (int e = 0; e < 64; ++e) { start[e] = s; s += (p.cnt()[(l * 64 + e) * CSTRIDE] + 255) >> 8; }
    start[64] = s; start[65] = s + 64;
  }
  __syncthreads();
  const int nmt = start[65];
  total_units = nmt;
  const int tid = full_tid();
  t8::MoeSched S{start, npn, nmt, G, c, nullptr, nullptr, 0, 0};
  int last_tab = -1;
  for (int i = 0; i < 16; ++i) {
    int mt, pn, tab;
    if (!S.locate(i, mt, pn, tab)) break;
    if (tab == last_tab) continue;
    last_tab = tab;
    int e = 64;
    if (mt < start[64]) {
      e = 0;
#pragma unroll 4
      for (int q = 1; q < 64; ++q) e = (start[q] <= mt) ? q : e;
    }
    if (tid == 0) start[128 + tab] = e;
    if (tid < 256) {
      int slot;
      if (mt >= start[64]) slot = T_ * 8 + (mt - start[64]) * 256 + tid;
      else {
        const int idx = (mt - start[e]) * 256 + tid;
        slot = idx < p.cnt()[(l * 64 + e) * CSTRIDE] ? p.list()[(size_t)e * LISTCAP + idx] : -1;
      }
      ((LAS int*)(lds + t8::TAB_OFF))[tab * 256 + tid] = slot;
      if (with_w) ((LAS float*)(lds + t8::TAB_OFF))[(6 + tab) * 256 + tid] = (slot < 0 || slot >= T_ * 8) ? 1.f : p.topw()[slot] * YSCALE;
    }
  }
  __syncthreads();
}

DI void item_mod(const P& p, unsigned char* smem, int item) {
  const int l = item / 192, cb = item % 192;
  const int tid = otid(), col = tid & 31, kg = tid >> 5;
  float* sc = (float*)smem;
  float* red = (float*)(smem + 32768);
  __syncthreads();
  for (int i = tid; i < 8192; i += NTHREADS) sc[i] = silu_f(p.c[i]);
  __syncthreads();
  const float* W = p.w_ada + (size_t)l * 1024 * 6144 + (size_t)(kg * 128) * 6144 + cb * 32 + col;
  float acc[8];
#pragma unroll
  for (int b = 0; b < 8; ++b) acc[b] = 0.f;
#pragma unroll 1
  for (int k0 = 0; k0 < 128; k0 += 32) {
    float wv[32];
#pragma unroll
    for (int u = 0; u < 32; ++u) wv[u] = W[(size_t)(k0 + u) * 6144];
#pragma unroll
    for (int u = 0; u < 32; ++u)
#pragma unroll
      for (int b = 0; b < 8; ++b) acc[b] += sc[b * 1024 + kg * 128 + k0 + u] * wv[u];
  }
#pragma unroll
  for (int b = 0; b < 8; ++b) red[(kg * 8 + b) * 32 + col] = acc[b];
  __syncthreads();
  {
    const int b = tid >> 5, cc = tid & 31;
    float v = 0.f;
#pragma unroll
    for (int g = 0; g < 8; ++g) v += red[(g * 8 + b) * 32 + cc];
    p.mod()[((size_t)l * 8 + b) * 6144 + cb * 32 + cc] = v + p.b_ada[(size_t)l * 6144 + cb * 32 + cc];
  }
}

DI void conv_tile(unsigned char* smem, const float* src, int ldsrc, int k0, int n0, bf16_t* dst, int lddst, int mode, const float* kscale) {
  float* t = (float*)smem;
  const int tid = otid();
  __syncthreads();
  {
    const int kk = tid >> 3, nq = tid & 7;
#pragma unroll
    for (int hh = 0; hh < 2; ++hh) {
      const int k = kk + 32 * hh;
      const float4 v = *(const float4*)(src + (size_t)(k0 + k) * ldsrc + n0 + nq * 4);
      const float s = kscale ? kscale[k0 + k] : 1.f;
      t[k * 33 + nq * 4 + 0] = v.x * s; t[k * 33 + nq * 4 + 1] = v.y * s; t[k * 33 + nq * 4 + 2] = v.z * s; t[k * 33 + nq * 4 + 3] = v.w * s;
    }
  }
  __syncthreads();
  {
    const int n = tid >> 3, kc = tid & 7;
    u32x4 wv;
    wv.x = pack2(t[(kc * 8 + 0) * 33 + n], t[(kc * 8 + 1) * 33 + n]);
    wv.y = pack2(t[(kc * 8 + 2) * 33 + n], t[(kc * 8 + 3) * 33 + n]);
    wv.z = pack2(t[(kc * 8 + 4) * 33 + n], t[(kc * 8 + 5) * 33 + n]);
    wv.w = pack2(t[(kc * 8 + 6) * 33 + n], t[(kc * 8 + 7) * 33 + n]);
    const int nn = n0 + n;
    const int orow = (mode == 0) ? nn : (256 * (nn >> 7) + 16 * ((nn & 127) >> 3) + (mode == 2 ? 8 : 0) + (nn & 7));
    *(u32x4*)(dst + (size_t)orow * lddst + k0 + kc * 8) = wv;
  }
}

DI void conv_big(unsigned char* smem, const float* src, int ldsrc, int k0, int n0, bf16_t* dst, int lddst, int mode, const float* kscale) {
  float* t = (float*)smem;
  const int tid = otid();
  __syncthreads();
  {
    const int c4 = tid & 31, r0 = tid >> 5;
    float4 v[8];
#pragma unroll
    for (int hh = 0; hh < 8; ++hh) v[hh] = *(const float4*)(src + (size_t)(k0 + r0 + 8 * hh) * ldsrc + n0 + c4 * 4);
#pragma unroll
    for (int hh = 0; hh < 8; ++hh) {
      const int k = r0 + 8 * hh;
      const float sc = kscale ? kscale[k0 + k] : 1.f;
      *(float4*)(t + k * 132 + c4 * 4) = (float4){v[hh].x * sc, v[hh].y * sc, v[hh].z * sc, v[hh].w * sc};
    }
  }
  __syncthreads();
  {
    const int n = tid >> 1, kh = tid & 1;
    const int nn = n0 + n;
    const int orow = (mode == 0) ? nn : (256 * (nn >> 7) + 16 * ((nn & 127) >> 3) + (mode == 2 ? 8 : 0) + (nn & 7));
    bf16_t* d = dst + (size_t)orow * lddst + k0 + kh * 32;
#pragma unroll
    for (int c = 0; c < 4; ++c) {
      const float* tp = t + (kh * 32 + c * 8) * 132 + n;
      u32x4 wv;
      wv.x = pack2(tp[0 * 132], tp[1 * 132]); wv.y = pack2(tp[2 * 132], tp[3 * 132]); wv.z = pack2(tp[4 * 132], tp[5 * 132]); wv.w = pack2(tp[6 * 132], tp[7 * 132]);
      *(u32x4*)(d + c * 8) = wv;
    }
  }
}

DI void item_conv(const P& p, unsigned char* smem, int l, int idx) {
  if (idx < 592) { conv_tile(smem, p.w_in + (size_t)l * 1024 * NIN, NIN, (idx / 37) * 64, (idx % 37) * 32, p.win_t(), 1024, 0, nullptr); return; }
  idx -= 592;
  if (idx < 24) { conv_big(smem, p.w_uq + (size_t)l * 256 * 768, 768, (idx / 6) * 64, (idx % 6) * 128, p.wuq_t(), 256, 0, p.g_q + l * 256); return; }
  idx -= 24;
  if (idx < 16) { conv_big(smem, p.w_ukv + (size_t)l * 128 * 1024, 1024, (idx / 8) * 64, (idx % 8) * 128, p.wukv_t(), 256, 0, p.g_kv + l * 128); return; }
  idx -= 16;
  if (idx < 128) { conv_big(smem, p.w_out + (size_t)l * 1024 * 1024, 1024, (idx / 8) * 64, (idx % 8) * 128, p.wout_t(), 1024, 0, nullptr); return; }
  idx -= 128;
  if (idx < 32) { conv_big(smem, p.ws_gate + (size_t)l * 1024 * 256, 256, (idx / 2) * 64, (idx % 2) * 128, p.wsg_t(), 1024, 1, nullptr); return; }
  idx -= 32;
  if (idx < 32) { conv_big(smem, p.ws_up + (size_t)l * 1024 * 256, 256, (idx / 2) * 64, (idx % 2) * 128, p.wsg_t(), 1024, 2, nullptr); return; }
  idx -= 32;
  if (idx < 32) { conv_big(smem, p.ws_down + (size_t)l * 256 * 1024, 1024, (idx / 8) * 64, (idx % 8) * 128, p.wsd_t(), 256, 0, nullptr); return; }
  idx -= 32;
  const int e = idx / 96, r = idx % 96;
  if (r < 32) conv_big(smem, p.w_gate + ((size_t)l * 64 + e) * 1024 * 256, 256, (r / 2) * 64, (r % 2) * 128, p.wgu_t() + (size_t)e * 512 * 1024, 1024, 1, nullptr);
  else if (r < 64) conv_big(smem, p.w_up + ((size_t)l * 64 + e) * 1024 * 256, 256, ((r - 32) / 2) * 64, ((r - 32) % 2) * 128, p.wgu_t() + (size_t)e * 512 * 1024, 1024, 2, nullptr);
  else conv_big(smem, p.w_down + ((size_t)l * 64 + e) * 256 * 1024, 1024, ((r - 64) / 8) * 64, ((r - 64) % 8) * 128, p.wd_t() + (size_t)e * 1024 * 256, 256, 0, nullptr);
}


DI void conv_big_desc(const P& p, int l, int idx, const float*& src, int& ldsrc, int& k0, int& n0, bf16_t*& dst, int& lddst, int& mode) {
  if (idx < 32) { src = p.ws_gate + (size_t)l * 1024 * 256; ldsrc = 256; k0 = (idx / 2) * 64; n0 = (idx % 2) * 128; dst = p.wsg_t(); lddst = 1024; mode = 1; return; }
  idx -= 32;
  if (idx < 32) { src = p.ws_up + (size_t)l * 1024 * 256; ldsrc = 256; k0 = (idx / 2) * 64; n0 = (idx % 2) * 128; dst = p.wsg_t(); lddst = 1024; mode = 2; return; }
  idx -= 32;
  if (idx < 32) { src = p.ws_down + (size_t)l * 256 * 1024; ldsrc = 1024; k0 = (idx / 8) * 64; n0 = (idx % 8) * 128; dst = p.wsd_t(); lddst = 256; mode = 0; return; }
  idx -= 32;
  const int e = idx / 96, r = idx % 96;
  if (r < 32) { src = p.w_gate + ((size_t)l * 64 + e) * 1024 * 256; ldsrc = 256; k0 = (r / 2) * 64; n0 = (r % 2) * 128; dst = p.wgu_t() + (size_t)e * 512 * 1024; lddst = 1024; mode = 1; }
  else if (r < 64) { src = p.w_up + ((size_t)l * 64 + e) * 1024 * 256; ldsrc = 256; k0 = ((r - 32) / 2) * 64; n0 = ((r - 32) % 2) * 128; dst = p.wgu_t() + (size_t)e * 512 * 1024; lddst = 1024; mode = 2; }
  else { src = p.w_down + ((size_t)l * 64 + e) * 256 * 1024; ldsrc = 1024; k0 = ((r - 64) / 8) * 64; n0 = ((r - 64) % 8) * 128; dst = p.wd_t() + (size_t)e * 1024 * 256; lddst = 256; mode = 0; }
}
DI void conv_big_load(const P& p, int l, int idx, int tid, f32x4 (&v)[8]) {
  idx = idx < CONV_BIG ? idx : CONV_BIG - 1;
  const float* src; int ldsrc, k0, n0; bf16_t* dst; int lddst, mode;
  conv_big_desc(p, l, idx, src, ldsrc, k0, n0, dst, lddst, mode);
  const int c4 = tid & 31, r0 = tid >> 5;
#pragma unroll
  for (int hh = 0; hh < 8; ++hh) v[hh] = *(const f32x4*)(src + (size_t)(k0 + r0 + 8 * hh) * ldsrc + n0 + c4 * 4);
}
DI void conv_big_finish(const P& p, unsigned char* smem, int l, int idx, int tid, const f32x4 (&v)[8]) {
  const float* src; int ldsrc, k0, n0; bf16_t* dst; int lddst, mode;
  conv_big_desc(p, l, idx, src, ldsrc, k0, n0, dst, lddst, mode);
  float* t = (float*)smem;
  const int c4 = tid & 31, r0 = tid >> 5;
  __syncthreads();
#pragma unroll
  for (int hh = 0; hh < 8; ++hh) *(f32x4*)(t + (r0 + 8 * hh) * 132 + c4 * 4) = v[hh];
  __syncthreads();
  const int n = tid >> 1, kh = tid & 1;
  const int nn = n0 + n;
  const int orow = (mode == 0) ? nn : (256 * (nn >> 7) + 16 * ((nn & 127) >> 3) + (mode == 2 ? 8 : 0) + (nn & 7));
  bf16_t* d = dst + (size_t)orow * lddst + k0 + kh * 32;
#pragma unroll
  for (int c = 0; c < 4; ++c) {
    const float* tp = t + (kh * 32 + c * 8) * 132 + n;
    u32x4 wv;
    wv.x = pack2(tp[0 * 132], tp[1 * 132]); wv.y = pack2(tp[2 * 132], tp[3 * 132]); wv.z = pack2(tp[4 * 132], tp[5 * 132]); wv.w = pack2(tp[6 * 132], tp[7 * 132]);
    *(u32x4*)(d + c * 8) = wv;
  }
}
DI void conv_big_loop(const P& p, unsigned char* smem, int l, int first, int step) {
  if (first >= CONV_BIG) return;
  const int tid = otid();
  f32x4 va[8], vb[8];
  conv_big_load(p, l, first, tid, va); conv_big_load(p, l, first + step, tid, vb);
  for (int it = first; it < CONV_BIG; it += 2 * step) {
    conv_big_finish(p, smem, l, it, tid, va);
    conv_big_load(p, l, it + 2 * step, tid, va);
    if (it + step >= CONV_BIG) break;
    conv_big_finish(p, smem, l, it + step, tid, vb);
    conv_big_load(p, l, it + 3 * step, tid, vb);
  }
}

constexpr int MISC_ITEMS = 64 + 128 + 512 + 64;
DI void item_misc(const P& p, int item) {
  const int tid = otid();
  if (item < 64) {
    const int i = (item * NTHREADS + tid) * 8;
    const int k0 = i & 127, t = (i >> 7) & 127;
    const float4 a = *(const float4*)(p.w_spatial + i), c = *(const float4*)(p.w_spatial + i + 4);
    u32x4 o;
    o.x = pack2(k0 + 0 <= t ? a.x : 0.f, k0 + 1 <= t ? a.y : 0.f); o.y = pack2(k0 + 2 <= t ? a.z : 0.f, k0 + 3 <= t ? a.w : 0.f);
    o.z = pack2(k0 + 4 <= t ? c.x : 0.f, k0 + 5 <= t ? c.y : 0.f); o.w = pack2(k0 + 6 <= t ? c.z : 0.f, k0 + 7 <= t ? c.w : 0.f);
    *(u32x4*)(p.wsp_b() + i) = o;
  } else if (item < 64 + 128) {
    const int i = (item - 64) * NTHREADS + tid;
    const int c = i & 63, dd = (i >> 6) & 63, lg = i >> 12;
    const f32x2 f = {p.w_pool[((size_t)lg * 64 + c) * 64 + dd], 0.f}; const bf16x2_t bb = __builtin_convertvector(f, bf16x2_t);
    p.wpool_t()[i] = (bf16_t)(__builtin_bit_cast(unsigned, bb) & 0xffffu);
  } else if (item >= 64 + 128 + 512) {
    const int i = (item - 704) * NTHREADS + tid;
    *(u32x4*)(p.wukv_t() + (size_t)(i >> 4) * 256 + 128 + (i & 15) * 8) = (u32x4){0u, 0u, 0u, 0u};
  } else {
    const int i = (item - 192) * NTHREADS + tid;
    const int e = i & 63, k = (i >> 6) & 1023, l = i >> 16;
    const float v = p.w_router[i];
    const unsigned hi = pack2(v, 0.f) & 0xffffu;
    const unsigned lo = pack2(v - bflo(hi), 0.f) & 0xffffu;
    p.wr_hi()[(size_t)l * 65536 + e * 1024 + k] = (bf16_t)hi;
    p.wr_lo()[(size_t)l * 65536 + e * 1024 + k] = (bf16_t)lo;
  }
}

DI void item_rope(const P& p, int item) {
  const int i = item * NTHREADS + otid();
  const int t = i >> 4, f = i & 15;
  const float inv = exp2f(-(float)(2 * f) * (13.287712379549449f / 32.f));
  const float ang = (float)p.pos[t] * inv;
  const double rev = (double)ang * 0.15915494309189535;
  const float fr = (float)(rev - floor(rev));
  p.ropec()[i] = __builtin_amdgcn_cosf(fr);
  p.ropes()[i] = __builtin_amdgcn_sinf(fr);
}

DI void item_norm0(const P& p, int item) {
  const int tid = otid(), w = tid >> 6, lane = tid & 63;
  const int t0 = item * 8 + w * 2, b = t0 >> 11;
  const float* md = p.mod() + (size_t)b * 6144;
  f32x4 v[2][4];
#pragma unroll
  for (int q = 0; q < 2; ++q)
#pragma unroll
    for (int j = 0; j < 4; ++j) v[q][j] = *(const f32x4*)(p.x + (size_t)(t0 + q) * 1024 + j * 256 + lane * 4);
  float ss[2] = {0.f, 0.f};
#pragma unroll
  for (int q = 0; q < 2; ++q)
#pragma unroll
    for (int j = 0; j < 4; ++j) ss[q] += v[q][j][0] * v[q][j][0] + v[q][j][1] * v[q][j][1] + v[q][j][2] * v[q][j][2] + v[q][j][3] * v[q][j][3];
  ss[0] = wsum(ss[0]); ss[1] = wsum(ss[1]);
#pragma unroll
  for (int q = 0; q < 2; ++q) {
    const float rstd = rsqrtf(ss[q] * (1.f / 1024.f) + EPS);
#pragma unroll
    for (int j = 0; j < 4; ++j) {
      const int idx = j * 256 + lane * 4;
      const f32x4 sh = *(const f32x4*)(md + idx), sc = *(const f32x4*)(md + 1024 + idx);
      const f32x4 hv = v[q][j] * rstd * (sc + 1.f) + sh;
      u32x2 o; o.x = pack2(hv[0], hv[1]); o.y = pack2(hv[2], hv[3]);
      *(u32x2*)(p.h() + (size_t)(t0 + q) * 1024 + idx) = o;
    }
  }
}

DI void item_p1(const P& p, unsigned char* smem, int item) {
  const int m = item / 10, nt = item % 10;
  const int tid = otid(), r_s = tid >> 3, c_s = tid & 7;
  __syncthreads();
  unsigned ao[4], bo[4];
#pragma unroll
  for (int j = 0; j < 4; ++j) {
    const int row = r_s + 32 * j;
    ao[j] = (unsigned)(((m * 128 + row) * 1024 + c_s * 8) * 2);
    int n = nt * 128 + row; n = n < NIN ? n : NIN - 1;
    bo[j] = (unsigned)((n * 1024 + c_s * 8) * 2);
  }
  bf16_t* proj = p.proj();
  gemm128(smem, (const unsigned char*)p.h(), ao, (const unsigned char*)p.win_t(), bo, 16, [=](f32x4 (&acc)[4][4], int wm, int wn, int fr, int fq) {
    unsigned char* ob = smem + wm * 16384;
#pragma unroll
    for (int i = 0; i < 4; ++i)
#pragma unroll
      for (int j = 0; j < 4; ++j) {
        u32x2 o; o.x = pack2(acc[i][j][0], acc[i][j][1]); o.y = pack2(acc[i][j][2], acc[i][j][3]);
        ot_put<256>(ob, i * 16 + fr, wn * 16 + j * 4 + fq, o);
      }
    __syncthreads();
    {
      const int tid2 = fq * 16 + fr + 64 * (wm * 2 + wn);
      const int chunk = tid2 & 15;
      if (nt * 128 + chunk * 8 < NIN) {
#pragma unroll
        for (int i = 0; i < 8; ++i) {
          const int row = (tid2 >> 4) + 16 * i;
          const u32x4 v = ot_get<256>(smem + (row >> 6) * 16384, row & 63, chunk);
          *(u32x4*)(proj + (size_t)(m * 128 + row) * NIN + nt * 128 + chunk * 8) = v;
        }
      }
    }
  });
}

DI void item_qproj(const P& p, unsigned char* smem, int item) {
  const int m = item / 6, nt = item % 6;
  const int tid = otid(), r_s = tid >> 3, c_s = tid & 7;
  float* rowf = (float*)(smem + SMEM_MAIN + 1024);
  __syncthreads();
  {
    const int row = tid >> 1, half = tid & 1;
    const bf16_t* src = p.proj() + (size_t)(m * 128 + row) * NIN + 768 + half * 128;
    float ss = 0.f;
#pragma unroll
    for (int q = 0; q < 16; ++q) {
      const u32x4 v = *(const u32x4*)(src + q * 8);
      ss += bflo(v.x) * bflo(v.x) + bfhi(v.x) * bfhi(v.x) + bflo(v.y) * bflo(v.y) + bfhi(v.y) * bfhi(v.y) + bflo(v.z) * bflo(v.z) + bfhi(v.z) * bfhi(v.z) + bflo(v.w) * bflo(v.w) + bfhi(v.w) * bfhi(v.w);
    }
    ss += __shfl_xor(ss, 1);
    if (half == 0) rowf[row] = rsqrtf(ss * (1.f / 256.f) + EPS);
  }
  unsigned ao[4], bo[4];
#pragma unroll
  for (int j = 0; j < 4; ++j) {
    const int row = r_s + 32 * j;
    ao[j] = (unsigned)(((m * 128 + row) * NIN + 768 + c_s * 8) * 2);
    bo[j] = (unsigned)(((nt * 128 + row) * 256 + c_s * 8) * 2);
  }
  bf16_t* Q = p.Q(); const float* ropec = p.ropec(); const float* ropes = p.ropes();
  const float QS = 0.10206207261596577f * 1.4426950408889634f;
  gemm128(smem, (const unsigned char*)p.proj(), ao, (const unsigned char*)p.wuq_t(), bo, 4, [=](f32x4 (&acc)[4][4], int wm, int wn, int fr, int fq) {
#pragma unroll
    for (int i = 0; i < 4; ++i) {
      const int tl = wm * 64 + i * 16 + fr, t = m * 128 + tl;
      const int b = t >> 11, s = t & 2047;
      const float rs = rowf[tl] * QS;
#pragma unroll
      for (int j = 0; j < 4; ++j) {
        const int c0 = nt * 128 + wn * 64 + j * 16;
        const int head = c0 / 96, d0 = c0 % 96;
        bf16_t* dst = Q + ((size_t)((b * 8 + head) * 2048 + s)) * 96 + d0 + fq * 4;
        if (d0 == 64) {
          if (j < 3) {
            const float4 cs = *(const float4*)(ropec + (size_t)t * 16 + fq * 4), sn = *(const float4*)(ropes + (size_t)t * 16 + fq * 4);
            const f32x4 x1 = acc[i][j] * rs, x2 = acc[i][j + 1 < 4 ? j + 1 : 3] * rs;
            u32x2 o1, o2;
            o1.x = pack2(x1[0] * cs.x - x2[0] * sn.x, x1[1] * cs.y - x2[1] * sn.y);
            o1.y = pack2(x1[2] * cs.z - x2[2] * sn.z, x1[3] * cs.w - x2[3] * sn.w);
            o2.x = pack2(x2[0] * cs.x + x1[0] * sn.x, x2[1] * cs.y + x1[1] * sn.y);
            o2.y = pack2(x2[2] * cs.z + x1[2] * sn.z, x2[3] * cs.w + x1[3] * sn.w);
            *(u32x2*)dst = o1; *(u32x2*)(dst + 16) = o2;
          }
        } else if (d0 != 80) {
          const f32x4 x = acc[i][j] * rs;
          u32x2 o; o.x = pack2(x[0], x[1]); o.y = pack2(x[2], x[3]);
          *(u32x2*)dst = o;
        }
      }
    }
  });
}

DI void item_kvproj(const P& p, unsigned char* smem, int item) {
  const int m = item >> 3, head = item & 7;
  const int tid = otid(), r_s = tid >> 3, c_s = tid & 7;
  float* rowf = (float*)(smem + SMEM_MAIN + 1024);
  __syncthreads();
  {
    const int row = tid >> 1, half = tid & 1;
    const int t = m * 128 + row, b = t >> 11, s = t & 2047;
    const bf16_t* src = p.proj() + (size_t)t * NIN + 1024 + half * 64;
    float ss = 0.f;
#pragma unroll
    for (int q = 0; q < 8; ++q) {
      const u32x4 v = *(const u32x4*)(src + q * 8);
      ss += bflo(v.x) * bflo(v.x) + bfhi(v.x) * bfhi(v.x) + bflo(v.y) * bflo(v.y) + bfhi(v.y) * bfhi(v.y) + bflo(v.z) * bflo(v.z) + bfhi(v.z) * bfhi(v.z) + bflo(v.w) * bflo(v.w) + bfhi(v.w) * bfhi(v.w);
    }
    ss += __shfl_xor(ss, 1);
    if (half == 0) rowf[row] = rsqrtf(ss * (1.f / 128.f) + EPS);
    const bf16_t* kp = p.proj() + (size_t)t * NIN + 1152 + half * 8;
    const u32x4 a1 = *(const u32x4*)kp, a2 = *(const u32x4*)(kp + 16);
    const float* cp = p.ropec() + (size_t)t * 16 + half * 8; const float* sp = p.ropes() + (size_t)t * 16 + half * 8;
    const float4 c0 = *(const float4*)cp, c1 = *(const float4*)(cp + 4), s0 = *(const float4*)sp, s1 = *(const float4*)(sp + 4);
    const float x1[8] = {bflo(a1.x), bfhi(a1.x), bflo(a1.y), bfhi(a1.y), bflo(a1.z), bfhi(a1.z), bflo(a1.w), bfhi(a1.w)};
    const float x2[8] = {bflo(a2.x), bfhi(a2.x), bflo(a2.y), bfhi(a2.y), bflo(a2.z), bfhi(a2.z), bflo(a2.w), bfhi(a2.w)};
    const float cc[8] = {c0.x, c0.y, c0.z, c0.w, c1.x, c1.y, c1.z, c1.w};
    const float sn[8] = {s0.x, s0.y, s0.z, s0.w, s1.x, s1.y, s1.z, s1.w};
    u32x4 o1, o2;
    o1.x = pack2(x1[0] * cc[0] - x2[0] * sn[0], x1[1] * cc[1] - x2[1] * sn[1]);
    o1.y = pack2(x1[2] * cc[2] - x2[2] * sn[2], x1[3] * cc[3] - x2[3] * sn[3]);
    o1.z = pack2(x1[4] * cc[4] - x2[4] * sn[4], x1[5] * cc[5] - x2[5] * sn[5]);
    o1.w = pack2(x1[6] * cc[6] - x2[6] * sn[6], x1[7] * cc[7] - x2[7] * sn[7]);
    o2.x = pack2(x2[0] * cc[0] + x1[0] * sn[0], x2[1] * cc[1] + x1[1] * sn[1]);
    o2.y = pack2(x2[2] * cc[2] + x1[2] * sn[2], x2[3] * cc[3] + x1[3] * sn[3]);
    o2.z = pack2(x2[4] * cc[4] + x1[4] * sn[4], x2[5] * cc[5] + x1[5] * sn[5]);
    o2.w = pack2(x2[6] * cc[6] + x1[6] * sn[6], x2[7] * cc[7] + x1[7] * sn[7]);
    bf16_t* kd = p.Kb() + ((size_t)((b * 8 + head) * 2048 + s)) * 96 + 64 + half * 8;
    *(u32x4*)kd = o1; *(u32x4*)(kd + 16) = o2;
  }
  unsigned ao[4], bo[4];
#pragma unroll
  for (int j = 0; j < 4; ++j) {
    const int row = r_s + 32 * j;
    ao[j] = (unsigned)(((m * 128 + row) * NIN + 1024 + c_s * 8) * 2);
    bo[j] = (unsigned)(((head * 128 + row) * 128 + c_s * 8) * 2);
  }
  bf16_t* Kb = p.Kb(); bf16_t* V = p.V();
  gemm128(smem, (const unsigned char*)p.proj(), ao, (const unsigned char*)p.wukv_t(), bo, 2, [=](f32x4 (&acc)[4][4], int wm, int wn, int fr, int fq) {
#pragma unroll
    for (int i = 0; i < 4; ++i) {
      const int tl = wm * 64 + i * 16 + fr, t = m * 128 + tl;
      const int b = t >> 11, s = t & 2047;
      const float rs = rowf[tl];
      const size_t rowi = (size_t)((b * 8 + head) * 2048 + s);
#pragma unroll
      for (int j = 0; j < 4; ++j) {
        const int d = j * 16 + fq * 4;
        const f32x4 x = acc[i][j] * rs;
        u32x2 o; o.x = pack2(x[0], x[1]); o.y = pack2(x[2], x[3]);
        if (wn == 0) *(u32x2*)(Kb + rowi * 96 + d) = o; else *(u32x2*)(V + rowi * 64 + d) = o;
      }
    }
  });
}

DI void item_pool(const P& p, unsigned char* smem, int l, int item) {
  const int tid = otid(), w = tid >> 6, lane = tid & 63, fr = lane & 15, fq = lane >> 4;
  const int tile = item >> 2, g = item & 3;
  const int t0 = tile * 128, s0 = t0 & 2047;
  const int wdw = 2 << g;
  unsigned char* al = smem;
  unsigned char* dl = smem + 20480;
  __syncthreads();
  for (int id = tid; id < 143 * 8; id += NTHREADS) {
    const int row = id >> 3, c = id & 7;
    const int srel = s0 - 15 + row;
    u32x4 v = (u32x4){0u, 0u, 0u, 0u};
    if (srel >= 0) v = *(const u32x4*)(p.proj() + (size_t)(t0 - 15 + row) * NIN + g * 64 + c * 8);
    *(u32x4*)(al + row * 128 + c * 16) = v;
  }
  __syncthreads();
  {
    const int tl = tid >> 1, cb = (tid & 1) * 4;
    const int pos = s0 + tl;
    const int nw = (pos + 1 < wdw) ? pos + 1 : wdw;
    const float inv = 1.f / (float)nw;
#pragma unroll
    for (int q = 0; q < 4; ++q) {
      const int c = cb + q;
      float sm[8];
#pragma unroll
      for (int e = 0; e < 8; ++e) sm[e] = 0.f;
      for (int j = 0; j < nw; ++j) {
        const u32x4 v = *(const u32x4*)(al + (tl + 15 - j) * 128 + c * 16);
        sm[0] += bflo(v.x); sm[1] += bfhi(v.x); sm[2] += bflo(v.y); sm[3] += bfhi(v.y); sm[4] += bflo(v.z); sm[5] += bfhi(v.z); sm[6] += bflo(v.w); sm[7] += bfhi(v.w);
      }
      const u32x4 a = *(const u32x4*)(al + (tl + 15) * 128 + c * 16);
      u32x4 o;
      o.x = pack2(sm[0] * inv - bflo(a.x), sm[1] * inv - bfhi(a.x)); o.y = pack2(sm[2] * inv - bflo(a.y), sm[3] * inv - bfhi(a.y));
      o.z = pack2(sm[4] * inv - bflo(a.z), sm[5] * inv - bfhi(a.z)); o.w = pack2(sm[6] * inv - bflo(a.w), sm[7] * inv - bfhi(a.w));
      *(u32x4*)(dl + tl * 128 + ((c ^ (tl & 7)) << 4)) = o;
    }
  }
  __syncthreads();
  {
    const bf16_t* wp = p.wpool_t() + ((size_t)(l * 4 + g) * 64) * 64;
    f32x4 acc[2][4];
#pragma unroll
    for (int i = 0; i < 2; ++i)
#pragma unroll
      for (int j = 0; j < 4; ++j) acc[i][j] = (f32x4){0.f, 0.f, 0.f, 0.f};
#pragma unroll
    for (int ks = 0; ks < 2; ++ks) {
      bf16x8 df[2], wf[4];
#pragma unroll
      for (int i = 0; i < 2; ++i) { const int row = w * 32 + i * 16 + fr; df[i] = *(const bf16x8*)(dl + row * 128 + (((ks * 4 + fq) ^ (row & 7)) << 4)); }
#pragma unroll
      for (int j = 0; j < 4; ++j) wf[j] = *(const bf16x8*)(wp + (size_t)(j * 16 + fr) * 64 + ks * 32 + fq * 8);
#pragma unroll
      for (int i = 0; i < 2; ++i)
#pragma unroll
        for (int j = 0; j < 4; ++j) acc[i][j] = __builtin_amdgcn_mfma_f32_16x16x32_bf16(wf[j], df[i], acc[i][j], 0, 0, 0);
    }
#pragma unroll
    for (int i = 0; i < 2; ++i) {
      const int t = t0 + w * 32 + i * 16 + fr;
#pragma unroll
      for (int j = 0; j < 4; ++j) {
        const int cc = g * 64 + j * 16 + fq * 4;
        const float4 ps = *(const float4*)(p.pool_scale + l * 256 + cc);
        u32x2 o; o.x = pack2(acc[i][j][0] * ps.x, acc[i][j][1] * ps.y); o.y = pack2(acc[i][j][2] * ps.z, acc[i][j][3] * ps.w);
        *(u32x2*)(p.Y() + (size_t)t * 1024 + cc) = o;
      }
    }
  }
}

DI void item_sgu(const P& p, unsigned char* smem, int l, int chunk) {
  const int tid = otid(), w = tid >> 6, lane = tid & 63, fr = lane & 15, fq = lane >> 4;
  const int t0 = chunk * 128;
  unsigned char* vn = smem;
  __syncthreads();
  {
    const int part = tid & 7;
    u32x4 raw[4][4];
#pragma unroll
    for (int ps = 0; ps < 4; ++ps) {
      const bf16_t* src = p.proj() + (size_t)(t0 + ps * 32 + (tid >> 3)) * NIN + 512 + part * 32;
#pragma unroll
      for (int q = 0; q < 4; ++q) raw[ps][q] = *(const u32x4*)(src + q * 8);
    }
#pragma unroll
    for (int ps = 0; ps < 4; ++ps) {
      const int tl = ps * 32 + (tid >> 3);
      float x[32];
#pragma unroll
      for (int q = 0; q < 4; ++q) {
        const u32x4 v = raw[ps][q];
        x[q * 8 + 0] = gelu_tanh(bflo(v.x)); x[q * 8 + 1] = gelu_tanh(bfhi(v.x)); x[q * 8 + 2] = gelu_tanh(bflo(v.y)); x[q * 8 + 3] = gelu_tanh(bfhi(v.y));
        x[q * 8 + 4] = gelu_tanh(bflo(v.z)); x[q * 8 + 5] = gelu_tanh(bfhi(v.z)); x[q * 8 + 6] = gelu_tanh(bflo(v.w)); x[q * 8 + 7] = gelu_tanh(bfhi(v.w));
      }
      float sm = 0.f;
#pragma unroll
      for (int e = 0; e < 32; ++e) sm += x[e];
      sm += __shfl_xor(sm, 1); sm += __shfl_xor(sm, 2); sm += __shfl_xor(sm, 4);
      const float mu = sm * (1.f / 256.f);
      float vs = 0.f;
#pragma unroll
      for (int e = 0; e < 32; ++e) { x[e] -= mu; vs += x[e] * x[e]; }
      vs += __shfl_xor(vs, 1); vs += __shfl_xor(vs, 2); vs += __shfl_xor(vs, 4);
      const float rstd = rsqrtf(vs * (1.f / 256.f) + EPS);
#pragma unroll
      for (int q = 0; q < 4; ++q) {
        const int c = part * 4 + q;
        u32x4 o;
        o.x = pack2(x[q * 8 + 0] * rstd, x[q * 8 + 1] * rstd); o.y = pack2(x[q * 8 + 2] * rstd, x[q * 8 + 3] * rstd);
        o.z = pack2(x[q * 8 + 4] * rstd, x[q * 8 + 5] * rstd); o.w = pack2(x[q * 8 + 6] * rstd, x[q * 8 + 7] * rstd);
        *(u32x4*)(vn + tl * 512 + (((c >> 1) ^ (tl & 7)) << 5) + ((c & 1) << 4)) = o;
      }
    }
  }
  __syncthreads();
  const int qq = fr >> 2, pp = fr & 3;
#pragma unroll 1
  for (int hh = 0; hh < 4; ++hh) {
    f32x4 acc[4][2];
#pragma unroll
    for (int df = 0; df < 4; ++df) { acc[df][0] = (f32x4){0.f, 0.f, 0.f, 0.f}; acc[df][1] = (f32x4){0.f, 0.f, 0.f, 0.f}; }
    const bf16_t* wb = p.wsp_b() + ((size_t)(l * 4 + hh) * 128) * 128;
    u32x2 wlo[4][2], whi[4][2], uu[2][4]; float bias[2];
#pragma unroll
    for (int kb = 0; kb < 4; ++kb)
#pragma unroll
      for (int f = 0; f < 2; ++f) { const bf16_t* wr = wb + (size_t)((2 * w + f) * 16 + fr) * 128 + kb * 32 + fq * 4; wlo[kb][f] = *(const u32x2*)wr; whi[kb][f] = *(const u32x2*)(wr + 16); }
#pragma unroll
    for (int f = 0; f < 2; ++f) {
      const int tl = (2 * w + f) * 16 + fr;
      bias[f] = p.b_spatial[(l * 4 + hh) * 128 + tl];
#pragma unroll
      for (int df = 0; df < 4; ++df) uu[f][df] = *(const u32x2*)(p.proj() + (size_t)(t0 + tl) * NIN + 256 + hh * 64 + df * 16 + fq * 4);
    }
#pragma unroll
    for (int kb = 0; kb < 4; ++kb) {
      if (kb <= w) {
        bf16x8 wf[2];
#pragma unroll
        for (int f = 0; f < 2; ++f) { u32x4 u; u.x = wlo[kb][f].x; u.y = wlo[kb][f].y; u.z = whi[kb][f].x; u.w = whi[kb][f].y; wf[f] = __builtin_bit_cast(bf16x8, u); }
#pragma unroll
        for (int df = 0; df < 4; ++df) {
          const int keyA = kb * 32 + fq * 4 + qq, keyB = keyA + 16;
          const int slot = hh * 4 + df;
          const s16x4 lo = __builtin_amdgcn_ds_read_tr16_b64_v4i16((LAS s16x4*)(vn + keyA * 512 + ((slot ^ (keyA & 7)) << 5) + pp * 8));
          const s16x4 hi = __builtin_amdgcn_ds_read_tr16_b64_v4i16((LAS s16x4*)(vn + keyB * 512 + ((slot ^ (keyB & 7)) << 5) + pp * 8));
          bf16x8 vf; vf[0] = lo[0]; vf[1] = lo[1]; vf[2] = lo[2]; vf[3] = lo[3]; vf[4] = hi[0]; vf[5] = hi[1]; vf[6] = hi[2]; vf[7] = hi[3];
          acc[df][0] = __builtin_amdgcn_mfma_f32_16x16x32_bf16(vf, wf[0], acc[df][0], 0, 0, 0);
          acc[df][1] = __builtin_amdgcn_mfma_f32_16x16x32_bf16(vf, wf[1], acc[df][1], 0, 0, 0);
        }
      }
    }
#pragma unroll
    for (int f = 0; f < 2; ++f) {
      const int tl = (2 * w + f) * 16 + fr, t = t0 + tl;
#pragma unroll
      for (int df = 0; df < 4; ++df) {
        const int d = hh * 64 + df * 16 + fq * 4;
        const u32x2 u2 = uu[f][df];
        u32x2 o;
        o.x = pack2(gelu_tanh(bflo(u2.x)) * (acc[df][f][0] + bias[f]), gelu_tanh(bfhi(u2.x)) * (acc[df][f][1] + bias[f]));
        o.y = pack2(gelu_tanh(bflo(u2.y)) * (acc[df][f][2] + bias[f]), gelu_tanh(bfhi(u2.y)) * (acc[df][f][3] + bias[f]));
        *(u32x2*)(p.Y() + (size_t)t * 1024 + 256 + d) = o;
      }
    }
  }
}

DI void item_attn(const P& p, unsigned char* smem, int item) {
  const int tid = otid(), w = tid >> 6, lane = tid & 63;
  const int fr = lane & 15, fq = lane >> 4;
  const int rnd = item >> 9, blk = item & 511;
  const int qb = rnd == 0 ? 15 - (blk >> 6) : (blk >> 6);
  const int bh = blk & 63, b = bh >> 3, h = bh & 7;
  const int q0 = qb * 128;
  const int nkt = 2 * qb + 2;
  const bf16_t* Qg = p.Q() + (size_t)bh * 2048 * 96;
  const bf16_t* Kg = p.Kb() + (size_t)bh * 2048 * 96;
  const bf16_t* Vg = p.V() + (size_t)bh * 2048 * 64;
  int kkey[3], kdst[3], kc[3];
#pragma unroll
  for (int j = 0; j < 3; ++j) { const int id = tid + 256 * j; kkey[j] = id / 12; kc[j] = id % 12; kdst[j] = kkey[j] * 256 + ((kc[j] ^ (kkey[j] & 15)) << 4); }
  int vkey[2], vdst[2], vc[2];
#pragma unroll
  for (int j = 0; j < 2; ++j) { const int id = tid + 256 * j; vkey[j] = id >> 3; vc[j] = id & 7; vdst[j] = vkey[j] * 128 + (((vc[j] >> 1) ^ ((vkey[j] >> 1) & 3)) << 5) + ((vc[j] & 1) << 4); }
  bf16x8 qf[3][2];
#pragma unroll
  for (int ks = 0; ks < 3; ++ks)
#pragma unroll
    for (int f = 0; f < 2; ++f) qf[ks][f] = *(const bf16x8*)(Qg + (size_t)(q0 + 32 * w + 16 * f + fr) * 96 + ks * 32 + fq * 8);
  f32x4 o[4][2];
#pragma unroll
  for (int f = 0; f < 4; ++f) { o[f][0] = (f32x4){0.f, 0.f, 0.f, 0.f}; o[f][1] = (f32x4){0.f, 0.f, 0.f, 0.f}; }
  float mrun[2] = {-INFINITY, -INFINITY}, lrun[2] = {0.f, 0.f};
  u32x4 rk[3], rv[2];
  __syncthreads();
#pragma unroll
  for (int j = 0; j < 3; ++j) rk[j] = *(const u32x4*)(Kg + (size_t)kkey[j] * 96 + kc[j] * 8);
#pragma unroll
  for (int j = 0; j < 2; ++j) rv[j] = *(const u32x4*)(Vg + (size_t)vkey[j] * 64 + vc[j] * 8);
#pragma unroll
  for (int j = 0; j < 3; ++j) *(u32x4*)(smem + kdst[j]) = rk[j];
#pragma unroll
  for (int j = 0; j < 2; ++j) *(u32x4*)(smem + 32768 + vdst[j]) = rv[j];
  __syncthreads();
  const int rowmin = q0 + 32 * w;
  for (int kt = 0; kt < nkt; ++kt) {
    const int cur = kt & 1;
    const bool more = kt + 1 < nkt;
    if (more) {
      const int key0n = (kt + 1) * 64;
#pragma unroll
      for (int j = 0; j < 3; ++j) rk[j] = *(const u32x4*)(Kg + (size_t)(key0n + kkey[j]) * 96 + kc[j] * 8);
#pragma unroll
      for (int j = 0; j < 2; ++j) rv[j] = *(const u32x4*)(Vg + (size_t)(key0n + vkey[j]) * 64 + vc[j] * 8);
    }
    const int key0 = kt * 64;
    if (key0 <= rowmin + 31) {
      const unsigned char* Kl = smem + cur * 16384;
      const unsigned char* Vl = smem + 32768 + cur * 8192;
      f32x4 st[4][2];
#pragma unroll
      for (int kf = 0; kf < 4; ++kf) { st[kf][0] = (f32x4){0.f, 0.f, 0.f, 0.f}; st[kf][1] = (f32x4){0.f, 0.f, 0.f, 0.f}; }
#pragma unroll
      for (int ks = 0; ks < 3; ++ks)
#pragma unroll
        for (int kf = 0; kf < 4; ++kf) {
          const int key = kf * 16 + fr;
          const bf16x8 a = *(const bf16x8*)(Kl + key * 256 + (((ks * 4 + fq) ^ (key & 15)) << 4));
          st[kf][0] = __builtin_amdgcn_mfma_f32_16x16x32_bf16(a, qf[ks][0], st[kf][0], 0, 0, 0);
          st[kf][1] = __builtin_amdgcn_mfma_f32_16x16x32_bf16(a, qf[ks][1], st[kf][1], 0, 0, 0);
        }
      const bool needmask = (key0 + 63 > rowmin);
#pragma unroll
      for (int f = 0; f < 2; ++f) {
        const int qabs = rowmin + 16 * f + fr;
        if (needmask) {
#pragma unroll
          for (int kf = 0; kf < 4; ++kf)
#pragma unroll
            for (int r = 0; r < 4; ++r) { const int kabs = key0 + kf * 16 + fq * 4 + r; if (kabs > qabs) st[kf][f][r] = -INFINITY; }
        }
        float mx = st[0][f][0];
#pragma unroll
        for (int kf = 0; kf < 4; ++kf)
#pragma unroll
          for (int r = 0; r < 4; ++r) mx = fmaxf(mx, st[kf][f][r]);
        mx = fmaxf(mx, __shfl_xor(mx, 16)); mx = fmaxf(mx, __shfl_xor(mx, 32));
        const float mnew = fmaxf(mrun[f], mx);
        const float alpha = __builtin_amdgcn_exp2f(mrun[f] - mnew);
        mrun[f] = mnew;
        float ls = 0.f;
#pragma unroll
        for (int kf = 0; kf < 4; ++kf)
#pragma unroll
          for (int r = 0; r < 4; ++r) { const float pv = __builtin_amdgcn_exp2f(st[kf][f][r] - mnew); st[kf][f][r] = pv; ls += pv; }
        lrun[f] = lrun[f] * alpha + ls;
#pragma unroll
        for (int df = 0; df < 4; ++df) o[df][f] = o[df][f] * alpha;
      }
      bf16x8 pf[2][2];
#pragma unroll
      for (int kb = 0; kb < 2; ++kb)
#pragma unroll
        for (int f = 0; f < 2; ++f) {
          u32x4 u;
          u.x = pack2(st[2 * kb][f][0], st[2 * kb][f][1]); u.y = pack2(st[2 * kb][f][2], st[2 * kb][f][3]);
          u.z = pack2(st[2 * kb + 1][f][0], st[2 * kb + 1][f][1]); u.w = pack2(st[2 * kb + 1][f][2], st[2 * kb + 1][f][3]);
          pf[kb][f] = __builtin_bit_cast(bf16x8, u);
        }
      const int qq = fr >> 2, pp = fr & 3;
#pragma unroll
      for (int kb = 0; kb < 2; ++kb)
#pragma unroll
        for (int df = 0; df < 4; ++df) {
          const int keyA = kb * 32 + fq * 4 + qq, keyB = keyA + 16;
          const int offA = keyA * 128 + ((df ^ ((keyA >> 1) & 3)) << 5) + pp * 8;
          const int offB = keyB * 128 + ((df ^ ((keyB >> 1) & 3)) << 5) + pp * 8;
          const s16x4 lo = __builtin_amdgcn_ds_read_tr16_b64_v4i16((LAS s16x4*)(Vl + offA));
          const s16x4 hi = __builtin_amdgcn_ds_read_tr16_b64_v4i16((LAS s16x4*)(Vl + offB));
          bf16x8 vf; vf[0] = lo[0]; vf[1] = lo[1]; vf[2] = lo[2]; vf[3] = lo[3]; vf[4] = hi[0]; vf[5] = hi[1]; vf[6] = hi[2]; vf[7] = hi[3];
          o[df][0] = __builtin_amdgcn_mfma_f32_16x16x32_bf16(vf, pf[kb][0], o[df][0], 0, 0, 0);
          o[df][1] = __builtin_amdgcn_mfma_f32_16x16x32_bf16(vf, pf[kb][1], o[df][1], 0, 0, 0);
        }
    }
    if (more) {
      const int nx = cur ^ 1;
#pragma unroll
      for (int j = 0; j < 3; ++j) *(u32x4*)(smem + nx * 16384 + kdst[j]) = rk[j];
#pragma unroll
      for (int j = 0; j < 2; ++j) *(u32x4*)(smem + 32768 + nx * 8192 + vdst[j]) = rv[j];
    }
    __syncthreads();
  }
#pragma unroll
  for (int f = 0; f < 2; ++f) {
    float lt = lrun[f]; lt += __shfl_xor(lt, 16); lt += __shfl_xor(lt, 32);
    const float inv = 1.f / lt;
    const int t = b * 2048 + rowmin + 16 * f + fr;
#pragma unroll
    for (int df = 0; df < 4; ++df) {
      const f32x4 x = o[df][f] * inv;
      u32x2 ov; ov.x = pack2(x[0], x[1]); ov.y = pack2(x[2], x[3]);
      *(u32x2*)(p.Y() + (size_t)t * 1024 + 512 + h * 64 + df * 16 + fq * 4) = ov;
    }
  }
}

DI void item_p4(const P& p, unsigned char* smem, int l, int item) {
  const int m = item >> 3, nt = item & 7;
  const int tid = otid(), r_s = tid >> 3, c_s = tid & 7;
  unsigned ao[4], bo[4];
#pragma unroll
  for (int j = 0; j < 4; ++j) {
    const int row = r_s + 32 * j;
    ao[j] = (unsigned)(((m * 128 + row) * 1024 + c_s * 8) * 2);
    bo[j] = (unsigned)(((nt * 128 + row) * 1024 + c_s * 8) * 2);
  }
  const float* xin = (l == 0) ? p.x : p.out;
  float* xout = p.out;
  const float* mod = p.mod() + (size_t)l * 8 * 6144 + 2048;
  float* rowss = p.rowss();
  gemm128(smem, (const unsigned char*)p.Y(), ao, (const unsigned char*)p.wout_t(), bo, 16, [=](f32x4 (&acc)[4][4], int wm, int wn, int fr, int fq) {
#pragma unroll
    for (int i = 0; i < 4; ++i) {
      const int t = m * 128 + wm * 64 + i * 16 + fr, b = t >> 11;
      float ss = 0.f;
#pragma unroll
      for (int j = 0; j < 4; ++j) {
        const int n = nt * 128 + wn * 64 + j * 16 + fq * 4;
        const float4 xv = *(const float4*)(xin + (size_t)t * 1024 + n);
        const float4 g = *(const float4*)(mod + (size_t)b * 6144 + n);
        float4 ov = {xv.x + g.x * acc[i][j][0], xv.y + g.y * acc[i][j][1], xv.z + g.z * acc[i][j][2], xv.w + g.w * acc[i][j][3]};
        ss += ov.x * ov.x + ov.y * ov.y + ov.z * ov.z + ov.w * ov.w;
        *(float4*)(xout + (size_t)t * 1024 + n) = ov;
      }
      ss += __shfl_xor(ss, 16); ss += __shfl_xor(ss, 32);
      if (fq == 0) rowss[(size_t)t * 16 + nt * 2 + wn] = ss;
    }
  });
}

DI void item_p5(const P& p, unsigned char* smem, int l, int item) {
  const int tid = otid(), w = tid >> 6, lane = tid & 63, fr = lane & 15, fq = lane >> 4;
  const int tf = w >> 1, kh = w & 1;
  const int tb = item * 32 + tf * 16;
  const int t = tb + fr, b = (item * 32) >> 11;
  const float* xr = p.out + (size_t)t * 1024 + kh * 512 + fq * 8;
  float* mds = (float*)(smem + 32768);
  __syncthreads();
  {
    const float* md = p.mod() + ((size_t)l * 8 + b) * 6144 + 3072;
    for (int i = tid; i < 512; i += NTHREADS) *(float4*)(mds + i * 4) = *(const float4*)(md + i * 4);
  }
  float rstd;
  {
    const float4* rp = (const float4*)(p.rowss() + (size_t)t * 16);
    const float4 a = rp[0], c = rp[1], d = rp[2], e = rp[3];
    const float ss = ((a.x + a.y) + (a.z + a.w)) + ((c.x + c.y) + (c.z + c.w)) + ((d.x + d.y) + (d.z + d.w)) + ((e.x + e.y) + (e.z + e.w));
    rstd = rsqrtf(ss * (1.f / 1024.f) + EPS);
  }
  const bf16_t* whi = p.wr_hi() + (size_t)l * 65536 + (size_t)fr * 1024 + kh * 512 + fq * 8;
  bf16_t* hdst = p.h() + (size_t)t * 1024 + kh * 512 + fq * 8;
  f32x4 acc[4];
#pragma unroll
  for (int nf = 0; nf < 4; ++nf) acc[nf] = (f32x4){0.f, 0.f, 0.f, 0.f};
  bf16x8 w0[4], w1[4], w2[4], w3[4]; f32x4 xa0, xb0, xa1, xb1, xa2, xb2, xa3, xb3;
#define P5_LOAD(W, XA, XB, ks_) do { const int kn_ = (ks_) < 16 ? (ks_) : 15; _Pragma("unroll") for (int nf = 0; nf < 4; ++nf) W[nf] = *(const bf16x8*)(whi + (size_t)nf * 16384 + kn_ * 32); \
    XA = *(const f32x4*)(xr + kn_ * 32); XB = *(const f32x4*)(xr + kn_ * 32 + 4); } while (0)
#define P5_STEP(W, XA, XB, ks_) do { const int k0 = kh * 512 + (ks_) * 32 + fq * 8; \
    const f32x4 ha = *(const f32x4*)(mds + k0), hb = *(const f32x4*)(mds + k0 + 4), sa = *(const f32x4*)(mds + 1024 + k0), sb = *(const f32x4*)(mds + 1024 + k0 + 4); \
    const f32x4 va = XA * rstd * (sa + 1.f) + ha, vb = XB * rstd * (sb + 1.f) + hb; \
    u32x4 uh, ul; uh.x = pack2(va[0], va[1]); uh.y = pack2(va[2], va[3]); uh.z = pack2(vb[0], vb[1]); uh.w = pack2(vb[2], vb[3]); \
    ul.x = pack2(va[0] - bflo(uh.x), va[1] - bfhi(uh.x)); ul.y = pack2(va[2] - bflo(uh.y), va[3] - bfhi(uh.y)); \
    ul.z = pack2(vb[0] - bflo(uh.z), vb[1] - bfhi(uh.z)); ul.w = pack2(vb[2] - bflo(uh.w), vb[3] - bfhi(uh.w)); \
    *(u32x4*)(hdst + (ks_) * 32) = uh; \
    const bf16x8 bh = __builtin_bit_cast(bf16x8, uh), bl = __builtin_bit_cast(bf16x8, ul); \
    _Pragma("unroll") for (int nf = 0; nf < 4; ++nf) { acc[nf] = __builtin_amdgcn_mfma_f32_16x16x32_bf16(W[nf], bh, acc[nf], 0, 0, 0); acc[nf] = __builtin_amdgcn_mfma_f32_16x16x32_bf16(W[nf], bl, acc[nf], 0, 0, 0); } } while (0)
  P5_LOAD(w0, xa0, xb0, 0); P5_LOAD(w1, xa1, xb1, 1); P5_LOAD(w2, xa2, xb2, 2);
  __syncthreads();
#pragma unroll 1
  for (int ks = 0; ks < 16; ks += 4) {
    P5_LOAD(w3, xa3, xb3, ks + 3); P5_STEP(w0, xa0, xb0, ks);
    P5_LOAD(w0, xa0, xb0, ks + 4); P5_STEP(w1, xa1, xb1, ks + 1);
    P5_LOAD(w1, xa1, xb1, ks + 5); P5_STEP(w2, xa2, xb2, ks + 2);
    P5_LOAD(w2, xa2, xb2, ks + 6); P5_STEP(w3, xa3, xb3, ks + 3);
  }
#undef P5_LOAD
#undef P5_STEP
  float* red = (float*)smem;
  int* info = (int*)(smem + 16384) + w * 512;
  int* cntw = (int*)(smem + 24576);
#pragma unroll
  for (int nf = 0; nf < 4; ++nf) *(f32x4*)(red + w * 1024 + fr * 64 + nf * 16 + fq * 4) = acc[nf];
  __syncthreads();
  const float bias = p.router_bias[l * 64 + lane];
  int cnt_local = 0;
  const int tq0 = kh * 8;
#pragma unroll 1
  for (int q = 0; q < 8; ++q) {
    const float lgt = red[(tf * 2) * 1024 + (tq0 + q) * 64 + lane] + red[(tf * 2 + 1) * 1024 + (tq0 + q) * 64 + lane];
    const float s = __builtin_amdgcn_rcpf(1.f + __expf(-lgt));
    const float sel = s + bias;
    const float m1 = max8(sel);
    const unsigned long long eq = __ballot(sel == m1);
    const int gbase = lane & ~7;
    const unsigned gm = (unsigned)((eq >> gbase) & 0xffull);
    const int first = gbase + __ffs(gm) - 1;
    const float m2 = max8((lane == first) ? -INFINITY : sel);
    const float gs = m1 + m2;
    const int myg = lane >> 3; int rank = 0;
#pragma unroll
    for (int j = 0; j < 8; ++j) { const float gj = __int_as_float(__builtin_amdgcn_readlane(__float_as_int(gs), j * 8)); rank += ((gj > gs) || (gj == gs && j < myg)) ? 1 : 0; }
    const bool gsel = rank < 4;
    const unsigned sb = (unsigned)__float_as_int(sel);
    const unsigned okey = (sb & 0x80000000u) ? ~sb : (sb | 0x80000000u);
    const unsigned key = gsel ? ((okey & ~63u) | (unsigned)(63 - lane)) : 0u;
    unsigned thr = 0u;
#pragma unroll
    for (int bit = 31; bit >= 0; --bit) {
      const unsigned cand = thr | (1u << bit);
      const int n = __popcll(__ballot(key >= cand));
      thr = (n >= 8) ? cand : thr;
    }
    const bool ch = key >= thr;
    const float tot = wsum(ch ? s : 0.f);
    const unsigned long long cm = __ballot(ch);
    const int kidx = __popcll(cm & ((1ull << lane) - 1ull));
    info[q * 64 + lane] = ch ? kidx : -1;
    if (ch) p.topw()[(size_t)(tb + tq0 + q) * 8 + kidx] = s * __builtin_amdgcn_rcpf(tot) * 2.5f;
    cnt_local += ch ? 1 : 0;
  }
  cntw[w * 64 + lane] = cnt_local;
  __syncthreads();
  if (w == 0) {
    const int tot = cntw[lane] + cntw[64 + lane] + cntw[128 + lane] + cntw[192 + lane];
    int bs = 0;
    if (tot > 0) bs = atomicAdd(p.cnt() + (l * 64 + lane) * CSTRIDE, tot);
    cntw[256 + lane] = bs;
  }
  __syncthreads();
  int base = cntw[256 + lane];
#pragma unroll
  for (int ww = 0; ww < 3; ++ww) base += (ww < w) ? cntw[ww * 64 + lane] : 0;
#pragma unroll 1
  for (int q = 0; q < 8; ++q) {
    const int k = info[q * 64 + lane];
    if (k >= 0) { p.list()[(size_t)lane * LISTCAP + base] = (tb + tq0 + q) * 8 + k; ++base; }
  }
}

DI void moe_table(const P& p, unsigned char* smem, int l) {
  int* start = (int*)(smem + SMEM_MAIN);
  __syncthreads();
  if (otid() == 0) {
    int s = 0;
    for (int e = 0; e < 64; ++e) { start[e] = s; s += (p.cnt()[(l * 64 + e) * CSTRIDE] + 127) >> 7; }
    start[64] = s;
  }
  __syncthreads();
}
DI void moe_rows(const P& p, unsigned char* smem, int l, int mt, int& e_out) {
  const int* start = (const int*)(smem + SMEM_MAIN);
  int* rowinfo = (int*)(smem + SMEM_MAIN + 512);
  const int tid = otid();
  int e;
  if (mt >= start[64]) { e = 64; if (tid < 128) rowinfo[tid] = T_ * 8 + (mt - start[64]) * 128 + tid; }
  else {
    e = 0;
    for (int q = 1; q < 64; ++q) e = (start[q] <= mt) ? q : e;
    const int tl = mt - start[e];
    const int cnt = p.cnt()[(l * 64 + e) * CSTRIDE];
    if (tid < 128) { const int idx = tl * 128 + tid; rowinfo[tid] = idx < cnt ? p.list()[(size_t)e * LISTCAP + idx] : -1; }
  }
  e_out = e;
}

DI void item_p7(const P& p, unsigned char* smem, int l, int item) {
  const int mt = item >> 2, nt = item & 3;
  const int tid = otid(), r_s = tid >> 3, c_s = tid & 7;
  int* rowinfo = (int*)(smem + SMEM_MAIN + 512);
  __syncthreads();
  int e; moe_rows(p, smem, l, mt, e);
  __syncthreads();
  const bf16_t* wbase = (e == 64) ? p.wsg_t() : p.wgu_t() + (size_t)e * 512 * 1024;
  unsigned ao[4], bo[4];
#pragma unroll
  for (int j = 0; j < 4; ++j) {
    const int row = r_s + 32 * j;
    const int slot = rowinfo[row];
    const int tok = slot < 0 ? 0 : (slot >= T_ * 8 ? slot - T_ * 8 : slot >> 3);
    ao[j] = (unsigned)((tok * 1024 + c_s * 8) * 2);
    bo[j] = (unsigned)(((nt * 128 + row) * 1024 + c_s * 8) * 2);
  }
  bf16_t* act = p.act();
  gemm128(smem, (const unsigned char*)p.h(), ao, (const unsigned char*)wbase, bo, 16, [=](f32x4 (&acc)[4][4], int wm, int wn, int fr, int fq) {
    unsigned char* ob = smem + wm * 8192;
#pragma unroll
    for (int i = 0; i < 4; ++i) {
#pragma unroll
      for (int jj = 0; jj < 2; ++jj) {
        const f32x4 g = acc[i][2 * jj], u = acc[i][2 * jj + 1];
        u32x2 o; o.x = pack2(silu_f(g[0]) * u[0], silu_f(g[1]) * u[1]); o.y = pack2(silu_f(g[2]) * u[2], silu_f(g[3]) * u[3]);
        ot_put<128>(ob, i * 16 + fr, wn * 8 + jj * 4 + fq, o);
      }
    }
    __syncthreads();
    {
      const int tid2 = fq * 16 + fr + 64 * (wm * 2 + wn);
      const int chunk = tid2 & 7;
#pragma unroll
      for (int i = 0; i < 4; ++i) {
        const int row = (tid2 >> 3) + 32 * i;
        const int slot = rowinfo[row];
        if (slot >= 0) {
          const u32x4 v = ot_get<128>(smem + (row >> 6) * 8192, row & 63, chunk);
          *(u32x4*)(act + (size_t)slot * 256 + nt * 64 + chunk * 8) = v;
        }
      }
    }
  });
}

DI void item_p8(const P& p, unsigned char* smem, int l, int item) {
  const int mt = item >> 1, nh = item & 1;
  const int tid = otid(), r_s = tid >> 3, c_s = tid & 7;
  int* rowinfo = (int*)(smem + SMEM_MAIN + 512);
  __syncthreads();
  int e; moe_rows(p, smem, l, mt, e);
  __syncthreads();
  const bf16_t* wbase = (e == 64) ? p.wsd_t() : p.wd_t() + (size_t)e * 1024 * 256;
  unsigned ao[4], bo[4];
#pragma unroll
  for (int j = 0; j < 4; ++j) {
    const int row = r_s + 32 * j;
    const int slot = rowinfo[row];
    ao[j] = (unsigned)(((slot < 0 ? 0 : slot) * 256 + c_s * 8) * 2);
    bo[j] = (unsigned)(((nh * 512 + row) * 256 + c_s * 8) * 2);
  }
  bf16_t* yrows = p.yrows(); bf16_t* ysh = p.ysh(); const float* topw = p.topw();
  gemm128_stream(smem, (const unsigned char*)p.act(), ao, (const unsigned char*)wbase, bo, 4, 4, (size_t)128 * 256, [=](f32x4 (&acc)[4][4], int tile, int cur, int wm, int wn, int fr, int fq) {
    const int nt = nh * 4 + tile;
    unsigned char* ob = smem + cur + (wm ? 32768 : 0);
    __syncthreads();
#pragma unroll
    for (int i = 0; i < 4; ++i) {
      const int slot = rowinfo[wm * 64 + i * 16 + fr];
      const float wv = (slot < 0 || slot >= T_ * 8) ? 1.f : topw[slot];
#pragma unroll
      for (int j = 0; j < 4; ++j) {
        const f32x4 x = acc[i][j] * wv;
        u32x2 o; o.x = pack2(x[0], x[1]); o.y = pack2(x[2], x[3]);
        ot_put<256>(ob, i * 16 + fr, wn * 16 + j * 4 + fq, o);
      }
    }
    __syncthreads();
    {
      const int tid2 = fq * 16 + fr + 64 * (wm * 2 + wn);
      const int chunk = tid2 & 15;
#pragma unroll
      for (int i = 0; i < 8; ++i) {
        const int row = (tid2 >> 4) + 16 * i;
        const int slot = rowinfo[row];
        if (slot >= 0) {
          const u32x4 v = ot_get<256>(smem + cur + ((row >> 6) ? 32768 : 0), row & 63, chunk);
          bf16_t* dst = (slot >= T_ * 8) ? ysh + (size_t)(slot - T_ * 8) * 1024 : yrows + (size_t)slot * 1024;
          *(u32x4*)(dst + nt * 128 + chunk * 8) = v;
        }
      }
    }
  });
}

struct P9Regs { u32x4 yk[8]; u32x4 ysh0, ysh1; };
DI void p9_load(const P& p, int t, int c0, P9Regs& R) {
  const unsigned char* yr = (const unsigned char*)p.yrows() + (size_t)t * 8 * 1024 + c0;
#pragma unroll
  for (int k = 0; k < 8; ++k) R.yk[k] = *(const u32x4*)(yr + k * 1024);
  R.ysh0 = *(const u32x4*)(p.ysh() + (size_t)t * 1024 + c0); R.ysh1 = *(const u32x4*)(p.ysh() + (size_t)t * 1024 + c0 + 8);
}
DI void p9_finish(const P& p, int l, int t, int c0, const P9Regs& R) {
  const int b = t >> 11;
  const float* md = p.mod() + ((size_t)l * 8 + b) * 6144;
  f32x4 xv[4];
#pragma unroll
  for (int q = 0; q < 4; ++q) xv[q] = *(const f32x4*)(p.out + (size_t)t * 1024 + c0 + q * 4);
  float a[16];
  a[0] = bflo(R.ysh0.x); a[1] = bfhi(R.ysh0.x); a[2] = bflo(R.ysh0.y); a[3] = bfhi(R.ysh0.y); a[4] = bflo(R.ysh0.z); a[5] = bfhi(R.ysh0.z); a[6] = bflo(R.ysh0.w); a[7] = bfhi(R.ysh0.w);
  a[8] = bflo(R.ysh1.x); a[9] = bfhi(R.ysh1.x); a[10] = bflo(R.ysh1.y); a[11] = bfhi(R.ysh1.y); a[12] = bflo(R.ysh1.z); a[13] = bfhi(R.ysh1.z); a[14] = bflo(R.ysh1.w); a[15] = bfhi(R.ysh1.w);
  float r[16];
#pragma unroll
  for (int e = 0; e < 16; ++e) r[e] = 0.f;
#pragma unroll
  for (int k = 0; k < 8; ++k) {
#pragma unroll
    for (int q = 0; q < 4; ++q) {
      const f32x2 lo = __builtin_amdgcn_cvt_pk_f32_fp8((int)R.yk[k][q], false), hi = __builtin_amdgcn_cvt_pk_f32_fp8((int)R.yk[k][q], true);
      r[q * 4 + 0] += lo.x; r[q * 4 + 1] += lo.y; r[q * 4 + 2] += hi.x; r[q * 4 + 3] += hi.y;
    }
  }
  float v[16]; float ss = 0.f;
#pragma unroll
  for (int q = 0; q < 4; ++q) {
    const f32x4 g = *(const f32x4*)(md + 5120 + c0 + q * 4);
#pragma unroll
    for (int e = 0; e < 4; ++e) { v[q * 4 + e] = xv[q][e] + g[e] * (a[q * 4 + e] + r[q * 4 + e] * (1.f / YSCALE)); ss += v[q * 4 + e] * v[q * 4 + e]; }
  }
  ss = wsum(ss);
  const float rstd = rsqrtf(ss * (1.f / 1024.f) + EPS);
  if (l == 0) {
    const float* md1 = p.mod() + ((size_t)8 + b) * 6144;
    unsigned hw[8];
#pragma unroll
    for (int q = 0; q < 4; ++q) {
      *(f32x4*)(p.out + (size_t)t * 1024 + c0 + q * 4) = (f32x4){v[q * 4 + 0], v[q * 4 + 1], v[q * 4 + 2], v[q * 4 + 3]};
      const f32x4 sh = *(const f32x4*)(md1 + c0 + q * 4), sc = *(const f32x4*)(md1 + 1024 + c0 + q * 4);
      hw[q * 2 + 0] = pack2(v[q * 4 + 0] * rstd * (1.f + sc[0]) + sh[0], v[q * 4 + 1] * rstd * (1.f + sc[1]) + sh[1]);
      hw[q * 2 + 1] = pack2(v[q * 4 + 2] * rstd * (1.f + sc[2]) + sh[2], v[q * 4 + 3] * rstd * (1.f + sc[3]) + sh[3]);
    }
    *(u32x4*)(p.h() + (size_t)t * 1024 + c0) = (u32x4){hw[0], hw[1], hw[2], hw[3]};
    *(u32x4*)(p.h() + (size_t)t * 1024 + c0 + 8) = (u32x4){hw[4], hw[5], hw[6], hw[7]};
  } else {
#pragma unroll
    for (int q = 0; q < 4; ++q) {
      const f32x4 fg = *(const f32x4*)(p.final_gain + c0 + q * 4);
      *(f32x4*)(p.out + (size_t)t * 1024 + c0 + q * 4) = (f32x4){v[q * 4 + 0] * rstd * fg[0], v[q * 4 + 1] * rstd * fg[1], v[q * 4 + 2] * rstd * fg[2], v[q * 4 + 3] * rstd * fg[3]};
    }
  }
}
DI void p9_loop(const P& p, int l, int gw, int nw) {
  const int lane = otid() & 63, c0 = lane * 16;
  P9Regs A, B;
  int t = gw;
  if (t >= T_) return;
  p9_load(p, t, c0, A);
  for (; t < T_; t += 2 * nw) {
    const int t1 = t + nw;
    p9_load(p, t1 < T_ ? t1 : t, c0, B);
    p9_finish(p, l, t, c0, A);
    if (t1 >= T_) break;
    const int t2 = t1 + nw;
    p9_load(p, t2 < T_ ? t2 : t1, c0, A);
    p9_finish(p, l, t1, c0, B);
  }
}

DI int xcd_vb(int bid, int G) { return ((G & 7) == 0) ? (bid & 7) * (G >> 3) + (bid >> 3) : bid; }

DI void phase_p1(const P& p, LAS unsigned char* lds, int G, int bid) {
  t8::DenseSched S; S.init(T_, 1280, 1024, G, bid, p.win_t());
  t8::DenseRows RO{2048u};
  bf16_t* proj = p.proj(); float* rsq = p.rsq();
  t8::gemm_phase<true>(lds, (const unsigned char*)p.h(), 1024, S, RO, [=](const f32x4 (&acc)[2][2][4][2], const t8::Unit& u, int wr, int wc, int fr, int fq) {
    const int c0 = u.pn * 256 + wc * 64 + fq * 16;
    const bool want_ss = (u.pn == 3) || (u.pn == 4 && wc < 2);
#pragma unroll
    for (int ai = 0; ai < 2; ++ai)
#pragma unroll
      for (int m = 0; m < 4; ++m) {
        const int r = u.pm * 256 + ai * 128 + wr * 64 + m * 16 + fr;
        if (want_ss) {
          float ss = 0.f;
#pragma unroll
          for (int bj = 0; bj < 2; ++bj)
#pragma unroll
            for (int n = 0; n < 2; ++n) { const f32x4 a = acc[ai][bj][m][n]; ss += a[0] * a[0] + a[1] * a[1] + a[2] * a[2] + a[3] * a[3]; }
          ss += __shfl_xor(ss, 16); ss += __shfl_xor(ss, 32);
          if (fq == 0) rsq[(size_t)r * 8 + (u.pn == 3 ? wc : 4 + wc)] = ss;
        }
        if (c0 < NIN) {
#pragma unroll
          for (int bj = 0; bj < 2; ++bj) {
            const f32x4 v0 = acc[ai][bj][m][0], v1 = acc[ai][bj][m][1];
            u32x4 o; o.x = pack2(v0[0], v0[1]); o.y = pack2(v0[2], v0[3]); o.z = pack2(v1[0], v1[1]); o.w = pack2(v1[2], v1[3]);
            *(u32x4*)(proj + (size_t)r * NIN + c0 + bj * 8) = o;
          }
        }
        asm volatile("" ::: "memory");
      }
  });
}

DI void phase_p4(const P& p, LAS unsigned char* lds, int l, int G, int bid) {
  t8::DenseSched S; S.init(T_, 1024, 1024, G, bid, p.wout_t());
  t8::DenseRows RO{2048u};
  const float* xin = (l == 0) ? p.x : p.out; float* xout = p.out;
  const float* mod = p.mod() + (size_t)l * 8 * 6144 + 2048;
  float* rowss = p.rowss();
  t8::gemm_phase<true>(lds, (const unsigned char*)p.Y(), 1024, S, RO, [=](const f32x4 (&acc)[2][2][4][2], const t8::Unit& u, int wr, int wc, int fr, int fq) {
    float4 xq[2][4];
    const int cbase = u.pn * 256 + wc * 64 + fq * 16;
    float4 gq[4];
#pragma unroll
    for (int q = 0; q < 4; ++q) gq[q] = *(const float4*)(mod + (size_t)((u.pm * 256) >> 11) * 6144 + cbase + q * 4);
    {
      const int r0 = u.pm * 256 + wr * 64 + fr;
#pragma unroll
      for (int q = 0; q < 4; ++q) xq[0][q] = *(const float4*)(xin + (size_t)r0 * 1024 + cbase + q * 4);
    }
#pragma unroll
    for (int ai = 0; ai < 2; ++ai)
#pragma unroll
      for (int m = 0; m < 4; ++m) {
        const int it = ai * 4 + m;
        const int r = u.pm * 256 + ai * 128 + wr * 64 + m * 16 + fr, b = r >> 11;
        if (it < 7) {
          const int rn = u.pm * 256 + ((it + 1) >> 2) * 128 + wr * 64 + ((it + 1) & 3) * 16 + fr;
#pragma unroll
          for (int q = 0; q < 4; ++q) xq[(it + 1) & 1][q] = *(const float4*)(xin + (size_t)rn * 1024 + cbase + q * 4);
        }
        float ss = 0.f;
#pragma unroll
        for (int bj = 0; bj < 2; ++bj)
#pragma unroll
          for (int n = 0; n < 2; ++n) {
            const int c0 = cbase + bj * 8 + n * 4;
            const float4 xv = xq[it & 1][bj * 2 + n];
            const float4 g = gq[bj * 2 + n];
            const f32x4 a = acc[ai][bj][m][n];
            float4 ov = {xv.x + g.x * a[0], xv.y + g.y * a[1], xv.z + g.z * a[2], xv.w + g.w * a[3]};
            ss += ov.x * ov.x + ov.y * ov.y + ov.z * ov.z + ov.w * ov.w;
            *(float4*)(xout + (size_t)r * 1024 + c0) = ov;
          }
        ss += __shfl_xor(ss, 16); ss += __shfl_xor(ss, 32);
        if (fq == 0) rowss[(size_t)r * 16 + u.pn * 4 + wc] = ss;
      }
  });
}

struct RowsP7 { LAS const int* tab; DI unsigned operator()(const t8::Unit& u, int row) const { const int slot = tab[u.tab * 256 + row]; const int tok = slot < 0 ? 0 : (slot >= T_ * 8 ? slot - T_ * 8 : slot >> 3); return (unsigned)tok * 2048u; } };
struct RowsP8 { LAS const int* tab; DI unsigned operator()(const t8::Unit& u, int row) const { const int slot = tab[u.tab * 256 + row]; return (unsigned)(slot < 0 ? 0 : slot) * 512u; } };

DI void phase_p7(const P& p, LAS unsigned char* lds, int l, int G, int bid) {
  int total; const int c = xcd_vb(bid, G);
  moe_prepare(p, lds, l, 2, G, c, total);
  t8::MoeSched S{(LAS const int*)(lds + t8::START_OFF), 2, total, G, c, (const unsigned char*)p.wgu_t(), (const unsigned char*)p.wsg_t(), (size_t)512 * 1024 * 2, (size_t)256 * 1024 * 2};
  RowsP7 RO{(LAS const int*)(lds + t8::TAB_OFF)};
  LAS const int* tab = (LAS const int*)(lds + t8::TAB_OFF);
  bf16_t* act = p.act();
  t8::gemm_phase<true>(lds, (const unsigned char*)p.h(), 1024, S, RO, [=](const f32x4 (&acc)[2][2][4][2], const t8::Unit& u, int wr, int wc, int fr, int fq) {
#pragma unroll
    for (int ai = 0; ai < 2; ++ai)
#pragma unroll
      for (int m = 0; m < 4; ++m) {
        const int slot = tab[u.tab * 256 + ai * 128 + wr * 64 + m * 16 + fr];
        if (slot >= 0) {
          const f32x4 g0 = acc[ai][0][m][0], g1 = acc[ai][0][m][1], u0 = acc[ai][1][m][0], u1 = acc[ai][1][m][1];
          u32x4 o;
          o.x = pack2(silu_f(g0[0]) * u0[0], silu_f(g0[1]) * u0[1]); o.y = pack2(silu_f(g0[2]) * u0[2], silu_f(g0[3]) * u0[3]);
          o.z = pack2(silu_f(g1[0]) * u1[0], silu_f(g1[1]) * u1[1]); o.w = pack2(silu_f(g1[2]) * u1[2], silu_f(g1[3]) * u1[3]);
          *(u32x4*)(act + (size_t)slot * 256 + u.pn * 128 + wc * 32 + fq * 8) = o;
        }
        asm volatile("" ::: "memory");
      }
  });
}

DI void phase_p8(const P& p, LAS unsigned char* lds, int l, int G, int bid) {
  int total; const int c = xcd_vb(bid, G);
  moe_prepare(p, lds, l, 4, G, c, total, true);
  t8::MoeSched S{(LAS const int*)(lds + t8::START_OFF), 4, total, G, c, (const unsigned char*)p.wd_t(), (const unsigned char*)p.wsd_t(), (size_t)1024 * 256 * 2, (size_t)256 * 256 * 2};
  RowsP8 RO{(LAS const int*)(lds + t8::TAB_OFF)};
  LAS const int* tab = (LAS const int*)(lds + t8::TAB_OFF);
  unsigned char* yrows = (unsigned char*)p.yrows(); bf16_t* ysh = p.ysh(); const float* topw = p.topw();
  t8::gemm_phase<true>(lds, (const unsigned char*)p.act(), 256, S, RO, [=](const f32x4 (&acc)[2][2][4][2], const t8::Unit& u, int wr, int wc, int fr, int fq) {
    int slots[2][4]; float wvs[2][4];
#pragma unroll
    for (int ai = 0; ai < 2; ++ai)
#pragma unroll
      for (int m = 0; m < 4; ++m) slots[ai][m] = tab[u.tab * 256 + ai * 128 + wr * 64 + m * 16 + fr];
#pragma unroll
    for (int ai = 0; ai < 2; ++ai)
#pragma unroll
      for (int m = 0; m < 4; ++m) wvs[ai][m] = ((LAS const float*)tab)[(6 + u.tab) * 256 + ai * 128 + wr * 64 + m * 16 + fr];
    const int c0 = u.pn * 256 + wc * 64 + fq * 16;
#pragma unroll
    for (int ai = 0; ai < 2; ++ai)
#pragma unroll
      for (int m = 0; m < 4; ++m) {
        const int slot = slots[ai][m];
        if (slot >= 0) {
          const float wv = wvs[ai][m];
          if (slot >= T_ * 8) {
            bf16_t* dst = ysh + (size_t)(slot - T_ * 8) * 1024 + c0;
#pragma unroll
            for (int bj = 0; bj < 2; ++bj) {
              const f32x4 v0 = acc[ai][bj][m][0], v1 = acc[ai][bj][m][1];
              u32x4 o; o.x = pack2(v0[0], v0[1]); o.y = pack2(v0[2], v0[3]); o.z = pack2(v1[0], v1[1]); o.w = pack2(v1[2], v1[3]);
              *(u32x4*)(dst + bj * 8) = o;
            }
          } else {
            u32x4 o;
            o.x = pack4_fp8(acc[ai][0][m][0] * wv); o.y = pack4_fp8(acc[ai][0][m][1] * wv); o.z = pack4_fp8(acc[ai][1][m][0] * wv); o.w = pack4_fp8(acc[ai][1][m][1] * wv);
            *(u32x4*)(yrows + (size_t)slot * 1024 + c0) = o;
          }
        }
        asm volatile("" ::: "memory");
      }
  });
}


DI void phase_kvproj(const P& p, LAS unsigned char* lds, int G, int bid) {
  t8::DenseSched S; S.init(T_, 1024, 256, G, bid, p.wukv_t());
  t8::DenseRows RO{(unsigned)(NIN * 2)};
  bf16_t* Kb = p.Kb(); bf16_t* V = p.V(); const float* rsq = p.rsq();
  t8::gemm_phase<true>(lds, (const unsigned char*)(p.proj() + 1024), 256, S, RO, [=](const f32x4 (&acc)[2][2][4][2], const t8::Unit& u, int wr, int wc, int fr, int fq) {
    const int head = u.pn * 2 + (wc >> 1), d0 = (wc & 1) * 64 + fq * 16;
    f32x2 rq[2][4];
#pragma unroll
    for (int ai = 0; ai < 2; ++ai)
#pragma unroll
      for (int m = 0; m < 4; ++m) rq[ai][m] = *(const f32x2*)(rsq + (size_t)(u.pm * 256 + ai * 128 + wr * 64 + m * 16 + fr) * 8 + 4);
#pragma unroll
    for (int ai = 0; ai < 2; ++ai)
#pragma unroll
      for (int m = 0; m < 4; ++m) {
        const int t = u.pm * 256 + ai * 128 + wr * 64 + m * 16 + fr, b = t >> 11, sq = t & 2047;
        const float rs = rsqrtf((rq[ai][m][0] + rq[ai][m][1]) * (1.f / 128.f) + EPS);
        const size_t rowi = (size_t)((b * 8 + head) * 2048 + sq);
        bf16_t* dst = (d0 < 64) ? Kb + rowi * 96 + d0 : V + rowi * 64 + (d0 - 64);
#pragma unroll
        for (int bj = 0; bj < 2; ++bj) {
          const f32x4 v0 = acc[ai][bj][m][0] * rs, v1 = acc[ai][bj][m][1] * rs;
          u32x4 o; o.x = pack2(v0[0], v0[1]); o.y = pack2(v0[2], v0[3]); o.z = pack2(v1[0], v1[1]); o.w = pack2(v1[2], v1[3]);
          *(u32x4*)(dst + bj * 8) = o;
        }
        asm volatile("" ::: "memory");
      }
  });
}
DI void phase_qproj(const P& p, LAS unsigned char* lds, int G, int bid) {
  t8::DenseSched S; S.init(T_, 768, 256, G, bid, p.wuq_t());
  t8::DenseRows RO{(unsigned)(NIN * 2)};
  bf16_t* Q = p.Q(); const float* rsq = p.rsq(); const float* ropec = p.ropec(); const float* ropes = p.ropes();
  const float QS = 0.10206207261596577f * 1.4426950408889634f;
  t8::gemm_phase<false>(lds, (const unsigned char*)(p.proj() + 768), 256, S, RO, [=](const f32x4 (&acc)[2][2][4][2], const t8::Unit& u, int wr, int wc, int fr, int fq) {
    f32x4 pqs[2][4];
#pragma unroll
    for (int ai = 0; ai < 2; ++ai)
#pragma unroll
      for (int m = 0; m < 4; ++m) pqs[ai][m] = *(const f32x4*)(rsq + (size_t)(u.pm * 256 + ai * 128 + wr * 64 + m * 16 + fr) * 8);
    f32x4 csq[2], snq[2];
    { const int t0 = u.pm * 256 + wr * 64 + fr; csq[0] = *(const f32x4*)(ropec + (size_t)t0 * 16 + fq * 4); snq[0] = *(const f32x4*)(ropes + (size_t)t0 * 16 + fq * 4); }
#pragma unroll
    for (int ai = 0; ai < 2; ++ai)
#pragma unroll
      for (int m = 0; m < 4; ++m) {
        const int it = ai * 4 + m;
        const int t = u.pm * 256 + ai * 128 + wr * 64 + m * 16 + fr, b = t >> 11, sq = t & 2047;
        if (it < 7) { const int tn = u.pm * 256 + ((it + 1) >> 2) * 128 + wr * 64 + ((it + 1) & 3) * 16 + fr;
          csq[(it + 1) & 1] = *(const f32x4*)(ropec + (size_t)tn * 16 + fq * 4); snq[(it + 1) & 1] = *(const f32x4*)(ropes + (size_t)tn * 16 + fq * 4); }
        const f32x4 pq = pqs[ai][m];
        const float rs = rsqrtf(((pq[0] + pq[1]) + (pq[2] + pq[3])) * (1.f / 256.f) + EPS) * QS;
#pragma unroll
        for (int bj = 0; bj < 2; ++bj) {
          const int cg = u.pn * 256 + bj * 128 + wc * 32;
          const int head = cg / 96, d0 = cg - head * 96;
          bf16_t* dst = Q + ((size_t)((b * 8 + head) * 2048 + sq)) * 96 + d0 + fq * 4;
          const f32x4 x1 = acc[ai][bj][m][0] * rs, x2 = acc[ai][bj][m][1] * rs;
          u32x2 o1, o2;
          if (d0 == 64) {
            const f32x4 cs = csq[it & 1], sn = snq[it & 1];
            const f32x4 y1 = x1 * cs - x2 * sn, y2 = x2 * cs + x1 * sn;
            o1.x = pack2(y1[0], y1[1]); o1.y = pack2(y1[2], y1[3]); o2.x = pack2(y2[0], y2[1]); o2.y = pack2(y2[2], y2[3]);
          } else {
            o1.x = pack2(x1[0], x1[1]); o1.y = pack2(x1[2], x1[3]); o2.x = pack2(x2[0], x2[1]); o2.y = pack2(x2[2], x2[3]);
          }
          *(u32x2*)dst = o1; *(u32x2*)(dst + 16) = o2;
        }
        asm volatile("" ::: "memory");
      }
  });
}
DI void item_kpe(const P& p, int item) {
  const int tid = otid();
  const int t = item * 128 + (tid >> 1), half = tid & 1, b = t >> 11, sq = t & 2047;
  const bf16_t* kp = p.proj() + (size_t)t * NIN + 1152 + half * 8;
  const u32x4 a1 = *(const u32x4*)kp, a2 = *(const u32x4*)(kp + 16);
  const float* cp = p.ropec() + (size_t)t * 16 + half * 8; const float* sp = p.ropes() + (size_t)t * 16 + half * 8;
  const f32x4 c0 = *(const f32x4*)cp, c1 = *(const f32x4*)(cp + 4), s0 = *(const f32x4*)sp, s1 = *(const f32x4*)(sp + 4);
  const f32x4 x1a = {bflo(a1.x), bfhi(a1.x), bflo(a1.y), bfhi(a1.y)}, x1b = {bflo(a1.z), bfhi(a1.z), bflo(a1.w), bfhi(a1.w)};
  const f32x4 x2a = {bflo(a2.x), bfhi(a2.x), bflo(a2.y), bfhi(a2.y)}, x2b = {bflo(a2.z), bfhi(a2.z), bflo(a2.w), bfhi(a2.w)};
  const f32x4 y1a = x1a * c0 - x2a * s0, y1b = x1b * c1 - x2b * s1, y2a = x2a * c0 + x1a * s0, y2b = x2b * c1 + x1b * s1;
  u32x4 o1, o2;
  o1.x = pack2(y1a[0], y1a[1]); o1.y = pack2(y1a[2], y1a[3]); o1.z = pack2(y1b[0], y1b[1]); o1.w = pack2(y1b[2], y1b[3]);
  o2.x = pack2(y2a[0], y2a[1]); o2.y = pack2(y2a[2], y2a[3]); o2.z = pack2(y2b[0], y2b[1]); o2.w = pack2(y2b[2], y2b[3]);
#pragma unroll
  for (int head = 0; head < 8; ++head) {
    bf16_t* kd = p.Kb() + ((size_t)((b * 8 + head) * 2048 + sq)) * 96 + 64 + half * 8;
    *(u32x4*)kd = o1; *(u32x4*)(kd + 16) = o2;
  }
}

constexpr int HALF_LDS = SMEM_MAIN + SMEM_EXTRA;
#define PHASE_LOOP(n, ...) for (int base_ = 2 * bid; base_ < (n); base_ += 2 * G) { int it = base_ + half; it = it < (n) ? it : (n) - 1; __VA_ARGS__ }
__global__ void __launch_bounds__(BLOCK_THREADS, 2) fwd_megakernel(P p) {
  const __attribute__((address_space(4))) P* kp_ = (const __attribute__((address_space(4))) P*)__builtin_amdgcn_kernarg_segment_ptr();
  (void)p;
#define LP() ([&]() __attribute__((always_inline)) { const __attribute__((address_space(4))) P* q_ = kp_; asm volatile("" : "+s"(q_)); P r_; __builtin_memcpy(&r_, q_, sizeof(P)); return r_; }())

  __shared__ __attribute__((aligned(16))) unsigned char smem_all[t8::STAGE_BYTES + 16384 + 16 + 256];
  const int G = gridDim.x, bid = blockIdx.x;
  {
    LAS int* wtab = (LAS int*)(smem_all + WTAB_OFF);
    if ((threadIdx.x & 63) == 0) wtab[hw_slot()] = (int)(threadIdx.x >> 6);
    __syncthreads();
  }
  const int half = __builtin_amdgcn_readfirstlane(full_tid() >> 8);
  unsigned char* smem = smem_all + half * HALF_LDS;
  volatile LAS unsigned* stw = (volatile LAS unsigned*)(smem_all + t8::STAGE_BYTES + 16384);
  LAS unsigned char* lds8 = (LAS unsigned char*)smem_all;
  if (full_tid() == 0) { stw[0] = 0u; stw[1] = 0u; }
  __syncthreads();
  XcdBarrier bar = xcd_barrier_post(LP().bar(), stw);

  PHASE_LOOP(384 + 1024 + MISC_ITEMS + CONV_SMALL,
    if (it < 384) item_mod(LP(), smem, it);
    else if (it < 384 + 1024) item_rope(LP(), it - 384);
    else if (it < 384 + 1024 + MISC_ITEMS) item_misc(LP(), it - 384 - 1024);
    else item_conv(LP(), smem, 0, it - 384 - 1024 - MISC_ITEMS);
  )
  xcd_barrier(bar);
  PHASE_LOOP(T_ / 8, item_norm0(LP(), it);)
  xcd_barrier(bar);

  for (int l = 0; l < 2; ++l) {
    phase_p1(LP(), lds8, G, bid);
    xcd_barrier(bar);
    phase_kvproj(LP(), lds8, G, bid);
    phase_qproj(LP(), lds8, G, bid);
    __syncthreads();
    {
      const int rb = G - 1 - bid;
      for (int base_ = 2 * rb; base_ < 128 + 512 + 128; base_ += 2 * G) {
        const int it = base_ + half;
        if (it < 128) item_sgu(LP(), smem, l, it);
        else if (it < 640) item_pool(LP(), smem, l, it - 128);
        else item_kpe(LP(), it - 640);
      }
    }
    xcd_barrier(bar);
    if ((bid >> 3) & 1) { conv_big_loop(LP(), smem, l, 2 * bid + half, 2 * G); PHASE_LOOP(1024, item_attn(LP(), smem, it);) }
    else { PHASE_LOOP(1024, item_attn(LP(), smem, it);) conv_big_loop(LP(), smem, l, 2 * bid + half, 2 * G); }
    xcd_barrier(bar);
    phase_p4(LP(), lds8, l, G, bid);
    xcd_barrier(bar);
    PHASE_LOOP(512 + (l == 0 ? CONV_SMALL : 0), if (it < 512) item_p5(LP(), smem, l, it); else item_conv(LP(), smem, 1, it - 512);)
    xcd_barrier(bar);
    phase_p7(LP(), lds8, l, G, bid);
    xcd_barrier(bar);
    phase_p8(LP(), lds8, l, G, bid);
    xcd_barrier(bar);
    p9_loop(LP(), l, bid * 8 + (full_tid() >> 6), G * 8);
    if (l == 0) xcd_barrier(bar);
  }
}

extern "C" void kernel_launch(void* const* d_in, const int* in_sizes, int n_in, void* d_out, int out_size, void* d_ws, size_t ws_size,
                              hipStream_t stream) {
  P p{};
  p.x = (const float*)d_in[0]; p.c = (const float*)d_in[1]; p.pos = (const int*)d_in[2];
  p.w_ada = (const float*)d_in[3]; p.b_ada = (const float*)d_in[4]; p.w_in = (const float*)d_in[5]; p.w_pool = (const float*)d_in[6];
  p.pool_scale = (const float*)d_in[7]; p.w_spatial = (const float*)d_in[8]; p.b_spatial = (const float*)d_in[9]; p.g_q = (const float*)d_in[10];
  p.w_uq = (const float*)d_in[11]; p.g_kv = (const float*)d_in[12]; p.w_ukv = (const float*)d_in[13]; p.w_out = (const float*)d_in[14];
  p.w_router = (const float*)d_in[15]; p.router_bias = (const float*)d_in[16]; p.w_gate = (const float*)d_in[17]; p.w_up = (const float*)d_in[18];
  p.w_down = (const float*)d_in[19]; p.ws_gate = (const float*)d_in[20]; p.ws_up = (const float*)d_in[21]; p.ws_down = (const float*)d_in[22];
  p.final_gain = (const float*)d_in[23];
  p.out = (float*)d_out;
  p.ws = (unsigned char*)d_ws;
  if (WS_NEED > ws_size) { fprintf(stderr, "workspace too small: need %zu have %zu\n", WS_NEED, ws_size); return; }
  hipMemsetAsync(p.ws + O_BAR, 0, CTRL_BYTES, stream);
  static int grid_blocks = 0;
  if (!grid_blocks) {
    int dev = 0, cus = 0, per_cu = 0;
    hipGetDevice(&dev);
    hipDeviceGetAttribute(&cus, hipDeviceAttributeMultiprocessorCount, dev);
    hipOccupancyMaxActiveBlocksPerMultiprocessor(&per_cu, fwd_megakernel, BLOCK_THREADS, 0);
    if (per_cu > 1) per_cu = 1;
    if (per_cu < 1) per_cu = 1;
    grid_blocks = cus * per_cu;
  }
  void* args[] = {&p};
  hipError_t e = hipLaunchCooperativeKernel((void*)fwd_megakernel, dim3(grid_blocks), dim3(BLOCK_THREADS), args, 0, stream);
  if (e != hipSuccess) fprintf(stderr, "cooperative launch failed: %s (grid %d)\n", hipGetErrorString(e), grid_blocks);
}
```

```cpp
#include <hip/hip_runtime.h>
#include <stdint.h>
#include <cstdio>

#define DI __device__ __forceinline__
#define LAS __attribute__((address_space(3)))

typedef unsigned short bf16_t;
typedef short bf16x8 __attribute__((ext_vector_type(8)));
typedef short s16x4 __attribute__((ext_vector_type(4)));
typedef float f32x4 __attribute__((ext_vector_type(4)));
typedef float f32x2 __attribute__((ext_vector_type(2)));
typedef unsigned u32x4 __attribute__((ext_vector_type(4)));
typedef unsigned u32x2 __attribute__((ext_vector_type(2)));
typedef __bf16 bf16x2_t __attribute__((ext_vector_type(2)));

constexpr int T_ = 16384, D_ = 1024, S_ = 2048, NIN = 1184;
constexpr int NTHREADS = 256;
constexpr int BLOCK_THREADS = 512;
constexpr int SMEM_MAIN = 65536, SMEM_EXTRA = 2048;
constexpr float EPS = 1e-6f;
constexpr int CSTRIDE = 64;
constexpr int LISTCAP = 16384;
constexpr int CONV_SMALL = 592 + 24 + 16 + 128;
constexpr int CONV_BIG = 96 + 6144;
constexpr int CONV_ITEMS = CONV_SMALL + CONV_BIG;

constexpr size_t al256(size_t x) { return (x + 255) & ~(size_t)255; }
constexpr size_t CTRL_BYTES = (size_t)3456 * 4 + (size_t)2 * 64 * CSTRIDE * 4;
constexpr size_t O_BAR = 0;
constexpr size_t O_MOD = O_BAR + al256(CTRL_BYTES);
constexpr size_t O_ROPEC = O_MOD + al256((size_t)2 * 8 * 6144 * 4);
constexpr size_t O_ROPES = O_ROPEC + al256((size_t)T_ * 16 * 4);
constexpr size_t O_WIN = O_ROPES + al256((size_t)T_ * 16 * 4);
constexpr size_t O_WUQ = O_WIN + al256((size_t)1280 * 1024 * 2);
constexpr size_t O_WUKV = O_WUQ + al256((size_t)768 * 256 * 2);
constexpr size_t O_WOUT = O_WUKV + al256((size_t)1024 * 256 * 2);
constexpr size_t O_WSG = O_WOUT + al256((size_t)1024 * 1024 * 2);
constexpr size_t O_WSD = O_WSG + al256((size_t)512 * 1024 * 2);
constexpr size_t O_WSP = O_WSD + al256((size_t)1024 * 256 * 2);
constexpr size_t O_WPOOL = O_WSP + al256((size_t)2 * 4 * 128 * 128 * 2);
constexpr size_t O_WRHI = O_WPOOL + al256((size_t)2 * 4 * 64 * 64 * 2);
constexpr size_t O_WRLO = O_WRHI + al256((size_t)2 * 64 * 1024 * 2);
constexpr size_t O_WGU = O_WRLO + al256((size_t)2 * 64 * 1024 * 2);
constexpr size_t O_WD = O_WGU + al256((size_t)64 * 512 * 1024 * 2);
constexpr size_t O_H = O_WD + al256((size_t)64 * 1024 * 256 * 2);
constexpr size_t O_ACT = O_H + al256((size_t)T_ * 1024 * 2);
constexpr size_t O_YSH = O_ACT + al256((size_t)(T_ * 8 + T_) * 256 * 2);
constexpr size_t O_LIST = O_YSH + al256((size_t)T_ * 1024 * 2);
constexpr size_t O_TOPW = O_LIST + al256((size_t)64 * LISTCAP * 4);
constexpr size_t O_ROWSS = O_TOPW + al256((size_t)T_ * 8 * 4);
constexpr size_t O_XB = O_ROWSS + al256((size_t)T_ * 16 * 4);
constexpr size_t O_RSQ = O_XB + al256((size_t)T_ * 1024 * 2);
constexpr size_t O_BIG = O_RSQ + al256((size_t)T_ * 8 * 4);
constexpr size_t O_YROWS = O_BIG;
constexpr size_t O_PROJ = O_BIG;
constexpr size_t O_Q = O_PROJ + al256((size_t)T_ * NIN * 2);
constexpr size_t O_KB = O_Q + al256((size_t)T_ * 8 * 96 * 2);
constexpr size_t O_V = O_KB + al256((size_t)T_ * 8 * 96 * 2);
constexpr size_t O_Y = O_V + al256((size_t)T_ * 8 * 64 * 2);
constexpr size_t O_MIXEND = O_Y + al256((size_t)T_ * 1024 * 2);
constexpr size_t WS_NEED = (O_BIG + al256((size_t)T_ * 8 * 1024) > O_MIXEND) ? O_BIG + al256((size_t)T_ * 8 * 1024) : O_MIXEND;

struct P {
  const float *x, *c; const int* pos;
  const float *w_ada, *b_ada, *w_in, *w_pool, *pool_scale, *w_spatial, *b_spatial, *g_q, *w_uq, *g_kv, *w_ukv, *w_out,
      *w_router, *router_bias, *w_gate, *w_up, *w_down, *ws_gate, *ws_up, *ws_down, *final_gain;
  float* out;
  unsigned char* ws;
  DI unsigned* bar() const { return (unsigned*)(ws + O_BAR); }
  DI int* cnt() const { return (int*)(ws + O_BAR) + 3456; }
  DI float* mod() const { return (float*)(ws + O_MOD); }
  DI float* ropec() const { return (float*)(ws + O_ROPEC); }
  DI float* ropes() const { return (float*)(ws + O_ROPES); }
  DI bf16_t* win_t() const { return (bf16_t*)(ws + O_WIN); }
  DI bf16_t* wuq_t() const { return (bf16_t*)(ws + O_WUQ); }
  DI bf16_t* wukv_t() const { return (bf16_t*)(ws + O_WUKV); }
  DI bf16_t* wout_t() const { return (bf16_t*)(ws + O_WOUT); }
  DI bf16_t* wsg_t() const { return (bf16_t*)(ws + O_WSG); }
  DI bf16_t* wsd_t() const { return (bf16_t*)(ws + O_WSD); }
  DI bf16_t* wsp_b() const { return (bf16_t*)(ws + O_WSP); }
  DI bf16_t* wpool_t() const { return (bf16_t*)(ws + O_WPOOL); }
  DI bf16_t* wr_hi() const { return (bf16_t*)(ws + O_WRHI); }
  DI bf16_t* wr_lo() const { return (bf16_t*)(ws + O_WRLO); }
  DI bf16_t* wgu_t() const { return (bf16_t*)(ws + O_WGU); }
  DI bf16_t* wd_t() const { return (bf16_t*)(ws + O_WD); }
  DI bf16_t* h() const { return (bf16_t*)(ws + O_H); }
  DI bf16_t* act() const { return (bf16_t*)(ws + O_ACT); }
  DI bf16_t* ysh() const { return (bf16_t*)(ws + O_YSH); }
  DI int* list() const { return (int*)(ws + O_LIST); }
  DI float* topw() const { return (float*)(ws + O_TOPW); }
  DI float* rowss() const { return (float*)(ws + O_ROWSS); }
  DI float* rsq() const { return (float*)(ws + O_RSQ); }
  DI bf16_t* xb() const { return (bf16_t*)(ws + O_XB); }
  DI bf16_t* yrows() const { return (bf16_t*)(ws + O_YROWS); }
  DI bf16_t* proj() const { return (bf16_t*)(ws + O_PROJ); }
  DI bf16_t* Q() const { return (bf16_t*)(ws + O_Q); }
  DI bf16_t* Kb() const { return (bf16_t*)(ws + O_KB); }
  DI bf16_t* V() const { return (bf16_t*)(ws + O_V); }
  DI unsigned char* Y8() const { return (unsigned char*)(ws + O_Y); }
};

DI unsigned pack2(float lo, float hi) { f32x2 f = {lo, hi}; bf16x2_t b = __builtin_convertvector(f, bf16x2_t); return __builtin_bit_cast(unsigned, b); }
DI float bf2f(unsigned short b) { return __uint_as_float(((unsigned)b) << 16); }
DI f32x4 bf4lo(u32x4 u) { return (f32x4){__uint_as_float(u.x << 16), __uint_as_float(u.x & 0xffff0000u), __uint_as_float(u.y << 16), __uint_as_float(u.y & 0xffff0000u)}; }
DI f32x4 bf4hi(u32x4 u) { return (f32x4){__uint_as_float(u.z << 16), __uint_as_float(u.z & 0xffff0000u), __uint_as_float(u.w << 16), __uint_as_float(u.w & 0xffff0000u)}; }
DI float bflo(unsigned u) { return __uint_as_float(u << 16); }
DI float bfhi(unsigned u) { return __uint_as_float(u & 0xffff0000u); }
constexpr int WTAB_OFF = 128 * 1024 + 16384 + 16;
DI int hw_slot() { return (int)(__builtin_amdgcn_s_getreg((5 << 11) | 4) & 63u); }
DI int lane_id() { unsigned z = 0u; asm volatile("" : "+v"(z)); return (int)__builtin_amdgcn_mbcnt_hi(~0u, __builtin_amdgcn_mbcnt_lo(~0u, z)); }
DI int full_tid() {
  const int wv = __builtin_amdgcn_readfirstlane(((LAS const int*)(size_t)WTAB_OFF)[hw_slot()]);
  int t = (wv << 6) | lane_id(); asm volatile("" : "+v"(t)); return t;
}
DI int otid() { return full_tid() & 255; }
DI float shx(float x, int m) { return __builtin_bit_cast(float, __builtin_amdgcn_ds_bpermute((lane_id() ^ m) << 2, __builtin_bit_cast(int, x))); }
DI float xmax_fq(float v) {
  typedef unsigned u2v __attribute__((ext_vector_type(2)));
  const unsigned x = __builtin_bit_cast(unsigned, v);
  const u2v a = __builtin_amdgcn_permlane32_swap(x, x, false, false);
  const float m = fmaxf(__builtin_bit_cast(float, a[0]), __builtin_bit_cast(float, a[1]));
  const unsigned y = __builtin_bit_cast(unsigned, m);
  const u2v b = __builtin_amdgcn_permlane16_swap(y, y, false, false);
  return fmaxf(__builtin_bit_cast(float, b[0]), __builtin_bit_cast(float, b[1]));
}
DI int shup(int x, int o) { return __builtin_amdgcn_ds_bpermute(((lane_id() - o) & 63) << 2, x); }

constexpr float YMIX_SCALE = 8.f;
constexpr float YSCALE = 16.f;
DI unsigned pack4_fp8(f32x4 v);
DI u32x2 pack8_fp8(f32x4 a, f32x4 b) { return (u32x2){pack4_fp8(a), pack4_fp8(b)}; }
DI unsigned pack4_fp8(f32x4 v) {
  const float a = __builtin_amdgcn_fmed3f(v[0], -448.f, 448.f), b = __builtin_amdgcn_fmed3f(v[1], -448.f, 448.f), c = __builtin_amdgcn_fmed3f(v[2], -448.f, 448.f), d = __builtin_amdgcn_fmed3f(v[3], -448.f, 448.f);
  int w = 0; w = __builtin_amdgcn_cvt_pk_fp8_f32(a, b, w, false); w = __builtin_amdgcn_cvt_pk_fp8_f32(c, d, w, true); return (unsigned)w;
}
DI float dpp_xor1(float x) { return __int_as_float(__builtin_amdgcn_update_dpp(0, __float_as_int(x), 0xB1, 0xF, 0xF, false)); }
DI float dpp_xor2(float x) { return __int_as_float(__builtin_amdgcn_update_dpp(0, __float_as_int(x), 0x4E, 0xF, 0xF, false)); }
DI float dpp_hmir(float x) { return __int_as_float(__builtin_amdgcn_update_dpp(0, __float_as_int(x), 0x141, 0xF, 0xF, false)); }
DI float dpp_mir(float x)  { return __int_as_float(__builtin_amdgcn_update_dpp(0, __float_as_int(x), 0x140, 0xF, 0xF, false)); }
DI float max8(float x) { x = fmaxf(x, dpp_xor1(x)); x = fmaxf(x, dpp_xor2(x)); return fmaxf(x, dpp_hmir(x)); }
DI float wsum(float v) {
  v += dpp_xor1(v); v += dpp_xor2(v); v += dpp_hmir(v); v += dpp_mir(v);
  auto a = __builtin_amdgcn_permlane16_swap(__float_as_uint(v), __float_as_uint(v), false, false);
  v = __uint_as_float(a[0]) + __uint_as_float(a[1]);
  auto c = __builtin_amdgcn_permlane32_swap(__float_as_uint(v), __float_as_uint(v), false, false);
  return __uint_as_float(c[0]) + __uint_as_float(c[1]);
}

DI f32x2 gelu_tanh2(f32x2 x) {
  const f32x2 x2 = x * x;
  const f32x2 t = x * (x2 * 0.10294324f + 2.3022082f);
  const f32x2 d = (f32x2){__builtin_amdgcn_exp2f(t[0]), __builtin_amdgcn_exp2f(t[1])} + 1.f;
  const f32x2 r = {__builtin_amdgcn_rcpf(d[0]), __builtin_amdgcn_rcpf(d[1])};
  return x - x * r;
}
DI f32x4 silu_mul4(f32x4 g, f32x4 u, float sc) {
  const f32x4 t = g * -1.4426950408889634f;
  const f32x4 d = (f32x4){__builtin_amdgcn_exp2f(t[0]), __builtin_amdgcn_exp2f(t[1]), __builtin_amdgcn_exp2f(t[2]), __builtin_amdgcn_exp2f(t[3])} + 1.f;
  const f32x4 r = {__builtin_amdgcn_rcpf(d[0]), __builtin_amdgcn_rcpf(d[1]), __builtin_amdgcn_rcpf(d[2]), __builtin_amdgcn_rcpf(d[3])};
  return (g * sc) * u * r;
}
DI float silu_f(float x) { return x * __builtin_amdgcn_rcpf(1.f + __expf(-x)); }
DI float gelu_tanh(float x) { const float z = 0.7978845608028654f * (x + 0.044715f * x * x * x); const float e = __builtin_amdgcn_exp2f(z * 2.8853900817779268f); return x * (1.f - __builtin_amdgcn_rcpf(1.f + e)); }

#define XB_TMO      128
#define XB_XCNT(j)  (256  + 64 * (j))
#define XB_XSUB(j)  (1280 + 64 * (j))
#define XB_XGEN(j)  (2304 + 64 * (j))
#define XB_TOP      3328
#define XB_TOPGEN   3392
#define XCD_BAR_WORDS 3456
#define XB_MODRDY   192
#define XB_SPIN_CAP (1u << 20)
DI unsigned xb_ld(unsigned* p) { return __hip_atomic_load(p, __ATOMIC_RELAXED, __HIP_MEMORY_SCOPE_AGENT); }
DI unsigned xb_add(unsigned* p, unsigned v) { return __hip_atomic_fetch_add(p, v, __ATOMIC_RELAXED, __HIP_MEMORY_SCOPE_AGENT); }
DI unsigned xb_xcc_id() { return (unsigned)__builtin_amdgcn_s_getreg((3 << 11) | 20) & 0xFu; }
#define XB_SPIN(cond, bar) do { unsigned _sp = 0; while (cond) { __builtin_amdgcn_s_sleep(1); \
    if ((++_sp & 255u) == 0u) { if (xb_ld(&(bar)[XB_TMO])) break; if (_sp > XB_SPIN_CAP) { atomicAdd(&(bar)[XB_TMO], 1u); break; } } } } while (0)
struct XcdBarrier { unsigned* bar; unsigned x; volatile LAS unsigned* st; };
DI XcdBarrier xcd_barrier_post(unsigned* bar, volatile LAS unsigned* st) {
  XcdBarrier b; b.bar = bar; b.x = xb_xcc_id(); b.st = st;
  if (full_tid() == 0) (void)xb_add(&bar[XB_XCNT(b.x)], 1u);
  return b;
}
DI void xcd_barrier_complete(unsigned* bar, unsigned x, unsigned& nloc, unsigned& nx) {
  const unsigned G = gridDim.x * gridDim.y * gridDim.z;
  unsigned sum, cnt, mine, sp = 0u;
  for (;;) {
    sum = 0u; cnt = 0u; mine = 0u;
#pragma unroll
    for (unsigned j = 0; j < 16; ++j) { const unsigned c = xb_ld(&bar[XB_XCNT(j)]); sum += c; cnt += (c > 0u) ? 1u : 0u; mine = (j == x) ? c : mine; }
    if (sum == G) break;
    __builtin_amdgcn_s_sleep(1);
    if ((++sp & 255u) == 0u) { if (xb_ld(&bar[XB_TMO])) break; if (sp > XB_SPIN_CAP) { atomicAdd(&bar[XB_TMO], 1u); break; } }
  }
  nloc = mine > 0u ? mine : 1u; nx = cnt > 0u ? cnt : 1u;
}
DI void xcd_barrier(const XcdBarrier& b0) {
  XcdBarrier b = b0; b.x = xb_xcc_id();
  asm volatile("s_waitcnt vmcnt(0)" ::: "memory");
  __syncthreads();
  if (full_tid() == 0) {
    unsigned* bar = b.bar;
    __builtin_amdgcn_s_waitcnt(0);
    unsigned nloc = b.st[0], nx = b.st[1];
    if (nloc == 0u) { xcd_barrier_complete(bar, b.x, nloc, nx); b.st[0] = nloc; b.st[1] = nx; }
    const unsigned old = xb_add(&bar[XB_XSUB(b.x)], 1u);
    const unsigned gen = old / nloc;
    if (old + 1u == (gen + 1u) * nloc) {
      __builtin_amdgcn_fence(__ATOMIC_RELEASE, "agent");
      asm volatile("s_waitcnt vmcnt(0)" ::: "memory");
      const unsigned og = xb_add(&bar[XB_TOP], 1u);
      const unsigned tg = og / nx;
      if (og + 1u == (tg + 1u) * nx) xb_add(&bar[XB_TOPGEN], 1u);
      else XB_SPIN(xb_ld(&bar[XB_TOPGEN]) == tg, bar);
      __builtin_amdgcn_fence(__ATOMIC_ACQUIRE, "agent");
      xb_add(&bar[XB_XGEN(b.x)], 1u);
      asm volatile("s_waitcnt vmcnt(0)" ::: "memory");
    } else {
      XB_SPIN(xb_ld(&bar[XB_XGEN(b.x)]) == gen, bar);
      __builtin_amdgcn_fence(__ATOMIC_ACQUIRE, "agent");
      asm volatile("s_waitcnt vmcnt(0)" ::: "memory");
    }
  }
  __syncthreads();
}
namespace t8 {
constexpr int BM = 256, BK = 64, HALF = 128, HTB = HALF * BK * 2, STAGE_BYTES = 8 * HTB;
DI int lds_byte(int r, int c) { const int st = (r >> 4) * 2 + (c >> 5), rr = r & 15, cc = c & 31, ob = rr * 64 + cc * 2; return st * 1024 + (ob ^ (((ob >> 9) & 1) << 5)); }
DI void stage_rc(int b, int& R, int& C) { const int st = b / 1024, sb = b % 1024, swz = sb ^ (((sb >> 9) & 1) << 5); R = (st >> 1) * 16 + swz / 64; C = (st & 1) * 32 + (swz % 64) / 2; }
DI int perm32(int rho) { const int n = rho >> 4, i = rho & 15; return 8 * (i >> 2) + 4 * n + (i & 3); }
struct Unit { int pm, pn, tab; const unsigned char* bbase; };
constexpr int TAB_OFF = STAGE_BYTES;
constexpr int START_OFF = STAGE_BYTES + 12288;

typedef int i32x4v __attribute__((ext_vector_type(4)));
typedef int i32x8v __attribute__((ext_vector_type(8)));
template <bool PERM, bool F8 = false, int SCB = 0x7A7A7A7A, int SCA = 0x7F7F7F7F, bool ONESHOT = false, class Sched, class RowOff, class Epi>
DI void gemm_phase(LAS unsigned char* lds, const unsigned char* Abase, const int Kb  , const Sched& S, const RowOff& RO, const Epi& E) {
  const int tid = full_tid();
  const int wid = __builtin_amdgcn_readfirstlane(tid >> 6), lane = tid & 63, wr = wid >> 2, wc = wid & 3, fr = lane & 15, fq = lane >> 4;
  const int nt = Kb / (BK * 2);
  unsigned voffB[2][2];
#pragma unroll
  for (int h = 0; h < 2; ++h)
#pragma unroll
    for (int i = 0; i < 2; ++i) { int R, C; stage_rc(tid * 16 + i * 8192, R, C); const int rho = h * HALF + R;
      const int Rb = PERM ? (((rho >> 5) & 3) * 64 + ((rho >> 2) & 3) * 16 + (rho >> 7) * 8 + ((rho >> 4) & 1) * 4 + (rho & 3)) : rho; voffB[h][i] = (unsigned)(Rb * Kb + C * 2); }
  auto apiece = [&](const Unit& u, int h, int i) -> unsigned { int R, C; stage_rc(tid * 16 + i * 8192, R, C); return RO(u, h * HALF + R) + (unsigned)(C * 2); };
  const size_t kstep = (size_t)(BK * 2);
  const unsigned ldsw = (unsigned)wid * 1024u;
  const int aoff = lds_byte(wr * 64 + fr, fq * 8), boff = lds_byte(wc * 32 + fr, fq * 8);
  LAS const unsigned char* ldsA = lds + aoff; LAS const unsigned char* ldsB = lds + 4 * HTB + boff;
  asm volatile("" : "+v"(ldsA), "+v"(ldsB));
#define T8_SA(b, h) (((b) * 2 + (h)) * HTB)
#define T8_SB(b, h) ((4 + (b) * 2 + (h)) * HTB)
#define T8_STAGE(bufoff, gbase, voff) do { _Pragma("unroll") for (int _i = 0; _i < 2; ++_i) \
    __builtin_amdgcn_global_load_lds((const unsigned*)((const char*)(gbase) + (voff)[_i]), (LAS unsigned*)(lds + (bufoff) + ldsw + _i * 8192), 16, 0, 0); } while (0)
#define T8_LDA(dst, b, h) do { _Pragma("unroll") for (int m = 0; m < 4; ++m) _Pragma("unroll") for (int k = 0; k < 2; ++k) dst[m][k] = *(const LAS bf16x8*)(ldsA + T8_SA(b, h) + m * 2048 + k * 1024); } while (0)
#define T8_LDB(dst, b, h) do { _Pragma("unroll") for (int n = 0; n < 2; ++n) _Pragma("unroll") for (int k = 0; k < 2; ++k) dst[n][k] = *(const LAS bf16x8*)(ldsB + (T8_SB(b, h) - 4 * HTB) + n * 2048 + k * 1024); } while (0)
#define T8_MMA(ai, bj, At, Bt) do { __builtin_amdgcn_s_setprio(1); _Pragma("unroll") for (int m = 0; m < 4; ++m) _Pragma("unroll") for (int n = 0; n < 2; ++n) { \
    if (F8) { const i32x8v wv_ = __builtin_shufflevector(__builtin_bit_cast(i32x4v, Bt[n][0]), __builtin_bit_cast(i32x4v, Bt[n][1]), 0, 1, 2, 3, 4, 5, 6, 7); \
              const i32x8v xv_ = __builtin_shufflevector(__builtin_bit_cast(i32x4v, At[m][0]), __builtin_bit_cast(i32x4v, At[m][1]), 0, 1, 2, 3, 4, 5, 6, 7); \
              acc[ai][bj][m][n] = __builtin_amdgcn_mfma_scale_f32_16x16x128_f8f6f4(wv_, xv_, acc[ai][bj][m][n], 0, 0, 0, SCB, 0, SCA); } \
    else { _Pragma("unroll") for (int k = 0; k < 2; ++k) acc[ai][bj][m][n] = __builtin_amdgcn_mfma_f32_16x16x32_bf16(Bt[n][k], At[m][k], acc[ai][bj][m][n], 0, 0, 0); } } \
    __builtin_amdgcn_s_setprio(0); } while (0)
#define T8_WAIT_V(n) asm volatile("s_waitcnt vmcnt(" #n ")" ::: "memory")
#define T8_WAIT_L(n) asm volatile("s_waitcnt lgkmcnt(" #n ")" ::: "memory")
#define T8_BAR __builtin_amdgcn_s_barrier()
#define T8_SCHED __builtin_amdgcn_sched_barrier(0)
  Unit cur, nxt; int ui = 0;
  if (!S.next(0, cur)) return;
  f32x4 acc[2][2][4][2];
#pragma unroll
  for (int a = 0; a < 2; ++a)
#pragma unroll
    for (int b = 0; b < 2; ++b)
#pragma unroll
      for (int m = 0; m < 4; ++m)
#pragma unroll
        for (int n = 0; n < 2; ++n) acc[a][b][m][n] = (f32x4){0.f, 0.f, 0.f, 0.f};
  bf16x8 At[4][2], B0[2][2], B1[2][2];
  unsigned vc[2][2];
#pragma unroll
  for (int h = 0; h < 2; ++h)
#pragma unroll
    for (int i = 0; i < 2; ++i) vc[h][i] = apiece(cur, h, i);
  const char* cB = (const char*)cur.bbase;
  const char* gA = (const char*)Abase;
  if constexpr (ONESHOT) {
#define T8_STAGE_UNIT(bb) do { T8_STAGE(T8_SB(0, 0), bb, voffB[0]); T8_STAGE(T8_SA(0, 0), gA, vc[0]); T8_STAGE(T8_SB(0, 1), bb, voffB[1]); T8_STAGE(T8_SA(0, 1), gA, vc[1]); \
      T8_STAGE(T8_SB(1, 0), bb + kstep, voffB[0]); T8_STAGE(T8_SA(1, 0), gA + kstep, vc[0]); T8_STAGE(T8_SB(1, 1), bb + kstep, voffB[1]); T8_STAGE(T8_SA(1, 1), gA + kstep, vc[1]); } while (0)
    T8_STAGE_UNIT(cB);
    for (;;) {
      const bool has_next = S.next(ui + 1, nxt);
      T8_WAIT_V(0); T8_BAR; T8_SCHED;
      T8_LDB(B0, 0, 0); T8_LDA(At, 0, 0); T8_SCHED; T8_LDB(B1, 0, 1); T8_MMA(0, 0, At, B0); T8_SCHED; T8_MMA(0, 1, At, B1); T8_SCHED;
      T8_LDA(At, 0, 1); T8_SCHED; T8_MMA(1, 0, At, B0); T8_MMA(1, 1, At, B1); T8_SCHED;
      T8_LDB(B0, 1, 0); T8_LDA(At, 1, 0); T8_SCHED; T8_LDB(B1, 1, 1); T8_MMA(0, 0, At, B0); T8_SCHED; T8_MMA(0, 1, At, B1); T8_SCHED;
      T8_LDA(At, 1, 1); T8_SCHED; T8_MMA(1, 0, At, B0); T8_MMA(1, 1, At, B1); T8_SCHED;
      T8_WAIT_L(0); T8_BAR; T8_SCHED;
      if (has_next) {
        const bool newA = nxt.tab != cur.tab;
        const int tl = full_tid();
#pragma unroll
        for (int h = 0; h < 2; ++h)
#pragma unroll
          for (int i = 0; i < 2; ++i) { int R, C; stage_rc(tl * 16 + i * 8192, R, C);
            const int rho = h * HALF + R; const int Rb = ((rho >> 5) & 3) * 64 + ((rho >> 2) & 3) * 16 + (rho >> 7) * 8 + ((rho >> 4) & 1) * 4 + (rho & 3); voffB[h][i] = (unsigned)(Rb * Kb + C * 2); }
        cB = (const char*)nxt.bbase;
        T8_STAGE(T8_SB(0, 0), cB, voffB[0]); T8_STAGE(T8_SB(0, 1), cB, voffB[1]); T8_STAGE(T8_SB(1, 0), cB + kstep, voffB[0]); T8_STAGE(T8_SB(1, 1), cB + kstep, voffB[1]);
        if (newA) {
#pragma unroll
          for (int h = 0; h < 2; ++h)
#pragma unroll
            for (int i = 0; i < 2; ++i) { int R, C; stage_rc(tl * 16 + i * 8192, R, C); vc[h][i] = RO(nxt, h * HALF + R) + (unsigned)(C * 2); }
          T8_STAGE(T8_SA(0, 0), gA, vc[0]); T8_STAGE(T8_SA(0, 1), gA, vc[1]); T8_STAGE(T8_SA(1, 0), gA + kstep, vc[0]); T8_STAGE(T8_SA(1, 1), gA + kstep, vc[1]);
        }
      }
      T8_SCHED;
      E(acc, cur, wr, wc, fr, fq);
      if (!has_next) break;
#pragma unroll
      for (int a = 0; a < 2; ++a)
#pragma unroll
        for (int b = 0; b < 2; ++b)
#pragma unroll
          for (int m = 0; m < 4; ++m)
#pragma unroll
            for (int n = 0; n < 2; ++n) acc[a][b][m][n] = (f32x4){0.f, 0.f, 0.f, 0.f};
      cur = nxt; ++ui;
    }
    T8_WAIT_V(0); T8_BAR;
#undef T8_STAGE_UNIT
  } else {
  T8_STAGE(T8_SB(0, 0), cB, voffB[0]); T8_STAGE(T8_SA(0, 0), gA, vc[0]); T8_STAGE(T8_SB(0, 1), cB, voffB[1]); T8_STAGE(T8_SA(0, 1), gA, vc[1]);
  if (wr == 1) T8_BAR;
  T8_WAIT_V(4); T8_BAR;
  T8_STAGE(T8_SB(1, 0), cB + kstep, voffB[0]); T8_STAGE(T8_SA(1, 0), gA + kstep, vc[0]); T8_STAGE(T8_SB(1, 1), cB + kstep, voffB[1]);
  T8_WAIT_V(6); T8_BAR;
  for (;;) {
    const bool has_next = S.next(ui + 1, nxt);
    const char* nB = has_next ? (const char*)nxt.bbase : cB;
#pragma unroll 1
    for (int t = 0; t < nt; t += 2) {
      const bool last = (t == nt - 2);
      const char* a1 = gA + (size_t)(t + 1) * kstep;
      const char* a2 = last ? gA : gA + (size_t)(t + 2) * kstep; const char* b2 = last ? nB : cB + (size_t)(t + 2) * kstep;
      const char* a3 = a2 + kstep; const char* b3 = b2 + kstep;
      if (last && has_next) { vc[0][0] = apiece(nxt, 0, 0); vc[0][1] = apiece(nxt, 0, 1); }
      T8_LDB(B0, 0, 0); T8_SCHED; T8_LDA(At, 0, 0); T8_STAGE(T8_SA(1, 1), a1, vc[1]);
      T8_WAIT_L(8); T8_BAR; T8_WAIT_L(0); T8_MMA(0, 0, At, B0); T8_BAR; T8_SCHED;
      if (last && has_next) { vc[1][0] = apiece(nxt, 1, 0); vc[1][1] = apiece(nxt, 1, 1); }
      T8_LDB(B1, 0, 1); T8_STAGE(T8_SB(0, 0), b2, voffB[0]);
      T8_BAR; T8_WAIT_L(0); T8_MMA(0, 1, At, B1); T8_BAR;
      T8_LDA(At, 0, 1); T8_STAGE(T8_SA(0, 0), a2, vc[0]);
      T8_BAR; T8_WAIT_L(0); T8_MMA(1, 0, At, B0); T8_BAR; T8_SCHED;
      T8_STAGE(T8_SB(0, 1), b2, voffB[1]);
      T8_WAIT_V(6); T8_BAR; T8_MMA(1, 1, At, B1); T8_BAR;
      T8_LDB(B0, 1, 0); T8_SCHED; T8_LDA(At, 1, 0); T8_STAGE(T8_SA(0, 1), a2, vc[1]);
      T8_WAIT_L(8); T8_BAR; T8_WAIT_L(0); T8_MMA(0, 0, At, B0); T8_BAR; T8_SCHED;
      T8_LDB(B1, 1, 1); T8_STAGE(T8_SB(1, 0), b3, voffB[0]);
      T8_BAR; T8_WAIT_L(0); T8_MMA(0, 1, At, B1); T8_BAR;
      T8_LDA(At, 1, 1); T8_STAGE(T8_SA(1, 0), a3, vc[0]);
      T8_BAR; T8_WAIT_L(0); T8_MMA(1, 0, At, B0); T8_BAR; T8_SCHED;
      T8_STAGE(T8_SB(1, 1), b3, voffB[1]);
      T8_WAIT_V(6); T8_BAR; T8_MMA(1, 1, At, B1); T8_BAR;
    }
    E(acc, cur, wr, wc, fr, fq);
    if (!has_next) break;
#pragma unroll
    for (int a = 0; a < 2; ++a)
#pragma unroll
      for (int b = 0; b < 2; ++b)
#pragma unroll
        for (int m = 0; m < 4; ++m)
#pragma unroll
          for (int n = 0; n < 2; ++n) acc[a][b][m][n] = (f32x4){0.f, 0.f, 0.f, 0.f};
    cur = nxt; cB = nB; ++ui;
  }
  T8_WAIT_V(0);
  if (wr == 0) T8_BAR;
  T8_BAR;
  }
#undef T8_SA
#undef T8_SB
#undef T8_STAGE
#undef T8_LDA
#undef T8_LDB
#undef T8_MMA
#undef T8_WAIT_V
#undef T8_WAIT_L
#undef T8_BAR
#undef T8_SCHED
}

struct DenseSched {
  int nM, nN, nwg, G, c; const unsigned char* Bt; size_t tstep;
  DI void init(int M, int N, int K, int G_, int c_, const void* Bt_) { nM = M / BM; nN = N / BM; nwg = nM * nN; G = G_; c = c_; Bt = (const unsigned char*)Bt_; tstep = (size_t)BM * K * 2; }
  DI bool next(int i, Unit& u) const {
    const long L = (long)i * G + c; if (L >= nwg) return false;
    int wgid = (int)L; { const int q = nwg / 8, r = nwg % 8, xcd = wgid % 8, off = wgid / 8; wgid = (xcd < r ? xcd * (q + 1) : r * (q + 1) + (xcd - r) * q) + off; }
    const int nig = 8 * nN, gid = wgid / nig, fm = gid * 8, gsz = (nM - fm) < 8 ? (nM - fm) : 8;
    u.pm = fm + ((wgid % nig) % gsz); u.pn = (wgid % nig) / gsz; u.tab = 0; u.bbase = Bt + (size_t)u.pn * tstep; return true;
  }
};
struct DenseRows { unsigned rowbytes; DI unsigned operator()(const Unit& u, int row) const { return (unsigned)(u.pm * BM + row) * rowbytes; } };

struct MoeSched {
  LAS const int* start; int npn, nmt, G, c; const unsigned char* wexp; const unsigned char* wsh; size_t estride, tstep;
  DI bool locate(int i, int& mt, int& pn, int& tab) const {
    const int R = nmt / G;
    if (i < R * npn) { const int r = i / npn; pn = i - r * npn; mt = r * G + c; tab = r; return true; }
    const int j = i - R * npn, L = j * G + c, rem = (nmt - R * G) * npn;
    if (L >= rem) return false;
    const int q = L / npn; pn = L - q * npn; mt = R * G + q; tab = R + j; return true;
  }
  DI bool next(int i, Unit& u) const {
    int mt, pn, tab;
    if (!locate(i, mt, pn, tab)) return false;
    u.pm = mt; u.pn = pn; u.tab = tab;
    const int e = __builtin_amdgcn_readfirstlane(start[128 + tab]);
    u.bbase = (e == 64 ? wsh : wexp + (size_t)e * estride) + (size_t)pn * tstep; return true;
  }
};
}

DI void moe_prepare(const P& p, LAS unsigned char* lds, int l, int npn, int G, int c, int& total_units, bool with_w = false) {
  LAS int* start = (LAS int*)(lds + t8::START_OFF);
  const int tid = full_tid();
  __syncthreads();
  if (tid < 64) {
    const int cn = p.cnt()[(l * 64 + tid) * CSTRIDE];
    const int nt = (cn + 255) >> 8;
    int incl = nt;
#pragma unroll
    for (int o = 1; o < 64; o <<= 1) { const int v = shup(incl, o); incl += (tid >= o) ? v : 0; }
    start[tid] = incl - nt; start[192 + tid] = cn;
    if (tid == 63) { start[64] = incl; start[65] = incl + 64; }
  }
  __syncthreads();
  const int nmt = start[65], nrt = start[64];
  total_units = nmt;
  const int R = nmt / G, rem = (nmt - R * G) * npn;
  int slot[3]; bool ok[3];
#pragma unroll
  for (int q = 0; q < 3; ++q) {
    const int j = tid + 512 * q, tab = j >> 8, row = j & 255;
    int mt = -1;
    if (tab < R) mt = tab * G + c;
    else { const int L = (tab - R) * G + c; if (L < rem) mt = R * G + L / npn; }
    ok[q] = (mt >= 0) && (tab < 6);
    const int mtc = ok[q] ? mt : 0;
    int lo = 0;
#pragma unroll
    for (int stp = 32; stp >= 1; stp >>= 1) lo = (lo + stp < 64 && start[lo + stp] <= mtc) ? lo + stp : lo;
    const int e = (mtc < nrt) ? lo : 64;
    if (ok[q] && row == 0) start[128 + tab] = e;
    const int ec = e < 64 ? e : 63;
    const int idx = (mtc - start[ec]) * 256 + row;
    const bool inr = (e < 64) && (idx >= 0) && (idx < start[192 + ec]);
    const int lv = p.list()[(size_t)ec * LISTCAP + (inr ? idx : 0)];
    slot[q] = !ok[q] ? -1 : (e == 64 ? T_ * 8 + (mtc - nrt) * 256 + row : (inr ? lv : -1));
  }
  float wq[3];
#pragma unroll
  for (int q = 0; q < 3; ++q) wq[q] = (with_w && ok[q] && slot[q] >= 0 && slot[q] < T_ * 8) ? p.topw()[slot[q]] * YSCALE : YSCALE;
#pragma unroll
  for (int q = 0; q < 3; ++q) {
    const int j = tid + 512 * q;
    if (ok[q]) { ((LAS int*)(lds + t8::TAB_OFF))[j] = slot[q]; if (with_w) ((LAS float*)(lds + t8::TAB_OFF))[6 * 256 + j] = wq[q]; }
  }
  __syncthreads();
}

DI void item_mod(const P& p, unsigned char* smem, int item) {
  const int l = item / 192, cb = item % 192;
  const int tid = otid(), col = tid & 31, kg = tid >> 5;
  float* sc = (float*)smem;
  float* red = (float*)(smem + 32768);
  __syncthreads();
  {
    float cv[32];
#pragma unroll
    for (int u = 0; u < 32; ++u) cv[u] = p.c[tid + NTHREADS * u];
#pragma unroll
    for (int u = 0; u < 32; ++u) sc[tid + NTHREADS * u] = silu_f(cv[u]);
  }
  __syncthreads();
  const float* W = p.w_ada + (size_t)l * 1024 * 6144 + (size_t)(kg * 128) * 6144 + cb * 32 + col;
  float acc[8];
#pragma unroll
  for (int b = 0; b < 8; ++b) acc[b] = 0.f;
#pragma unroll 1
  for (int k0 = 0; k0 < 128; k0 += 32) {
    float wv[32];
#pragma unroll
    for (int u = 0; u < 32; ++u) wv[u] = W[(size_t)(k0 + u) * 6144];
#pragma unroll
    for (int u = 0; u < 32; ++u)
#pragma unroll
      for (int b = 0; b < 8; ++b) acc[b] += sc[b * 1024 + kg * 128 + k0 + u] * wv[u];
  }
#pragma unroll
  for (int b = 0; b < 8; ++b) red[(kg * 8 + b) * 32 + col] = acc[b];
  __syncthreads();
  {
    const int b = tid >> 5, cc = tid & 31;
    float v = 0.f;
#pragma unroll
    for (int g = 0; g < 8; ++g) v += red[(g * 8 + b) * 32 + cc];
    p.mod()[((size_t)l * 8 + b) * 6144 + cb * 32 + cc] = v + p.b_ada[(size_t)l * 6144 + cb * 32 + cc];
  }
  if (item < 64) {
    asm volatile("s_waitcnt vmcnt(0)" ::: "memory");
    __syncthreads();
    if (full_tid() == 0) {
      __builtin_amdgcn_fence(__ATOMIC_RELEASE, "agent");
      asm volatile("s_waitcnt vmcnt(0)" ::: "memory");
      (void)xb_add(&p.bar()[XB_MODRDY], 2u);
    }
  }
}

DI void conv_tile(unsigned char* smem, const float* src, int ldsrc, int k0, int n0, bf16_t* dst, int lddst, int mode, const float* kscale) {
  float* t = (float*)smem;
  const int tid = otid();
  __syncthreads();
  {
    const int kk = tid >> 3, nq = tid & 7;
#pragma unroll
    for (int hh = 0; hh < 2; ++hh) {
      const int k = kk + 32 * hh;
      const float4 v = *(const float4*)(src + (size_t)(k0 + k) * ldsrc + n0 + nq * 4);
      const float s = kscale ? kscale[k0 + k] : 1.f;
      t[k * 33 + nq * 4 + 0] = v.x * s; t[k * 33 + nq * 4 + 1] = v.y * s; t[k * 33 + nq * 4 + 2] = v.z * s; t[k * 33 + nq * 4 + 3] = v.w * s;
    }
  }
  __syncthreads();
  {
    const int n = tid >> 3, kc = tid & 7;
    u32x4 wv;
    wv.x = pack2(t[(kc * 8 + 0) * 33 + n], t[(kc * 8 + 1) * 33 + n]);
    wv.y = pack2(t[(kc * 8 + 2) * 33 + n], t[(kc * 8 + 3) * 33 + n]);
    wv.z = pack2(t[(kc * 8 + 4) * 33 + n], t[(kc * 8 + 5) * 33 + n]);
    wv.w = pack2(t[(kc * 8 + 6) * 33 + n], t[(kc * 8 + 7) * 33 + n]);
    const int nn = n0 + n;
    const int orow = (mode == 0) ? nn : (256 * (nn >> 7) + 16 * ((nn & 127) >> 3) + (mode == 2 ? 8 : 0) + (nn & 7));
    *(u32x4*)(dst + (size_t)orow * lddst + k0 + kc * 8) = wv;
  }
}

DI void conv_big(unsigned char* smem, const float* src, int ldsrc, int k0, int n0, bf16_t* dst, int lddst, int mode, const float* kscale, const bool f8 = false) {
  float* t = (float*)smem;
  const int tid = otid();
  __syncthreads();
  {
    const int c4 = tid & 31, r0 = tid >> 5;
    float4 v[8];
#pragma unroll
    for (int hh = 0; hh < 8; ++hh) v[hh] = *(const float4*)(src + (size_t)(k0 + r0 + 8 * hh) * ldsrc + n0 + c4 * 4);
#pragma unroll
    for (int hh = 0; hh < 8; ++hh) {
      const int k = r0 + 8 * hh;
      const float sc = kscale ? kscale[k0 + k] : 1.f;
      *(float4*)(t + k * 132 + c4 * 4) = (float4){v[hh].x * sc, v[hh].y * sc, v[hh].z * sc, v[hh].w * sc};
    }
  }
  __syncthreads();
  {
    const int n = tid >> 1, kh = tid & 1;
    const int nn = n0 + n;
    const int orow = (mode == 0) ? nn : (256 * (nn >> 7) + 16 * ((nn & 127) >> 3) + (mode == 2 ? 8 : 0) + (nn & 7));
    if (f8) {
      unsigned char* d8 = (unsigned char*)dst + (size_t)orow * lddst + k0 + kh * 32;
#pragma unroll
      for (int c = 0; c < 2; ++c) {
        const float* tp = t + (kh * 32 + c * 16) * 132 + n;
        u32x4 wv;
        wv.x = pack4_fp8((f32x4){tp[0 * 132], tp[1 * 132], tp[2 * 132], tp[3 * 132]} * 32.f); wv.y = pack4_fp8((f32x4){tp[4 * 132], tp[5 * 132], tp[6 * 132], tp[7 * 132]} * 32.f);
        wv.z = pack4_fp8((f32x4){tp[8 * 132], tp[9 * 132], tp[10 * 132], tp[11 * 132]} * 32.f); wv.w = pack4_fp8((f32x4){tp[12 * 132], tp[13 * 132], tp[14 * 132], tp[15 * 132]} * 32.f);
        *(u32x4*)(d8 + c * 16) = wv;
      }
      return;
    }
    bf16_t* d = dst + (size_t)orow * lddst + k0 + kh * 32;
#pragma unroll
    for (int c = 0; c < 4; ++c) {
      const float* tp = t + (kh * 32 + c * 8) * 132 + n;
      u32x4 wv;
      wv.x = pack2(tp[0 * 132], tp[1 * 132]); wv.y = pack2(tp[2 * 132], tp[3 * 132]); wv.z = pack2(tp[4 * 132], tp[5 * 132]); wv.w = pack2(tp[6 * 132], tp[7 * 132]);
      *(u32x4*)(d + c * 8) = wv;
    }
  }
}

DI void item_conv(const P& p, unsigned char* smem, int l, int idx) {
  if (idx < 592) { conv_tile(smem, p.w_in + (size_t)l * 1024 * NIN, NIN, (idx / 37) * 64, (idx % 37) * 32, p.win_t(), 1024, 0, nullptr); return; }
  idx -= 592;
  if (idx < 24) { conv_big(smem, p.w_uq + (size_t)l * 256 * 768, 768, (idx / 6) * 64, (idx % 6) * 128, p.wuq_t(), 256, 0, p.g_q + l * 256); return; }
  idx -= 24;
  if (idx < 16) { conv_big(smem, p.w_ukv + (size_t)l * 128 * 1024, 1024, (idx / 8) * 64, (idx % 8) * 128, p.wukv_t(), 128, 0, p.g_kv + l * 128); return; }
  idx -= 16;
  if (idx < 128) { conv_big(smem, p.w_out + (size_t)l * 1024 * 1024, 1024, (idx / 8) * 64, (idx % 8) * 128, p.wout_t(), 1024, 0, nullptr, true); return; }
}


DI void conv_big_desc(const P& p, int l, int idx, const float*& src, int& ldsrc, int& k0, int& n0, bf16_t*& dst, int& lddst, int& mode) {
  if (idx < 32) { src = p.ws_gate + (size_t)l * 1024 * 256; ldsrc = 256; k0 = (idx / 2) * 64; n0 = (idx % 2) * 128; dst = p.wsg_t(); lddst = 1024; mode = 1; return; }
  idx -= 32;
  if (idx < 32) { src = p.ws_up + (size_t)l * 1024 * 256; ldsrc = 256; k0 = (idx / 2) * 64; n0 = (idx % 2) * 128; dst = p.wsg_t(); lddst = 1024; mode = 2; return; }
  idx -= 32;
  if (idx < 32) { src = p.ws_down + (size_t)l * 256 * 1024; ldsrc = 1024; k0 = (idx / 8) * 64; n0 = (idx % 8) * 128; dst = p.wsd_t(); lddst = 256; mode = 0; return; }
  idx -= 32;
  const int e = idx / 96, r = idx % 96;
  if (r < 32) { src = p.w_gate + ((size_t)l * 64 + e) * 1024 * 256; ldsrc = 256; k0 = (r / 2) * 64; n0 = (r % 2) * 128; dst = (bf16_t*)((unsigned char*)p.wgu_t() + (size_t)e * 512 * 1024); lddst = 1024; mode = 1; }
  else if (r < 64) { src = p.w_up + ((size_t)l * 64 + e) * 1024 * 256; ldsrc = 256; k0 = ((r - 32) / 2) * 64; n0 = ((r - 32) % 2) * 128; dst = (bf16_t*)((unsigned char*)p.wgu_t() + (size_t)e * 512 * 1024); lddst = 1024; mode = 2; }
  else { src = p.w_down + ((size_t)l * 64 + e) * 256 * 1024; ldsrc = 1024; k0 = ((r - 64) / 8) * 64; n0 = ((r - 64) % 8) * 128; dst = (bf16_t*)((unsigned char*)p.wd_t() + (size_t)e * 1024 * 256); lddst = 256; mode = 0; }
}
DI void conv_big_load(const P& p, int l, int idx, int tid, f32x4 (&v)[8]) {
  idx = idx < CONV_BIG ? idx : CONV_BIG - 1;
  const float* src; int ldsrc, k0, n0; bf16_t* dst; int lddst, mode;
  conv_big_desc(p, l, idx, src, ldsrc, k0, n0, dst, lddst, mode);
  const int c4 = tid & 31, r0 = tid >> 5;
#pragma unroll
  for (int hh = 0; hh < 8; ++hh) v[hh] = *(const f32x4*)(src + (size_t)(k0 + r0 + 8 * hh) * ldsrc + n0 + c4 * 4);
}
DI void conv_big_finish(const P& p, unsigned char* smem, int l, int idx, int tid, const f32x4 (&v)[8]) {
  const float* src; int ldsrc, k0, n0; bf16_t* dst; int lddst, mode;
  conv_big_desc(p, l, idx, src, ldsrc, k0, n0, dst, lddst, mode);
  float* t = (float*)smem;
  const int c4 = tid & 31, r0 = tid >> 5;
  __syncthreads();
#pragma unroll
  for (int hh = 0; hh < 8; ++hh) *(f32x4*)(t + (r0 + 8 * hh) * 132 + c4 * 4) = v[hh];
  __syncthreads();
  const int n = tid >> 1, kh = tid & 1;
  const int nn = n0 + n;
  const int orow = (mode == 0) ? nn : (256 * (nn >> 7) + 16 * ((nn & 127) >> 3) + (mode == 2 ? 8 : 0) + (nn & 7));
  {
    const float wsc = (mode != 0) ? 32.f : 16.f;
    unsigned char* d8 = (unsigned char*)dst + (size_t)orow * lddst + k0 + kh * 32;
#pragma unroll
    for (int c = 0; c < 2; ++c) {
      const float* tp = t + (kh * 32 + c * 16) * 132 + n;
      u32x4 wv;
      wv.x = pack4_fp8((f32x4){tp[0 * 132], tp[1 * 132], tp[2 * 132], tp[3 * 132]} * wsc); wv.y = pack4_fp8((f32x4){tp[4 * 132], tp[5 * 132], tp[6 * 132], tp[7 * 132]} * wsc);
      wv.z = pack4_fp8((f32x4){tp[8 * 132], tp[9 * 132], tp[10 * 132], tp[11 * 132]} * wsc); wv.w = pack4_fp8((f32x4){tp[12 * 132], tp[13 * 132], tp[14 * 132], tp[15 * 132]} * wsc);
      *(u32x4*)(d8 + c * 16) = wv;
    }
  }
}
DI void conv_big_loop(const P& p, unsigned char* smem, int l, int first, int step) {
  if (first >= CONV_BIG) return;
  const int tid = otid();
  f32x4 va[8], vb[8];
  conv_big_load(p, l, first, tid, va); conv_big_load(p, l, first + step, tid, vb);
  for (int it = first; it < CONV_BIG; it += 2 * step) {
    conv_big_finish(p, smem, l, it, tid, va);
    conv_big_load(p, l, it + 2 * step, tid, va);
    if (it + step >= CONV_BIG) break;
    conv_big_finish(p, smem, l, it + step, tid, vb);
    conv_big_load(p, l, it + 3 * step, tid, vb);
  }
}

constexpr int MISC_ITEMS = 64 + 128 + 512;
DI void item_misc(const P& p, int item) {
  const int tid = otid();
  if (item < 64) {
    const int i = (item * NTHREADS + tid) * 8;
    const int k0 = i & 127, t = (i >> 7) & 127;
    const float4 a = *(const float4*)(p.w_spatial + i), c = *(const float4*)(p.w_spatial + i + 4);
    u32x4 o;
    o.x = pack2(k0 + 0 <= t ? a.x : 0.f, k0 + 1 <= t ? a.y : 0.f); o.y = pack2(k0 + 2 <= t ? a.z : 0.f, k0 + 3 <= t ? a.w : 0.f);
    o.z = pack2(k0 + 4 <= t ? c.x : 0.f, k0 + 5 <= t ? c.y : 0.f); o.w = pack2(k0 + 6 <= t ? c.z : 0.f, k0 + 7 <= t ? c.w : 0.f);
    *(u32x4*)(p.wsp_b() + i) = o;
  } else if (item < 64 + 128) {
    const int i = (item - 64) * NTHREADS + tid;
    const int c = i & 63, dd = (i >> 6) & 63, lg = i >> 12;
    const f32x2 f = {p.w_pool[((size_t)lg * 64 + c) * 64 + dd], 0.f}; const bf16x2_t bb = __builtin_convertvector(f, bf16x2_t);
    p.wpool_t()[i] = (bf16_t)(__builtin_bit_cast(unsigned, bb) & 0xffffu);
  } else {
    const int i = (item - 192) * NTHREADS + tid;
    const int e = i & 63, k = (i >> 6) & 1023, l = i >> 16;
    const float v = p.w_router[i];
    const unsigned hi = pack2(v, 0.f) & 0xffffu;
    const unsigned lo = pack2(v - bflo(hi), 0.f) & 0xffffu;
    p.wr_hi()[(size_t)l * 65536 + e * 1024 + k] = (bf16_t)hi;
    p.wr_lo()[(size_t)l * 65536 + e * 1024 + k] = (bf16_t)lo;
  }
}

DI void item_rope(const P& p, int item) {
  const int i = item * NTHREADS + otid();
  const int t = i >> 4, f = i & 15;
  const float inv = exp2f(-(float)(2 * f) * (13.287712379549449f / 32.f));
  const float ang = (float)p.pos[t] * inv;
  const double rev = (double)ang * 0.15915494309189535;
  const float fr = (float)(rev - floor(rev));
  p.ropec()[i] = __builtin_amdgcn_cosf(fr);
  p.ropes()[i] = __builtin_amdgcn_sinf(fr);
}

DI void wait_mod_ready(const P& p) {
  if (full_tid() == 0) {
    unsigned* bar = p.bar();
    XB_SPIN(xb_ld(&bar[XB_MODRDY]) < 64u, bar);
    __builtin_amdgcn_fence(__ATOMIC_ACQUIRE, "agent");
    asm volatile("s_waitcnt vmcnt(0)" ::: "memory");
  }
  __syncthreads();
}
DI void item_norm0(const P& p, int item) {
  const int tid = otid(), w = tid >> 6, lane = tid & 63;
  const int t0 = item * 8 + w * 2, b = t0 >> 11;
  const float* md = p.mod() + (size_t)b * 6144;
  f32x4 v[2][4];
#pragma unroll
  for (int q = 0; q < 2; ++q)
#pragma unroll
    for (int j = 0; j < 4; ++j) v[q][j] = *(const f32x4*)(p.x + (size_t)(t0 + q) * 1024 + j * 256 + lane * 4);
  float ss[2] = {0.f, 0.f};
#pragma unroll
  for (int q = 0; q < 2; ++q)
#pragma unroll
    for (int j = 0; j < 4; ++j) ss[q] += v[q][j][0] * v[q][j][0] + v[q][j][1] * v[q][j][1] + v[q][j][2] * v[q][j][2] + v[q][j][3] * v[q][j][3];
  ss[0] = wsum(ss[0]); ss[1] = wsum(ss[1]);
#pragma unroll
  for (int q = 0; q < 2; ++q) {
    const float rstd = rsqrtf(ss[q] * (1.f / 1024.f) + EPS);
#pragma unroll
    for (int j = 0; j < 4; ++j) {
      const int idx = j * 256 + lane * 4;
      const f32x4 sh = *(const f32x4*)(md + idx), sc = *(const f32x4*)(md + 1024 + idx);
      const f32x4 hv = v[q][j] * rstd * (sc + 1.f) + sh;
      u32x2 o; o.x = pack2(hv[0], hv[1]); o.y = pack2(hv[2], hv[3]);
      *(u32x2*)(p.h() + (size_t)(t0 + q) * 1024 + idx) = o;
    }
  }
}

DI void item_pool(const P& p, unsigned char* smem, int l, int item) {
  const int tid = otid(), w = tid >> 6, lane = tid & 63, fr = lane & 15, fq = lane >> 4;
  const int tile = item >> 2, g = item & 3;
  const int t0 = tile * 128, s0 = t0 & 2047;
  const int wdw = 2 << g;
  unsigned char* al = smem;
  unsigned char* dl = smem + 20480;
  __syncthreads();
  for (int id = tid; id < 143 * 8; id += NTHREADS) {
    const int row = id >> 3, c = id & 7;
    const int srel = s0 - 15 + row;
    u32x4 v = (u32x4){0u, 0u, 0u, 0u};
    if (srel >= 0) v = *(const u32x4*)(p.proj() + (size_t)(t0 - 15 + row) * NIN + g * 64 + c * 8);
    *(u32x4*)(al + row * 128 + c * 16) = v;
  }
  __syncthreads();
  {
    const int tl = tid >> 1, cb = (tid & 1) * 4;
    const int pos = s0 + tl;
    const int nw = (pos + 1 < wdw) ? pos + 1 : wdw;
    const float inv = 1.f / (float)nw;
#pragma unroll
    for (int q = 0; q < 4; ++q) {
      const int c = cb + q;
      float sm[8];
#pragma unroll
      for (int e = 0; e < 8; ++e) sm[e] = 0.f;
      for (int j = 0; j < nw; ++j) {
        const u32x4 v = *(const u32x4*)(al + (tl + 15 - j) * 128 + c * 16);
        sm[0] += bflo(v.x); sm[1] += bfhi(v.x); sm[2] += bflo(v.y); sm[3] += bfhi(v.y); sm[4] += bflo(v.z); sm[5] += bfhi(v.z); sm[6] += bflo(v.w); sm[7] += bfhi(v.w);
      }
      const u32x4 a = *(const u32x4*)(al + (tl + 15) * 128 + c * 16);
      u32x4 o;
      o.x = pack2(sm[0] * inv - bflo(a.x), sm[1] * inv - bfhi(a.x)); o.y = pack2(sm[2] * inv - bflo(a.y), sm[3] * inv - bfhi(a.y));
      o.z = pack2(sm[4] * inv - bflo(a.z), sm[5] * inv - bfhi(a.z)); o.w = pack2(sm[6] * inv - bflo(a.w), sm[7] * inv - bfhi(a.w));
      *(u32x4*)(dl + tl * 128 + ((c ^ (tl & 7)) << 4)) = o;
    }
  }
  __syncthreads();
  {
    const bf16_t* wp = p.wpool_t() + ((size_t)(l * 4 + g) * 64) * 64;
    f32x4 acc[2][4];
#pragma unroll
    for (int i = 0; i < 2; ++i)
#pragma unroll
      for (int j = 0; j < 4; ++j) acc[i][j] = (f32x4){0.f, 0.f, 0.f, 0.f};
#pragma unroll
    for (int ks = 0; ks < 2; ++ks) {
      bf16x8 df[2], wf[4];
#pragma unroll
      for (int i = 0; i < 2; ++i) { const int row = w * 32 + i * 16 + fr; df[i] = *(const bf16x8*)(dl + row * 128 + (((ks * 4 + fq) ^ (row & 7)) << 4)); }
#pragma unroll
      for (int j = 0; j < 4; ++j) wf[j] = *(const bf16x8*)(wp + (size_t)((fr >> 2) * 16 + j * 4 + (fr & 3)) * 64 + ks * 32 + fq * 8);
#pragma unroll
      for (int i = 0; i < 2; ++i)
#pragma unroll
        for (int j = 0; j < 4; ++j) acc[i][j] = __builtin_amdgcn_mfma_f32_16x16x32_bf16(wf[j], df[i], acc[i][j], 0, 0, 0);
    }
#pragma unroll
    for (int i = 0; i < 2; ++i) {
      const int t = t0 + w * 32 + i * 16 + fr;
      const int c0 = g * 64 + fq * 16;
      u32x4 o;
#pragma unroll
      for (int j = 0; j < 4; ++j) {
        const f32x4 ps = *(const f32x4*)(p.pool_scale + l * 256 + c0 + j * 4);
        o[j] = pack4_fp8(acc[i][j] * ps * YMIX_SCALE);
      }
      *(u32x4*)(p.Y8() + (size_t)t * 1024 + c0) = o;
    }
  }
}

DI void item_sgu(const P& p, unsigned char* smem, int l, int chunk) {
  const int tid = otid(), w = tid >> 6, lane = tid & 63, fr = lane & 15, fq = lane >> 4;
  const int t0 = chunk * 128;
  unsigned char* vn = smem;
  __syncthreads();
  {
    const int part = tid & 7;
    u32x4 raw[4][4];
#pragma unroll
    for (int ps = 0; ps < 4; ++ps) {
      const bf16_t* src = p.proj() + (size_t)(t0 + ps * 32 + (tid >> 3)) * NIN + 512 + part * 32;
#pragma unroll
      for (int q = 0; q < 4; ++q) raw[ps][q] = *(const u32x4*)(src + q * 8);
    }
#pragma unroll
    for (int ps = 0; ps < 4; ++ps) {
      const int tl = ps * 32 + (tid >> 3);
      float x[32];
#pragma unroll
      for (int q = 0; q < 4; ++q) {
        const u32x4 v = raw[ps][q];
        const f32x2 g0 = gelu_tanh2((f32x2){bflo(v.x), bfhi(v.x)}), g1 = gelu_tanh2((f32x2){bflo(v.y), bfhi(v.y)}), g2 = gelu_tanh2((f32x2){bflo(v.z), bfhi(v.z)}), g3 = gelu_tanh2((f32x2){bflo(v.w), bfhi(v.w)});
        x[q * 8 + 0] = g0[0]; x[q * 8 + 1] = g0[1]; x[q * 8 + 2] = g1[0]; x[q * 8 + 3] = g1[1]; x[q * 8 + 4] = g2[0]; x[q * 8 + 5] = g2[1]; x[q * 8 + 6] = g3[0]; x[q * 8 + 7] = g3[1];
      }
      float sm = 0.f;
#pragma unroll
      for (int e = 0; e < 32; ++e) sm += x[e];
      sm += dpp_xor1(sm); sm += dpp_xor2(sm); sm += dpp_hmir(sm);
      const float mu = sm * (1.f / 256.f);
      float vs = 0.f;
#pragma unroll
      for (int e = 0; e < 32; ++e) { x[e] -= mu; vs += x[e] * x[e]; }
      vs += dpp_xor1(vs); vs += dpp_xor2(vs); vs += dpp_hmir(vs);
      const float rstd = rsqrtf(vs * (1.f / 256.f) + EPS);
#pragma unroll
      for (int q = 0; q < 4; ++q) {
        const int c = part * 4 + q;
        u32x4 o;
        o.x = pack2(x[q * 8 + 0] * rstd, x[q * 8 + 1] * rstd); o.y = pack2(x[q * 8 + 2] * rstd, x[q * 8 + 3] * rstd);
        o.z = pack2(x[q * 8 + 4] * rstd, x[q * 8 + 5] * rstd); o.w = pack2(x[q * 8 + 6] * rstd, x[q * 8 + 7] * rstd);
        *(u32x4*)(vn + tl * 512 + (((c >> 1) ^ (tl & 7)) << 5) + ((c & 1) << 4)) = o;
      }
    }
  }
  __syncthreads();
  const int qq = fr >> 2, pp = fr & 3;
#pragma unroll 1
  for (int hh = 0; hh < 4; ++hh) {
    f32x4 acc[4][2];
#pragma unroll
    for (int df = 0; df < 4; ++df) { acc[df][0] = (f32x4){0.f, 0.f, 0.f, 0.f}; acc[df][1] = (f32x4){0.f, 0.f, 0.f, 0.f}; }
    const bf16_t* wb = p.wsp_b() + ((size_t)(l * 4 + hh) * 128) * 128;
    u32x2 wlo[4][2], whi[4][2], uu[2][4]; float bias[2];
#pragma unroll
    for (int kb = 0; kb < 4; ++kb)
#pragma unroll
      for (int f = 0; f < 2; ++f) { const bf16_t* wr = wb + (size_t)((2 * w + f) * 16 + fr) * 128 + kb * 32 + fq * 4; wlo[kb][f] = *(const u32x2*)wr; whi[kb][f] = *(const u32x2*)(wr + 16); }
#pragma unroll
    for (int f = 0; f < 2; ++f) {
      const int tl = (2 * w + f) * 16 + fr;
      bias[f] = p.b_spatial[(l * 4 + hh) * 128 + tl];
#pragma unroll
      for (int df = 0; df < 4; ++df) uu[f][df] = *(const u32x2*)(p.proj() + (size_t)(t0 + tl) * NIN + 256 + hh * 64 + df * 16 + fq * 4);
    }
#pragma unroll
    for (int kb = 0; kb < 4; ++kb) {
      if (kb <= w) {
        bf16x8 wf[2];
#pragma unroll
        for (int f = 0; f < 2; ++f) { u32x4 u; u.x = wlo[kb][f].x; u.y = wlo[kb][f].y; u.z = whi[kb][f].x; u.w = whi[kb][f].y; wf[f] = __builtin_bit_cast(bf16x8, u); }
#pragma unroll
        for (int df = 0; df < 4; ++df) {
          const int keyA = kb * 32 + fq * 4 + qq, keyB = keyA + 16;
          const int slot = hh * 4 + df;
          const s16x4 lo = __builtin_amdgcn_ds_read_tr16_b64_v4i16((LAS s16x4*)(vn + keyA * 512 + ((slot ^ (keyA & 7)) << 5) + pp * 8));
          const s16x4 hi = __builtin_amdgcn_ds_read_tr16_b64_v4i16((LAS s16x4*)(vn + keyB * 512 + ((slot ^ (keyB & 7)) << 5) + pp * 8));
          bf16x8 vf; vf[0] = lo[0]; vf[1] = lo[1]; vf[2] = lo[2]; vf[3] = lo[3]; vf[4] = hi[0]; vf[5] = hi[1]; vf[6] = hi[2]; vf[7] = hi[3];
          acc[df][0] = __builtin_amdgcn_mfma_f32_16x16x32_bf16(vf, wf[0], acc[df][0], 0, 0, 0);
          acc[df][1] = __builtin_amdgcn_mfma_f32_16x16x32_bf16(vf, wf[1], acc[df][1], 0, 0, 0);
        }
      }
    }
#pragma unroll
    for (int f = 0; f < 2; ++f) {
      const int tl = (2 * w + f) * 16 + fr, t = t0 + tl;
      unsigned dw[4];
#pragma unroll
      for (int df = 0; df < 4; ++df) {
        const u32x2 u2 = uu[f][df];
        const f32x2 ga = gelu_tanh2((f32x2){bflo(u2.x), bfhi(u2.x)}), gb = gelu_tanh2((f32x2){bflo(u2.y), bfhi(u2.y)});
        const f32x4 ov = (f32x4){ga[0], ga[1], gb[0], gb[1]} * (acc[df][f] + bias[f]);
        dw[df] = pack4_fp8(ov * YMIX_SCALE);
      }
      const auto p02 = __builtin_amdgcn_permlane32_swap(dw[0], dw[2], false, false);
      const auto p13 = __builtin_amdgcn_permlane32_swap(dw[1], dw[3], false, false);
      const auto qa = __builtin_amdgcn_permlane16_swap(p02[0], p13[0], false, false);
      const auto qc = __builtin_amdgcn_permlane16_swap(p02[1], p13[1], false, false);
      *(u32x4*)(p.Y8() + (size_t)t * 1024 + 256 + hh * 64 + fq * 16) = (u32x4){qa[0], qa[1], qc[0], qc[1]};
    }
  }
}

typedef float f32x16 __attribute__((ext_vector_type(16)));
typedef LAS const char* lds_cptr;
constexpr int A8_KSLOT = 12288, A8_VSLOT = 8192, A8_LDS_K = 0, A8_LDS_V = 3 * A8_KSLOT, A8_LDS_WS = A8_LDS_V + 3 * A8_VSLOT, A8_LDS_OST = A8_LDS_WS + 8 * 256, A8_LDS_END = A8_LDS_OST + 8 * 4096;
static_assert(A8_LDS_END <= 128 * 1024, "attention LDS");
#define A8_SBAR() __builtin_amdgcn_sched_barrier(0)
#define A8_PIN(x) asm volatile("" : "+v"(x))
#define A8_MFMA(a, b, c) __builtin_amdgcn_mfma_f32_32x32x16_bf16(a, b, c, 0, 0, 0)
#define A8_WAIT_BAR(N) asm volatile("s_waitcnt vmcnt(" #N ") lgkmcnt(0)\n\ts_barrier" ::: "memory")
DI int a8_crow(int r, int hi) { return (r & 3) + 8 * (r >> 2) + 4 * hi; }
DI void a8_glds16(const void* g, unsigned lds_base) {
  unsigned sv; asm volatile("s_mov_b32 %0, m0\n\ts_mov_b32 m0, %2\n\ts_nop 0\n\tglobal_load_lds_dwordx4 %1, off\n\ts_mov_b32 m0, %0" : "=&s"(sv) : "v"(g), "s"(lds_base) : "memory"); }
DI void a8_kload2(bf16x8* kf, lds_cptr kp, int d0) { kf[2 * d0] = *(const LAS bf16x8*)(kp + d0 * 2048); kf[2 * d0 + 1] = *(const LAS bf16x8*)(kp + d0 * 2048 + 512); }
DI s16x4 a8_vtr(lds_cptr p) { return __builtin_amdgcn_ds_read_tr16_b64_v4i16((LAS s16x4*)p); }
#define A8_MX3(a, b, c) __builtin_fmaxf(__builtin_fmaxf((a), (b)), (c))
DI float a8_rowmax(const f32x16& p0, const f32x16& p1) {
  float a = A8_MX3(p0[0], p0[1], p1[0]), b = A8_MX3(p0[2], p0[3], p1[1]); a = A8_MX3(a, p1[2], p1[3]);
#pragma unroll
  for (int r = 4; r < 16; r += 4) { a = A8_MX3(a, p0[r], p0[r + 1]); b = A8_MX3(b, p0[r + 2], p0[r + 3]); a = A8_MX3(a, p1[r], p1[r + 1]); b = A8_MX3(b, p1[r + 2], p1[r + 3]); }
  const float m = __builtin_fmaxf(a, b);
  typedef unsigned u2v __attribute__((ext_vector_type(2)));
  const u2v rr = __builtin_amdgcn_permlane32_swap(__builtin_bit_cast(unsigned, m), __builtin_bit_cast(unsigned, m), false, false);
  return __builtin_fmaxf(__builtin_bit_cast(float, rr[0]), __builtin_bit_cast(float, rr[1]));
}
DI void a8_cmask(f32x16& p0, f32x16& p1, int jb, int qrel, int hi) {
  const int kb = 64 * jb + 4 * hi;
#pragma unroll
  for (int r = 0; r < 16; ++r) { const int kv = kb + (r & 3) + 8 * (r >> 2); if (kv > qrel) p0[r] = -INFINITY; if (kv + 32 > qrel) p1[r] = -INFINITY; }
}
constexpr float A8_THR = 8.f;

DI void attn8_unit(const P& p, int bh, int qb) {
  const int tid = full_tid(), lane = tid & 63, r32 = lane & 31, hi = lane >> 5; const int wid = __builtin_amdgcn_readfirstlane(tid >> 6);
  const int b = bh >> 3, h = bh & 7;
  const int q0 = qb * 256, NT = (q0 + 256) / 64;
  const bf16_t* Qw = p.Q() + ((size_t)bh * 2048 + q0 + wid * 32) * 96;
  const bf16_t* Kg = p.Kb() + (size_t)bh * 2048 * 96;
  const bf16_t* Vg = p.V() + (size_t)bh * 2048 * 64;
  LAS float* wsf = (LAS float*)(size_t)(A8_LDS_WS + wid * 256);
  const bf16_t* ksrc0 = Kg + (size_t)lane * 96 + wid * 8;
  const bf16_t* ksrc1 = Kg + (size_t)lane * 96 + (8 + (wid & 3)) * 8;
  const bf16_t* vsrc = Vg + (size_t)(16 * (wid & 3) + (lane >> 2)) * 64 + (wid >> 2) * 32 + (lane & 3) * 8;
  const unsigned kdst0 = A8_LDS_K + wid * 1024, kdst1 = A8_LDS_K + (8 + (wid & 3)) * 1024, vdst = A8_LDS_V + wid * 1024;
#define A8_DMA_K(t, slot) do { a8_glds16(ksrc0 + (size_t)(t) * 64 * 96, (unsigned)__builtin_amdgcn_readfirstlane(kdst0 + (slot))); a8_glds16(ksrc1 + (size_t)(t) * 64 * 96, (unsigned)__builtin_amdgcn_readfirstlane(kdst1 + (slot))); } while (0)
#define A8_DMA_V(t, slot) a8_glds16(vsrc + (size_t)(t) * 64 * 64, (unsigned)__builtin_amdgcn_readfirstlane(vdst + (slot)))
  const lds_cptr vp0 = (lds_cptr)(size_t)(A8_LDS_V + ((lane >> 4) & 1) * 32 + (lane & 3) * 8 + (4 * hi + ((lane & 15) >> 2)) * 64);
  const lds_cptr kp0 = (lds_cptr)(size_t)(A8_LDS_K + hi * 1024 + r32 * 16);
  asm volatile("s_waitcnt vmcnt(0) lgkmcnt(0)\n\ts_barrier" ::: "memory");
  A8_DMA_K(0, 0); A8_DMA_V(0, 0); A8_DMA_K(1, A8_KSLOT);
  bf16x8 qr[6];
#pragma unroll
  for (int d0 = 0; d0 < 6; ++d0) qr[d0] = *(const bf16x8*)(Qw + (size_t)r32 * 96 + d0 * 16 + hi * 8);
  const size_t trow = (size_t)b * 2048 + q0 + wid * 32 + r32;
  const float* rcp_ = p.ropec() + trow * 16 + hi * 8; const float* rsp_ = p.ropes() + trow * 16 + hi * 8;
  const f32x4 rc0 = *(const f32x4*)rcp_, rc1 = *(const f32x4*)(rcp_ + 4), rs0 = *(const f32x4*)rsp_, rs1 = *(const f32x4*)(rsp_ + 4);
  float mhat = 0.f, l_reg = 0.f; f32x16 o[2];
#pragma unroll
  for (int r = 0; r < 16; ++r) { o[0][r] = 0.f; o[1][r] = 0.f; }
  const f32x16 zero16 = {0.f, 0.f, 0.f, 0.f, 0.f, 0.f, 0.f, 0.f, 0.f, 0.f, 0.f, 0.f, 0.f, 0.f, 0.f, 0.f};
  const int qrel = wid * 32 + r32; bool resc = false;
  f32x16 pA0, pA1, pB0, pB1; bf16x8 kf[12]; s16x4 vlo[8], vhi[8]; u32x4 pw0, pw1, pw2, pw3;
  int ks_cur = 0, ks_next = A8_KSLOT, vs_prev = 0, vs_cur = 0, vs_next = A8_VSLOT;
#define A8_ROT() do { vs_prev = vs_cur; vs_cur = vs_next; vs_next = (vs_next == 2 * A8_VSLOT) ? 0 : vs_next + A8_VSLOT; ks_cur = ks_next; ks_next = (ks_next == 2 * A8_KSLOT) ? 0 : ks_next + A8_KSLOT; } while (0)
#define A8_EX(v) __builtin_amdgcn_exp2f((v) + nmh)
#define A8_RESC() do { if (resc) { _Pragma("unroll") for (int d_ = 0; d_ < 2; ++d_) _Pragma("unroll") for (int r = 0; r < 16; ++r) o[d_][r] *= wsf[a8_crow(r, hi)]; } } while (0)
  A8_DMA_K(2, 2 * A8_KSLOT);
  A8_WAIT_BAR(5);
  {
    const u32x4 a1 = __builtin_bit_cast(u32x4, qr[4]), a2 = __builtin_bit_cast(u32x4, qr[5]);
    const f32x4 x1a = {bflo(a1.x), bfhi(a1.x), bflo(a1.y), bfhi(a1.y)}, x1b = {bflo(a1.z), bfhi(a1.z), bflo(a1.w), bfhi(a1.w)};
    const f32x4 x2a = {bflo(a2.x), bfhi(a2.x), bflo(a2.y), bfhi(a2.y)}, x2b = {bflo(a2.z), bfhi(a2.z), bflo(a2.w), bfhi(a2.w)};
    const f32x4 y1a = x1a * rc0 - x2a * rs0, y1b = x1b * rc1 - x2b * rs1, y2a = x2a * rc0 + x1a * rs0, y2b = x2b * rc1 + x1b * rs1;
    qr[4] = __builtin_bit_cast(bf16x8, (u32x4){pack2(y1a[0], y1a[1]), pack2(y1a[2], y1a[3]), pack2(y1b[0], y1b[1]), pack2(y1b[2], y1b[3])});
    qr[5] = __builtin_bit_cast(bf16x8, (u32x4){pack2(y2a[0], y2a[1]), pack2(y2a[2], y2a[3]), pack2(y2b[0], y2b[1]), pack2(y2b[2], y2b[3])});
  }
#pragma unroll
  for (int d0 = 0; d0 < 6; ++d0) a8_kload2(kf, kp0, d0);
  pA0 = A8_MFMA(kf[0], qr[0], zero16); pA1 = A8_MFMA(kf[1], qr[0], zero16);
#pragma unroll
  for (int d0 = 1; d0 < 6; ++d0) { pA0 = A8_MFMA(kf[2 * d0], qr[d0], pA0); pA1 = A8_MFMA(kf[2 * d0 + 1], qr[d0], pA1); }
  if (NT == 4) a8_cmask(pA0, pA1, 0, qrel, hi);
  { const float rm = a8_rowmax(pA0, pA1); mhat = rm; const float nmh = -mhat;
#pragma unroll
    for (int r = 0; r < 16; ++r) { pA0[r] = A8_EX(pA0[r]); pA1[r] = A8_EX(pA1[r]); } }
  A8_WAIT_BAR(0);
  A8_DMA_K(3, 0); A8_DMA_V(1, A8_VSLOT); A8_ROT();
#pragma unroll
  for (int d0 = 0; d0 < 6; ++d0) a8_kload2(kf, kp0 + ks_cur, d0);
  A8_WAIT_BAR(3);
#define A8_PKW(Pv, i) pack2(Pv[i], Pv[i + 1])
#define A8_PAF(k) __builtin_bit_cast(bf16x8, pw##k)
#define A8_VFR(i) (bf16x8){vlo[i][0], vlo[i][1], vlo[i][2], vlo[i][3], vhi[i][0], vhi[i][1], vhi[i][2], vhi[i][3]}
#define A8_VRD(i) do { vlo[i] = a8_vtr(vp_ + (((i) >> 2) * 4096 + ((i) & 3) * 1024)); vhi[i] = a8_vtr(vp_ + (((i) >> 2) * 4096 + ((i) & 3) * 1024 + 512)); } while (0)
#define A8_KRD(G, d0) do { if (G) { a8_kload2(kf, kp0 + ks_next, d0); A8_SBAR(); } } while (0)
#define A8_GAPA(MF, a0, a1, a2, a3, W0, W1, PW) do { MF; sacc += a0; sacc += a1; sacc += a2; sacc += a3; W0; W1; A8_PIN(PW); A8_PIN(sacc); A8_SBAR(); } while (0)
#define A8_GAPB(MF, X, i) do { MF; X[i] = A8_EX(X[i]); X[i + 1] = A8_EX(X[i + 1]); X[i + 2] = A8_EX(X[i + 2]); X[i + 3] = A8_EX(X[i + 3]); A8_PIN(X); A8_SBAR(); } while (0)
#define A8_STEP(C0, C1, P0, P1, t, MASK, GK, GV, GL) do { A8_SBAR(); \
    const lds_cptr vp_ = vp0 + vs_prev; \
    A8_VRD(0); A8_SBAR(); float sacc = P0[0] + P0[1]; \
                          A8_GAPA(C0 = A8_MFMA(kf[0], qr[0], zero16), P0[2], P0[3], P0[4], P0[5],     pw0[0] = A8_PKW(P0, 0),  pw0[1] = A8_PKW(P0, 2),  pw0); \
    A8_VRD(4); A8_SBAR(); A8_GAPA(C1 = A8_MFMA(kf[1], qr[0], zero16), P0[6], P0[7], P0[8], P0[9],     pw0[2] = A8_PKW(P0, 4),  pw0[3] = A8_PKW(P0, 6),  pw0); \
    A8_VRD(1); A8_SBAR(); A8_GAPA(C0 = A8_MFMA(kf[2], qr[1], C0),     P0[10], P0[11], P0[12], P0[13], pw1[0] = A8_PKW(P0, 8),  pw1[1] = A8_PKW(P0, 10), pw1); \
    A8_VRD(5); A8_SBAR(); A8_GAPA(C1 = A8_MFMA(kf[3], qr[1], C1),     P0[14], P0[15], P1[0], P1[1],   pw1[2] = A8_PKW(P0, 12), pw1[3] = A8_PKW(P0, 14), pw1); \
    A8_VRD(2); A8_SBAR(); A8_GAPA(C0 = A8_MFMA(kf[4], qr[2], C0),     P1[2], P1[3], P1[4], P1[5],     pw2[0] = A8_PKW(P1, 0),  pw2[1] = A8_PKW(P1, 2),  pw2); \
    A8_VRD(6); A8_SBAR(); A8_GAPA(C1 = A8_MFMA(kf[5], qr[2], C1),     P1[6], P1[7], P1[8], P1[9],     pw2[2] = A8_PKW(P1, 4),  pw2[3] = A8_PKW(P1, 6),  pw2); \
    A8_VRD(3); A8_SBAR(); A8_GAPA(C0 = A8_MFMA(kf[6], qr[3], C0),     P1[10], P1[11], P1[12], P1[13], pw3[0] = A8_PKW(P1, 8),  pw3[1] = A8_PKW(P1, 10), pw3); \
    A8_VRD(7); A8_SBAR(); A8_GAPA(C1 = A8_MFMA(kf[7], qr[3], C1),     P1[14], P1[15], 0.f, 0.f,       pw3[2] = A8_PKW(P1, 12), pw3[3] = A8_PKW(P1, 14), pw3); \
    C0 = A8_MFMA(kf[8], qr[4], C0); C1 = A8_MFMA(kf[9], qr[4], C1); C0 = A8_MFMA(kf[10], qr[5], C0); C1 = A8_MFMA(kf[11], qr[5], C1); A8_SBAR(); \
    l_reg += sacc; \
    if (GK) A8_DMA_K((t) + 3, ks_cur); if (GV) A8_DMA_V((t) + 1, vs_next); \
    if (MASK) a8_cmask(C0, C1, (t) - (NT - 4), qrel, hi); \
    { const float rm = a8_rowmax(C0, C1) - mhat; resc = false; \
      if (__builtin_expect(__builtin_amdgcn_ballot_w64(rm > A8_THR) != 0, 0)) { const float dl = __builtin_fmaxf(rm, 0.f); mhat += dl; \
          const float f = __builtin_amdgcn_exp2f(-dl); l_reg *= f; if (hi == 0) wsf[r32] = f; resc = true; } } \
    const float nmh = -mhat; A8_SBAR(); \
    A8_GAPB(o[0] = A8_MFMA(A8_PAF(0), A8_VFR(0), o[0]), C0, 0);                  A8_GAPB(o[1] = A8_MFMA(A8_PAF(0), A8_VFR(4), o[1]), C0, 4); \
    A8_KRD(GL, 0); A8_GAPB(o[0] = A8_MFMA(A8_PAF(1), A8_VFR(1), o[0]), C0, 8);  A8_KRD(GL, 1); A8_GAPB(o[1] = A8_MFMA(A8_PAF(1), A8_VFR(5), o[1]), C0, 12); \
    A8_KRD(GL, 2); A8_GAPB(o[0] = A8_MFMA(A8_PAF(2), A8_VFR(2), o[0]), C1, 0);  A8_KRD(GL, 3); A8_GAPB(o[1] = A8_MFMA(A8_PAF(2), A8_VFR(6), o[1]), C1, 4); \
    A8_KRD(GL, 4); A8_GAPB(o[0] = A8_MFMA(A8_PAF(3), A8_VFR(3), o[0]), C1, 8);  A8_KRD(GL, 5); A8_GAPB(o[1] = A8_MFMA(A8_PAF(3), A8_VFR(7), o[1]), C1, 12); \
    } while (0)
  int t = 1;
  for (; t + 5 < NT; t += 2) {
    A8_STEP(pB0, pB1, pA0, pA1, t, false, true, true, true);     A8_WAIT_BAR(3); A8_RESC(); A8_ROT();
    A8_STEP(pA0, pA1, pB0, pB1, t + 1, false, true, true, true); A8_WAIT_BAR(3); A8_RESC(); A8_ROT();
  }
#define A8_ENDW(tt) do { if ((tt) + 3 < NT) { A8_WAIT_BAR(3); } else if ((tt) + 2 < NT) { A8_WAIT_BAR(1); } else { A8_WAIT_BAR(0); } } while (0)
  for (; t + 1 < NT; t += 2) {
    A8_STEP(pB0, pB1, pA0, pA1, t, true, (t + 3 < NT), (t + 1 < NT), (t + 1 < NT));         A8_ENDW(t);     A8_RESC(); A8_ROT();
    A8_STEP(pA0, pA1, pB0, pB1, t + 1, true, (t + 4 < NT), (t + 2 < NT), (t + 2 < NT));     A8_ENDW(t + 1); A8_RESC(); A8_ROT();
  }
  A8_STEP(pB0, pB1, pA0, pA1, NT - 1, true, false, false, false); A8_RESC();
  { float sacc = pB0[0] + pB0[1];
#pragma unroll
    for (int r = 2; r < 16; ++r) sacc += pB0[r];
#pragma unroll
    for (int r = 0; r < 16; ++r) sacc += pB1[r];
    l_reg += sacc;
    pw0 = (u32x4){A8_PKW(pB0, 0), A8_PKW(pB0, 2), A8_PKW(pB0, 4), A8_PKW(pB0, 6)}; pw1 = (u32x4){A8_PKW(pB0, 8), A8_PKW(pB0, 10), A8_PKW(pB0, 12), A8_PKW(pB0, 14)};
    pw2 = (u32x4){A8_PKW(pB1, 0), A8_PKW(pB1, 2), A8_PKW(pB1, 4), A8_PKW(pB1, 6)}; pw3 = (u32x4){A8_PKW(pB1, 8), A8_PKW(pB1, 10), A8_PKW(pB1, 12), A8_PKW(pB1, 14)};
    const lds_cptr vp_ = vp0 + vs_cur;
#pragma unroll
    for (int i = 0; i < 8; ++i) A8_VRD(i);
    o[0] = A8_MFMA(A8_PAF(0), A8_VFR(0), o[0]); o[1] = A8_MFMA(A8_PAF(0), A8_VFR(4), o[1]); o[0] = A8_MFMA(A8_PAF(1), A8_VFR(1), o[0]); o[1] = A8_MFMA(A8_PAF(1), A8_VFR(5), o[1]);
    o[0] = A8_MFMA(A8_PAF(2), A8_VFR(2), o[0]); o[1] = A8_MFMA(A8_PAF(2), A8_VFR(6), o[1]); o[0] = A8_MFMA(A8_PAF(3), A8_VFR(3), o[0]); o[1] = A8_MFMA(A8_PAF(3), A8_VFR(7), o[1]); }
  { typedef unsigned u2v __attribute__((ext_vector_type(2)));
    const u2v rr = __builtin_amdgcn_permlane32_swap(__builtin_bit_cast(unsigned, l_reg), __builtin_bit_cast(unsigned, l_reg), false, false);
    l_reg = __builtin_bit_cast(float, rr[0]) + __builtin_bit_cast(float, rr[1]); }
  if (hi == 0) wsf[32 + r32] = l_reg;
  asm volatile("s_waitcnt lgkmcnt(0)" ::: "memory");
  float rli[16];
#pragma unroll
  for (int r = 0; r < 16; ++r) rli[r] = __builtin_amdgcn_rcpf(wsf[32 + a8_crow(r, hi)]);
  unsigned char* Ow = p.Y8() + ((size_t)b * 2048 + q0 + wid * 32) * 1024 + 512 + h * 64;
  LAS bf16_t* stg = (LAS bf16_t*)(size_t)(A8_LDS_OST + wid * 4096);
#pragma unroll
  for (int r = 0; r < 16; ++r) { const int orow = a8_crow(r, hi);
#pragma unroll
    for (int d0 = 0; d0 < 2; ++d0) stg[orow * 64 + d0 * 32 + r32] = (bf16_t)(pack2(o[d0][r] * rli[r], 0.f) & 0xffffu); }
  asm volatile("s_waitcnt lgkmcnt(0)" ::: "memory");
#pragma unroll
  for (int i = 0; i < 2; ++i) {
    const int row = i * 16 + (lane >> 2), ch = lane & 3;
    const u32x4 v = *(const LAS u32x4*)(stg + row * 64 + ch * 16), v2 = *(const LAS u32x4*)(stg + row * 64 + ch * 16 + 8);
    const f32x4 va = {bflo(v.x), bfhi(v.x), bflo(v.y), bfhi(v.y)}, vb = {bflo(v.z), bfhi(v.z), bflo(v.w), bfhi(v.w)};
    const f32x4 vc = {bflo(v2.x), bfhi(v2.x), bflo(v2.y), bfhi(v2.y)}, vd = {bflo(v2.z), bfhi(v2.z), bflo(v2.w), bfhi(v2.w)};
    const u32x2 o0 = pack8_fp8(va * YMIX_SCALE, vb * YMIX_SCALE), o1 = pack8_fp8(vc * YMIX_SCALE, vd * YMIX_SCALE);
    *(u32x4*)(Ow + (size_t)row * 1024 + ch * 16) = (u32x4){o0.x, o0.y, o1.x, o1.y};
  }
  asm volatile("s_waitcnt lgkmcnt(0)\n\ts_barrier" ::: "memory");
#undef A8_DMA_K
#undef A8_DMA_V
#undef A8_ROT
#undef A8_EX
#undef A8_RESC
#undef A8_PKW
#undef A8_PAF
#undef A8_VFR
#undef A8_VRD
#undef A8_KRD
#undef A8_ENDW
#undef A8_GAPA
#undef A8_GAPB
#undef A8_STEP
}

DI void item_p5(const P& p, unsigned char* smem, int l, int item) {
  const int tid = otid(), w = tid >> 6, lane = tid & 63, fr = lane & 15, fq = lane >> 4;
  const int tf = w >> 1, kh = w & 1;
  const int tb = item * 32 + tf * 16;
  const int t = tb + fr, b = (item * 32) >> 11;
  const bf16_t* xr = p.xb() + (size_t)t * 1024 + kh * 512 + fq * 8;
  float* mds = (float*)(smem + 32768);
  const float bias = p.router_bias[l * 64 + lane];
  __syncthreads();
  {
    const float* md = p.mod() + ((size_t)l * 8 + b) * 6144 + 3072;
    const float4 m0 = *(const float4*)(md + tid * 4), m1 = *(const float4*)(md + (tid + NTHREADS) * 4);
    *(float4*)(mds + tid * 4) = m0; *(float4*)(mds + (tid + NTHREADS) * 4) = m1;
  }
  float rstd;
  {
    const float4* rp = (const float4*)(p.rowss() + (size_t)t * 16);
    const float4 a = rp[0], c = rp[1], d = rp[2], e = rp[3];
    const float ss = ((a.x + a.y) + (a.z + a.w)) + ((c.x + c.y) + (c.z + c.w)) + ((d.x + d.y) + (d.z + d.w)) + ((e.x + e.y) + (e.z + e.w));
    rstd = rsqrtf(ss * (1.f / 1024.f) + EPS);
  }
  const bf16_t* whi = p.wr_hi() + (size_t)l * 65536 + (size_t)fr * 1024 + kh * 512 + fq * 8;
  unsigned char* hdst = (unsigned char*)p.h() + (size_t)t * 1024 + kh * 512 + fq * 8;
  f32x4 acc[4];
#pragma unroll
  for (int nf = 0; nf < 4; ++nf) acc[nf] = (f32x4){0.f, 0.f, 0.f, 0.f};
  bf16x8 w0[4], w1[4], w2[4], w3[4]; f32x4 xa0, xb0, xa1, xb1, xa2, xb2, xa3, xb3;
#define P5_LOAD(W, XA, XB, ks_) do { const int kn_ = (ks_) < 16 ? (ks_) : 15; _Pragma("unroll") for (int nf = 0; nf < 4; ++nf) W[nf] = *(const bf16x8*)(whi + (size_t)nf * 16384 + kn_ * 32); \
    { const u32x4 xw_ = *(const u32x4*)(xr + kn_ * 32); XA = bf4lo(xw_); XB = bf4hi(xw_); } } while (0)
#define P5_STEP(W, XA, XB, ks_) do { const int k0 = kh * 512 + (ks_) * 32 + fq * 8; \
    const f32x4 ha = *(const f32x4*)(mds + k0), hb = *(const f32x4*)(mds + k0 + 4), sa = *(const f32x4*)(mds + 1024 + k0), sb = *(const f32x4*)(mds + 1024 + k0 + 4); \
    const f32x4 va = XA * rstd * (sa + 1.f) + ha, vb = XB * rstd * (sb + 1.f) + hb; \
    u32x4 uh, ul; uh.x = pack2(va[0], va[1]); uh.y = pack2(va[2], va[3]); uh.z = pack2(vb[0], vb[1]); uh.w = pack2(vb[2], vb[3]); \
    ul.x = pack2(va[0] - bflo(uh.x), va[1] - bfhi(uh.x)); ul.y = pack2(va[2] - bflo(uh.y), va[3] - bfhi(uh.y)); \
    ul.z = pack2(vb[0] - bflo(uh.z), vb[1] - bfhi(uh.z)); ul.w = pack2(vb[2] - bflo(uh.w), vb[3] - bfhi(uh.w)); \
    *(u32x2*)(hdst + (ks_) * 32) = pack8_fp8(va, vb); \
    const bf16x8 bh = __builtin_bit_cast(bf16x8, uh), bl = __builtin_bit_cast(bf16x8, ul); \
    _Pragma("unroll") for (int nf = 0; nf < 4; ++nf) { acc[nf] = __builtin_amdgcn_mfma_f32_16x16x32_bf16(W[nf], bh, acc[nf], 0, 0, 0); acc[nf] = __builtin_amdgcn_mfma_f32_16x16x32_bf16(W[nf], bl, acc[nf], 0, 0, 0); } } while (0)
  P5_LOAD(w0, xa0, xb0, 0); P5_LOAD(w1, xa1, xb1, 1); P5_LOAD(w2, xa2, xb2, 2);
  __syncthreads();
#pragma unroll 1
  for (int ks = 0; ks < 16; ks += 4) {
    P5_LOAD(w3, xa3, xb3, ks + 3); P5_STEP(w0, xa0, xb0, ks);
    P5_LOAD(w0, xa0, xb0, ks + 4); P5_STEP(w1, xa1, xb1, ks + 1);
    P5_LOAD(w1, xa1, xb1, ks + 5); P5_STEP(w2, xa2, xb2, ks + 2);
    P5_LOAD(w2, xa2, xb2, ks + 6); P5_STEP(w3, xa3, xb3, ks + 3);
  }
#undef P5_LOAD
#undef P5_STEP
  float* red = (float*)smem;
  int* info = (int*)(smem + 16384) + w * 512;
  int* cntw = (int*)(smem + 24576);
#pragma unroll
  for (int nf = 0; nf < 4; ++nf) *(f32x4*)(red + w * 1024 + fr * 64 + nf * 16 + fq * 4) = acc[nf];
  __syncthreads();
  int cnt_local = 0;
  const int tq0 = kh * 8;
#pragma unroll 2
  for (int q = 0; q < 8; ++q) {
    const float lgt = red[(tf * 2) * 1024 + (tq0 + q) * 64 + lane] + red[(tf * 2 + 1) * 1024 + (tq0 + q) * 64 + lane];
    const float s = __builtin_amdgcn_rcpf(1.f + __expf(-lgt));
    const float sel = s + bias;
    const float m1 = max8(sel);
    const unsigned long long eq = __ballot(sel == m1);
    const int gbase = lane & ~7;
    const unsigned gm = (unsigned)((eq >> gbase) & 0xffull);
    const int first = gbase + __ffs(gm) - 1;
    const float m2 = max8((lane == first) ? -INFINITY : sel);
    const float gs = m1 + m2;
    const int myg = lane >> 3; int rank = 0;
#pragma unroll
    for (int j = 0; j < 8; ++j) { const float gj = __int_as_float(__builtin_amdgcn_readlane(__float_as_int(gs), j * 8)); rank += ((gj > gs) || (gj == gs && j < myg)) ? 1 : 0; }
    const bool gsel = rank < 4;
    const unsigned sb = (unsigned)__float_as_int(sel);
    const unsigned okey = (sb & 0x80000000u) ? ~sb : (sb | 0x80000000u);
    const unsigned key = gsel ? ((okey & ~63u) | (unsigned)(63 - lane)) : 0u;
    unsigned long long gmask = __ballot(gsel);
    int rk = 0;
#pragma unroll
    for (int j = 0; j < 4; ++j) {
      const int gb = __builtin_ctzll(gmask) & ~7;
      gmask &= ~(0xFFull << gb);
#pragma unroll
      for (int e = 0; e < 8; ++e) { const unsigned ko = (unsigned)__builtin_amdgcn_readlane((int)key, gb + e); rk += (ko > key) ? 1 : 0; }
    }
    const bool ch = gsel && rk < 8;
    const float tot = wsum(ch ? s : 0.f);
    const unsigned long long cm = __ballot(ch);
    const int kidx = __popcll(cm & ((1ull << lane) - 1ull));
    info[q * 64 + lane] = ch ? kidx : -1;
    if (ch) p.topw()[(size_t)(tb + tq0 + q) * 8 + kidx] = s * __builtin_amdgcn_rcpf(tot) * 2.5f;
    cnt_local += ch ? 1 : 0;
  }
  cntw[w * 64 + lane] = cnt_local;
  __syncthreads();
  if (w == 0) {
    const int tot = cntw[lane] + cntw[64 + lane] + cntw[128 + lane] + cntw[192 + lane];
    int bs = 0;
    if (tot > 0) bs = atomicAdd(p.cnt() + (l * 64 + lane) * CSTRIDE, tot);
    cntw[256 + lane] = bs;
  }
  __syncthreads();
  int base = cntw[256 + lane];
#pragma unroll
  for (int ww = 0; ww < 3; ++ww) base += (ww < w) ? cntw[ww * 64 + lane] : 0;
#pragma unroll 1
  for (int q = 0; q < 8; ++q) {
    const int k = info[q * 64 + lane];
    if (k >= 0) { p.list()[(size_t)lane * LISTCAP + base] = (tb + tq0 + q) * 8 + k; ++base; }
  }
}

struct P9Regs { u32x4 yk[9]; };
DI void p9_load(const P& p, int t, int c0, P9Regs& R) {
  const unsigned char* yr = (const unsigned char*)p.yrows() + (size_t)t * 8 * 1024 + c0;
#pragma unroll
  for (int k = 0; k < 8; ++k) R.yk[k] = *(const u32x4*)(yr + k * 1024);
  R.yk[8] = *(const u32x4*)((const unsigned char*)p.ysh() + (size_t)t * 1024 + c0);
}
DI void p9_finish(const P& p, int l, int t, int c0, const P9Regs& R) {
  const int b = t >> 11;
  const float* md = p.mod() + ((size_t)l * 8 + b) * 6144;
  f32x4 xv[4];
  { const u32x4 xa_ = *(const u32x4*)(p.xb() + (size_t)t * 1024 + c0), xc_ = *(const u32x4*)(p.xb() + (size_t)t * 1024 + c0 + 8); xv[0] = bf4lo(xa_); xv[1] = bf4hi(xa_); xv[2] = bf4lo(xc_); xv[3] = bf4hi(xc_); }
  float r[16];
#pragma unroll
  for (int e = 0; e < 16; ++e) r[e] = 0.f;
#pragma unroll
  for (int k = 0; k < 9; ++k) {
#pragma unroll
    for (int q = 0; q < 4; ++q) {
      const f32x2 lo = __builtin_amdgcn_cvt_pk_f32_fp8((int)R.yk[k][q], false), hi = __builtin_amdgcn_cvt_pk_f32_fp8((int)R.yk[k][q], true);
      r[q * 4 + 0] += lo.x; r[q * 4 + 1] += lo.y; r[q * 4 + 2] += hi.x; r[q * 4 + 3] += hi.y;
    }
  }
  float v[16]; float ss = 0.f;
#pragma unroll
  for (int q = 0; q < 4; ++q) {
    const f32x4 g = *(const f32x4*)(md + 5120 + c0 + q * 4);
#pragma unroll
    for (int e = 0; e < 4; ++e) { v[q * 4 + e] = xv[q][e] + g[e] * (r[q * 4 + e] * (1.f / YSCALE)); ss += v[q * 4 + e] * v[q * 4 + e]; }
  }
  ss = wsum(ss);
  const float rstd = rsqrtf(ss * (1.f / 1024.f) + EPS);
  if (l == 0) {
    const float* md1 = p.mod() + ((size_t)8 + b) * 6144;
    unsigned hw[8];
    *(u32x4*)(p.xb() + (size_t)t * 1024 + c0) = (u32x4){pack2(v[0], v[1]), pack2(v[2], v[3]), pack2(v[4], v[5]), pack2(v[6], v[7])};
    *(u32x4*)(p.xb() + (size_t)t * 1024 + c0 + 8) = (u32x4){pack2(v[8], v[9]), pack2(v[10], v[11]), pack2(v[12], v[13]), pack2(v[14], v[15])};
#pragma unroll
    for (int q = 0; q < 4; ++q) {
      const f32x4 sh = *(const f32x4*)(md1 + c0 + q * 4), sc = *(const f32x4*)(md1 + 1024 + c0 + q * 4);
      hw[q * 2 + 0] = pack2(v[q * 4 + 0] * rstd * (1.f + sc[0]) + sh[0], v[q * 4 + 1] * rstd * (1.f + sc[1]) + sh[1]);
      hw[q * 2 + 1] = pack2(v[q * 4 + 2] * rstd * (1.f + sc[2]) + sh[2], v[q * 4 + 3] * rstd * (1.f + sc[3]) + sh[3]);
    }
    *(u32x4*)(p.h() + (size_t)t * 1024 + c0) = (u32x4){hw[0], hw[1], hw[2], hw[3]};
    *(u32x4*)(p.h() + (size_t)t * 1024 + c0 + 8) = (u32x4){hw[4], hw[5], hw[6], hw[7]};
  } else {
#pragma unroll
    for (int q = 0; q < 4; ++q) {
      const f32x4 fg = *(const f32x4*)(p.final_gain + c0 + q * 4);
      *(f32x4*)(p.out + (size_t)t * 1024 + c0 + q * 4) = (f32x4){v[q * 4 + 0] * rstd * fg[0], v[q * 4 + 1] * rstd * fg[1], v[q * 4 + 2] * rstd * fg[2], v[q * 4 + 3] * rstd * fg[3]};
    }
  }
}
DI void p9_loop(const P& p, int l, int gw, int nw) {
  const int lane = otid() & 63, c0 = lane * 16;
  P9Regs A, B;
  int t = gw;
  if (t >= T_) return;
  p9_load(p, t, c0, A);
  for (; t < T_; t += 2 * nw) {
    const int t1 = t + nw;
    p9_load(p, t1 < T_ ? t1 : t, c0, B);
    p9_finish(p, l, t, c0, A);
    if (t1 >= T_) break;
    const int t2 = t1 + nw;
    p9_load(p, t2 < T_ ? t2 : t1, c0, A);
    p9_finish(p, l, t1, c0, B);
  }
}

DI int xcd_vb(int bid, int G) { return ((G & 7) == 0) ? (bid & 7) * (G >> 3) + (bid >> 3) : bid; }

DI void phase_p1(const P& p, LAS unsigned char* lds, int G, int bid) {
  t8::DenseSched S; S.init(T_, 1280, 1024, G, bid, p.win_t());
  t8::DenseRows RO{2048u};
  bf16_t* proj = p.proj(); float* rsq = p.rsq();
  t8::gemm_phase<true>(lds, (const unsigned char*)p.h(), 2048, S, RO, [=](const f32x4 (&acc)[2][2][4][2], const t8::Unit& u, int wr, int wc, int fr, int fq) {
    const int c0 = u.pn * 256 + wc * 64 + fq * 16;
    const bool want_ss = (u.pn == 3) || (u.pn == 4 && wc < 2);
#pragma unroll
    for (int ai = 0; ai < 2; ++ai)
#pragma unroll
      for (int m = 0; m < 4; ++m) {
        const int r = u.pm * 256 + ai * 128 + wr * 64 + m * 16 + fr;
        if (want_ss) {
          float ss = 0.f;
#pragma unroll
          for (int bj = 0; bj < 2; ++bj)
#pragma unroll
            for (int n = 0; n < 2; ++n) { const f32x4 a = acc[ai][bj][m][n]; ss += a[0] * a[0] + a[1] * a[1] + a[2] * a[2] + a[3] * a[3]; }
          ss += shx(ss, 16); ss += shx(ss, 32);
          if (fq == 0) rsq[(size_t)r * 8 + (u.pn == 3 ? wc : 4 + wc)] = ss;
        }
        if (c0 < NIN) {
#pragma unroll
          for (int bj = 0; bj < 2; ++bj) {
            const f32x4 v0 = acc[ai][bj][m][0], v1 = acc[ai][bj][m][1];
            u32x4 o; o.x = pack2(v0[0], v0[1]); o.y = pack2(v0[2], v0[3]); o.z = pack2(v1[0], v1[1]); o.w = pack2(v1[2], v1[3]);
            *(u32x4*)(proj + (size_t)r * NIN + c0 + bj * 8) = o;
          }
        }
        asm volatile("" ::: "memory");
      }
  });
}

DI void phase_p4(const P& p, LAS unsigned char* lds, int l, int G, int bid) {
  t8::DenseSched S; S.init(T_, 1024, 1024, G, bid, p.wout_t()); S.tstep = (size_t)256 * 1024;
  t8::DenseRows RO{1024u};
  const float* xf = p.x; const bf16_t* xbi = p.xb(); bf16_t* xbo = p.xb();
  const float* mod = p.mod() + (size_t)l * 8 * 6144 + 2048;
  float* rowss = p.rowss();
  t8::gemm_phase<true, true, 0x7A7A7A7A, 0x7C7C7C7C>(lds, (const unsigned char*)p.Y8(), 1024, S, RO, [=](const f32x4 (&acc)[2][2][4][2], const t8::Unit& u, int wr, int wc, int fr, int fq) {
    f32x4 xq[2][4];
    const int cbase = u.pn * 256 + wc * 64 + fq * 16;
    f32x4 gq[4];
#pragma unroll
    for (int q = 0; q < 4; ++q) gq[q] = *(const f32x4*)(mod + (size_t)((u.pm * 256) >> 11) * 6144 + cbase + q * 4);
    auto loadx = [&](int r, f32x4 (&d)[4]) __attribute__((always_inline)) {
      if (l == 0) {
#pragma unroll
        for (int q = 0; q < 4; ++q) d[q] = *(const f32x4*)(xf + (size_t)r * 1024 + cbase + q * 4);
      } else {
        const u32x4 a = *(const u32x4*)(xbi + (size_t)r * 1024 + cbase), c = *(const u32x4*)(xbi + (size_t)r * 1024 + cbase + 8);
        d[0] = bf4lo(a); d[1] = bf4hi(a); d[2] = bf4lo(c); d[3] = bf4hi(c);
      }
    };
    loadx(u.pm * 256 + wr * 64 + fr, xq[0]);
#pragma unroll
    for (int ai = 0; ai < 2; ++ai)
#pragma unroll
      for (int m = 0; m < 4; ++m) {
        const int it = ai * 4 + m;
        const int r = u.pm * 256 + ai * 128 + wr * 64 + m * 16 + fr;
        if (it < 7) loadx(u.pm * 256 + ((it + 1) >> 2) * 128 + wr * 64 + ((it + 1) & 3) * 16 + fr, xq[(it + 1) & 1]);
        float ss = 0.f;
        unsigned ow[8];
#pragma unroll
        for (int bj = 0; bj < 2; ++bj)
#pragma unroll
          for (int n = 0; n < 2; ++n) {
            const f32x4 ov = xq[it & 1][bj * 2 + n] + gq[bj * 2 + n] * acc[ai][bj][m][n];
            ss += ov[0] * ov[0] + ov[1] * ov[1] + ov[2] * ov[2] + ov[3] * ov[3];
            ow[(bj * 2 + n) * 2] = pack2(ov[0], ov[1]); ow[(bj * 2 + n) * 2 + 1] = pack2(ov[2], ov[3]);
          }
        *(u32x4*)(xbo + (size_t)r * 1024 + cbase) = (u32x4){ow[0], ow[1], ow[2], ow[3]};
        *(u32x4*)(xbo + (size_t)r * 1024 + cbase + 8) = (u32x4){ow[4], ow[5], ow[6], ow[7]};
        ss += shx(ss, 16); ss += shx(ss, 32);
        if (fq == 0) rowss[(size_t)r * 16 + u.pn * 4 + wc] = ss;
      }
  });
}

struct RowsP7 { LAS const int* tab; DI unsigned operator()(const t8::Unit& u, int row) const { const int slot = tab[u.tab * 256 + row]; const int tok = slot < 0 ? 0 : (slot >= T_ * 8 ? slot - T_ * 8 : slot >> 3); return (unsigned)tok * 1024u; } };
struct RowsP8 { LAS const int* tab; DI unsigned operator()(const t8::Unit& u, int row) const { const int slot = tab[u.tab * 256 + row]; return (unsigned)(slot < 0 ? 0 : slot) * 256u; } };

DI void phase_p7(const P& p, LAS unsigned char* lds, int l, int G, int bid) {
  int total; const int c = xcd_vb(bid, G);
  moe_prepare(p, lds, l, 2, G, c, total);
  t8::MoeSched S{(LAS const int*)(lds + t8::START_OFF), 2, total, G, c, (const unsigned char*)p.wgu_t(), (const unsigned char*)p.wsg_t(), (size_t)512 * 1024, (size_t)256 * 1024};
  RowsP7 RO{(LAS const int*)(lds + t8::TAB_OFF)};
  LAS const int* tab = (LAS const int*)(lds + t8::TAB_OFF);
  unsigned char* act = (unsigned char*)p.act();
  t8::gemm_phase<true, true>(lds, (const unsigned char*)p.h(), 1024, S, RO, [=](const f32x4 (&acc)[2][2][4][2], const t8::Unit& u, int wr, int wc, int fr, int fq) {
    int slots[2][4];
#pragma unroll
    for (int ai = 0; ai < 2; ++ai)
#pragma unroll
      for (int m = 0; m < 4; ++m) slots[ai][m] = tab[u.tab * 256 + ai * 128 + wr * 64 + m * 16 + fr];
#pragma unroll
    for (int ai = 0; ai < 2; ++ai)
#pragma unroll
      for (int mp = 0; mp < 2; ++mp) {
        u32x2 oa, ob;
        oa.x = pack4_fp8(silu_mul4(acc[ai][0][2 * mp][0], acc[ai][1][2 * mp][0], 4.f));
        oa.y = pack4_fp8(silu_mul4(acc[ai][0][2 * mp][1], acc[ai][1][2 * mp][1], 4.f));
        ob.x = pack4_fp8(silu_mul4(acc[ai][0][2 * mp + 1][0], acc[ai][1][2 * mp + 1][0], 4.f));
        ob.y = pack4_fp8(silu_mul4(acc[ai][0][2 * mp + 1][1], acc[ai][1][2 * mp + 1][1], 4.f));
        const auto sx = __builtin_amdgcn_permlane16_swap(oa.x, ob.x, false, false);
        const auto sy = __builtin_amdgcn_permlane16_swap(oa.y, ob.y, false, false);
        const int slot = (fq & 1) ? slots[ai][2 * mp + 1] : slots[ai][2 * mp];
        if (slot >= 0) *(u32x4*)(act + (size_t)slot * 256 + u.pn * 128 + wc * 32 + (fq >> 1) * 16) = (u32x4){sx[0], sy[0], sx[1], sy[1]};
        asm volatile("" ::: "memory");
      }
  });
}

DI void phase_p8(const P& p, LAS unsigned char* lds, int l, int G, int bid) {
  int total; const int c = xcd_vb(bid, G);
  moe_prepare(p, lds, l, 4, G, c, total, true);
  t8::MoeSched S{(LAS const int*)(lds + t8::START_OFF), 4, total, G, c, (const unsigned char*)p.wd_t(), (const unsigned char*)p.wsd_t(), (size_t)1024 * 256, (size_t)256 * 256};
  RowsP8 RO{(LAS const int*)(lds + t8::TAB_OFF)};
  LAS const int* tab = (LAS const int*)(lds + t8::TAB_OFF);
  unsigned char* yrows = (unsigned char*)p.yrows(); unsigned char* ysh = (unsigned char*)p.ysh();
  t8::gemm_phase<true, true, 0x7B7B7B7B, 0x7D7D7D7D, true>(lds, (const unsigned char*)p.act(), 256, S, RO, [=](const f32x4 (&acc)[2][2][4][2], const t8::Unit& u, int wr, int wc, int fr, int fq) {
    int frl = fr; asm volatile("" : "+v"(frl));
    int slots[2][4];
#pragma unroll
    for (int ai = 0; ai < 2; ++ai)
#pragma unroll
      for (int m = 0; m < 4; ++m) slots[ai][m] = tab[u.tab * 256 + ai * 128 + wr * 64 + m * 16 + frl];
    const int c0 = u.pn * 256 + wc * 64 + fq * 16;
#pragma unroll
    for (int ai = 0; ai < 2; ++ai)
#pragma unroll
      for (int m = 0; m < 4; ++m) {
        const int slot = slots[ai][m];
        if (slot >= 0) {
          const float wv = ((LAS const float*)tab)[(6 + u.tab) * 256 + ai * 128 + wr * 64 + m * 16 + frl];
          unsigned char* dst = (slot >= T_ * 8) ? ysh + (size_t)(slot - T_ * 8) * 1024 + c0 : yrows + (size_t)slot * 1024 + c0;
          u32x4 o;
          o.x = pack4_fp8(acc[ai][0][m][0] * wv); o.y = pack4_fp8(acc[ai][0][m][1] * wv); o.z = pack4_fp8(acc[ai][1][m][0] * wv); o.w = pack4_fp8(acc[ai][1][m][1] * wv);
          *(u32x4*)dst = o;
        }
        asm volatile("" ::: "memory");
      }
  });
}


DI void phase_kvproj(const P& p, LAS unsigned char* lds, int G, int bid) {
  t8::DenseSched S; S.init(T_, 1024, 128, G, bid, p.wukv_t());
  int kbkv = 256; asm volatile("" : "+s"(kbkv));
  t8::DenseRows RO{(unsigned)(NIN * 2)};
  bf16_t* Kb = p.Kb(); bf16_t* V = p.V(); const float* rsq = p.rsq();
  t8::gemm_phase<true>(lds, (const unsigned char*)(p.proj() + 1024), kbkv, S, RO, [=](const f32x4 (&acc)[2][2][4][2], const t8::Unit& u, int wr, int wc, int fr, int fq) {
    const int head = u.pn * 2 + (wc >> 1), d0 = (wc & 1) * 64 + fq * 16;
    f32x2 rq[2][4];
#pragma unroll
    for (int ai = 0; ai < 2; ++ai)
#pragma unroll
      for (int m = 0; m < 4; ++m) rq[ai][m] = *(const f32x2*)(rsq + (size_t)(u.pm * 256 + ai * 128 + wr * 64 + m * 16 + fr) * 8 + 4);
#pragma unroll
    for (int ai = 0; ai < 2; ++ai)
#pragma unroll
      for (int m = 0; m < 4; ++m) {
        const int t = u.pm * 256 + ai * 128 + wr * 64 + m * 16 + fr, b = t >> 11, sq = t & 2047;
        const float rs = rsqrtf((rq[ai][m][0] + rq[ai][m][1]) * (1.f / 128.f) + EPS);
        const size_t rowi = (size_t)((b * 8 + head) * 2048 + sq);
        bf16_t* dst = (d0 < 64) ? Kb + rowi * 96 + d0 : V + rowi * 64 + (d0 - 64);
#pragma unroll
        for (int bj = 0; bj < 2; ++bj) {
          const f32x4 v0 = acc[ai][bj][m][0] * rs, v1 = acc[ai][bj][m][1] * rs;
          u32x4 o; o.x = pack2(v0[0], v0[1]); o.y = pack2(v0[2], v0[3]); o.z = pack2(v1[0], v1[1]); o.w = pack2(v1[2], v1[3]);
          *(u32x4*)(dst + bj * 8) = o;
        }
        asm volatile("" ::: "memory");
      }
  });
}
DI void phase_qproj(const P& p, LAS unsigned char* lds, int G, int bid) {
  t8::DenseSched S; S.init(T_, 768, 256, G, bid, p.wuq_t());
  t8::DenseRows RO{(unsigned)(NIN * 2)};
  bf16_t* Q = p.Q(); const float* rsq = p.rsq();
  const float QS = 0.10206207261596577f * 1.4426950408889634f;
  t8::gemm_phase<true>(lds, (const unsigned char*)(p.proj() + 768), 512, S, RO, [=](const f32x4 (&acc)[2][2][4][2], const t8::Unit& u, int wr, int wc, int fr, int fq) {
    f32x4 pqs[2][4];
#pragma unroll
    for (int ai = 0; ai < 2; ++ai)
#pragma unroll
      for (int m = 0; m < 4; ++m) pqs[ai][m] = *(const f32x4*)(rsq + (size_t)(u.pm * 256 + ai * 128 + wr * 64 + m * 16 + fr) * 8);
    const int c0 = u.pn * 256 + wc * 64 + fq * 16;
    const int head = c0 / 96, d0 = c0 - head * 96;
#pragma unroll
    for (int ai = 0; ai < 2; ++ai)
#pragma unroll
      for (int m = 0; m < 4; ++m) {
        const int t = u.pm * 256 + ai * 128 + wr * 64 + m * 16 + fr, b = t >> 11, sq = t & 2047;
        const f32x4 pq = pqs[ai][m];
        const float rs = rsqrtf(((pq[0] + pq[1]) + (pq[2] + pq[3])) * (1.f / 256.f) + EPS) * QS;
        bf16_t* dst = Q + ((size_t)((b * 8 + head) * 2048 + sq)) * 96 + d0;
#pragma unroll
        for (int bj = 0; bj < 2; ++bj) {
          const f32x4 v0 = acc[ai][bj][m][0] * rs, v1 = acc[ai][bj][m][1] * rs;
          u32x4 o; o.x = pack2(v0[0], v0[1]); o.y = pack2(v0[2], v0[3]); o.z = pack2(v1[0], v1[1]); o.w = pack2(v1[2], v1[3]);
          *(u32x4*)(dst + bj * 8) = o;
        }
        asm volatile("" ::: "memory");
      }
  });
}
DI void item_kpe(const P& p, int item) {
  const int tid = otid();
  const int t = item * 128 + (tid >> 1), half = tid & 1, b = t >> 11, sq = t & 2047;
  const bf16_t* kp = p.proj() + (size_t)t * NIN + 1152 + half * 8;
  const u32x4 a1 = *(const u32x4*)kp, a2 = *(const u32x4*)(kp + 16);
  const float* cp = p.ropec() + (size_t)t * 16 + half * 8; const float* sp = p.ropes() + (size_t)t * 16 + half * 8;
  const f32x4 c0 = *(const f32x4*)cp, c1 = *(const f32x4*)(cp + 4), s0 = *(const f32x4*)sp, s1 = *(const f32x4*)(sp + 4);
  const f32x4 x1a = {bflo(a1.x), bfhi(a1.x), bflo(a1.y), bfhi(a1.y)}, x1b = {bflo(a1.z), bfhi(a1.z), bflo(a1.w), bfhi(a1.w)};
  const f32x4 x2a = {bflo(a2.x), bfhi(a2.x), bflo(a2.y), bfhi(a2.y)}, x2b = {bflo(a2.z), bfhi(a2.z), bflo(a2.w), bfhi(a2.w)};
  const f32x4 y1a = x1a * c0 - x2a * s0, y1b = x1b * c1 - x2b * s1, y2a = x2a * c0 + x1a * s0, y2b = x2b * c1 + x1b * s1;
  u32x4 o1, o2;
  o1.x = pack2(y1a[0], y1a[1]); o1.y = pack2(y1a[2], y1a[3]); o1.z = pack2(y1b[0], y1b[1]); o1.w = pack2(y1b[2], y1b[3]);
  o2.x = pack2(y2a[0], y2a[1]); o2.y = pack2(y2a[2], y2a[3]); o2.z = pack2(y2b[0], y2b[1]); o2.w = pack2(y2b[2], y2b[3]);
#pragma unroll
  for (int head = 0; head < 8; ++head) {
    bf16_t* kd = p.Kb() + ((size_t)((b * 8 + head) * 2048 + sq)) * 96 + 64 + half * 8;
    *(u32x4*)kd = o1; *(u32x4*)(kd + 16) = o2;
  }
}

constexpr int HALF_LDS = SMEM_MAIN + SMEM_EXTRA;
#define PHASE_LOOP(n, ...) for (int base_ = 2 * bid; base_ < (n); base_ += 2 * G) { int it = base_ + half; it = it < (n) ? it : (n) - 1; __VA_ARGS__ }
__global__ void __launch_bounds__(BLOCK_THREADS, 2) fwd_megakernel(P p) {
  const __attribute__((address_space(4))) P* kp_ = (const __attribute__((address_space(4))) P*)__builtin_amdgcn_kernarg_segment_ptr();
  (void)p;
#define LP() ([&]() __attribute__((always_inline)) { const __attribute__((address_space(4))) P* q_ = kp_; asm volatile("" : "+s"(q_)); P r_; __builtin_memcpy(&r_, q_, sizeof(P)); return r_; }())

  __shared__ __attribute__((aligned(16))) unsigned char smem_all[t8::STAGE_BYTES + 16384 + 16 + 256];
  const int G = gridDim.x, bid = blockIdx.x;
  {
    LAS int* wtab = (LAS int*)(smem_all + WTAB_OFF);
    if ((threadIdx.x & 63) == 0) wtab[hw_slot()] = (int)(threadIdx.x >> 6);
    __syncthreads();
  }
  const int half = __builtin_amdgcn_readfirstlane(full_tid() >> 8);
  unsigned char* smem = smem_all + half * HALF_LDS;
  volatile LAS unsigned* stw = (volatile LAS unsigned*)(smem_all + t8::STAGE_BYTES + 16384);
  LAS unsigned char* lds8 = (LAS unsigned char*)smem_all;
  if (full_tid() == 0) { stw[0] = 0u; stw[1] = 0u; }
  __syncthreads();
  XcdBarrier bar = xcd_barrier_post(LP().bar(), stw);

  PHASE_LOOP(384 + 1024 + MISC_ITEMS + CONV_SMALL,
    if (it < 384) item_mod(LP(), smem, it);
    else if (it < 384 + 1024) item_rope(LP(), it - 384);
    else if (it < 384 + 1024 + MISC_ITEMS) item_misc(LP(), it - 384 - 1024);
    else item_conv(LP(), smem, 0, it - 384 - 1024 - MISC_ITEMS);
  )
  wait_mod_ready(LP());
  PHASE_LOOP(T_ / 8, item_norm0(LP(), it);)
  xcd_barrier(bar);

  for (int l = 0; l < 2; ++l) {
    phase_p1(LP(), lds8, G, bid);
    xcd_barrier(bar);
    phase_kvproj(LP(), lds8, G, bid);
    phase_qproj(LP(), lds8, G, bid);
    __syncthreads();
    {
      const int rb = G - 1 - bid;
      if (rb < 64) item_sgu(LP(), smem, l, 2 * rb + half);
      else {
        const int rc = rb - 64;
        item_pool(LP(), smem, l, 2 * rc + half);
        if (rc < 64) item_pool(LP(), smem, l, 384 + 2 * (rc ^ 1) + half);
        else if (rc < 128) item_kpe(LP(), 2 * (rc - 64) + half);
      }
    }
    xcd_barrier(bar);
    if ((bid >> 3) & 1) { conv_big_loop(LP(), smem, l, 2 * bid + half, 2 * G); attn8_unit(LP(), bid & 63, bid >> 6); attn8_unit(LP(), bid & 63, 7 - (bid >> 6)); }
    else { attn8_unit(LP(), bid & 63, bid >> 6); attn8_unit(LP(), bid & 63, 7 - (bid >> 6)); conv_big_loop(LP(), smem, l, 2 * bid + half, 2 * G); }
    xcd_barrier(bar);
    phase_p4(LP(), lds8, l, G, bid);
    xcd_barrier(bar);
    PHASE_LOOP(512 + (l == 0 ? CONV_SMALL : 0), if (it < 512) item_p5(LP(), smem, l, it); else item_conv(LP(), smem, 1, it - 512);)
    xcd_barrier(bar);
    phase_p7(LP(), lds8, l, G, bid);
    xcd_barrier(bar);
    phase_p8(LP(), lds8, l, G, bid);
    xcd_barrier(bar);
    p9_loop(LP(), l, bid * 8 + (full_tid() >> 6), G * 8);
    if (l == 0) xcd_barrier(bar);
  }
}

extern "C" void kernel_launch(void* const* d_in, const int* in_sizes, int n_in, void* d_out, int out_size, void* d_ws, size_t ws_size,
                              hipStream_t stream) {
  P p{};
  p.x = (const float*)d_in[0]; p.c = (const float*)d_in[1]; p.pos = (const int*)d_in[2];
  p.w_ada = (const float*)d_in[3]; p.b_ada = (const float*)d_in[4]; p.w_in = (const float*)d_in[5]; p.w_pool = (const float*)d_in[6];
  p.pool_scale = (const float*)d_in[7]; p.w_spatial = (const float*)d_in[8]; p.b_spatial = (const float*)d_in[9]; p.g_q = (const float*)d_in[10];
  p.w_uq = (const float*)d_in[11]; p.g_kv = (const float*)d_in[12]; p.w_ukv = (const float*)d_in[13]; p.w_out = (const float*)d_in[14];
  p.w_router = (const float*)d_in[15]; p.router_bias = (const float*)d_in[16]; p.w_gate = (const float*)d_in[17]; p.w_up = (const float*)d_in[18];
  p.w_down = (const float*)d_in[19]; p.ws_gate = (const float*)d_in[20]; p.ws_up = (const float*)d_in[21]; p.ws_down = (const float*)d_in[22];
  p.final_gain = (const float*)d_in[23];
  p.out = (float*)d_out;
  p.ws = (unsigned char*)d_ws;
  if (WS_NEED > ws_size) { fprintf(stderr, "workspace too small: need %zu have %zu\n", WS_NEED, ws_size); return; }
  hipMemsetAsync(p.ws + O_BAR, 0, CTRL_BYTES, stream);
  static int grid_blocks = 0;
  if (!grid_blocks) {
    int dev = 0, cus = 0, per_cu = 0;
    hipGetDevice(&dev);
    hipDeviceGetAttribute(&cus, hipDeviceAttributeMultiprocessorCount, dev);
    hipOccupancyMaxActiveBlocksPerMultiprocessor(&per_cu, fwd_megakernel, BLOCK_THREADS, 0);
    if (per_cu > 1) per_cu = 1;
    if (per_cu < 1) per_cu = 1;
    grid_blocks = cus * per_cu;
  }
  void* args[] = {&p};
  hipError_t e = hipLaunchCooperativeKernel((void*)fwd_megakernel, dim3(grid_blocks), dim3(BLOCK_THREADS), args, 0, stream);
  if (e != hipSuccess) fprintf(stderr, "cooperative launch failed: %s (grid %d)\n", hipGetErrorString(e), grid_blocks);
}
```
